# Optimizing an MI355X kernel written in HIP

```python
import jax
import jax.numpy as jnp
from jax import lax
import numpy as np

D_MODEL = 1024
BATCH = 2
SEQ = 16384
DEPTH = 2

GRID_W = 64
CTX_LEN = 256

ML_HEADS = 4
ML_DH = 64
ML_W = ML_HEADS * ML_DH
ML_CHUNK = 64
FT_GROUPS = 4
FT_GC = 64
FT_W = FT_GROUPS * FT_GC
GQ_KV = 2
GQ_G = 4
GQ_HEADS = GQ_KV * GQ_G
GQ_DH = 64
GQ_W = GQ_HEADS * GQ_DH
GQ_BLOCK = 128
ROPE_PAIRS = GQ_DH // 4
ROPE_BASE = 10000.0
GL_HEADS = 4
GL_DK = 64
GL_DV = 64
GL_W = GL_HEADS * GL_DV
GL_RANK = 16
GL_TAU = 16.0
GL_CHUNK = 64
FF_DENSE = 2816
N_EXPERTS = 8
TOP_K = 2
FF_EXPERT = 1408

N_BRANCH = 4
BRANCH_WIDTHS = (ML_W, FT_W, GQ_W, GL_W)
MIX_W = ML_W + FT_W + GQ_W + GL_W
N_ADA = 6
LN_EPS = 1e-6
DEEPNORM_ALPHA = (2.0 * DEPTH) ** 0.25
DEEPNORM_BETA = (8.0 * DEPTH) ** -0.25

IN_COLS = (
    ('ml_q', ML_W), ('ml_k', ML_W), ('ml_v', ML_W), ('ml_o', ML_W),
    ('ml_if', ML_HEADS), ('ml_ff', ML_HEADS), ('ml_ib', ML_HEADS), ('ml_fb', ML_HEADS),
    ('ft', FT_W),
    ('gq_q', GQ_W), ('gq_k', GQ_KV * GQ_DH), ('gq_v', GQ_KV * GQ_DH),
    ('gl_q', GL_HEADS * GL_DK), ('gl_k', GL_HEADS * GL_DK), ('gl_v', GL_HEADS * GL_DV), ('gl_r', GL_W),
    ('gl_af', GL_RANK), ('gl_ab', GL_RANK),
)
N_IN = sum(w for _, w in IN_COLS)

kernel_name = 'hybrid_diffusion_mlstm_fnet_gqa_gla_moe'

F32 = jnp.float32


def _layernorm(x):
    xf = x.astype(F32)
    xc = xf - jnp.mean(xf, axis=-1, keepdims=True)
    var = jnp.mean(xc * xc, axis=-1, keepdims=True)
    return (xc * lax.rsqrt(var + LN_EPS)).astype(x.dtype)


def _rms(x):
    xf = x.astype(F32)
    return (xf * lax.rsqrt(jnp.mean(xf * xf, axis=-1, keepdims=True) + LN_EPS)).astype(x.dtype)


def _modulate(x, shift, scale):
    return _layernorm(x) * (1.0 + scale) + shift


def _post_ln(x, g, b):
    return _layernorm(x) * g + b


def _split_cols(p):
    out = {}
    off = 0
    for name, w in IN_COLS:
        out[name] = p[..., off:off + w]
        off += w
    return out


def _heads(a, n):
    b_, t, w = a.shape
    return a.reshape(b_, t, n, w // n).transpose(0, 2, 1, 3)


def _merge_heads(a):
    b_, n, t, d = a.shape
    return a.transpose(0, 2, 1, 3).reshape(b_, t, n * d)


def _to_chunks(a, size):
    nc = a.shape[2] // size
    a = a.reshape(a.shape[:2] + (nc, size) + a.shape[3:])
    return jnp.moveaxis(a, 2, 0)


def _from_chunks(a):
    a = jnp.moveaxis(a, 0, 2)
    return a.reshape(a.shape[:2] + (a.shape[2] * a.shape[3],) + a.shape[4:])


def _flip(a):
    return jnp.flip(a, axis=2)


def _mlstm_scan(q, k, v, li, lf, state):
    size = ML_CHUNK
    causal = jnp.tril(jnp.ones((size, size), dtype=bool))

    def step(carry, inp):
        cmat, nvec, m = carry
        qc, kc, vc, ic, fc = inp
        b = jnp.cumsum(fc, axis=-1)
        d = jnp.where(causal, b[..., :, None] - b[..., None, :] + ic[..., None, :], -jnp.inf)
        inter = b + m[..., None]
        m_t = jnp.maximum(inter, jnp.max(d, axis=-1))
        w_intra = jnp.exp(d - m_t[..., None]) * jnp.einsum('bhtd,bhsd->bhts', qc, kc)
        w_inter = jnp.exp(inter - m_t)
        num = (jnp.einsum('bhts,bhsd->bhtd', w_intra, vc)
               + w_inter[..., None] * jnp.einsum('bhvk,bhtk->bhtv', cmat, qc))
        den = jnp.sum(w_intra, axis=-1) + w_inter * jnp.einsum('bhk,bhtk->bht', nvec, qc)
        h = num / jnp.maximum(jnp.abs(den), jnp.exp(-m_t))[..., None]
        b_last = b[..., -1]
        g = b_last[..., None] - b + ic
        m_new = jnp.maximum(b_last + m, jnp.max(g, axis=-1))
        ws = jnp.exp(g - m_new[..., None])
        wc = jnp.exp(b_last + m - m_new)
        cmat = wc[..., None, None] * cmat + jnp.einsum('bhs,bhsv,bhsk->bhvk', ws, vc, kc)
        nvec = wc[..., None] * nvec + jnp.einsum('bhs,bhsk->bhk', ws, kc)
        return (cmat, nvec, m_new), h

    xs = (_to_chunks(q, size), _to_chunks(k, size), _to_chunks(v, size),
          _to_chunks(li, size), _to_chunks(lf, size))
    state, h = lax.scan(step, state, xs)
    return _from_chunks(h), state


def _mlstm_zero(b_):
    return (jnp.zeros((b_, ML_HEADS, ML_DH, ML_DH), F32), jnp.zeros((b_, ML_HEADS, ML_DH), F32),
            jnp.zeros((b_, ML_HEADS), F32))


def _mlstm_stream(cols, gate_b, init_f, init_b):
    q = _heads(cols['ml_q'], ML_HEADS).astype(F32)
    k = _heads(cols['ml_k'], ML_HEADS).astype(F32) * (ML_DH ** -0.5)
    v = _heads(cols['ml_v'], ML_HEADS).astype(F32)

    def gate(name, j):
        return jnp.swapaxes(cols[name].astype(F32) + gate_b[j].astype(F32), 1, 2)

    li_f, lf_f = gate('ml_if', 0), jax.nn.log_sigmoid(gate('ml_ff', 1))
    li_b, lf_b = gate('ml_ib', 2), jax.nn.log_sigmoid(gate('ml_fb', 3))
    h_f, st_f = _mlstm_scan(q, k, v, li_f, lf_f, init_f)
    h_b, st_b = _mlstm_scan(_flip(q), _flip(k), _flip(v), _flip(li_b), _flip(lf_b), init_b)
    return h_f + _flip(h_b), st_f, st_b


def _mlstm_finish(h, o_pre, norm_g):
    hn = _merge_heads(_layernorm(h)) * norm_g.astype(F32)
    return hn.astype(o_pre.dtype) * jax.nn.sigmoid(o_pre)


def _fourier(u):
    b_, t, _ = u.shape
    ug = u.astype(F32).reshape(b_, t, FT_GROUPS, FT_GC)
    y = jnp.fft.fft2(ug, axes=(1, 3), norm='ortho').real
    return y.reshape(b_, t, FT_W).astype(u.dtype)


def _rope_tables(rows, dtype):
    row = jnp.repeat(jnp.arange(rows, dtype=F32), GRID_W)
    col = jnp.tile(jnp.arange(GRID_W, dtype=F32), rows)
    inv = jnp.power(ROPE_BASE, -jnp.arange(ROPE_PAIRS, dtype=F32) / ROPE_PAIRS)
    ang = jnp.stack([row[:, None] * inv, col[:, None] * inv], axis=1)
    return jnp.cos(ang).astype(dtype), jnp.sin(ang).astype(dtype)


def _rope(x, cos, sin):
    xs = x.reshape(x.shape[:-1] + (2, 2, ROPE_PAIRS))
    x1, x2 = xs[..., 0, :], xs[..., 1, :]
    out = jnp.stack([x1 * cos - x2 * sin, x1 * sin + x2 * cos], axis=-2)
    return out.reshape(x.shape)


def _gqa_q(cols, g):
    b_, t, _ = cols['gq_q'].shape
    q = cols['gq_q'].reshape(b_, t, GQ_KV, GQ_G, GQ_DH).transpose(0, 2, 3, 1, 4)
    return _rms(q) * g


def _gqa_kv(cols, g):
    return _rms(_heads(cols['gq_k'], GQ_KV)) * g, _heads(cols['gq_v'], GQ_KV)


def _gqa_attend(q, k, v):
    b_, kv, g, t, dh = q.shape
    nb = t // GQ_BLOCK
    qb = jnp.moveaxis(q.reshape(b_, kv, g, nb, GQ_BLOCK, dh), 3, 0)

    def attend(qblk):
        s = jnp.einsum('bkgqd,bksd->bkgqs', qblk, k).astype(F32) * (GQ_DH ** -0.5)
        p = jax.nn.softmax(s, axis=-1).astype(v.dtype)
        return jnp.einsum('bkgqs,bksd->bkgqd', p, v)

    o = jnp.moveaxis(lax.map(attend, qb), 0, 3).reshape(b_, kv, g, t, dh)
    return o.transpose(0, 3, 1, 2, 4).reshape(b_, t, kv * g * dh)


def _gla_scan(q, k, v, la, s0):
    size = GL_CHUNK
    causal = jnp.tril(jnp.ones((size, size), dtype=bool))[:, :, None]

    def step(s, inp):
        qc, kc, vc, ac = inp
        g = jnp.cumsum(ac, axis=2)
        diff = jnp.where(causal, g[:, :, :, None, :] - g[:, :, None, :, :], -jnp.inf)
        a = jnp.einsum('bhtk,bhsk,bhtsk->bhts', qc, kc, jnp.exp(diff))
        o = (jnp.einsum('bhts,bhsv->bhtv', a, vc)
             + jnp.einsum('bhtk,bhkv->bhtv', qc * jnp.exp(g), s))
        g_last = g[:, :, -1:, :]
        s = (jnp.exp(g_last[:, :, 0, :])[..., None] * s
             + jnp.einsum('bhsk,bhsv->bhkv', kc * jnp.exp(g_last - g), vc))
        return s, o

    xs = (_to_chunks(q, size), _to_chunks(k, size), _to_chunks(v, size), _to_chunks(la, size))
    s, o = lax.scan(step, s0, xs)
    return _from_chunks(o), s


def _gla_zero(b_):
    return jnp.zeros((b_, GL_HEADS, GL_DK, GL_DV), F32)


def _gla_stream(cols, w2, b2, init_f, init_b):
    q = _heads(cols['gl_q'], GL_HEADS).astype(F32) * (GL_DK ** -0.5)
    k = _heads(cols['gl_k'], GL_HEADS).astype(F32)
    v = _heads(cols['gl_v'], GL_HEADS).astype(F32)

    def log_decay(name, j):
        a = (cols[name] @ w2[j] + b2[j]).astype(F32)
        return _heads(jax.nn.log_sigmoid(a) / GL_TAU, GL_HEADS)

    o_f, s_f = _gla_scan(q, k, v, log_decay('gl_af', 0), init_f)
    o_b, s_b = _gla_scan(_flip(q), _flip(k), _flip(v), _flip(log_decay('gl_ab', 1)), init_b)
    return o_f + _flip(o_b), s_f, s_b


def _gla_finish(o, r_pre, norm_g):
    on = _merge_heads(_rms(o)) * norm_g.astype(F32)
    return on.astype(r_pre.dtype) * jax.nn.silu(r_pre)


def _merge_branches(h, branches, w_branch, w_gate, b_gate, w_out):
    gates = jax.nn.sigmoid(h @ w_gate + b_gate)
    mixed = None
    off = 0
    for j, br in enumerate(branches):
        wd = br.shape[-1]
        u = gates[..., j * D_MODEL:(j + 1) * D_MODEL] * (br @ w_branch[off:off + wd])
        mixed = u if mixed is None else mixed + u
        off += wd
    return mixed @ w_out


def _swiglu(x, wg, wu, wd):
    return (jax.nn.silu(x @ wg) * (x @ wu)) @ wd


def _moe(x, wr, br, wg, wu, wd):
    logits = (x @ wr).astype(F32)
    _, idx = lax.top_k(logits + br.astype(F32), TOP_K)
    w = jax.nn.softmax(jnp.take_along_axis(logits, idx, axis=-1), axis=-1)
    dense = jnp.sum(jax.nn.one_hot(idx, N_EXPERTS, dtype=F32) * w[..., None], axis=-2).astype(x.dtype)
    out = dense[..., 0:1] * _swiglu(x, wg[0], wu[0], wd[0])
    for e in range(1, N_EXPERTS):
        out = out + dense[..., e:e + 1] * _swiglu(x, wg[e], wu[e], wd[e])
    return out


def setup_inputs(seed: int = 0) -> dict:
    key = jax.random.key(seed)
    keys = iter(jax.random.split(key, 48))

    def nrm(shape, scale):
        return jax.random.normal(next(keys), shape, jnp.float32) * scale

    d = D_MODEL
    nl = DEPTH
    n_dense = (DEPTH + 1) // 2
    n_moe = DEPTH // 2
    f_bias = jnp.linspace(3.0, 6.0, ML_HEADS, dtype=jnp.float32)
    z_bias = jnp.zeros((ML_HEADS,), jnp.float32)
    gate_base = jnp.stack([z_bias, f_bias, z_bias, f_bias])
    w_branch = jnp.concatenate([nrm((nl, w, d), w ** -0.5) for w in BRANCH_WIDTHS], axis=1)
    return {
        'x': nrm((BATCH, SEQ, d), 1.0),
        'c': nrm((BATCH, d), 1.0),
        'ctx': nrm((BATCH, CTX_LEN, d), 1.0),
        'c_ctx': nrm((d,), 1.0),
        'w_ada': nrm((nl, d, N_ADA * d), 0.5 * d ** -0.5),
        'b_ada': nrm((nl, N_ADA * d), 0.01),
        'w_in': nrm((nl, d, N_IN), d ** -0.5),
        'ml_gate_b': gate_base + nrm((nl, 4, ML_HEADS), 0.1),
        'ml_norm_g': 1.0 + nrm((nl, ML_W), 0.02),
        'gq_qnorm_g': 1.0 + nrm((nl, GQ_DH), 0.02),
        'gq_knorm_g': 1.0 + nrm((nl, GQ_DH), 0.02),
        'gl_w2': nrm((nl, 2, GL_RANK, GL_HEADS * GL_DK), GL_RANK ** -0.5),
        'gl_b2': nrm((nl, 2, GL_HEADS * GL_DK), 0.1),
        'gl_norm_g': 1.0 + nrm((nl, GL_W), 0.02),
        'w_branch': w_branch,
        'w_gate': nrm((nl, d, N_BRANCH * d), d ** -0.5),
        'b_gate': nrm((nl, N_BRANCH * d), 0.01),
        'w_out': nrm((nl, d, d), DEEPNORM_BETA * d ** -0.5),
        'ln1_g': 1.0 + nrm((nl, d), 0.02),
        'ln1_b': nrm((nl, d), 0.01),
        'ln2_g': 1.0 + nrm((nl, d), 0.02),
        'ln2_b': nrm((nl, d), 0.01),
        'ffd_wg': nrm((n_dense, d, FF_DENSE), d ** -0.5),
        'ffd_wu': nrm((n_dense, d, FF_DENSE), d ** -0.5),
        'ffd_wd': nrm((n_dense, FF_DENSE, d), DEEPNORM_BETA * FF_DENSE ** -0.5),
        'moe_wr': nrm((n_moe, d, N_EXPERTS), d ** -0.5),
        'moe_br': nrm((n_moe, N_EXPERTS), 0.01),
        'moe_wg': nrm((n_moe, N_EXPERTS, d, FF_EXPERT), d ** -0.5),
        'moe_wu': nrm((n_moe, N_EXPERTS, d, FF_EXPERT), d ** -0.5),
        'moe_wd': nrm((n_moe, N_EXPERTS, FF_EXPERT, d), DEEPNORM_BETA * FF_EXPERT ** -0.5),
    }


def reference(x, c, ctx, c_ctx, w_ada, b_ada, w_in, ml_gate_b, ml_norm_g, gq_qnorm_g, gq_knorm_g,
              gl_w2, gl_b2, gl_norm_g, w_branch, w_gate, b_gate, w_out, ln1_g, ln1_b, ln2_g, ln2_b,
              ffd_wg, ffd_wu, ffd_wd, moe_wr, moe_br, moe_wg, moe_wu, moe_wd):
    b_ = x.shape[0]
    rows = x.shape[1] // GRID_W
    cos, sin = _rope_tables(rows, x.dtype)
    alpha = DEEPNORM_ALPHA
    xc = ctx
    for l in range(DEPTH):
        last = l == DEPTH - 1
        ada = (jax.nn.silu(c) @ w_ada[l] + b_ada[l]).reshape(b_, N_ADA, 1, D_MODEL)
        ada_c = (jax.nn.silu(c_ctx) @ w_ada[l] + b_ada[l]).reshape(N_ADA, 1, D_MODEL)

        h = _modulate(x, ada[:, 0], ada[:, 1])
        hc = _modulate(xc, ada_c[0], ada_c[1])
        pl = _split_cols(h @ w_in[l])
        pc = _split_cols(hc @ w_in[l])

        ml_c, ml_sf, ml_sb = _mlstm_stream(pc, ml_gate_b[l], _mlstm_zero(b_), _mlstm_zero(b_))
        gl_c, gl_sf, gl_sb = _gla_stream(pc, gl_w2[l], gl_b2[l], _gla_zero(b_), _gla_zero(b_))
        k_c, v_c = _gqa_kv(pc, gq_knorm_g[l])

        ml_l, _, _ = _mlstm_stream(pl, ml_gate_b[l], ml_sf, ml_sb)
        gl_l, _, _ = _gla_stream(pl, gl_w2[l], gl_b2[l], gl_sf, gl_sb)
        k_l, v_l = _gqa_kv(pl, gq_knorm_g[l])
        q_l = _rope(_gqa_q(pl, gq_qnorm_g[l]), cos, sin)
        att_l = _gqa_attend(q_l, jnp.concatenate([_rope(k_l, cos, sin), k_c], axis=2),
                            jnp.concatenate([v_l, v_c], axis=2))
        br_l = [_mlstm_finish(ml_l, pl['ml_o'], ml_norm_g[l]), _fourier(pl['ft']), att_l,
                _gla_finish(gl_l, pl['gl_r'], gl_norm_g[l])]
        y = _merge_branches(h, br_l, w_branch[l], w_gate[l], b_gate[l], w_out[l])
        x_mid = _post_ln(alpha * x + ada[:, 2] * y, ln1_g[l], ln1_b[l])

        if not last:
            att_c = _gqa_attend(_gqa_q(pc, gq_qnorm_g[l]), k_c, v_c)
            br_c = [_mlstm_finish(ml_c, pc['ml_o'], ml_norm_g[l]), _fourier(pc['ft']), att_c,
                    _gla_finish(gl_c, pc['gl_r'], gl_norm_g[l])]
            yc = _merge_branches(hc, br_c, w_branch[l], w_gate[l], b_gate[l], w_out[l])
            xc = _post_ln(alpha * xc + ada_c[2] * yc, ln1_g[l], ln1_b[l])

        h2 = _modulate(x_mid, ada[:, 3], ada[:, 4])
        if l % 2 == 0:
            j = l // 2
            f = _swiglu(h2, ffd_wg[j], ffd_wu[j], ffd_wd[j])
            if not last:
                h2c = _modulate(xc, ada_c[3], ada_c[4])
                fc = _swiglu(h2c, ffd_wg[j], ffd_wu[j], ffd_wd[j])
                xc = _post_ln(alpha * xc + ada_c[5] * fc, ln2_g[l], ln2_b[l])
        else:
            j = l // 2
            f = _moe(h2, moe_wr[j], moe_br[j], moe_wg[j], moe_wu[j], moe_wd[j])
            if not last:
                h2c = _modulate(xc, ada_c[3], ada_c[4])
                fc = _moe(h2c, moe_wr[j], moe_br[j], moe_wg[j], moe_wu[j], moe_wd[j])
                xc = _post_ln(alpha * xc + ada_c[5] * fc, ln2_g[l], ln2_b[l])
        x = _post_ln(alpha * x_mid + ada[:, 5] * f, ln2_g[l], ln2_b[l])
    return x
```

```cpp
#include <hip/hip_runtime.h>
#include <hip/hip_bf16.h>
#include <cstdio>
#include <cstdint>

#ifndef MK_N_LAUNCHES
#define MK_N_LAUNCHES 1
#endif
#ifndef DBG_LEVEL
#define DBG_LEVEL 99
#endif

#define GAS __attribute__((address_space(1)))
#define LAS __attribute__((address_space(3)))
typedef unsigned short bf16;
typedef unsigned v4u __attribute__((ext_vector_type(4)));
typedef unsigned v2u __attribute__((ext_vector_type(2)));
typedef float f32x4 __attribute__((ext_vector_type(4)));
typedef float f32x2 __attribute__((ext_vector_type(2)));
typedef short bf16x8 __attribute__((ext_vector_type(8)));
typedef float f32x16 __attribute__((ext_vector_type(16)));
typedef GAS unsigned gu32;
#define RLX_AGENT __ATOMIC_RELAXED, __HIP_MEMORY_SCOPE_AGENT
#define LDS_WAIT() asm volatile("s_waitcnt lgkmcnt(0)" ::: "memory")
#define VM_WAIT() asm volatile("s_waitcnt vmcnt(0)" ::: "memory")

constexpr int D = 1024, NB = 2, T = 16384, CTX = 256;
constexpr int RL = NB * T;
constexpr int R = RL + NB * CTX;
constexpr int NPAN = R / 256, NPAN_L = RL / 256;
constexpr int NIN = 3120;
constexpr int NP = 3072;
constexpr int TC_MLQ = 0, TC_MLK = 256, TC_MLV = 512, TC_MLO = 768, TC_FT = 1024, TC_GQQ = 1280, TC_GQK = 1792, TC_GQV = 1920,
              TC_GLQ = 2048, TC_GLK = 2304, TC_GLV = 2560, TC_GLR = 2816;
constexpr int SMP = 64;
constexpr int FFD = 2816, NEXP = 8, FFE = 1408;
constexpr float LN_EPS = 1e-6f;
constexpr float ALPHA = 1.4142135623730951f;
constexpr int NCH = 260;
constexpr int NCHAIN = 16;
constexpr float C2Q = 0.125f * 1.4426950408889634f;

constexpr size_t MiB = 1u << 20;
constexpr size_t WS_CTL = 0, CTL_ZERO_BYTES = 128 * 1024;
constexpr size_t WS_ADA = 1 * MiB;
constexpr size_t WS_TAB = WS_ADA + 256 * 1024;
constexpr size_t WS_ROPE_C = WS_TAB, WS_ROPE_S = WS_TAB + 16384, WS_DFT_C = WS_TAB + 32768, WS_DFT_S = WS_DFT_C + 32768;
constexpr size_t WS_MOE = 2 * MiB;
constexpr size_t WS_XC = 4 * MiB;
constexpr size_t WS_SM = 6 * MiB;
constexpr size_t WS_SCAL = 15 * MiB;
constexpr size_t WS_W = 20 * MiB;
constexpr size_t W_IN = 0, W_GATE = W_IN + (size_t)3328 * 1024 * 2, W_OUT = W_GATE + (size_t)4096 * 1024 * 2,
                 W_BML = W_OUT + (size_t)1024 * 1024 * 2, W_BFT = W_BML + (size_t)1024 * 256 * 2, W_BAT = W_BFT + (size_t)1024 * 512 * 2,
                 W_BGL = W_BAT + (size_t)1024 * 512 * 2, W_FFN = W_BGL + (size_t)1024 * 256 * 2;
constexpr size_t W_FFD_GU = W_FFN, W_FFD_D = W_FFN + (size_t)5632 * 1024 * 2;
constexpr size_t W_MOE_GU = W_FFN, W_MOE_D = W_FFN + (size_t)8 * 2816 * 1024 * 2;
constexpr size_t W_END = W_MOE_D + (size_t)8 * 1024 * 1408 * 2;
static_assert(W_END <= 86 * MiB, "weights region");
constexpr size_t WS_H = 106 * MiB;
constexpr size_t WS_P = 172 * MiB;
constexpr size_t WS_XM = 368 * MiB;
constexpr size_t WS_UQ = 498 * MiB;
constexpr size_t WS_PA = 502 * MiB;
constexpr size_t WS_DP = 506 * MiB;
constexpr size_t WS_END = 510 * MiB;
static_assert(WS_H + (size_t)R * 1024 * 2 <= WS_P && WS_P + (size_t)R * NP * 2 <= WS_XM && WS_XM + (size_t)R * 1024 * 4 <= WS_END, "ws map");
constexpr size_t XO_MLC = 0;
constexpr size_t XO_GLS = 33 * MiB;
constexpr size_t XO_MIX = 0;
constexpr size_t XO_IM1 = 68 * MiB;
constexpr size_t XO_GST = 65 * MiB;
constexpr size_t XO_FT = 97 * MiB + 512 * 1024;
static_assert(XO_FT + (size_t)R * 512 * 2 <= (size_t)R * 1024 * 4 && XO_GST + 32 * MiB <= XO_FT && XO_IM1 + 16 * MiB <= XO_FT && XO_GLS + 33 * MiB <= XO_IM1, "XM overlays");
constexpr size_t SC_MLN = 0;
constexpr size_t SC_MLA = SC_MLN + (size_t)16 * 260 * 64 * 4;
constexpr size_t SC_MLB = SC_MLA + 16 * 260 * 4;
constexpr size_t SC_MLM = SC_MLB + 16 * 260 * 4;
constexpr size_t SC_GLD = SC_MLM + 16 * 260 * 4;
static_assert(SC_GLD + (size_t)16 * 260 * 64 * 4 <= 5 * MiB, "scal");
constexpr int MOE_MAXT = 264;
constexpr size_t MO_TOK = 0;
constexpr size_t MO_DST = MO_TOK + (size_t)MOE_MAXT * 256 * 4;
constexpr size_t MO_SEL = MO_DST + (size_t)MOE_MAXT * 256 * 4;
static_assert(MO_SEL + (size_t)RL * 16 <= 2 * MiB, "moe tables");
constexpr int CW_TMO = 0, CW_CODE = 1, CW_BAR = 4096, CW_MOECNT = 16384  , CW_MOECUR = 16384 + 8 * 64;
static_assert((CW_MOECUR + 8 * 64) * 4 <= (int)CTL_ZERO_BYTES && (CW_BAR + 3456) * 4 <= (int)CTL_ZERO_BYTES, "control words inside the per-call memset");
#define XB_TMO      128
#define XB_XCNT(j)  (256  + 64 * (j))
#define XB_XSUB(j)  (1280 + 64 * (j))
#define XB_XGEN(j)  (2304 + 64 * (j))
#define XB_TOP      3328
#define XB_TOPGEN   3392
#define XCD_BAR_WORDS 3456
#define XB_SPIN_CAP (1u << 18)

constexpr int RING_BYTES = 131072, LDSCTL_OFF = RING_BYTES, MISC_OFF = LDSCTL_OFF + 320, LDS_BYTES = 147456;
constexpr int NWAVES = 8;

template <class T_> __device__ __forceinline__ T_* opq(T_* p) { asm volatile("" : "+s"(p)); return p; }
__device__ __forceinline__ int opq_s(int v) { asm volatile("" : "+s"(v)); return v; }
__device__ __forceinline__ int opq_v(int v) { asm volatile("" : "+v"(v)); return v; }
__device__ __forceinline__ unsigned f2bf(float f) { unsigned u = __builtin_bit_cast(unsigned, f); return (u + 0x7fffu + ((u >> 16) & 1u)) >> 16; }
typedef __bf16 hwbf16x2 __attribute__((ext_vector_type(2)));
__device__ __forceinline__ unsigned pk2(float lo, float hi) { const f32x2 v = {lo, hi}; return __builtin_bit_cast(unsigned, __builtin_convertvector(v, hwbf16x2)); }
__device__ __forceinline__ float bflo(unsigned w) { return __uint_as_float(w << 16); }
__device__ __forceinline__ float bfhi(unsigned w) { return __uint_as_float(w & 0xffff0000u); }
__device__ __forceinline__ float bf2f(bf16 b) { return __uint_as_float((unsigned)b << 16); }
__device__ __forceinline__ void unpack8(const v4u a, float (&x)[8]) { x[0] = bflo(a.x); x[1] = bfhi(a.x); x[2] = bflo(a.y); x[3] = bfhi(a.y); x[4] = bflo(a.z); x[5] = bfhi(a.z); x[6] = bflo(a.w); x[7] = bfhi(a.w); }
__device__ __forceinline__ v4u pack8(const float (&x)[8]) { v4u w; w.x = pk2(x[0], x[1]); w.y = pk2(x[2], x[3]); w.z = pk2(x[4], x[5]); w.w = pk2(x[6], x[7]); return w; }
__device__ __forceinline__ float wave_sum(float v) {
#pragma unroll
    for (int o = 1; o < 64; o <<= 1) v += __shfl_xor(v, o);
    return v;
}
__device__ __forceinline__ float sigm(float x) { return __builtin_amdgcn_rcpf(1.f + __expf(-x)); }
__device__ __forceinline__ float logsig(float a) { return fminf(a, 0.f) - __logf(1.f + __expf(-fabsf(a))); }

__device__ __forceinline__ unsigned xb_ld(unsigned* p)              { return __hip_atomic_load(p, __ATOMIC_RELAXED, __HIP_MEMORY_SCOPE_AGENT); }
__device__ __forceinline__ unsigned xb_add(unsigned* p, unsigned v) { return __hip_atomic_fetch_add(p, v, __ATOMIC_RELAXED, __HIP_MEMORY_SCOPE_AGENT); }
__device__ __forceinline__ unsigned xb_xcc_id() { return (unsigned)__builtin_amdgcn_s_getreg((3 << 11) | 20) & 0xFu; }
#define XB_SPIN(cond, bar) do { unsigned _sp = 0; while (cond) { __builtin_amdgcn_s_sleep(1); \
    if ((++_sp & 255u) == 0u) { if (xb_ld(&(bar)[XB_TMO])) break; if (_sp > XB_SPIN_CAP) { atomicAdd(&(bar)[XB_TMO], 1u); break; } } } } while (0)
struct XcdBarrier { unsigned* bar; unsigned x; volatile LAS unsigned* st; };
__device__ __forceinline__ XcdBarrier xcd_barrier_post(unsigned* bar, volatile LAS unsigned* st) {
    XcdBarrier b; b.bar = bar; b.x = xb_xcc_id(); b.st = st;
    if (threadIdx.x == 0) (void)xb_add(&bar[XB_XCNT(b.x)], 1u);
    return b;
}
__device__ __forceinline__ void xcd_barrier_complete(unsigned* bar, unsigned x, unsigned& nloc, unsigned& nx) {
    const unsigned G = gridDim.x * gridDim.y * gridDim.z;
    unsigned sum, cnt, mine, sp = 0u;
    for (;;) {
        sum = 0u; cnt = 0u; mine = 0u;
#pragma unroll
        for (unsigned j = 0; j < 16; ++j) { const unsigned c = xb_ld(&bar[XB_XCNT(j)]); sum += c; cnt += (c > 0u) ? 1u : 0u; mine = (j == x) ? c : mine; }
        if (sum == G) break;
        __builtin_amdgcn_s_sleep(1);
        if ((++sp & 255u) == 0u) { if (xb_ld(&bar[XB_TMO])) break; if (sp > XB_SPIN_CAP) { atomicAdd(&bar[XB_TMO], 1u); break; } }
    }
    nloc = mine > 0u ? mine : 1u; nx = cnt > 0u ? cnt : 1u;
}
__device__ __forceinline__ void xcd_barrier(const XcdBarrier& b) {
    asm volatile("s_waitcnt vmcnt(0)" ::: "memory");
    __syncthreads();
    if (threadIdx.x == 0) {
        unsigned* bar = b.bar;
        __builtin_amdgcn_s_waitcnt(0);
        unsigned nloc = b.st[0], nx = b.st[1];
        if (nloc == 0u) { xcd_barrier_complete(bar, b.x, nloc, nx); b.st[0] = nloc; b.st[1] = nx; }
        const unsigned old = xb_add(&bar[XB_XSUB(b.x)], 1u);
        const unsigned gen = old / nloc;
        if (old + 1u == (gen + 1u) * nloc) {
            __builtin_amdgcn_fence(__ATOMIC_RELEASE, "agent");
            asm volatile("s_waitcnt vmcnt(0)" ::: "memory");
            const unsigned og = xb_add(&bar[XB_TOP], 1u);
            const unsigned tg = og / nx;
            if (og + 1u == (tg + 1u) * nx) xb_add(&bar[XB_TOPGEN], 1u);
            else XB_SPIN(xb_ld(&bar[XB_TOPGEN]) == tg, bar);
            __builtin_amdgcn_fence(__ATOMIC_ACQUIRE, "agent");
            xb_add(&bar[XB_XGEN(b.x)], 1u);
            asm volatile("s_waitcnt vmcnt(0)" ::: "memory");
        } else {
            XB_SPIN(xb_ld(&bar[XB_XGEN(b.x)]) == gen, bar);
            __builtin_amdgcn_fence(__ATOMIC_ACQUIRE, "agent");
            asm volatile("s_waitcnt vmcnt(0)" ::: "memory");
        }
    }
    __syncthreads();
}
namespace pg8 {
constexpr int BM = 256, BK = 64, HALF = 128, HTB = HALF * BK * 2, STAGE_BYTES = 8 * HTB, NXCD = 8, WGM = 8;
__host__ __device__ __forceinline__ int lds_byte(int r, int c) { const int st = (r >> 4) * 2 + (c >> 5), rr = r & 15, cc = c & 31, ob = rr * 64 + cc * 2; return st * 1024 + (ob ^ (((ob >> 9) & 1) << 5)); }
__host__ __device__ __forceinline__ void stage_rc(int b, int& R_, int& C_) { const int st = b / 1024, sb = b % 1024, swz = sb ^ (((sb >> 9) & 1) << 5); R_ = (st >> 1) * 16 + swz / 64; C_ = (st & 1) * 32 + (swz % 64) / 2; }
__host__ __device__ __forceinline__ int perm32(int rho) { const int n = rho >> 4, i = rho & 15; return 8 * (i >> 2) + 4 * n + (i & 3); }
struct GU { unsigned ao, bo; unsigned lda, ldb; int nt; int pm, pn, kind, aux; };
__device__ __forceinline__ bool tile_of(long L, int nM, int nN, int& pm, int& pn) {
    const int nwg = nM * nN; if (L >= nwg) return false;
    int wgid = (int)L; { const int q = nwg / NXCD, r = nwg % NXCD, xcd = wgid % NXCD, off = wgid / NXCD; wgid = (xcd < r ? xcd * (q + 1) : r * (q + 1) + (xcd - r) * q) + off; }
    const int nig = WGM * nN, gid = wgid / nig, fm = gid * WGM, gsz = (nM - fm) < WGM ? (nM - fm) : WGM;
    pm = fm + ((wgid % nig) % gsz); pn = (wgid % nig) / gsz; return true;
}
__device__ __forceinline__ unsigned cvt_pk_bf16(float lo, float hi) { return pk2(lo, hi); }

template <class S>
__device__ __forceinline__ void gemm_stream(LAS unsigned char* lds, const S& sch) {
    const int tid = opq_v((int)threadIdx.x), wid = __builtin_amdgcn_readfirstlane(tid >> 6), lane = tid & 63, wr = wid >> 2, wc = wid & 3, fr = lane & 15, fq = lane >> 4;
    const unsigned ldsw = (unsigned)wid * 1024u;
    const int aoff = lds_byte(wr * 64 + fr, fq * 8), boff = lds_byte(wc * 32 + fr, fq * 8);
#define PG8_SA(b, h) (((b) * 2 + (h)) * HTB)
#define PG8_SB(b, h) ((4 + (b) * 2 + (h)) * HTB)
#define PG8_STG(bufoff, soff, o0, o1) do { \
        __builtin_amdgcn_raw_ptr_buffer_load_lds(rs, (LAS unsigned*)(lds + (bufoff) + ldsw), 16, (o0), (soff), 0, 0); \
        __builtin_amdgcn_raw_ptr_buffer_load_lds(rs, (LAS unsigned*)(lds + (bufoff) + ldsw + 8192), 16, (o1), (soff), 0, 0); } while (0)
#define PG8_LDA(dst, b, h) do { _Pragma("unroll") for (int m = 0; m < 4; ++m) _Pragma("unroll") for (int k = 0; k < 2; ++k) dst[m][k] = *(const LAS bf16x8*)(lds + PG8_SA(b, h) + aoff + m * 2048 + k * 1024); } while (0)
#define PG8_LDB(dst, b, h) do { _Pragma("unroll") for (int n = 0; n < 2; ++n) _Pragma("unroll") for (int k = 0; k < 2; ++k) dst[n][k] = *(const LAS bf16x8*)(lds + PG8_SB(b, h) + boff + n * 2048 + k * 1024); } while (0)
#define PG8_MMA(ai, bj, At, Bt) do { __builtin_amdgcn_s_setprio(1); _Pragma("unroll") for (int m = 0; m < 4; ++m) _Pragma("unroll") for (int n = 0; n < 2; ++n) _Pragma("unroll") for (int k = 0; k < 2; ++k) \
        acc[ai][bj][m][n] = __builtin_amdgcn_mfma_f32_16x16x32_bf16(Bt[n][k], At[m][k], acc[ai][bj][m][n], 0, 0, 0); __builtin_amdgcn_s_setprio(0); } while (0)
#define PG8_WAIT_V(n) asm volatile("s_waitcnt vmcnt(" #n ")" ::: "memory")
#define PG8_WAIT_L(n) asm volatile("s_waitcnt lgkmcnt(" #n ")" ::: "memory")
#define PG8_BAR __builtin_amdgcn_s_barrier()
#define PG8_SCHED __builtin_amdgcn_sched_barrier(0)
#define PG8_SETUP(u, oA, oB, hB) do { _Pragma("unroll") for (int i = 0; i < 2; ++i) { \
        int R_, C_; stage_rc(tid * 16 + i * 8192, R_, C_); const unsigned RA_ = (unsigned)R_, RB_ = (unsigned)(S::PERM ? ((R_ & ~31) + perm32(R_ & 31)) : R_), CB_ = (unsigned)C_ * 2u; \
        if constexpr (S::GATHER) { oA[0][i] = sch.arow(u, (int)RA_) + CB_; oA[1][i] = sch.arow(u, (int)RA_ + 128) + CB_; } \
        else { oA[0][i] = RA_ * (u).lda + CB_; oA[1][i] = oA[0][i] + 128u * (u).lda; } \
        oB[i] = RB_ * (u).ldb + CB_; } hB = 128u * (u).ldb; } while (0)
    GU cur, nxt; int ui = 0;
    if (!sch.next(0, cur)) return;
    f32x4 acc[2][2][4][2];
#pragma unroll
    for (int a = 0; a < 2; ++a)
#pragma unroll
        for (int b = 0; b < 2; ++b)
#pragma unroll
            for (int m = 0; m < 4; ++m)
#pragma unroll
                for (int n = 0; n < 2; ++n) acc[a][b][m][n] = (f32x4){0.f, 0.f, 0.f, 0.f};
    bf16x8 At[4][2], B0[2][2], B1[2][2];
    const __amdgpu_buffer_rsrc_t rs = __builtin_amdgcn_make_buffer_rsrc((void*)sch.wsbase(), (short)0, (int)WS_END, 0x00020000);
    unsigned oA[2][2], oB[2]; unsigned hB;
    PG8_SETUP(cur, oA, oB, hB);
    unsigned cA = cur.ao, cB = cur.bo;
    PG8_STG(PG8_SB(0, 0), cB, oB[0], oB[1]); PG8_STG(PG8_SB(0, 1), cB + hB, oB[0], oB[1]); PG8_STG(PG8_SA(0, 0), cA, oA[0][0], oA[0][1]); PG8_STG(PG8_SA(0, 1), cA, oA[1][0], oA[1][1]);
    if (wr == 1) PG8_BAR;
    PG8_WAIT_V(2); PG8_BAR;
    PG8_STG(PG8_SB(1, 0), cB + 128, oB[0], oB[1]); PG8_STG(PG8_SA(1, 0), cA + 128, oA[0][0], oA[0][1]); PG8_STG(PG8_SB(1, 1), cB + hB + 128, oB[0], oB[1]);
    PG8_WAIT_V(6); PG8_BAR;
    for (;;) {
        const bool has_next = sch.next(ui + 1, nxt);
        unsigned gA[2][2];
        if constexpr (S::GATHER) { if (has_next) {
#pragma unroll
            for (int i = 0; i < 2; ++i) { int R_, C_; stage_rc(tid * 16 + i * 8192, R_, C_); gA[0][i] = sch.arow(nxt, R_) + (unsigned)C_ * 2u; gA[1][i] = sch.arow(nxt, R_ + 128) + (unsigned)C_ * 2u; } } }
        const int nt = cur.nt;
        for (int t = 0; t < nt; t += 2) {
            const bool last = (t == nt - 2);
            const unsigned a1 = cA + (unsigned)(t + 1) * 128u;
            PG8_LDB(B0, 0, 0); PG8_LDB(B1, 0, 1); PG8_SCHED; PG8_LDA(At, 0, 0); PG8_STG(PG8_SA(1, 1), a1, oA[1][0], oA[1][1]);
            PG8_WAIT_V(8); PG8_WAIT_L(0); PG8_BAR; PG8_MMA(0, 0, At, B0); PG8_MMA(0, 1, At, B1); PG8_BAR; PG8_SCHED;
            unsigned a2 = cA + (unsigned)(t + 2) * 128u, b2 = cB + (unsigned)(t + 2) * 128u;
            if (last) { a2 = cA; b2 = cB;
                if (has_next) { a2 = nxt.ao; b2 = nxt.bo;
                    if constexpr (S::GATHER) { oA[0][0] = gA[0][0]; oA[0][1] = gA[0][1]; oA[1][0] = gA[1][0]; oA[1][1] = gA[1][1];
#pragma unroll
                        for (int i = 0; i < 2; ++i) { int R_, C_; stage_rc(tid * 16 + i * 8192, R_, C_); const unsigned RB_ = (unsigned)(S::PERM ? ((R_ & ~31) + perm32(R_ & 31)) : R_); oB[i] = RB_ * nxt.ldb + (unsigned)C_ * 2u; }
                        hB = 128u * nxt.ldb; }
                    else { PG8_SETUP(nxt, oA, oB, hB); } } }
            const unsigned a3 = a2 + 128u, b3 = b2 + 128u;
            PG8_LDA(At, 0, 1); PG8_STG(PG8_SB(0, 0), b2, oB[0], oB[1]); PG8_STG(PG8_SB(0, 1), b2 + hB, oB[0], oB[1]); PG8_STG(PG8_SA(0, 0), a2, oA[0][0], oA[0][1]);
            PG8_WAIT_V(8); PG8_WAIT_L(0); PG8_BAR; PG8_MMA(1, 0, At, B0); PG8_MMA(1, 1, At, B1); PG8_BAR; PG8_SCHED;
            PG8_LDB(B0, 1, 0); PG8_LDB(B1, 1, 1); PG8_SCHED; PG8_LDA(At, 1, 0); PG8_STG(PG8_SA(0, 1), a2, oA[1][0], oA[1][1]);
            PG8_WAIT_V(8); PG8_WAIT_L(0); PG8_BAR; PG8_MMA(0, 0, At, B0); PG8_MMA(0, 1, At, B1); PG8_BAR; PG8_SCHED;
            PG8_LDA(At, 1, 1); PG8_STG(PG8_SB(1, 0), b3, oB[0], oB[1]); PG8_STG(PG8_SB(1, 1), b3 + hB, oB[0], oB[1]); PG8_STG(PG8_SA(1, 0), a3, oA[0][0], oA[0][1]);
            PG8_WAIT_V(8); PG8_WAIT_L(0); PG8_BAR; PG8_MMA(1, 0, At, B0); PG8_MMA(1, 1, At, B1); PG8_BAR; PG8_SCHED;
        }
        if (wr == 0) PG8_BAR;
        sch.epi(acc, cur, wr, wc, fr, fq);
        if (!has_next) break;
#pragma unroll
        for (int a = 0; a < 2; ++a)
#pragma unroll
            for (int b = 0; b < 2; ++b)
#pragma unroll
                for (int m = 0; m < 4; ++m)
#pragma unroll
                    for (int n = 0; n < 2; ++n) acc[a][b][m][n] = (f32x4){0.f, 0.f, 0.f, 0.f};
        cur = nxt; cA = cur.ao; cB = cur.bo; ++ui;
        if (wr == 1) PG8_BAR;
    }
    PG8_WAIT_V(0);
    PG8_BAR;
#undef PG8_SA
#undef PG8_SB
#undef PG8_STG
#undef PG8_LDA
#undef PG8_LDB
#undef PG8_MMA
#undef PG8_WAIT_V
#undef PG8_WAIT_L
#undef PG8_BAR
#undef PG8_SCHED
#undef PG8_SETUP
}
}
struct Args { const float* in[30]; float* out; unsigned char* ws; int ph_lo, ph_hi, li, pad; };
constexpr int INTAB_OFF = LDSCTL_OFF + 512;
struct InTab { LAS unsigned char* lds;
    __device__ __forceinline__ const float* operator[](int i) const { return (const float*)(*(const LAS unsigned long long*)(lds + INTAB_OFF + 8 * i)); } };
struct Frame {
    LAS unsigned char* lds; volatile LAS unsigned* MISC;
    int tid, lane, wave, vcu, G;
    InTab in; float* out; unsigned char* ws;
    __device__ __forceinline__ gu32* ctl() const { return (gu32*)(ws + WS_CTL); }
    __device__ __forceinline__ bf16* H() const { return (bf16*)(ws + WS_H); }
    __device__ __forceinline__ bf16* P() const { return (bf16*)(ws + WS_P); }
    __device__ __forceinline__ float* XM() const { return (float*)(ws + WS_XM); }
    __device__ __forceinline__ float* XC() const { return (float*)(ws + WS_XC); }
    __device__ __forceinline__ float* SM() const { return (float*)(ws + WS_SM); }
    __device__ __forceinline__ float* ADA() const { return (float*)(ws + WS_ADA); }
};
enum { I_X = 0, I_C, I_CTX, I_CCTX, I_WADA, I_BADA, I_WIN, I_MLGB, I_MLNG, I_GQQG, I_GQKG, I_GLW2, I_GLB2, I_GLNG, I_WBR, I_WGATE, I_BGATE, I_WOUT,
       I_LN1G, I_LN1B, I_LN2G, I_LN2B, I_FFDWG, I_FFDWU, I_FFDWD, I_MOEWR, I_MOEBR, I_MOEWG, I_MOEWU, I_MOEWD };
__device__ __forceinline__ int set_of_panel(int pm) { return pm < 64 ? 0 : (pm < 128 ? 1 : 2); }
__device__ __forceinline__ int set_of_row(int r) { return r < T ? 0 : (r < RL ? 1 : 2); }
__device__ __forceinline__ const float* ada_vec(const Frame& F, int l, int set, int k) { return F.ADA() + ((size_t)(l * 3 + set) * 6 + k) * D; }
__device__ __forceinline__ const float* xin_row(const Frame& F, int l, int r) {
    if (l == 0) return r < RL ? F.in[I_X] + (size_t)r * D : F.in[I_CTX] + (size_t)(r - RL) * D;
    return r < RL ? F.out + (size_t)r * D : F.XC() + (size_t)(r - RL) * D;
}

typedef pg8::GU GU;
struct SchedBase { int G, c; };
struct SchedIn : SchedBase {
    static constexpr bool PERM = true, GATHER = false;
    unsigned char* ws;
    __device__ __forceinline__ bool next(int i, GU& u) const {
        if (!pg8::tile_of((long)i * G + c, NPAN, 13, u.pm, u.pn)) return false;
        u.ao = (unsigned)WS_H + (unsigned)u.pm * 256u * D * 2u; u.lda = D * 2; u.bo = (unsigned)(WS_W + W_IN) + (unsigned)u.pn * 256u * D * 2u; u.ldb = D * 2; u.nt = D / 64; return true; }
    __device__ __forceinline__ unsigned char* wsbase() const { return ws; }
    __device__ __forceinline__ void epi(const f32x4 (&acc)[2][2][4][2], const GU& u, int wr, int wc, int fr, int fq) const {
        const int row0 = u.pm * 256 + wr * 64 + fr; bf16* P = (bf16*)(ws + WS_P); float* SM = (float*)(ws + WS_SM);
        if (u.pn < 12) {
#pragma unroll
            for (int ai = 0; ai < 2; ++ai)
#pragma unroll
                for (int m = 0; m < 4; ++m) { bf16* rowp = P + (size_t)(row0 + ai * 128 + m * 16) * NP + u.pn * 256 + wc * 32 + 8 * fq;
#pragma unroll
                    for (int bj = 0; bj < 2; ++bj) { const f32x4 v0 = acc[ai][bj][m][0], v1 = acc[ai][bj][m][1];
                        v4u w; w.x = pg8::cvt_pk_bf16(v0[0], v0[1]); w.y = pg8::cvt_pk_bf16(v0[2], v0[3]); w.z = pg8::cvt_pk_bf16(v1[0], v1[1]); w.w = pg8::cvt_pk_bf16(v1[2], v1[3]);
                        *(GAS v4u*)(rowp + bj * 128) = w; } }
        } else if (wc < 2) {
            const int col = wc * 32 + 8 * fq;
#pragma unroll
            for (int ai = 0; ai < 2; ++ai)
#pragma unroll
                for (int m = 0; m < 4; ++m) { float* rowp = SM + (size_t)(row0 + ai * 128 + m * 16) * SMP + col;
                    *(GAS f32x4*)(rowp) = acc[ai][0][m][0]; *(GAS f32x4*)(rowp + 4) = acc[ai][0][m][1]; }
        }
    }
};
struct SchedMerge : SchedBase {
    static constexpr bool PERM = true, GATHER = false;
    int npan; unsigned char* ws; const float* bgate;
    __device__ __forceinline__ bool next(int i, GU& u) const {
        const int njl = (NPAN_L * 4 - c + G - 1) / G;
        int j;
        if (i < 8 * njl) { pg8::tile_of((long)(i >> 3) * G + c, NPAN_L, 4, u.pm, u.pn); const int sub = i & 7; j = sub >> 1; u.kind = sub & 1; u.aux = j; }
        else { if (npan == NPAN_L) return false; const int qi = i - 8 * njl, qj = c + (qi >> 1) * G; if (qj >= 32) return false;
            u.pm = NPAN_L + (qj >> 4); u.pn = (qj >> 2) & 3; j = qj & 3; u.kind = qi & 1; u.aux = j + (u.kind ? 4 : 0); }
        unsigned ao, bo; unsigned la, lb; int nt;
        if (u.kind == 0) { ao = (unsigned)WS_H + (unsigned)u.pm * 256u * D * 2u; la = D * 2; bo = (unsigned)(WS_W + W_GATE) + ((unsigned)j * 1024u + u.pn * 256u) * D * 2u; lb = D * 2; nt = 16; }
        else { const bool isP = (j != 1); const int tc = (j == 0) ? TC_MLO : (j == 2 ? TC_GQQ : TC_GLR); const int kk = (j == 1 || j == 2) ? 512 : 256;
            ao = isP ? (unsigned)WS_P + ((unsigned)u.pm * 256u * NP + tc) * 2u : (unsigned)(WS_XM + XO_FT) + (unsigned)u.pm * 256u * 512u * 2u; la = isP ? NP * 2 : 1024;
            const unsigned wo = (unsigned)((j == 0) ? W_BML : (j == 1 ? W_BFT : (j == 2 ? W_BAT : W_BGL)));
            bo = (unsigned)WS_W + wo + (unsigned)u.pn * 256u * kk * 2u; lb = kk * 2; nt = kk / 64; }
        u.ao = ao; u.bo = bo; u.lda = la; u.ldb = lb; u.nt = nt;
        return true; }
    __device__ __forceinline__ unsigned char* wsbase() const { return ws; }
    __device__ __forceinline__ void epi(const f32x4 (&acc)[2][2][4][2], const GU& u, int wr, int wc, int fr, int fq) const {
        const int tid = threadIdx.x; v4u* sp_ = (v4u*)(ws + WS_XM + XO_GST) + (size_t)blockIdx.x * 8192 + tid;
        if (u.kind == 0) {
            const float* bp = bgate + u.aux * 1024 + u.pn * 256 + wc * 32 + 8 * fq;
#pragma unroll
            for (int ai = 0; ai < 2; ++ai)
#pragma unroll
                for (int m = 0; m < 4; ++m)
#pragma unroll
                    for (int bj = 0; bj < 2; ++bj) { const f32x4 v0 = acc[ai][bj][m][0] + *(const GAS f32x4*)(bp + bj * 128), v1 = acc[ai][bj][m][1] + *(const GAS f32x4*)(bp + bj * 128 + 4);
                        v4u w; w.x = pg8::cvt_pk_bf16(sigm(v0[0]), sigm(v0[1])); w.y = pg8::cvt_pk_bf16(sigm(v0[2]), sigm(v0[3])); w.z = pg8::cvt_pk_bf16(sigm(v1[0]), sigm(v1[1])); w.w = pg8::cvt_pk_bf16(sigm(v1[2]), sigm(v1[3]));
                        *(GAS v4u*)sp_ = w; sp_ += 512; asm volatile("" : "+v"(sp_) :: "memory"); }
        } else {
            bf16* rowp = (u.aux < 4 ? (bf16*)(ws + WS_XM + XO_MIX) + (size_t)(u.pm * 256) * D : (bf16*)(ws + WS_UQ) + ((size_t)(u.aux - 4) * 512 + (u.pm - NPAN_L) * 256) * D) + (size_t)(wr * 64 + fr) * D + u.pn * 256 + wc * 32 + 8 * fq;
            const bool accum = (u.aux > 0 && u.aux < 4);
            bf16* nxp = rowp; v4u g_n = *(const GAS v4u*)sp_; v4u p_n = (v4u){0u, 0u, 0u, 0u}; if (accum) p_n = *(const GAS v4u*)nxp;
#pragma unroll
            for (int e = 0; e < 16; ++e) { const int ai = e >> 3, m = (e >> 1) & 3, bj = e & 1;
                const v4u g = g_n, p = p_n; bf16* curp = nxp;
                if (e < 15) { sp_ += 512; asm volatile("" : "+v"(sp_)); nxp += (bj == 0) ? 128 : ((m == 3 ? 80 : 16) * D - 128); asm volatile("" : "+v"(nxp));
                    g_n = *(const GAS v4u*)sp_; if (accum) p_n = *(const GAS v4u*)nxp; }
                const f32x4 a0 = acc[ai][bj][m][0], a1 = acc[ai][bj][m][1];
                const float o0 = bflo(g.x) * a0[0] + bflo(p.x), o1 = bfhi(g.x) * a0[1] + bfhi(p.x), o2 = bflo(g.y) * a0[2] + bflo(p.y), o3 = bfhi(g.y) * a0[3] + bfhi(p.y);
                const float o4 = bflo(g.z) * a1[0] + bflo(p.z), o5 = bfhi(g.z) * a1[1] + bfhi(p.z), o6 = bflo(g.w) * a1[2] + bflo(p.w), o7 = bfhi(g.w) * a1[3] + bfhi(p.w);
                v4u w; w.x = pg8::cvt_pk_bf16(o0, o1); w.y = pg8::cvt_pk_bf16(o2, o3); w.z = pg8::cvt_pk_bf16(o4, o5); w.w = pg8::cvt_pk_bf16(o6, o7);
                *(GAS v4u*)curp = w; }
        }
    }
};
struct SchedOut : SchedBase {
    static constexpr bool PERM = false, GATHER = false;
    int npan, l; unsigned char* ws; const float* xlat; const float* xctx;
    __device__ __forceinline__ bool next(int i, GU& u) const {
        const int nul = (NPAN_L * 4 - c + G - 1) / G;
        if (i < nul) { pg8::tile_of((long)i * G + c, NPAN_L, 4, u.pm, u.pn); u.ao = (unsigned)(WS_XM + XO_MIX) + (unsigned)u.pm * 256u * D * 2u; }
        else { if (npan == NPAN_L) return false; const int q = c + (i - nul) * G; if (q >= 8) return false; u.pm = NPAN_L + (q >> 2); u.pn = q & 3; u.ao = (unsigned)WS_PA + (unsigned)q * 524288u; }
        u.lda = D * 2; u.bo = (unsigned)(WS_W + W_OUT) + (unsigned)u.pn * 256u * D * 2u; u.ldb = D * 2; u.nt = 16; return true; }
    __device__ __forceinline__ unsigned char* wsbase() const { return ws; }
    __device__ __forceinline__ void epi(const f32x4 (&acc)[2][2][4][2], const GU& u, int wr, int wc, int fr, int fq) const {
        const int r0 = u.pm * 256, col0 = u.pn * 256 + wc * 32 + 4 * fq, rl = wr * 64 + fr; const float* ada = (const float*)(ws + WS_ADA); float* XM = (float*)(ws + WS_P);
        const float* xs = r0 < RL ? xlat + (size_t)r0 * D : xctx + (size_t)(r0 - RL) * D; const float* gv = ada + ((size_t)(l * 3 + set_of_panel(u.pm)) * 6 + 2) * D + col0;
        f32x4 gg[2][2];
#pragma unroll
        for (int bj = 0; bj < 2; ++bj)
#pragma unroll
            for (int n = 0; n < 2; ++n) gg[bj][n] = *(const GAS f32x4*)(gv + bj * 128 + n * 16);
        const float* xp = xs + (size_t)rl * D + col0; float* op = XM + (size_t)(r0 + rl) * D + col0;
        f32x4 xn00 = *(const GAS f32x4*)(xp), xn01 = *(const GAS f32x4*)(xp + 16), xn10 = *(const GAS f32x4*)(xp + 128), xn11 = *(const GAS f32x4*)(xp + 144);
#pragma unroll
        for (int g = 0; g < 8; ++g) { const int ai = g >> 2, m = g & 3;
            const f32x4 x00 = xn00, x01 = xn01, x10 = xn10, x11 = xn11; float* oc = op;
            if (g < 7) { const int step = (m == 3 ? 80 : 16) * D; xp += step; op += step; asm volatile("" : "+v"(xp), "+v"(op));
                xn00 = *(const GAS f32x4*)(xp); xn01 = *(const GAS f32x4*)(xp + 16); xn10 = *(const GAS f32x4*)(xp + 128); xn11 = *(const GAS f32x4*)(xp + 144); }
            *(GAS f32x4*)(oc) = x00 * ALPHA + gg[0][0] * acc[ai][0][m][0]; *(GAS f32x4*)(oc + 16) = x01 * ALPHA + gg[0][1] * acc[ai][0][m][1];
            *(GAS f32x4*)(oc + 128) = x10 * ALPHA + gg[1][0] * acc[ai][1][m][0]; *(GAS f32x4*)(oc + 144) = x11 * ALPHA + gg[1][1] * acc[ai][1][m][1]; }
    }
};
__device__ __forceinline__ void swiglu_store(const f32x4 (&acc)[2][2][4][2], bf16* ACT, size_t pitch, int row0, int hid0, int wc, int fq) {
#pragma unroll
    for (int ai = 0; ai < 2; ++ai)
#pragma unroll
        for (int m = 0; m < 4; ++m) { bf16* rowp = ACT + (size_t)(row0 + ai * 128 + m * 16) * pitch + hid0 + wc * 16 + 4 * fq;
#pragma unroll
            for (int bj = 0; bj < 2; ++bj) { const f32x4 g = acc[ai][bj][m][0], uu = acc[ai][bj][m][1];
                v2u w; w.x = pg8::cvt_pk_bf16(g[0] * sigm(g[0]) * uu[0], g[1] * sigm(g[1]) * uu[1]); w.y = pg8::cvt_pk_bf16(g[2] * sigm(g[2]) * uu[2], g[3] * sigm(g[3]) * uu[3]);
                *(GAS v2u*)(rowp + bj * 64) = w; } }
}
struct SchedUp : SchedBase {
    static constexpr bool PERM = true, GATHER = false;
    unsigned char* ws;
    __device__ __forceinline__ bool next(int i, GU& u) const {
        if (!pg8::tile_of((long)i * G + c, NPAN, 22, u.pm, u.pn)) return false;
        u.ao = (unsigned)WS_H + (unsigned)u.pm * 256u * D * 2u; u.lda = D * 2; u.bo = (unsigned)(WS_W + W_FFD_GU) + (unsigned)u.pn * 256u * D * 2u; u.ldb = D * 2; u.nt = 16; return true; }
    __device__ __forceinline__ unsigned char* wsbase() const { return ws; }
    __device__ __forceinline__ void epi(const f32x4 (&acc)[2][2][4][2], const GU& u, int wr, int wc, int fr, int fq) const {
        swiglu_store(acc, (bf16*)(ws + WS_P), FFD, u.pm * 256 + wr * 64 + fr, u.pn * 128, wc, fq); }
};
struct SchedDown : SchedBase {
    static constexpr bool PERM = false, GATHER = false;
    int l; unsigned char* ws;
    __device__ __forceinline__ bool next(int i, GU& u) const {
        const int nul = (NPAN_L * 4 - c + G - 1) / G; u.aux = 0; u.nt = FFD / 64; unsigned ko = 0;
        if (i < nul) pg8::tile_of((long)i * G + c, NPAN_L, 4, u.pm, u.pn);
        else { const int q = c + (i - nul) * G; if (q >= 16) return false; u.pm = NPAN_L + (q >> 3); u.pn = (q >> 1) & 3; u.aux = 1 + (q & 1); u.nt = FFD / 128; ko = (unsigned)(q & 1) * (FFD / 128) * 128u; }
        u.ao = (unsigned)WS_P + (unsigned)u.pm * 256u * FFD * 2u + ko; u.lda = FFD * 2; u.bo = (unsigned)(WS_W + W_FFD_D) + (unsigned)u.pn * 256u * FFD * 2u + ko; u.ldb = FFD * 2; return true; }
    __device__ __forceinline__ unsigned char* wsbase() const { return ws; }
    __device__ __forceinline__ void epi(const f32x4 (&acc)[2][2][4][2], const GU& u, int wr, int wc, int fr, int fq) const {
        const int col0 = u.pn * 256 + wc * 32 + 4 * fq, row0 = u.pm * 256 + wr * 64 + fr; const float* ada = (const float*)(ws + WS_ADA); float* XM = (float*)(ws + WS_XM);
        if (u.aux) { float* dp = (float*)(ws + WS_DP) + ((size_t)(u.aux - 1) * 512 + (row0 - RL)) * D + col0;
#pragma unroll
            for (int ai = 0; ai < 2; ++ai)
#pragma unroll
                for (int m = 0; m < 4; ++m)
#pragma unroll
                    for (int bj = 0; bj < 2; ++bj)
#pragma unroll
                        for (int n = 0; n < 2; ++n) *(GAS f32x4*)(dp + (size_t)(ai * 128 + m * 16) * D + bj * 128 + n * 16) = acc[ai][bj][m][n];
            return; }
        const float* gv = ada + ((size_t)(l * 3 + set_of_panel(u.pm)) * 6 + 5) * D + col0;
        f32x4 gg[2][2];
#pragma unroll
        for (int bj = 0; bj < 2; ++bj)
#pragma unroll
            for (int n = 0; n < 2; ++n) gg[bj][n] = *(const GAS f32x4*)(gv + bj * 128 + n * 16);
        float* op = XM + (size_t)row0 * D + col0;
        f32x4 xn00 = *(const GAS f32x4*)(op), xn01 = *(const GAS f32x4*)(op + 16), xn10 = *(const GAS f32x4*)(op + 128), xn11 = *(const GAS f32x4*)(op + 144);
#pragma unroll
        for (int g = 0; g < 8; ++g) { const int ai = g >> 2, m = g & 3;
            const f32x4 x00 = xn00, x01 = xn01, x10 = xn10, x11 = xn11; float* oc = op;
            if (g < 7) { op += (m == 3 ? 80 : 16) * D; asm volatile("" : "+v"(op));
                xn00 = *(const GAS f32x4*)(op); xn01 = *(const GAS f32x4*)(op + 16); xn10 = *(const GAS f32x4*)(op + 128); xn11 = *(const GAS f32x4*)(op + 144); }
            *(GAS f32x4*)(oc) = x00 * ALPHA + gg[0][0] * acc[ai][0][m][0]; *(GAS f32x4*)(oc + 16) = x01 * ALPHA + gg[0][1] * acc[ai][0][m][1];
            *(GAS f32x4*)(oc + 128) = x10 * ALPHA + gg[1][0] * acc[ai][1][m][0]; *(GAS f32x4*)(oc + 144) = x11 * ALPHA + gg[1][1] * acc[ai][1][m][1]; }
    }
};
struct MoeTabs { unsigned char* ws;
    __device__ __forceinline__ const int* tok() const { return (const int*)(ws + WS_MOE + MO_TOK); }
    __device__ __forceinline__ const int* dst() const { return (const int*)(ws + WS_MOE + MO_DST); }
    __device__ __forceinline__ const int* tile_e() const { return (const int*)(ws + WS_MOE + MO_SEL + (size_t)RL * 16); }
    __device__ __forceinline__ const int* ntiles() const { return tile_e() + 512; } };
struct SchedMoeUp : SchedBase {
    static constexpr bool PERM = true, GATHER = true;
    MoeTabs mt; int nt_;
    __device__ __forceinline__ bool next(int i, GU& u) const {
        if (!pg8::tile_of((long)i * G + c, nt_, 11, u.pm, u.pn)) return false;
        const int e = mt.tile_e()[u.pm]; u.aux = e;
        u.ao = (unsigned)WS_H; u.lda = D * 2; u.bo = (unsigned)(WS_W + W_MOE_GU) + ((unsigned)e * 2816u + u.pn * 256u) * D * 2u; u.ldb = D * 2; u.nt = 16; return true; }
    __device__ __forceinline__ unsigned char* wsbase() const { return mt.ws; }
    __device__ __forceinline__ unsigned arow(const GU& u, int r) const { return (unsigned)mt.tok()[u.pm * 256 + r] * (unsigned)(D * 2); }
    __device__ __forceinline__ void epi(const f32x4 (&acc)[2][2][4][2], const GU& u, int wr, int wc, int fr, int fq) const {
        swiglu_store(acc, (bf16*)(mt.ws + WS_P), FFE, u.pm * 256 + wr * 64 + fr, u.pn * 128, wc, fq); }
};
struct SchedMoeDown : SchedBase {
    static constexpr bool PERM = true, GATHER = false;
    MoeTabs mt; bf16* Dst; int nt_;
    __device__ __forceinline__ bool next(int i, GU& u) const {
        if (!pg8::tile_of((long)i * G + c, nt_, 4, u.pm, u.pn)) return false;
        const int e = mt.tile_e()[u.pm];
        u.ao = (unsigned)WS_P + (unsigned)u.pm * 256u * FFE * 2u; u.lda = FFE * 2; u.bo = (unsigned)(WS_W + W_MOE_D) + ((unsigned)e * 1024u + u.pn * 256u) * FFE * 2u; u.ldb = FFE * 2; u.nt = FFE / 64; return true; }
    __device__ __forceinline__ unsigned char* wsbase() const { return mt.ws; }
    __device__ __forceinline__ void epi(const f32x4 (&acc)[2][2][4][2], const GU& u, int wr, int wc, int fr, int fq) const {
        const int srow0 = u.pm * 256 + wr * 64 + fr;
#pragma unroll
        for (int ai = 0; ai < 2; ++ai)
#pragma unroll
            for (int m = 0; m < 4; ++m) { asm volatile("" ::: "memory"); const int d = ((const GAS int*)mt.dst())[srow0 + ai * 128 + m * 16];
                if (d >= 0) { bf16* rowp = Dst + (size_t)d * D + u.pn * 256 + wc * 32 + 8 * fq;
#pragma unroll
                    for (int bj = 0; bj < 2; ++bj) { const f32x4 v0 = acc[ai][bj][m][0], v1 = acc[ai][bj][m][1];
                        v4u w; w.x = pg8::cvt_pk_bf16(v0[0], v0[1]); w.y = pg8::cvt_pk_bf16(v0[2], v0[3]); w.z = pg8::cvt_pk_bf16(v1[0], v1[1]); w.w = pg8::cvt_pk_bf16(v1[2], v1[3]);
                        *(GAS v4u*)(rowp + bj * 128) = w; } } }
    }
};
template <class Map>
__device__ __forceinline__ void tr_convert(const Frame& F, int K, int N, int ldw, bf16* WT, const Map& map) {
    LAS float* scr = (LAS float*)(F.lds + F.wave * 16384);
    const int gw = F.vcu * NWAVES + F.wave, NGW = F.G * NWAVES, lane = F.lane;
    const int nblk = N / 32, nitems = (K / 64) * nblk;
    for (int it = gw; it < nitems; it += NGW) {
        const int kb = it / nblk, nb = it % nblk, k0 = 64 * kb, n0 = 32 * nb;
        const float* src = map(n0 + (lane & 31));
        float tv[32];
#pragma unroll
        for (int i = 0; i < 32; ++i) { const int kk = 2 * i + (lane >> 5); tv[i] = src ? src[(size_t)(k0 + kk) * ldw] : 0.f; }
#pragma unroll
        for (int i = 0; i < 32; ++i) { const int kk = 2 * i + (lane >> 5); scr[kk * 33 + (lane & 31)] = tv[i]; }
        LDS_WAIT(); asm volatile("" ::: "memory");
        const int c = lane & 7;
#pragma unroll
        for (int j = 0; j < 4; ++j) { const int n = (lane >> 3) + 8 * j; const LAS float* s = scr + (8 * c) * 33 + n;
            v4u o; o.x = pk2(s[0 * 33], s[1 * 33]); o.y = pk2(s[2 * 33], s[3 * 33]); o.z = pk2(s[4 * 33], s[5 * 33]); o.w = pk2(s[6 * 33], s[7 * 33]);
            *(GAS v4u*)(WT + (size_t)(n0 + n) * K + k0 + 8 * c) = o; }
        LDS_WAIT(); asm volatile("" ::: "memory");
    }
}
struct MapLin { const float* base; __device__ __forceinline__ const float* operator()(int n) const { return base + n; } };
struct MapIn { const float* w;
    __device__ __forceinline__ const float* operator()(int n) const {
        int o;
        if (n < 1024) o = n; else if (n < 1280) o = 1040 + (n - 1024); else if (n < 1792) o = 1296 + (n - 1280); else if (n < 2048) o = 1808 + (n - 1792);
        else if (n < 3072) o = 2064 + (n - 2048); else { const int j = n - 3072; if (j < 16) o = 1024 + j; else if (j < 48) o = 3088 + (j - 16); else return nullptr; }
        return w + o; } };
struct MapGU { const float* wg; const float* wu;
    __device__ __forceinline__ const float* operator()(int n) const { const int hid = (n >> 8) * 128 + ((n & 255) >> 3) * 4 + (n & 3); const long dlt = (n & 4) ? (long)(wu - wg) : 0l; return wg + dlt + hid; } };

__device__ __forceinline__ void convert_layer_weights(const Frame& F, int l) {
    unsigned char* wb = F.ws + WS_W;
    { MapIn m{F.in[I_WIN] + (size_t)l * D * NIN}; tr_convert(F, D, 3328, NIN, (bf16*)(wb + W_IN), m); }
    { MapLin m{F.in[I_WGATE] + (size_t)l * D * 4096}; tr_convert(F, D, 4096, 4096, (bf16*)(wb + W_GATE), m); }
    { MapLin m{F.in[I_WOUT] + (size_t)l * D * D}; tr_convert(F, D, D, D, (bf16*)(wb + W_OUT), m); }
    const float* wbr = F.in[I_WBR] + (size_t)l * 1280 * D;
    { MapLin m{wbr}; tr_convert(F, 256, D, D, (bf16*)(wb + W_BML), m); }
    { MapLin m{wbr + (size_t)512 * D}; tr_convert(F, 512, D, D, (bf16*)(wb + W_BAT), m); }
    { MapLin m{wbr + (size_t)1024 * D}; tr_convert(F, 256, D, D, (bf16*)(wb + W_BGL), m); }
    { bf16* WT = (bf16*)(wb + W_BFT); const float* src = wbr + (size_t)256 * D;
      for (int idx = (F.vcu * 512 + F.tid); idx < 512 * 1024; idx += F.G * 512) { const int n = idx & 1023, kp = idx >> 10, part = kp >> 8, g = (kp >> 6) & 3, c = kp & 63;
          float s = 0.f;
          for (int k3 = 0; k3 < 64; ++k3) { const float ph = (float)((k3 * c) & 63) * (1.f / 32.f); const float tr = part ? sinpif(ph) : cospif(ph); s += tr * src[(size_t)(64 * g + k3) * D + n]; }
          WT[(size_t)n * 512 + kp] = (bf16)f2bf(s * 0.125f); } }
    if (l == 0) {
        { MapGU m{F.in[I_FFDWG], F.in[I_FFDWU]}; tr_convert(F, D, 2 * FFD, FFD, (bf16*)(wb + W_FFD_GU), m); }
        { MapLin m{F.in[I_FFDWD]}; tr_convert(F, FFD, D, D, (bf16*)(wb + W_FFD_D), m); }
    } else {
        for (int e = 0; e < NEXP; ++e) {
            { MapGU m{F.in[I_MOEWG] + (size_t)e * D * FFE, F.in[I_MOEWU] + (size_t)e * D * FFE}; tr_convert(F, D, 2 * FFE, FFE, (bf16*)(wb + W_MOE_GU) + (size_t)e * 2816 * D, m); }
            { MapLin m{F.in[I_MOEWD] + (size_t)e * FFE * D}; tr_convert(F, FFE, D, D, (bf16*)(wb + W_MOE_D) + (size_t)e * 1024 * FFE, m); }
        }
    }
}
__device__ __forceinline__ void build_tables(const Frame& F) {
    const int gt = F.vcu * 512 + F.tid, NT_ = F.G * 512;
    float* rc = (float*)(F.ws + WS_ROPE_C); float* rs = (float*)(F.ws + WS_ROPE_S);
    for (int i = gt; i < 256 * 16; i += NT_) { const int pos = i >> 4, p = i & 15;
        double inv = (p & 3) == 0 ? 1.0 : ((p & 3) == 1 ? 0.5623413251903491 : ((p & 3) == 2 ? 0.31622776601683794 : 0.17782794100389228));
        for (int q = 0; q < (p >> 2); ++q) inv *= 0.1;
        const float angf = (float)pos * (float)inv;
        double xr = (double)angf * 0.3183098861837907; xr -= 2.0 * rint(xr * 0.5);
        rc[i] = cospif((float)xr); rs[i] = sinpif((float)xr); }
    bf16* dc = (bf16*)(F.ws + WS_DFT_C); bf16* ds = (bf16*)(F.ws + WS_DFT_S);
    for (int i = gt; i < 128 * 128; i += NT_) { const int j = i >> 7, k = i & 127; const float ph = (float)((j * k) & 127) * (1.f / 64.f); dc[i] = (bf16)f2bf(cospif(ph)); ds[i] = (bf16)f2bf(sinpif(ph)); }
}
__device__ __forceinline__ void ada_phase(const Frame& F) {
    LAS float* sc = (LAS float*)(F.lds);
    LAS float* red = (LAS float*)(F.lds + 16384);
    for (int i = F.tid; i < 3 * D; i += 512) { const int s = i >> 10, k = i & 1023; const float v = s < 2 ? F.in[I_C][s * D + k] : F.in[I_CCTX][k]; sc[i] = v * sigm(v); }
    __syncthreads();
    for (int task = F.vcu; task < 2 * 96; task += F.G) { const int l = task / 96, cb = task % 96, col = cb * 64 + F.lane;
        const float* w = F.in[I_WADA] + (size_t)l * D * 6144 + col; float a0 = 0.f, a1 = 0.f, a2 = 0.f;
        const int kb = F.wave * 128;
#pragma unroll 32
        for (int k = 0; k < 128; ++k) { const float wv = w[(size_t)(kb + k) * 6144]; a0 += sc[kb + k] * wv; a1 += sc[D + kb + k] * wv; a2 += sc[2 * D + kb + k] * wv; }
        red[(F.wave * 3 + 0) * 64 + F.lane] = a0; red[(F.wave * 3 + 1) * 64 + F.lane] = a1; red[(F.wave * 3 + 2) * 64 + F.lane] = a2;
        __syncthreads();
        if (F.tid < 192) { const int s = F.tid >> 6, ln = F.tid & 63; float t = 0.f;
#pragma unroll
            for (int w8 = 0; w8 < 8; ++w8) t += red[(w8 * 3 + s) * 64 + ln];
            F.ADA()[(size_t)(l * 3 + s) * 6144 + cb * 64 + ln] = t + F.in[I_BADA][(size_t)l * 6144 + cb * 64 + ln]; }
        __syncthreads();
    }
}
struct Row16 { f32x4 v[4]; };
__device__ __forceinline__ Row16 ld_row(const float* p, int lane) { Row16 r; const GAS f32x4* q = (const GAS f32x4*)p + lane;
#pragma unroll
    for (int j = 0; j < 4; ++j) r.v[j] = q[64 * j];
    return r; }
__device__ __forceinline__ void st_row(float* p, int lane, const Row16& r) { GAS f32x4* q = (GAS f32x4*)p + lane;
#pragma unroll
    for (int j = 0; j < 4; ++j) q[64 * j] = r.v[j]; }
__device__ __forceinline__ void ln_norm(Row16& r) {
    float s = 0.f;
#pragma unroll
    for (int j = 0; j < 4; ++j) s += (r.v[j].x + r.v[j].y) + (r.v[j].z + r.v[j].w);
    const float mean = wave_sum(s) * (1.f / D); float s2 = 0.f;
#pragma unroll
    for (int j = 0; j < 4; ++j) { r.v[j] = r.v[j] - mean; s2 += (r.v[j].x * r.v[j].x + r.v[j].y * r.v[j].y) + (r.v[j].z * r.v[j].z + r.v[j].w * r.v[j].w); }
    const float rstd = 1.f / sqrtf(wave_sum(s2) * (1.f / D) + LN_EPS);
#pragma unroll
    for (int j = 0; j < 4; ++j) r.v[j] = r.v[j] * rstd;
}
__device__ __forceinline__ void affine(Row16& r, const float* g, const float* b, int lane, bool one_plus) {
    const Row16 gg = ld_row(g, lane), bb = ld_row(b, lane);
#pragma unroll
    for (int j = 0; j < 4; ++j) r.v[j] = r.v[j] * (one_plus ? gg.v[j] + 1.0f : gg.v[j]) + bb.v[j];
}
__device__ __forceinline__ void st_row_bf16(bf16* p, int lane, const Row16& r) { GAS v2u* q = (GAS v2u*)p + lane;
#pragma unroll
    for (int j = 0; j < 4; ++j) { v2u w; w.x = pk2(r.v[j].x, r.v[j].y); w.y = pk2(r.v[j].z, r.v[j].w); q[64 * j] = w; } }
__device__ __forceinline__ void phase_ln_mod(const Frame& F, int l) {
    const int gw = F.vcu * NWAVES + F.wave, NGW = F.G * NWAVES;
    Row16 nx; if (gw < R) nx = ld_row(xin_row(F, l, gw), F.lane);
    for (int r = gw; r < R; r += NGW) { Row16 x = nx; if (r + NGW < R) nx = ld_row(xin_row(F, l, r + NGW), F.lane);
        ln_norm(x); const int s = set_of_row(r);
        affine(x, ada_vec(F, l, s, 1), ada_vec(F, l, s, 0), F.lane, true); st_row_bf16(F.H() + (size_t)r * D, F.lane, x); }
}
__device__ __forceinline__ void phase_qk(const Frame& F, int l, bool dry = false) {
    const int gw = F.vcu * NWAVES + F.wave, NGW = F.G * NWAVES, lane = F.lane, hd = lane >> 2, qd = lane & 3;
    const float* rc = (const float*)(F.ws + WS_ROPE_C); const float* rs = (const float*)(F.ws + WS_ROPE_S);
    const float* gq = F.in[I_GQQG] + l * 64; const float* gk = F.in[I_GQKG] + l * 64;
    for (int r = gw; r < R; r += NGW) {
        float x[16]; bf16* p = F.P() + (size_t)r * NP + (hd < 8 ? TC_GQQ + hd * 64 : TC_GQK + (hd - 8) * 64) + qd * 16;
        float ss = 0.f;
        if (hd < 10) { const v4u a = *(const v4u*)p, b = *(const v4u*)(p + 8);
            x[0] = bflo(a.x); x[1] = bfhi(a.x); x[2] = bflo(a.y); x[3] = bfhi(a.y); x[4] = bflo(a.z); x[5] = bfhi(a.z); x[6] = bflo(a.w); x[7] = bfhi(a.w);
            x[8] = bflo(b.x); x[9] = bfhi(b.x); x[10] = bflo(b.y); x[11] = bfhi(b.y); x[12] = bflo(b.z); x[13] = bfhi(b.z); x[14] = bflo(b.w); x[15] = bfhi(b.w);
#pragma unroll
            for (int i = 0; i < 16; ++i) ss += x[i] * x[i]; }
        else {
#pragma unroll
            for (int i = 0; i < 16; ++i) x[i] = 0.f; }
        ss += __shfl_xor(ss, 1); ss += __shfl_xor(ss, 2);
        const float rstd = 1.f / sqrtf(ss * (1.f / 64.f) + LN_EPS);
        const float* g = (hd < 8 ? gq : gk) + qd * 16;
#pragma unroll
        for (int i = 0; i < 16; ++i) x[i] = x[i] * rstd * g[i];
        float y[16];
#pragma unroll
        for (int i = 0; i < 16; ++i) y[i] = __shfl_xor(x[i], 1);
        if (r < RL) { const int t = r & (T - 1), pos = (qd >> 1) ? (t & 63) : (t >> 6); const float* c = rc + pos * 16; const float* s = rs + pos * 16;
#pragma unroll
            for (int i = 0; i < 16; ++i) x[i] = (qd & 1) ? (y[i] * s[i] + x[i] * c[i]) : (x[i] * c[i] - y[i] * s[i]); }
        if (hd < 8) {
#pragma unroll
            for (int i = 0; i < 16; ++i) x[i] *= C2Q; }
        if (hd < 10 && !dry) { v4u a, b; a.x = pk2(x[0], x[1]); a.y = pk2(x[2], x[3]); a.z = pk2(x[4], x[5]); a.w = pk2(x[6], x[7]); b.x = pk2(x[8], x[9]); b.y = pk2(x[10], x[11]); b.z = pk2(x[12], x[13]); b.w = pk2(x[14], x[15]);
            *(v4u*)p = a; *(v4u*)(p + 8) = b; }
    }
}
__device__ __forceinline__ void build_ctx_panels(const Frame& F) {
    const int q = (int)blockIdx.x; if (q >= 8) return;
    const bf16* uq = (const bf16*)(F.ws + WS_UQ) + (size_t)(q >> 2) * 256 * D; bf16* pa = (bf16*)(F.ws + WS_PA) + (size_t)q * 256 * D;
    for (int idx = F.tid; idx < 256 * D / 8; idx += 512) { float a[8], t[8]; unpack8(*(const v4u*)(uq + (size_t)idx * 8), a);
#pragma unroll
        for (int j = 1; j < 4; ++j) { unpack8(*(const v4u*)(uq + (size_t)j * 512 * D + (size_t)idx * 8), t);
#pragma unroll
            for (int e = 0; e < 8; ++e) a[e] += t[e]; }
        *(v4u*)(pa + (size_t)idx * 8) = pack8(a); }
    asm volatile("s_waitcnt vmcnt(0)" ::: "memory"); __syncthreads();
}
__device__ __forceinline__ void phase_post_mix(const Frame& F, int l, int nrows, const float* T1) {
    const int gw = F.vcu * NWAVES + F.wave, NGW = F.G * NWAVES, lane = F.lane;
    volatile LAS int* hist = (volatile LAS int*)(F.lds + 1024);
    if (l == 1) { if (F.tid < 8) hist[F.tid] = 0; __syncthreads(); }
    Row16 nx; if (gw < nrows) nx = ld_row(T1 + (size_t)gw * D, lane);
    for (int r = gw; r < nrows; r += NGW) {
        Row16 x = nx; if (r + NGW < nrows) nx = ld_row(T1 + (size_t)(r + NGW) * D, lane);
        ln_norm(x); affine(x, F.in[I_LN1G] + l * D, F.in[I_LN1B] + l * D, lane, false);
        st_row(F.XM() + (size_t)r * D, lane, x);
        ln_norm(x); const int s = set_of_row(r); affine(x, ada_vec(F, l, s, 4), ada_vec(F, l, s, 3), lane, true);
        st_row_bf16(F.H() + (size_t)r * D, lane, x);
        if (l == 1) {
            float lg[8];
#pragma unroll
            for (int e = 0; e < 8; ++e) lg[e] = 0.f;
            const float* wr = F.in[I_MOEWR];
#pragma unroll
            for (int j = 0; j < 4; ++j)
#pragma unroll
                for (int q = 0; q < 4; ++q) { const float xv = x.v[j][q]; const GAS f32x4* wp = (const GAS f32x4*)(wr + (size_t)(256 * j + 4 * lane + q) * 8); const f32x4 w0 = wp[0], w1 = wp[1];
                    lg[0] += xv * w0.x; lg[1] += xv * w0.y; lg[2] += xv * w0.z; lg[3] += xv * w0.w; lg[4] += xv * w1.x; lg[5] += xv * w1.y; lg[6] += xv * w1.z; lg[7] += xv * w1.w; }
#pragma unroll
            for (int e = 0; e < 8; ++e) lg[e] = wave_sum(lg[e]);
            const float* br = F.in[I_MOEBR];
            int i0 = 0; float b0 = lg[0] + br[0];
#pragma unroll
            for (int e = 1; e < 8; ++e) { const float v = lg[e] + br[e]; if (v > b0) { b0 = v; i0 = e; } }
            int i1 = (i0 == 0) ? 1 : 0; float b1 = (i0 == 0) ? lg[1] + br[1] : lg[0] + br[0];
#pragma unroll
            for (int e = 1; e < 8; ++e) { const float v = lg[e] + br[e]; if (e != i0 && v > b1) { b1 = v; i1 = e; } }
            float l0 = 0.f, l1 = 0.f;
#pragma unroll
            for (int e = 0; e < 8; ++e) { l0 = (e == i0) ? lg[e] : l0; l1 = (e == i1) ? lg[e] : l1; }
            const float mx = fmaxf(l0, l1), e0 = __expf(l0 - mx), e1 = __expf(l1 - mx), inv = 1.f / (e0 + e1);
            if (lane == 0) { int* sel = (int*)(F.ws + WS_MOE + MO_SEL) + (size_t)r * 4; sel[0] = i0; sel[1] = i1; ((float*)sel)[2] = e0 * inv; ((float*)sel)[3] = e1 * inv;
                __hip_atomic_fetch_add((LAS int*)&hist[i0], 1, __ATOMIC_RELAXED, __HIP_MEMORY_SCOPE_WORKGROUP); __hip_atomic_fetch_add((LAS int*)&hist[i1], 1, __ATOMIC_RELAXED, __HIP_MEMORY_SCOPE_WORKGROUP); }
        }
    }
    if (l == 1) { __syncthreads(); if (F.tid < 8) __hip_atomic_fetch_add((unsigned*)(F.ctl() + CW_MOECNT + 64 * F.tid), (unsigned)hist[F.tid], RLX_AGENT); }
}
__device__ __forceinline__ void phase_moe_assign(const Frame& F) {
    volatile LAS int* L = (volatile LAS int*)(F.lds + 1024);
    int* tok = (int*)(F.ws + WS_MOE + MO_TOK); int* dst = (int*)(F.ws + WS_MOE + MO_DST); int* tile_e = (int*)(F.ws + WS_MOE + MO_SEL + (size_t)RL * 16); int* ntl = tile_e + 512;
    if (F.tid < 8) L[F.tid] = 0;
    if (F.tid == 0) { int base = 0;
        for (int e = 0; e < 8; ++e) { const int c = (int)__hip_atomic_load((unsigned*)(F.ctl() + CW_MOECNT + 64 * e), RLX_AGENT); const int tl = (c + 255) >> 8; L[16 + e] = base * 256; L[24 + e] = c;
            if (blockIdx.x == 0) for (int q = 0; q < tl; ++q) tile_e[base + q] = e;
            base += tl; }
        if (blockIdx.x == 0) ntl[0] = base; }
    __syncthreads();
    const int wg = F.vcu; int e = 0, rank = 0, token = 0, k = 0; const bool act = F.tid < 256 && wg * 128 < RL;
    for (int w0 = wg; w0 * 128 < RL; w0 += F.G) {
        if (F.tid < 256) { token = w0 * 128 + (F.tid >> 1); k = F.tid & 1; e = ((const int*)(F.ws + WS_MOE + MO_SEL))[(size_t)token * 4 + k]; rank = __hip_atomic_fetch_add((LAS int*)&L[e], 1, __ATOMIC_RELAXED, __HIP_MEMORY_SCOPE_WORKGROUP); }
        __syncthreads();
        if (F.tid < 8) { L[8 + F.tid] = (int)__hip_atomic_fetch_add((unsigned*)(F.ctl() + CW_MOECUR + 64 * F.tid), (unsigned)L[F.tid], RLX_AGENT); }
        __syncthreads();
        if (F.tid < 256) { const int slot = L[16 + e] + L[8 + e] + rank; tok[slot] = token; dst[slot] = token * 2 + k; }
        __syncthreads();
        if (F.tid < 8) L[F.tid] = 0;
        __syncthreads();
    }
    (void)act;
    if (wg < 8) { const int c = L[24 + wg], tl = (c + 255) >> 8, b = L[16 + wg]; for (int s = c + F.tid; s < tl * 256; s += 512) { tok[b + s] = 0; dst[b + s] = -1; } }
}
__device__ __forceinline__ void phase_final(const Frame& F, int l) {
    const int gw = F.vcu * NWAVES + F.wave, NGW = F.G * NWAVES, lane = F.lane;
    if (l == 0) {
        Row16 nx; if (gw < R) nx = ld_row(F.XM() + (size_t)gw * D, lane);
        for (int r = gw; r < R; r += NGW) {
            Row16 x = nx; if (r + NGW < R) nx = ld_row(F.XM() + (size_t)(r + NGW) * D, lane);
            if (r >= RL) { const float* dp = (const float*)(F.ws + WS_DP) + (size_t)(r - RL) * D; const Row16 p0 = ld_row(dp, lane), p1 = ld_row(dp + (size_t)512 * D, lane), g5 = ld_row(ada_vec(F, 0, 2, 5), lane);
#pragma unroll
                for (int j = 0; j < 4; ++j) x.v[j] = x.v[j] * ALPHA + g5.v[j] * (p0.v[j] + p1.v[j]); }
            ln_norm(x); affine(x, F.in[I_LN2G], F.in[I_LN2B], lane, false);
            st_row(r < RL ? F.out + (size_t)r * D : F.XC() + (size_t)(r - RL) * D, lane, x);
            ln_norm(x); const int s = set_of_row(r); affine(x, ada_vec(F, 1, s, 1), ada_vec(F, 1, s, 0), lane, true);
            st_row_bf16(F.H() + (size_t)r * D, lane, x); }
    } else {
        Row16 nx; v2u na[4], nb[4]; float nw0 = 0.f, nw1 = 0.f;
#define FIN_LOAD(rr) do { const int* sel_ = (const int*)(F.ws + WS_MOE + MO_SEL) + (size_t)(rr) * 4; nw0 = ((const float*)sel_)[2]; nw1 = ((const float*)sel_)[3]; \
            const bf16* d0_ = (const bf16*)F.out + (size_t)(rr) * 2 * D; const GAS v2u* q0_ = (const GAS v2u*)d0_ + lane; const GAS v2u* q1_ = (const GAS v2u*)(d0_ + D) + lane; \
            nx = ld_row(F.XM() + (size_t)(rr) * D, lane); _Pragma("unroll") for (int j = 0; j < 4; ++j) { na[j] = q0_[64 * j]; nb[j] = q1_[64 * j]; } } while (0)
        if (gw < RL) FIN_LOAD(gw);
        for (int r = gw; r < RL; r += NGW) {
            Row16 x = nx; v2u a4[4], b4[4]; const float w0 = nw0, w1 = nw1;
#pragma unroll
            for (int j = 0; j < 4; ++j) { a4[j] = na[j]; b4[j] = nb[j]; }
            if (r + NGW < RL) FIN_LOAD(r + NGW);
            const Row16 g5 = ld_row(ada_vec(F, 1, set_of_row(r), 5), lane);
#pragma unroll
            for (int j = 0; j < 4; ++j) { const v2u a = a4[j], b = b4[j];
                f32x4 f; f.x = w0 * bflo(a.x) + w1 * bflo(b.x); f.y = w0 * bfhi(a.x) + w1 * bfhi(b.x); f.z = w0 * bflo(a.y) + w1 * bflo(b.y); f.w = w0 * bfhi(a.y) + w1 * bfhi(b.y);
                x.v[j] = x.v[j] * ALPHA + g5.v[j] * f; }
            ln_norm(x); affine(x, F.in[I_LN2G] + D, F.in[I_LN2B] + D, lane, false);
            st_row(F.out + (size_t)r * D, lane, x); }
#undef FIN_LOAD
    }
}
__device__ __forceinline__ void lds_barrier() { asm volatile("s_waitcnt lgkmcnt(0)\n\ts_barrier" ::: "memory"); }
constexpr int PT = 72;
typedef LAS bf16* ltile;
__device__ __forceinline__ bf16x8 ldfrag(const LAS bf16* t, int row, int k0, int pitch) { return *(const LAS bf16x8*)(t + row * pitch + k0); }
template <int KD, int PX, int PY>
__device__ __forceinline__ f32x4 mmt(f32x4 acc, const LAS bf16* X, int x0, const LAS bf16* Y, int y0, int fr, int fq) {
#pragma unroll
    for (int kk = 0; kk < KD; kk += 32) acc = __builtin_amdgcn_mfma_f32_16x16x32_bf16(ldfrag(X, x0 + fr, kk + 8 * fq, PX), ldfrag(Y, y0 + fr, kk + 8 * fq, PY), acc, 0, 0, 0);
    return acc;
}
typedef short s16x4_t __attribute__((ext_vector_type(4)));
__device__ __forceinline__ bf16x8 ldfrag_tr(const LAS bf16* X, int k0, int n0, int pitch, int lane) {
    const int fq = lane >> 4, q = (lane & 15) >> 2, p = lane & 3;
    const LAS bf16* a = X + (k0 + 8 * fq + q) * pitch + n0 + 4 * p;
    const s16x4_t lo = __builtin_bit_cast(s16x4_t, __builtin_amdgcn_ds_read_tr16_b64_v4i16((LAS s16x4_t*)a));
    const s16x4_t hi = __builtin_bit_cast(s16x4_t, __builtin_amdgcn_ds_read_tr16_b64_v4i16((LAS s16x4_t*)(a + 4 * pitch)));
    return (bf16x8){lo[0], lo[1], lo[2], lo[3], hi[0], hi[1], hi[2], hi[3]};
}
template <int KD, int PX, int PY>
__device__ __forceinline__ f32x4 mmt_tx(f32x4 acc, const LAS bf16* XR, int x0, const LAS bf16* Y, int y0, int fr, int fq, int lane) {
#pragma unroll
    for (int kk = 0; kk < KD; kk += 32) acc = __builtin_amdgcn_mfma_f32_16x16x32_bf16(ldfrag_tr(XR, kk, x0, PX, lane), ldfrag(Y, y0 + fr, kk + 8 * fq, PY), acc, 0, 0, 0);
    return acc;
}
template <int KD, int PX, int PY>
__device__ __forceinline__ f32x4 mmt_txy(f32x4 acc, const LAS bf16* XR, int x0, const LAS bf16* YR, int y0, int lane) {
#pragma unroll
    for (int kk = 0; kk < KD; kk += 32) acc = __builtin_amdgcn_mfma_f32_16x16x32_bf16(ldfrag_tr(XR, kk, x0, PX, lane), ldfrag_tr(YR, kk, y0, PY, lane), acc, 0, 0, 0);
    return acc;
}
__device__ __forceinline__ float wave_incl_scan_add(float v, int lane) {
#pragma unroll
    for (int o = 1; o < 64; o <<= 1) { const float u = __shfl_up(v, o); if (lane >= o) v += u; }
    return v; }
__device__ __forceinline__ float wave_incl_scan_max(float v, int lane) {
#pragma unroll
    for (int o = 1; o < 64; o <<= 1) { const float u = __shfl_up(v, o); if (lane >= o) v = fmaxf(v, u); }
    return v; }
__device__ __forceinline__ float wave_max(float v) {
#pragma unroll
    for (int o = 1; o < 64; o <<= 1) v = fmaxf(v, __shfl_xor(v, o));
    return v; }

constexpr int DIRB = 65536;
constexpr int L_QS = 0, L_KS = 9216, L_VT = 18432, L_WS = 27648, L_CS = 36864, L_VEC = 48384, L_AF = 49408, L_PRE = 53504, L_G = 27648, L_HB = 0;
struct ScanPtrs { bf16* Cst; float* Nst; float* Amx; float* Bl; float* Mst; bf16* Gst; float* Gld; };
__device__ __forceinline__ int chunk_row0(int b, int tc) { return tc < 4 ? RL + b * CTX + tc * 64 : b * T + (tc - 4) * 64; }
__device__ __forceinline__ int chunk_pos(int tc, int d) { return d == 0 ? tc : (tc < 4 ? 3 - tc : 263 - tc); }

struct ScanRegs { v4u q0, q1, k0, k1, v0, v1, st0, st1; f32x4 nv0, nv1, af; v2u og0, og1, og2, og3; float gi, gf, mc; };
#define SR_SEL2(R, f, rep) ((rep) == 0 ? (R).f##0 : (R).f##1)
struct UnitId { int fam, b, head, tc; };
__device__ __forceinline__ bool unit_decode(int u, UnitId& id) { if (u >= 2 * 2080) return false; id.fam = u & 1; const int rem = u >> 1; id.b = rem / 1040; id.head = (rem / 260) & 3; id.tc = rem % 260; return true; }
template <bool OUT>
__device__ __forceinline__ void scan_fetch(const Frame& F, int l, const UnitId& id, const ScanPtrs& sp, ScanRegs& R_) {
    const int tid = F.tid, d = tid >> 8, ht = tid & 255, lane = F.lane, hw = F.wave & 3;
    const int row0 = chunk_row0(id.b, id.tc), pos = chunk_pos(id.tc, d), chain = (id.b * 4 + id.head) * 2 + d; const size_t slot = (size_t)chain * NCH + pos;
    const bool ml = id.fam == 0;
#define SF_ONE(rep, QF, KF, VF, SF) { const int q = ht + 256 * rep, i = q >> 3, c8 = q & 7, tok = d ? 63 - i : i; \
        const bf16* rp = F.P() + (size_t)(row0 + tok) * NP + id.head * 64 + c8 * 8; \
        if (OUT) R_.QF = *(const v4u*)(rp + (ml ? TC_MLQ : TC_GLQ)); \
        R_.KF = *(const v4u*)(rp + (ml ? TC_MLK : TC_GLK)); R_.VF = *(const v4u*)(rp + (ml ? TC_MLV : TC_GLV)); \
        if (OUT) { const bf16* Cg = (ml ? sp.Cst : sp.Gst) + slot * 4096; R_.SF = *(const v4u*)(Cg + (q >> 3) * 64 + c8 * 8); } }
    SF_ONE(0, q0, k0, v0, st0) SF_ONE(1, q1, k1, v1, st1)
#undef SF_ONE
    { const int tok = d ? 63 - lane : lane; const float* sm = F.SM() + (size_t)(row0 + tok) * SMP + d * 8 + id.head; R_.gi = sm[0]; R_.gf = sm[4]; }
    R_.mc = 0.f; R_.nv0 = (f32x4){0.f, 0.f, 0.f, 0.f}; R_.nv1 = R_.nv0;
    if (OUT) { R_.mc = sp.Mst[slot]; const float* np_ = sp.Nst + slot * 64 + (ht & 7) * 8; R_.nv0 = *(const f32x4*)np_; R_.nv1 = *(const f32x4*)(np_ + 4); }
    { const int i = ht >> 2, q4 = ht & 3, tok = d ? 63 - i : i; R_.af = *(const f32x4*)(F.SM() + (size_t)(row0 + tok) * SMP + 16 + d * 16 + q4 * 4); }
    R_.og0 = (v2u){0u, 0u}; R_.og1 = R_.og0; R_.og2 = R_.og0; R_.og3 = R_.og0;
    if (!OUT) { R_.q0 = (v4u){0u, 0u, 0u, 0u}; R_.q1 = R_.q0; R_.st0 = R_.q0; R_.st1 = R_.q0; }
    if (OUT) { const int fr = lane & 15, fq = lane >> 4, t = 16 * hw + fr; const bf16* op = F.P() + (size_t)(row0 + t) * NP + (ml ? TC_MLO : TC_GLR) + id.head * 64;
        R_.og0 = *(const v2u*)(op + 4 * fq); R_.og1 = *(const v2u*)(op + 16 + 4 * fq); R_.og2 = *(const v2u*)(op + 32 + 4 * fq); R_.og3 = *(const v2u*)(op + 48 + 4 * fq); }
}
__device__ __forceinline__ void gla_build_g(const Frame& F, int l, int head, int d, const f32x4 af, LAS unsigned char* base, int ht) {
    LAS float* AF = (LAS float*)(base + L_AF); LAS float* G = (LAS float*)(base + L_G); LAS float* PRE = (LAS float*)(base + L_PRE);
    { const int i = ht >> 2, q4 = ht & 3; *(LAS f32x4*)(AF + i * 16 + q4 * 4) = af; }
    lds_barrier();
    const int k = ht & 63, tq = ht >> 6;
    const float* w2 = F.in[I_GLW2] + ((size_t)(l * 2 + d) * 16) * 256 + head * 64 + k; const float bb = F.in[I_GLB2][(size_t)(l * 2 + d) * 256 + head * 64 + k];
    float w[16];
#pragma unroll
    for (int r = 0; r < 16; ++r) w[r] = w2[(size_t)r * 256];
    float run = 0.f;
#pragma unroll 4
    for (int ii = 0; ii < 16; ++ii) { const int i = 16 * tq + ii; float a = bb;
        const f32x4 f0 = *(const LAS f32x4*)(AF + i * 16), f1 = *(const LAS f32x4*)(AF + i * 16 + 4), f2 = *(const LAS f32x4*)(AF + i * 16 + 8), f3 = *(const LAS f32x4*)(AF + i * 16 + 12);
        a += f0.x * w[0] + f0.y * w[1] + f0.z * w[2] + f0.w * w[3]; a += f1.x * w[4] + f1.y * w[5] + f1.z * w[6] + f1.w * w[7];
        a += f2.x * w[8] + f2.y * w[9] + f2.z * w[10] + f2.w * w[11]; a += f3.x * w[12] + f3.y * w[13] + f3.z * w[14] + f3.w * w[15];
        run += logsig(a) * (1.f / 16.f); G[i * 65 + k] = run; }
    PRE[tq * 64 + k] = run;
    lds_barrier();
    float off = 0.f;
#pragma unroll
    for (int q = 0; q < 3; ++q) off += (q < tq) ? PRE[q * 64 + k] : 0.f;
    if (tq > 0) { for (int ii = 0; ii < 16; ++ii) G[(16 * tq + ii) * 65 + k] += off; }
    lds_barrier();
}
__device__ __forceinline__ void ml_gates(const Frame& F, int l, int head, int d, float gi, float gf, int lane, float& a, float& bcum) {
    const float* gb = F.in[I_MLGB] + (size_t)l * 16 + d * 8 + head;
    const float li = gi + gb[0], lf = logsig(gf + gb[4]);
    bcum = wave_incl_scan_add(lf, lane); a = li - bcum;
}
template <bool IS_ML>
__device__ __forceinline__ void scan_local_unit(const Frame& F, int l, int b, int head, int tc, const ScanPtrs& sp, const ScanRegs& R_) {
    const int tid = F.tid, d = tid >> 8, ht = tid & 255, hw = F.wave & 3, lane = F.lane, fr = lane & 15, fq = lane >> 4;
    LAS unsigned char* base = F.lds + d * DIRB;
    LAS bf16* Kt = (LAS bf16*)(base + L_KS); LAS bf16* Vt = (LAS bf16*)(base + L_VT); LAS float* vec = (LAS float*)(base + L_VEC);
    const int pos = chunk_pos(tc, d), chain = (b * 4 + head) * 2 + d; const size_t slot = (size_t)chain * NCH + pos;
    if constexpr (IS_ML) {
        if (hw == 0) { float a, bc; ml_gates(F, l, head, d, R_.gi, R_.gf, lane, a, bc); const float amax = wave_max(a); vec[lane] = __expf(a - amax);
            if (lane == 63) { sp.Amx[slot] = amax; sp.Bl[slot] = bc; } }
        lds_barrier();
    } else { gla_build_g(F, l, head, d, R_.af, base, ht); }
    const LAS float* G = (const LAS float*)(base + L_G);
#pragma unroll
    for (int rep = 0; rep < 2; ++rep) { const int q = ht + 256 * rep, i = q >> 3, c8 = q & 7;
        float kx[8], vx[8]; unpack8(SR_SEL2(R_, k, rep), kx); unpack8(SR_SEL2(R_, v, rep), vx);
        const float wsi = IS_ML ? vec[i] : 1.f;
#pragma unroll
        for (int e = 0; e < 8; ++e) { kx[e] = IS_ML ? kx[e] * 0.125f : kx[e] * __expf(-G[i * 65 + c8 * 8 + e]); vx[e] *= wsi; }
        *(LAS v4u*)(Kt + i * PT + c8 * 8) = pack8(kx); *(LAS v4u*)(Vt + i * PT + c8 * 8) = pack8(vx); }
    if (!IS_ML && ht < 64) sp.Gld[slot * 64 + ht] = __expf(G[63 * 65 + ht]);
    lds_barrier();
    bf16* Cg = (IS_ML ? sp.Cst : sp.Gst) + slot * 4096;
#pragma unroll
    for (int kt = 0; kt < 4; ++kt) { f32x4 acc = {0.f, 0.f, 0.f, 0.f}; acc = mmt_txy<64, PT, PT>(acc, Kt, 16 * kt, Vt, 16 * hw, lane);
        v2u w; w.x = pk2(acc[0], acc[1]); w.y = pk2(acc[2], acc[3]); *(v2u*)(Cg + (size_t)(16 * hw + fr) * 64 + 16 * kt + 4 * fq) = w; }
    if (IS_ML && ht < 64) { float s_ = 0.f; for (int i = 0; i < 64; ++i) s_ += bf2f(Kt[i * PT + ht]) * vec[i]; sp.Nst[slot * 64 + ht] = s_; }
    lds_barrier();
}
template <bool IS_ML>
__device__ __forceinline__ void scan_chain(const Frame& F, int chain, const ScanPtrs& sp, bool dry = false) {
    const int tid = F.tid, k0 = (tid & 7) * 8;
    LAS float* LA = (LAS float*)(F.lds);
    if constexpr (IS_ML) { for (int p = tid; p < NCH; p += 512) { LA[p] = sp.Amx[(size_t)chain * NCH + p]; LA[512 + p] = sp.Bl[(size_t)chain * NCH + p]; } }
    else { for (int q = tid; q < NCH * 16; q += 512) *(LAS f32x4*)(LA + q * 4) = *(const f32x4*)(sp.Gld + (size_t)chain * NCH * 64 + q * 4); }
    __syncthreads();
    float S[8]; float nst = 0.f, m = 0.f;
#pragma unroll
    for (int e = 0; e < 8; ++e) S[e] = 0.f;
    bf16* Cb = (IS_ML ? sp.Cst : sp.Gst) + (size_t)chain * NCH * 4096 + (size_t)tid * 8;
    constexpr int GS = 13;
    v4u cn[GS]; float nn[GS];
#pragma unroll
    for (int j = 0; j < GS; ++j) nn[j] = 0.f;
#define SC_LOAD(g) do { _Pragma("unroll") for (int j = 0; j < GS; ++j) { cn[j] = *(const v4u*)(Cb + (size_t)((g) * GS + j) * 4096); \
        if constexpr (IS_ML) { if (tid < 64) nn[j] = sp.Nst[((size_t)chain * NCH + (g) * GS + j) * 64 + tid]; } } } while (0)
    SC_LOAD(0);
    for (int g = 0; g < NCH / GS; ++g) {
        v4u cc[GS]; float nc[GS];
#pragma unroll
        for (int j = 0; j < GS; ++j) { cc[j] = cn[j]; nc[j] = nn[j]; }
        if (g + 1 < NCH / GS) SC_LOAD(g + 1);
#pragma unroll
        for (int j = 0; j < GS; ++j) { const int pp = g * GS + j; const size_t p = (size_t)chain * NCH + pp;
            if (!dry) *(v4u*)(Cb + (size_t)pp * 4096) = pack8(S);
            float x[8]; unpack8(cc[j], x);
            if constexpr (IS_ML) {
                if (tid < 64 && !dry) sp.Nst[p * 64 + tid] = nst;
                if (tid == 0 && !dry) sp.Mst[p] = m;
                const float am = LA[pp], bl = LA[512 + pp];
                const float mx = fmaxf(m, am), fa = __expf(m - mx), fb = __expf(am - mx);
#pragma unroll
                for (int e = 0; e < 8; ++e) S[e] = fa * S[e] + fb * x[e];
                nst = fa * nst + fb * nc[j]; m = bl + mx;
            } else {
                const f32x4 e0 = *(const LAS f32x4*)(LA + pp * 64 + k0), e1 = *(const LAS f32x4*)(LA + pp * 64 + k0 + 4);
                const float dd[8] = {e0.x, e0.y, e0.z, e0.w, e1.x, e1.y, e1.z, e1.w};
#pragma unroll
                for (int e = 0; e < 8; ++e) S[e] = dd[e] * (S[e] + x[e]);
            }
        }
    }
#undef SC_LOAD
    if (dry && S[0] == 1.2345e-33f) sp.Mst[0] = nst + m;
    __syncthreads();
}
template <bool IS_ML>
__device__ __forceinline__ void scan_out_unit(const Frame& F, int l, int b, int head, int tc, const ScanPtrs& sp, const ScanRegs& R_, bool dry = false) {
    const int tid = F.tid, d = tid >> 8, ht = tid & 255, hw = F.wave & 3, lane = F.lane, fr = lane & 15, fq = lane >> 4;
    LAS unsigned char* base = F.lds + d * DIRB;
    LAS bf16* Qs = (LAS bf16*)(base + L_QS); LAS bf16* Ks = (LAS bf16*)(base + L_KS); LAS bf16* Vt = (LAS bf16*)(base + L_VT); LAS bf16* Ws = (LAS bf16*)(base + L_WS); LAS bf16* Cs = (LAS bf16*)(base + L_CS);
    LAS float* vec = (LAS float*)(base + L_VEC);
    const int row0 = chunk_row0(b, tc), pos = chunk_pos(tc, d), chain = (b * 4 + head) * 2 + d; const size_t slot = (size_t)chain * NCH + pos;
    float m_c = 0.f;
    if constexpr (IS_ML) {
        m_c = R_.mc;
        if (hw == 0) { float a, bc; ml_gates(F, l, head, d, R_.gi, R_.gf, lane, a, bc); const float cm = wave_incl_scan_max(a, lane); vec[lane] = a; vec[64 + lane] = fmaxf(m_c, cm); vec[128 + lane] = bc; }
    } else { gla_build_g(F, l, head, d, R_.af, base, ht); }
    const LAS float* G = (const LAS float*)(base + L_G);
#pragma unroll
    for (int rep = 0; rep < 2; ++rep) { const int q = ht + 256 * rep, i = q >> 3, c8 = q & 7;
        float qx[8], kx[8], vx[8]; unpack8(SR_SEL2(R_, q, rep), qx); unpack8(SR_SEL2(R_, k, rep), kx); unpack8(SR_SEL2(R_, v, rep), vx);
#pragma unroll
        for (int e = 0; e < 8; ++e) {
            if constexpr (IS_ML) { kx[e] *= 0.125f; } else { const float g = G[i * 65 + c8 * 8 + e]; qx[e] *= 0.125f * __expf(g); kx[e] *= __expf(-g); }
        }
        *(LAS v4u*)(Qs + i * PT + c8 * 8) = pack8(qx); *(LAS v4u*)(Ks + i * PT + c8 * 8) = pack8(kx); *(LAS v4u*)(Vt + i * PT + c8 * 8) = pack8(vx); }
    if constexpr (!IS_ML) lds_barrier();
    {
#pragma unroll
        for (int rep = 0; rep < 2; ++rep) { const int q = ht + 256 * rep, v = q >> 3, c8 = q & 7; *(LAS v4u*)(Cs + v * PT + c8 * 8) = SR_SEL2(R_, st, rep); }
        if constexpr (IS_ML) { if (ht < 128) { const int rr = 64 + (ht >> 3), c8 = ht & 7; const bool isn = (rr == 64);
            const float x[8] = {isn ? R_.nv0.x : 0.f, isn ? R_.nv0.y : 0.f, isn ? R_.nv0.z : 0.f, isn ? R_.nv0.w : 0.f, isn ? R_.nv1.x : 0.f, isn ? R_.nv1.y : 0.f, isn ? R_.nv1.z : 0.f, isn ? R_.nv1.w : 0.f};
            *(LAS v4u*)(Cs + rr * PT + c8 * 8) = pack8(x); } }
    }
    lds_barrier();
    const int t = 16 * hw + fr; float rs = 0.f;
    const float Mt = IS_ML ? vec[64 + t] : 0.f;
#pragma unroll
    for (int st = 0; st < 4; ++st) {
        v2u w; w.x = 0u; w.y = 0u;
        if (st <= hw) { f32x4 acc = {0.f, 0.f, 0.f, 0.f}; acc = mmt<64, PT, PT>(acc, Ks, 16 * st, Qs, 16 * hw, fr, fq);
            float o[4];
#pragma unroll
            for (int r = 0; r < 4; ++r) { const int s = 16 * st + 4 * fq + r; float wg = (s <= t) ? 1.f : 0.f; if constexpr (IS_ML) wg = (s <= t) ? __expf(vec[s] - Mt) : 0.f; o[r] = wg * acc[r]; rs += o[r]; }
            w.x = pk2(o[0], o[1]); w.y = pk2(o[2], o[3]); }
        *(LAS v2u*)(Ws + t * PT + 16 * st + 4 * fq) = w; }
    rs += __shfl_xor(rs, 16); rs += __shfl_xor(rs, 32);
    float h[4][4]; float wi = 1.f, dn = 1.f;
    if constexpr (IS_ML) { f32x4 an = {0.f, 0.f, 0.f, 0.f}; an = mmt<64, PT, PT>(an, Cs, 64, Qs, 16 * hw, fr, fq); const float nq = __shfl(an[0], fr);
        wi = __expf(m_c - Mt); const float den = rs + wi * nq; dn = 1.f / fmaxf(fabsf(den), __expf(-(vec[128 + t] + Mt))); }
#pragma unroll
    for (int vt = 0; vt < 4; ++vt) { f32x4 ai = {0.f, 0.f, 0.f, 0.f}, ac = {0.f, 0.f, 0.f, 0.f};
        ai = mmt_tx<64, PT, PT>(ai, Vt, 16 * vt, Ws, 16 * hw, fr, fq, lane); ac = mmt<64, PT, PT>(ac, Cs, 16 * vt, Qs, 16 * hw, fr, fq);
#pragma unroll
        for (int r = 0; r < 4; ++r) h[vt][r] = (ai[r] + wi * ac[r]) * dn; }
    lds_barrier();
    LAS float* HB = (LAS float*)(F.lds + DIRB + L_HB);
    if (d == 1) {
#pragma unroll
        for (int vt = 0; vt < 4; ++vt)
#pragma unroll
            for (int r = 0; r < 4; ++r) HB[(63 - t) * 65 + 16 * vt + 4 * fq + r] = h[vt][r]; }
    lds_barrier();
    if (d == 0) {
        float s1 = 0.f;
#pragma unroll
        for (int vt = 0; vt < 4; ++vt)
#pragma unroll
            for (int r = 0; r < 4; ++r) { h[vt][r] += HB[t * 65 + 16 * vt + 4 * fq + r]; s1 += IS_ML ? h[vt][r] : h[vt][r] * h[vt][r]; }
        s1 += __shfl_xor(s1, 16); s1 += __shfl_xor(s1, 32);
        float mean = 0.f, rstd;
        if constexpr (IS_ML) { mean = s1 * (1.f / 64.f); float s2 = 0.f;
#pragma unroll
            for (int vt = 0; vt < 4; ++vt)
#pragma unroll
                for (int r = 0; r < 4; ++r) { const float dd = h[vt][r] - mean; s2 += dd * dd; }
            s2 += __shfl_xor(s2, 16); s2 += __shfl_xor(s2, 32); rstd = 1.f / sqrtf(s2 * (1.f / 64.f) + LN_EPS);
        } else rstd = 1.f / sqrtf(s1 * (1.f / 64.f) + LN_EPS);
        const float* ng = F.in[IS_ML ? I_MLNG : I_GLNG] + (size_t)l * 256 + head * 64;
        bf16* op = F.P() + (size_t)(row0 + t) * NP + (IS_ML ? TC_MLO : TC_GLR) + head * 64;
#pragma unroll
        for (int vt = 0; vt < 4; ++vt) { const int c = 16 * vt + 4 * fq; const v2u gp = (vt == 0) ? R_.og0 : (vt == 1 ? R_.og1 : (vt == 2 ? R_.og2 : R_.og3)); const f32x4 gn = *(const f32x4*)(ng + c);
            const float gt[4] = {bflo(gp.x), bfhi(gp.x), bflo(gp.y), bfhi(gp.y)}; float y[4];
#pragma unroll
            for (int r = 0; r < 4; ++r) { const float gate = IS_ML ? sigm(gt[r]) : gt[r] * sigm(gt[r]); y[r] = (h[vt][r] - mean) * rstd * gn[r] * gate; }
            v2u w; w.x = pk2(y[0], y[1]); w.y = pk2(y[2], y[3]); if (!dry) *(v2u*)(op + c) = w; }
    }
    lds_barrier();
}
constexpr int DP = 136;
constexpr int LF_C = 0, LF_S = 34816, LF_XR = 69632, LF_XI = 69632 + 18432;
__device__ __forceinline__ void dft_load_mats(const Frame& F) {
    LAS bf16* CM = (LAS bf16*)(F.lds + LF_C); LAS bf16* SMt = (LAS bf16*)(F.lds + LF_S);
    const bf16* gc = (const bf16*)(F.ws + WS_DFT_C); const bf16* gs = (const bf16*)(F.ws + WS_DFT_S);
    for (int q = F.tid; q < 128 * 16; q += 512) { const int j = q >> 4, c8 = q & 15; *(LAS v4u*)(CM + j * DP + c8 * 8) = *(const v4u*)(gc + j * 128 + c8 * 8); *(LAS v4u*)(SMt + j * DP + c8 * 8) = *(const v4u*)(gs + j * 128 + c8 * 8); }
    __syncthreads();
}
template <int STEP>
__device__ __forceinline__ void dft_unit(const Frame& F, int b, int idx, int slab, bf16* IM1, bf16* FT, bool dry = false) {
    LAS bf16* CM = (LAS bf16*)(F.lds + LF_C); LAS bf16* SMt = (LAS bf16*)(F.lds + LF_S); LAS bf16* XR = (LAS bf16*)(F.lds + LF_XR); LAS bf16* XI = (LAS bf16*)(F.lds + LF_XI);
    const int tid = F.tid, lane = F.lane, fr = lane & 15, fq = lane >> 4, w = F.wave;
#pragma unroll
    for (int rep = 0; rep < 2; ++rep) { const int q = tid + 512 * rep, i = q >> 3, c8 = q & 7;
        const int row = (STEP == 1) ? b * T + 128 * i + idx : b * T + 128 * idx + i;
        *(LAS v4u*)(XR + i * PT + c8 * 8) = *(const v4u*)(F.P() + (size_t)row * NP + TC_FT + slab * 64 + c8 * 8);
        if (STEP == 2) *(LAS v4u*)(XI + i * PT + c8 * 8) = *(const v4u*)(IM1 + (size_t)row * 256 + slab * 64 + c8 * 8); }
    lds_barrier();
    const int j = 16 * w + fr;
    bf16x8 cf[4], sf[4];
#pragma unroll
    for (int kq = 0; kq < 4; ++kq) { cf[kq] = ldfrag(CM, 16 * w + fr, 32 * kq + 8 * fq, DP); sf[kq] = ldfrag(SMt, 16 * w + fr, 32 * kq + 8 * fq, DP); }
#pragma unroll
    for (int ct = 0; ct < 4; ++ct) {
        f32x4 dr = {0.f, 0.f, 0.f, 0.f}, p1 = {0.f, 0.f, 0.f, 0.f}, p2 = {0.f, 0.f, 0.f, 0.f};
#pragma unroll
        for (int kq = 0; kq < 4; ++kq) { const bf16x8 xr = ldfrag_tr(XR, 32 * kq, 16 * ct, PT, lane);
            dr = __builtin_amdgcn_mfma_f32_16x16x32_bf16(xr, cf[kq], dr, 0, 0, 0); p2 = __builtin_amdgcn_mfma_f32_16x16x32_bf16(xr, sf[kq], p2, 0, 0, 0);
            if (STEP == 2) { const bf16x8 xi = ldfrag_tr(XI, 32 * kq, 16 * ct, PT, lane);
                dr = __builtin_amdgcn_mfma_f32_16x16x32_bf16(xi, sf[kq], dr, 0, 0, 0); p1 = __builtin_amdgcn_mfma_f32_16x16x32_bf16(xi, cf[kq], p1, 0, 0, 0); } }
        float orr[4], oi[4];
        if (STEP == 1) { const float ph = (float)((j * idx) & 16383) * (1.f / 8192.f); const float cs = cospif(ph), sn = sinpif(ph);
#pragma unroll
            for (int r = 0; r < 4; ++r) { const float di = -p2[r]; orr[r] = dr[r] * cs + di * sn; oi[r] = di * cs - dr[r] * sn; }
            const int orow = b * T + 128 * j + idx;
            v2u wr_, wi_; wr_.x = pk2(orr[0], orr[1]); wr_.y = pk2(orr[2], orr[3]); wi_.x = pk2(oi[0], oi[1]); wi_.y = pk2(oi[2], oi[3]);
            if (!dry) { *(v2u*)(F.P() + (size_t)orow * NP + TC_FT + slab * 64 + 16 * ct + 4 * fq) = wr_; *(v2u*)(IM1 + (size_t)orow * 256 + slab * 64 + 16 * ct + 4 * fq) = wi_; }
        } else {
#pragma unroll
            for (int r = 0; r < 4; ++r) { orr[r] = dr[r] * (1.f / 128.f); oi[r] = (p1[r] - p2[r]) * (1.f / 128.f); }
            const int orow = b * T + idx + 128 * j;
            v2u wr_, wi_; wr_.x = pk2(orr[0], orr[1]); wr_.y = pk2(orr[2], orr[3]); wi_.x = pk2(oi[0], oi[1]); wi_.y = pk2(oi[2], oi[3]);
            if (!dry) { *(v2u*)(FT + (size_t)orow * 512 + slab * 64 + 16 * ct + 4 * fq) = wr_; *(v2u*)(FT + (size_t)orow * 512 + 256 + slab * 64 + 16 * ct + 4 * fq) = wi_; }
        } }
    lds_barrier();
}
__device__ __forceinline__ void ctx_dft(const Frame& F, bf16* FT, int widx, int nw) {
    LAS float* ct = (LAS float*)(F.lds + LF_XR); LAS float* st = ct + 256;
    if (F.tid < 256) { const float ph = (float)F.tid * (1.f / 128.f); ct[F.tid] = cospif(ph); st[F.tid] = sinpif(ph); }
    __syncthreads();
    for (int o = widx * 512 + F.tid; o < NB * 256 * 256; o += nw * 512) { const int col = o & 255, k = (o >> 8) & 255, b = o >> 16;
        const bf16* up = F.P() + (size_t)(RL + b * CTX) * NP + TC_FT + col; float re = 0.f, im = 0.f;
        for (int t = 0; t < 256; ++t) { const float u = bf2f(up[(size_t)t * NP]); const int a = (k * t) & 255; re += u * ct[a]; im -= u * st[a]; }
        bf16* op = FT + (size_t)(RL + b * CTX + k) * 512 + col; op[0] = (bf16)f2bf(re * 0.0625f); op[256] = (bf16)f2bf(im * 0.0625f); }
    __syncthreads();
}
namespace attn_body {
using bf16=__hip_bfloat16;
using bf16x8=__attribute__((ext_vector_type(8)))short;
using s16x4=__attribute__((ext_vector_type(4)))short;
using f32x16=__attribute__((ext_vector_type(16)))float;
using u32x4=__attribute__((ext_vector_type(4)))unsigned;
constexpr int D=64,DM=3072;
constexpr int NW=8,QBLK=32,QB=QBLK*NW,KVBLK=64;
constexpr int ATTN_PITCH=DM, ATTN_UNIT_ROWS=QB;
__device__ __forceinline__ int crow(int r,int hi){return (r&3)+8*(r>>2)+4*hi;}
#define SBAR() __builtin_amdgcn_sched_barrier(0)
__device__ __forceinline__ void cmask(f32x16&p0,f32x16&p1,int jb,int qrel,int hi){
  const float NEG=-INFINITY; int kb=64*jb+4*hi;
  #pragma unroll
  for(int r=0;r<16;++r){int kv=kb+(r&3)+8*(r>>2); if(kv>qrel)p0[r]=NEG; if(kv+32>qrel)p1[r]=NEG;}
}

constexpr int NSLOT=3, SLOTB=8192;
constexpr int LDS_K=0, LDS_V=NSLOT*SLOTB, LDS_WS=2*NSLOT*SLOTB, LDS_OST=LDS_WS+NW*64*4, LDS_BYTES=LDS_OST+NW*4096;
constexpr float C2=0.125f*1.4426950408889634f;
__device__ __forceinline__ void glds16(const void*gsrc,unsigned lds_dst){unsigned keep;
  asm volatile("s_mov_b32 %0, m0\n\ts_mov_b32 m0, %2\n\ts_nop 0\n\tglobal_load_lds_dwordx4 %1, off\n\ts_mov_b32 m0, %0":"=&s"(keep):"v"(gsrc),"s"(lds_dst):"memory");}
__device__ __forceinline__ float max3f(float a,float b,float c){float r;asm("v_max3_f32 %0, %1, %2, %3":"=v"(r):"v"(a),"v"(b),"v"(c));return r;}
__device__ __forceinline__ float max2f(float a,float b){float r;asm("v_max_f32_e32 %0, %1, %2":"=v"(r):"v"(a),"v"(b));return r;}
__device__ __forceinline__ float fadd_s(float a,float b){float r;asm("v_add_f32_e32 %0, %1, %2":"=v"(r):"v"(a),"v"(b));return r;}
__device__ __forceinline__ float fsub_s(float a,float b){float r;asm("v_sub_f32_e32 %0, %1, %2":"=v"(r):"v"(a),"v"(b));return r;}
typedef float f32x2_t __attribute__((ext_vector_type(2))); typedef __bf16 bf16x2_t __attribute__((ext_vector_type(2)));
__device__ __forceinline__ unsigned cvtpk_s(float lo,float hi){f32x2_t v={lo,hi};bf16x2_t b=__builtin_convertvector(v,bf16x2_t);return __builtin_bit_cast(unsigned,b);}
#define WAIT_BAR(N) asm volatile("s_waitcnt vmcnt(" #N ") lgkmcnt(0)\n\ts_barrier":::"memory")

__device__ __forceinline__ void qkt(f32x16&p0,f32x16&p1,const char*Kslot,const bf16x8*qr,const f32x16&negm,int r32,int hi){
  const char*kb=Kslot+hi*1024+r32*16;
  #pragma unroll
  for(int d0=0;d0<4;++d0){
    const bf16x8 b0=*reinterpret_cast<const bf16x8*>(kb+d0*2048);
    const bf16x8 b1=*reinterpret_cast<const bf16x8*>(kb+d0*2048+512);
    if(d0==0){p0=__builtin_amdgcn_mfma_f32_32x32x16_bf16(b0,qr[0],negm,0,0,0);p1=__builtin_amdgcn_mfma_f32_32x32x16_bf16(b1,qr[0],negm,0,0,0);}
    else{p0=__builtin_amdgcn_mfma_f32_32x32x16_bf16(b0,qr[d0],p0,0,0,0);p1=__builtin_amdgcn_mfma_f32_32x32x16_bf16(b1,qr[d0],p1,0,0,0);}}
}
typedef __attribute__((address_space(3))) const char* lds_cptr;
typedef short v4i16_t __attribute__((ext_vector_type(4)));
__device__ __forceinline__ void kload8(bf16x8*kf,lds_cptr kp){
  kf[0]=*(const __attribute__((address_space(3))) bf16x8*)(kp);      kf[1]=*(const __attribute__((address_space(3))) bf16x8*)(kp+512);
  kf[2]=*(const __attribute__((address_space(3))) bf16x8*)(kp+2048); kf[3]=*(const __attribute__((address_space(3))) bf16x8*)(kp+2560);
  kf[4]=*(const __attribute__((address_space(3))) bf16x8*)(kp+4096); kf[5]=*(const __attribute__((address_space(3))) bf16x8*)(kp+4608);
  kf[6]=*(const __attribute__((address_space(3))) bf16x8*)(kp+6144); kf[7]=*(const __attribute__((address_space(3))) bf16x8*)(kp+6656);
}
__device__ __forceinline__ void kload2(bf16x8*kf,lds_cptr kp,int j){ kf[2*j]=*(const __attribute__((address_space(3))) bf16x8*)(kp+j*2048); kf[2*j+1]=*(const __attribute__((address_space(3))) bf16x8*)(kp+j*2048+512); }
__device__ __forceinline__ s16x4 vtr(lds_cptr p){ return __builtin_bit_cast(s16x4,__builtin_amdgcn_ds_read_tr16_b64_v4i16((__attribute__((address_space(3))) v4i16_t*)p)); }
__device__ __forceinline__ float rowmax(const f32x16&p0,const f32x16&p1){
  float a=max3f(p0[0],p0[1],p1[0]),b=max3f(p0[2],p0[3],p1[1]);a=max3f(a,p1[2],p1[3]);
  #pragma unroll
  for(int r=4;r<16;r+=4){a=max3f(a,p0[r],p0[r+1]);b=max3f(b,p0[r+2],p0[r+3]);a=max3f(a,p1[r],p1[r+1]);b=max3f(b,p1[r+2],p1[r+3]);}
  const float m=max2f(a,b);
  auto rr=__builtin_amdgcn_permlane32_swap(__float_as_uint(m),__float_as_uint(m),false,false);
  return max2f(__uint_as_float(rr[0]),__uint_as_float(rr[1]));
}
__device__ __forceinline__ void pv(f32x16*o,int vb,bf16x8 pa0,bf16x8 pa1,bf16x8 pa2,bf16x8 pa3){
  #pragma unroll
  for(int d0=0;d0<2;++d0){s16x4 lo[4],hi[4];
    #pragma unroll
    for(int ks=0;ks<4;++ks){
      asm volatile("ds_read_b64_tr_b16 %0,%1 offset:%c2":"=&v"(lo[ks]):"v"(vb),"i"(d0*4096+ks*1024):"memory");
      asm volatile("ds_read_b64_tr_b16 %0,%1 offset:%c2":"=&v"(hi[ks]):"v"(vb),"i"(d0*4096+ks*1024+512):"memory");}
    asm volatile("s_waitcnt lgkmcnt(0)":::"memory");SBAR();
    #define PK(k) (bf16x8){lo[k][0],lo[k][1],lo[k][2],lo[k][3],hi[k][0],hi[k][1],hi[k][2],hi[k][3]}
    o[d0]=__builtin_amdgcn_mfma_f32_32x32x16_bf16(pa0,PK(0),o[d0],0,0,0);
    o[d0]=__builtin_amdgcn_mfma_f32_32x32x16_bf16(pa1,PK(1),o[d0],0,0,0);
    o[d0]=__builtin_amdgcn_mfma_f32_32x32x16_bf16(pa2,PK(2),o[d0],0,0,0);
    o[d0]=__builtin_amdgcn_mfma_f32_32x32x16_bf16(pa3,PK(3),o[d0],0,0,0);
    #undef PK
  }
}

#ifndef ATTN_STORE16
#define ATTN_STORE16(p,v) (*(u32x4*)(p)=(v))
#endif
template<int THRL> __device__ __forceinline__ void attn_unit(const bf16*Qw0,const bf16*__restrict__ KL,const bf16*__restrict__ VL,const bf16*__restrict__ KC,const bf16*__restrict__ VC,int nlt,const int NT,bf16*Ow0,char*shm,const float MB){
  const int tid=threadIdx.x,lane=tid&63,r32=lane&31,hi=lane>>5; const int wid=__builtin_amdgcn_readfirstlane(tid>>6);
  const bf16*Qw=Qw0+(long)(wid*QBLK)*DM;
  const unsigned lds0=(unsigned)(uintptr_t)shm;
  float*wsf=(float*)(shm+LDS_WS)+wid*64;
  const long kvo_k=(long)lane*DM+wid*8; const bf16*ksrcL=KL+kvo_k; const bf16*ksrcC=KC+kvo_k-(long)nlt*KVBLK*DM;
  const long kvo_v=(long)(16*(wid&3)+(lane>>2))*DM+(wid>>2)*32+(lane&3)*8; const bf16*vsrcL=VL+kvo_v; const bf16*vsrcC=VC+kvo_v-(long)nlt*KVBLK*DM;
  const unsigned kdst=lds0+LDS_K+wid*1024, vdst=lds0+LDS_V+wid*1024;
  #define DMA_K(t,slot) glds16(((t)<nlt?ksrcL:ksrcC)+(long)(t)*KVBLK*DM,(unsigned)__builtin_amdgcn_readfirstlane(kdst+(slot)))
  #define DMA_V(t,slot) glds16(((t)<nlt?vsrcL:vsrcC)+(long)(t)*KVBLK*DM,(unsigned)__builtin_amdgcn_readfirstlane(vdst+(slot)))
  const int vb0=(int)(lds0+LDS_V)+((lane>>4)&1)*32+(lane&3)*8+(4*hi+((lane&15)>>2))*64;
  const char*Kbase=shm+LDS_K; bf16x8 kf[8];
  const lds_cptr shm3=(lds_cptr)shm; const lds_cptr kp0=shm3+LDS_K+hi*1024+r32*16; const lds_cptr vp0=shm3+LDS_V+((lane>>4)&1)*32+(lane&3)*8+(4*hi+((lane&15)>>2))*64;
  DMA_K(0,0);DMA_V(0,0);DMA_K(1,SLOTB);
  bf16x8 qr[4];
  #pragma unroll
  for(int d0=0;d0<4;++d0)qr[d0]=*reinterpret_cast<const bf16x8*>(&Qw[(long)r32*DM+d0*16+hi*8]);
  float l_reg=0.f;f32x16 o[2];o[0]=f32x16{};o[1]=f32x16{};f32x16 negm;
  #pragma unroll
  for(int r=0;r<16;++r)negm[r]=-MB;
  asm volatile("":"+v"(negm));
  #define CMASK(P0,P1,t) do{}while(0)
  #define START(P0,P1) do{ _Pragma("unroll") for(int r=0;r<16;++r)P0[r]=__builtin_amdgcn_exp2f(P0[r]); }while(0)
  #define RESC() do{}while(0)
  f32x16 pA0,pA1,pB0,pB1;
  int sl_prev=0,sl_cur=0,sl_next=SLOTB;
  #define ROT() do{sl_prev=sl_cur;sl_cur=sl_next;sl_next=(sl_next==(NSLOT-1)*SLOTB)?0:sl_next+SLOTB;}while(0)
  DMA_K(2,2*SLOTB);
  WAIT_BAR(3);
  qkt(pA0,pA1,Kbase,qr,negm,r32,hi);asm volatile("s_nop 15\n\ts_nop 7":"+v"(pA0),"+v"(pA1));CMASK(pA0,pA1,0);
  START(pA0,pA1);
  _Pragma("unroll") for(int r=0;r<16;++r)pA1[r]=__builtin_amdgcn_exp2f(pA1[r]);
  WAIT_BAR(0);
  DMA_K(3,0);DMA_V(1,SLOTB);
  ROT();
  kload8(kf,kp0+sl_cur);
  WAIT_BAR(2);
  s16x4 vlo[8],vhi[8]; u32x4 pw0,pw1,pw2,pw3;
  #define PKW(P,B) cvtpk_s(P[B],P[B+1])
  #define PAF(k) __builtin_bit_cast(bf16x8,pw##k)
  #define VFR(i) (bf16x8){vlo[i][0],vlo[i][1],vlo[i][2],vlo[i][3],vhi[i][0],vhi[i][1],vhi[i][2],vhi[i][3]}
  #define PIN(x) asm volatile("":"+v"(x))
  #define MX3(a,b,c) __builtin_fmaxf(__builtin_fmaxf((a),(b)),(c))
  #define GAPA(MF,A0,A1,A2,A3,W0,W1,PW) do{ MF; sacc+=A0; sacc+=A1; sacc+=A2; sacc+=A3; PIN(sacc); W0; W1; PIN(PW); SBAR(); }while(0)
  #define EX(v) __builtin_amdgcn_exp2f(v)
  #define GAPB(MF,X,B) do{ MF; X[B]=EX(X[B]); X[B+1]=EX(X[B+1]); X[B+2]=EX(X[B+2]); X[B+3]=EX(X[B+3]); PIN(X); SBAR(); }while(0)
  #define VRD(i) do{ vlo[i]=vtr(vp_+(((i)>>2)*4096+((i)&3)*1024)); vhi[i]=vtr(vp_+(((i)>>2)*4096+((i)&3)*1024+512)); }while(0)
  #define KRD(G,j) do{ if(G){ kload2(kf,kp0+sl_next,j); SBAR(); } }while(0)
  #define STEP(C0,C1,P0,P1,t,GK,GV,GL) do{ SBAR(); \
    const lds_cptr vp_=vp0+sl_prev; \
    VRD(0); SBAR(); float sacc=(P0[0]+P0[1]); \
    GAPA(C0=__builtin_amdgcn_mfma_f32_32x32x16_bf16(kf[0],qr[0],negm,0,0,0), P0[2],P0[3],P0[4],P0[5],     pw0[0]=PKW(P0,0), pw0[1]=PKW(P0,2), pw0); \
    VRD(4); SBAR(); GAPA(C1=__builtin_amdgcn_mfma_f32_32x32x16_bf16(kf[1],qr[0],negm,0,0,0), P0[6],P0[7],P0[8],P0[9],     pw0[2]=PKW(P0,4), pw0[3]=PKW(P0,6), pw0); \
    VRD(1); SBAR(); GAPA(C0=__builtin_amdgcn_mfma_f32_32x32x16_bf16(kf[2],qr[1],C0,0,0,0),   P0[10],P0[11],P0[12],P0[13], pw1[0]=PKW(P0,8), pw1[1]=PKW(P0,10), pw1); \
    VRD(5); SBAR(); GAPA(C1=__builtin_amdgcn_mfma_f32_32x32x16_bf16(kf[3],qr[1],C1,0,0,0),   P0[14],P0[15],P1[0],P1[1],   pw1[2]=PKW(P0,12),pw1[3]=PKW(P0,14), pw1); \
    VRD(2); SBAR(); GAPA(C0=__builtin_amdgcn_mfma_f32_32x32x16_bf16(kf[4],qr[2],C0,0,0,0),   P1[2],P1[3],P1[4],P1[5],     pw2[0]=PKW(P1,0), pw2[1]=PKW(P1,2), pw2); \
    VRD(6); SBAR(); GAPA(C1=__builtin_amdgcn_mfma_f32_32x32x16_bf16(kf[5],qr[2],C1,0,0,0),   P1[6],P1[7],P1[8],P1[9],     pw2[2]=PKW(P1,4), pw2[3]=PKW(P1,6), pw2); \
    VRD(3); SBAR(); GAPA(C0=__builtin_amdgcn_mfma_f32_32x32x16_bf16(kf[6],qr[3],C0,0,0,0),   P1[10],P1[11],P1[12],P1[13], pw3[0]=PKW(P1,8), pw3[1]=PKW(P1,10), pw3); \
    VRD(7); SBAR(); GAPA(C1=__builtin_amdgcn_mfma_f32_32x32x16_bf16(kf[7],qr[3],C1,0,0,0),   P1[14],P1[15],0.f,0.f,       pw3[2]=PKW(P1,12),pw3[3]=PKW(P1,14), pw3); \
    l_reg+=sacc; \
    if(GK){DMA_K((t)+3,sl_cur);} if(GV){DMA_V((t)+1,sl_next);} \
    CMASK(C0,C1,t); \
    SBAR(); \
    GAPB(o[0]=__builtin_amdgcn_mfma_f32_32x32x16_bf16(PAF(0),VFR(0),o[0],0,0,0), C0,0); \
    GAPB(o[1]=__builtin_amdgcn_mfma_f32_32x32x16_bf16(PAF(0),VFR(4),o[1],0,0,0), C0,4); \
    KRD(GL,0); GAPB(o[0]=__builtin_amdgcn_mfma_f32_32x32x16_bf16(PAF(1),VFR(1),o[0],0,0,0), C0,8); \
    KRD(GL,1); GAPB(o[1]=__builtin_amdgcn_mfma_f32_32x32x16_bf16(PAF(1),VFR(5),o[1],0,0,0), C0,12); \
    KRD(GL,2); GAPB(o[0]=__builtin_amdgcn_mfma_f32_32x32x16_bf16(PAF(2),VFR(2),o[0],0,0,0), C1,0); \
    KRD(GL,3); GAPB(o[1]=__builtin_amdgcn_mfma_f32_32x32x16_bf16(PAF(2),VFR(6),o[1],0,0,0), C1,4); \
    GAPB(o[0]=__builtin_amdgcn_mfma_f32_32x32x16_bf16(PAF(3),VFR(3),o[0],0,0,0), C1,8); \
    GAPB(o[1]=__builtin_amdgcn_mfma_f32_32x32x16_bf16(PAF(3),VFR(7),o[1],0,0,0), C1,12); \
    }while(0)
  int t=1;
  #undef CMASK
  #define CMASK(P0,P1,t) do{}while(0)
  for(;t+5<NT;t+=2){
    STEP(pB0,pB1,pA0,pA1,t,true,true,true);     WAIT_BAR(2); RESC(); ROT();
    STEP(pA0,pA1,pB0,pB1,t+1,true,true,true);   WAIT_BAR(2); RESC(); ROT();
  }
  #undef CMASK
  #define CMASK(P0,P1,t) do{}while(0)
  #define ENDW(tt) do{ if((tt)+3<NT){WAIT_BAR(2);} else if((tt)+2<NT){WAIT_BAR(1);} else {WAIT_BAR(0);} }while(0)
  for(;t+1<NT;t+=2){
    STEP(pB0,pB1,pA0,pA1,t,(t+3<NT),(t+1<NT),(t+1<NT));       ENDW(t);   RESC(); ROT();
    STEP(pA0,pA1,pB0,pB1,t+1,(t+4<NT),(t+2<NT),(t+2<NT));     ENDW(t+1); RESC(); ROT();
  }
  STEP(pB0,pB1,pA0,pA1,NT-1,false,false,false); RESC();
  { float sacc=pB0[0]+pB0[1]; _Pragma("unroll") for(int r=2;r<16;++r)sacc+=pB0[r]; _Pragma("unroll") for(int r=0;r<16;++r)sacc+=pB1[r]; l_reg+=sacc;
    pw0=(u32x4){PKW(pB0,0),PKW(pB0,2),PKW(pB0,4),PKW(pB0,6)};pw1=(u32x4){PKW(pB0,8),PKW(pB0,10),PKW(pB0,12),PKW(pB0,14)};pw2=(u32x4){PKW(pB1,0),PKW(pB1,2),PKW(pB1,4),PKW(pB1,6)};pw3=(u32x4){PKW(pB1,8),PKW(pB1,10),PKW(pB1,12),PKW(pB1,14)};
    SBAR(); pv(o,vb0+sl_cur,PAF(0),PAF(1),PAF(2),PAF(3)); }
  #undef PKW
  #undef PAF
  #undef VFR
  #undef PIN
  #undef MX3
  #undef GAPA
  #undef GAPB
  #undef EX
  #undef VRD
  #undef KRD
  #undef STEP
  #undef ENDW
  {auto rr=__builtin_amdgcn_permlane32_swap(__float_as_uint(l_reg),__float_as_uint(l_reg),false,false);l_reg=__uint_as_float(rr[0])+__uint_as_float(rr[1]);}
  if(hi==0)wsf[32+r32]=l_reg;asm volatile("s_waitcnt lgkmcnt(0)":::"memory");
  float rli[16];
  #pragma unroll
  for(int r=0;r<16;++r)rli[r]=__builtin_amdgcn_rcpf(wsf[32+crow(r,hi)]);
  bf16*Ow=Ow0+(long)(wid*QBLK)*DM;
  { bf16*stg=(bf16*)(shm+LDS_OST)+wid*2048;
    #pragma unroll
    for(int r=0;r<16;++r){const int orow=crow(r,hi);
      #pragma unroll
      for(int d0=0;d0<2;++d0)stg[orow*64+d0*32+r32]=__float2bfloat16(o[d0][r]*rli[r]);}
    asm volatile("s_waitcnt lgkmcnt(0)":::"memory");
    #pragma unroll
    for(int i=0;i<4;++i){const int row=i*8+(lane>>3),ch=lane&7; const u32x4 v=*(const u32x4*)(stg+row*64+ch*8); ATTN_STORE16(Ow+(long)row*DM+ch*8,v);} }
  asm volatile("s_waitcnt lgkmcnt(0)\n\ts_barrier":::"memory");
  #undef DMA_K
  #undef DMA_V
  #undef CMASK
  #undef START
  #undef RESC
  #undef ROT
}
constexpr int ATTN_LDS_BYTES=LDS_BYTES;
#undef SBAR
#undef WAIT_BAR
}

constexpr int PH_PER_LAYER = 11, PH_L0 = 2, N_PHASES = PH_L0 + 2 * PH_PER_LAYER;
__device__ __forceinline__ void phase_scale_rows(const Frame& F, int l, bool from_x) {
    const int gw = F.vcu * NWAVES + F.wave, NGW = F.G * NWAVES;
    for (int r = gw; r < R; r += NGW) { Row16 x = ld_row(from_x ? xin_row(F, l, r) : F.XM() + (size_t)r * D, F.lane);
#pragma unroll
        for (int j = 0; j < 4; ++j) x.v[j] = x.v[j] * ALPHA;
        st_row(F.XM() + (size_t)r * D, F.lane, x); }
}
__device__ __forceinline__ Frame make_frame(unsigned char* lds_, unsigned char* ws, float* out) {
    Frame F; F.lds = (LAS unsigned char*)lds_; F.MISC = (volatile LAS unsigned*)(F.lds + MISC_OFF);
    F.tid = opq_v((int)threadIdx.x); F.lane = F.tid & 63; F.wave = __builtin_amdgcn_readfirstlane(F.tid >> 6);
    F.G = opq_s((int)gridDim.x); { const int bx = opq_s((int)blockIdx.x); F.vcu = (F.G % 8 == 0) ? (bx % 8) * (F.G / 8) + bx / 8 : bx; }
    F.ws = opq(ws); F.out = opq(out); F.in.lds = F.lds; return F; }
#ifndef PHM
#define PHM 0xFF
#endif
#ifndef R_IN
#define R_IN 1
#endif
#ifndef R_LOC
#define R_LOC 1
#endif
#ifndef R_MRG
#define R_MRG 1
#endif
#ifndef R_OUT
#define R_OUT 1
#endif
#ifndef R_UP
#define R_UP 1
#endif
#ifndef R_ATT
#define R_ATT 0
#endif
#ifndef D_OUTU
#define D_OUTU 0
#endif
#ifndef D_CHAIN
#define D_CHAIN 0
#endif
#ifndef D_DFT
#define D_DFT 0
#endif
#ifndef D_QK
#define D_QK 0
#endif
#ifndef R_FIN0
#define R_FIN0 1
#endif
#ifndef R_PM0
#define R_PM0 1
#endif
#ifndef R_MDN
#define R_MDN 1
#endif
#ifndef X_BAR
#define X_BAR 0
#endif
#ifndef R_CONV
#define R_CONV 1
#endif
#ifndef R_PRO
#define R_PRO 1
#endif
#define MKF() Frame F = make_frame(lds, args.ws, args.out)
#define IN(k) (args.ph_lo <= (k) && (k) < args.ph_hi)
#define SEAM(k) do { if (IN(k) && IN((k) + 1)) { XcdBarrier bar_; bar_.bar = (unsigned*)((gu32*)(opq(args.ws) + WS_CTL) + CW_BAR) + args.li * XCD_BAR_WORDS; bar_.x = xb_xcc_id(); \
        bar_.st = (volatile LAS unsigned*)((LAS unsigned char*)lds + MISC_OFF) + 8; xcd_barrier(bar_); if (X_BAR) xcd_barrier(bar_); } } while (0)
#define xm (F.ws + WS_XM)
#define P_IM1 ((bf16*)(xm + XO_IM1))
#define P_FT ((bf16*)(xm + XO_FT))
#define MK_SP() ScanPtrs sp; sp.Cst = (bf16*)(xm + XO_MLC); sp.Gst = (bf16*)(xm + XO_GLS); sp.Nst = (float*)(F.ws + WS_SCAL + SC_MLN); sp.Amx = (float*)(F.ws + WS_SCAL + SC_MLA); sp.Bl = (float*)(F.ws + WS_SCAL + SC_MLB); sp.Mst = (float*)(F.ws + WS_SCAL + SC_MLM); sp.Gld = (float*)(F.ws + WS_SCAL + SC_GLD)

template <int l> __device__ __forceinline__ void layer_body(const Args& args, unsigned char* lds) {
        const int pb = PH_L0 + l * PH_PER_LAYER;
        if (IN(pb + 0)) {
#if DBG_LEVEL >= 3 && (PHM & 1)
            for (int rep = 0; rep < R_IN; ++rep) { SchedIn S; S.G = opq_s((int)gridDim.x); S.c = opq_s((int)blockIdx.x); S.ws = opq(args.ws);
            pg8::gemm_stream((LAS unsigned char*)lds, S); }
#endif
        }
        SEAM(pb + 0);
        if (IN(pb + 1)) {
#if DBG_LEVEL >= 3 && (PHM & 2)
            MKF(); MK_SP(); phase_qk(F, l); for (int rep = 0; rep < D_QK; ++rep) phase_qk(F, l, __builtin_amdgcn_readfirstlane(opq_v(1)) != 0);
            dft_load_mats(F);
            for (int u = F.vcu; u < 1024; u += F.G) dft_unit<1>(F, u >> 9, (u >> 2) & 127, u & 3, P_IM1, P_FT);
            for (int rep = 0; rep < D_DFT; ++rep) for (int u = F.vcu; u < 1024; u += F.G) dft_unit<1>(F, u >> 9, (u >> 2) & 127, u & 3, P_IM1, P_FT, __builtin_amdgcn_readfirstlane(opq_v(1)) != 0);
            __syncthreads();
            for (int rep = 0; rep < R_LOC; ++rep) {
                UnitId id, idn; ScanRegs RA, RB; int u = F.vcu; bool ok = unit_decode(u, id);
                if (ok) scan_fetch<false>(F, l, id, sp, RA);
                while (ok) { const int un = u + F.G; const bool okn = unit_decode(un, idn);
                    if (okn) scan_fetch<false>(F, l, idn, sp, RB);
                    if (id.fam == 0) scan_local_unit<true>(F, l, id.b, id.head, id.tc, sp, RA); else scan_local_unit<false>(F, l, id.b, id.head, id.tc, sp, RA);
                    RA = RB; id = idn; u = un; ok = okn; } }
#endif
        }
        SEAM(pb + 1);
        if (IN(pb + 2)) {
#if DBG_LEVEL >= 3 && (PHM & 4)
            MKF(); MK_SP(); const bool split = F.G > 64; const int nsc = split ? 32 : F.G;
            if (F.vcu < nsc) for (int rep = 0; rep <= D_CHAIN; ++rep) for (int c = F.vcu; c < 32; c += nsc) { const bool dry = __builtin_amdgcn_readfirstlane(opq_v(rep)) != 0; if (c < 16) scan_chain<true>(F, c, sp, dry); else scan_chain<false>(F, c - 16, sp, dry); }
            if (!split || F.vcu >= 32) { const int widx = split ? F.vcu - 32 : F.vcu, nw = split ? F.G - 32 : F.G;
                dft_load_mats(F);
                for (int rep = 0; rep <= D_DFT; ++rep) for (int u = widx; u < 1024; u += nw) dft_unit<2>(F, u >> 9, (u >> 2) & 127, u & 3, P_IM1, P_FT, __builtin_amdgcn_readfirstlane(opq_v(rep)) != 0);
                if (l == 0) ctx_dft(F, P_FT, widx, nw); }
#endif
        }
        SEAM(pb + 2);
        if (IN(pb + 3)) {
#if DBG_LEVEL >= 3 && (PHM & 24)
#if (PHM & 8)
            {   MKF(); typedef attn_body::bf16 abf; abf* Pb = (abf*)F.P();
                const float MB = fminf(C2Q * 64.f * wave_max(fabsf(F.in[I_GQQG][l * 64 + F.lane])) * wave_max(fabsf(F.in[I_GQKG][l * 64 + F.lane])), 40.f);
                for (int i = 0;; ++i) { const int U = i * F.G + F.vcu; if (U >= 1024) break;
                    const int combo = (U >> 6) & 3, hg = (U >> 8) & 3, qb = U & 63, b = combo >> 1, kvh = combo & 1, h = kvh * 4 + hg;
                    abf* q = Pb + (size_t)(b * T + qb * 256) * NP + TC_GQQ + h * 64; const abf* kl = Pb + (size_t)(b * T) * NP + TC_GQK + kvh * 64; const abf* kc = Pb + (size_t)(RL + b * CTX) * NP + TC_GQK + kvh * 64;
                    attn_body::attn_unit<8>(q, kl, kl + (TC_GQV - TC_GQK), kc, kc + (TC_GQV - TC_GQK), 256, 260, q, (char*)lds, MB); }
                for (int rep = 0; rep < R_ATT; ++rep)
                for (int i = 0;; ++i) { const int U = i * F.G + F.vcu; if (U >= 1024) break;
                    const int combo = (U >> 6) & 3, hg = (U >> 8) & 3, qb = U & 63, b = combo >> 1, kvh = combo & 1, h = kvh * 4 + hg;
                    abf* q = Pb + (size_t)(b * T + qb * 256) * NP + TC_MLQ + (h & 3) * 64; const abf* kl = Pb + (size_t)(b * T) * NP + TC_GQK + kvh * 64; const abf* kc = Pb + (size_t)(RL + b * CTX) * NP + TC_GQK + kvh * 64;
                    attn_body::attn_unit<8>(q, kl, kl + (TC_GQV - TC_GQK), kc, kc + (TC_GQV - TC_GQK), 256, 260, Pb + (size_t)(b * T + qb * 256) * NP + TC_FT + (h & 3) * 64, (char*)lds, MB); }
                if (l == 0 && F.vcu < 16) { const int b = F.vcu >> 3, h = F.vcu & 7, kvh = h >> 2;
                    abf* q = Pb + (size_t)(RL + b * CTX) * NP + TC_GQQ + h * 64; const abf* kc = Pb + (size_t)(RL + b * CTX) * NP + TC_GQK + kvh * 64;
                    attn_body::attn_unit<8>(q, kc, kc + (TC_GQV - TC_GQK), kc, kc + (TC_GQV - TC_GQK), 4, 4, q, (char*)lds, MB); }
            }
#endif
            __syncthreads();
#if (PHM & 16)
            {   MKF(); MK_SP();
                for (int rep = D_OUTU; rep >= 0; --rep) { const bool dry = __builtin_amdgcn_readfirstlane(opq_v(rep)) != 0;
                    UnitId id, idn; ScanRegs RA, RB; int u = F.vcu; bool ok = unit_decode(u, id);
                    while (ok && l == 1 && id.tc < 4) { u += F.G; ok = unit_decode(u, id); }
                    if (ok) scan_fetch<true>(F, l, id, sp, RA);
                    while (ok) { int un = u + F.G; bool okn = unit_decode(un, idn);
                        while (okn && l == 1 && idn.tc < 4) { un += F.G; okn = unit_decode(un, idn); }
                        if (okn) scan_fetch<true>(F, l, idn, sp, RB);
                        if (id.fam == 0) scan_out_unit<true>(F, l, id.b, id.head, id.tc, sp, RA, dry); else scan_out_unit<false>(F, l, id.b, id.head, id.tc, sp, RA, dry);
                        RA = RB; id = idn; u = un; ok = okn; } }
            }
#endif
#endif
        }
        SEAM(pb + 3);
        if (IN(pb + 4)) {
#if DBG_LEVEL >= 3 && (PHM & 32)
            for (int rep = 0; rep < R_MRG; ++rep) { SchedMerge S; S.G = opq_s((int)gridDim.x); S.c = opq_s((int)blockIdx.x); S.npan = (l == 0) ? NPAN : NPAN_L; S.ws = opq(args.ws); S.bgate = args.in[I_BGATE] + (size_t)l * 4096;
            pg8::gemm_stream((LAS unsigned char*)lds, S); }
#endif
        }
        SEAM(pb + 4);
        if (IN(pb + 5)) {
#if DBG_LEVEL >= 3 && (PHM & 64)
            SchedOut S; S.G = opq_s((int)gridDim.x); S.c = opq_s((int)blockIdx.x); S.npan = (l == 0) ? NPAN : NPAN_L; S.l = l; S.ws = opq(args.ws); S.xlat = (l == 0) ? args.in[I_X] : args.out; S.xctx = (l == 0) ? args.in[I_CTX] : (const float*)(args.ws + WS_XC);
            if (l == 0) { MKF(); build_ctx_panels(F); }
            for (int rep = 0; rep < R_OUT; ++rep) pg8::gemm_stream((LAS unsigned char*)lds, S);
#else
            MKF(); phase_scale_rows(F, l, true);
#endif
        }
        SEAM(pb + 5);
        if (IN(pb + 6)) { MKF();
#if DBG_LEVEL >= 3 && (PHM & 64)
            phase_post_mix(F, l, l == 0 ? R : RL, (const float*)(F.ws + WS_P)); if (l == 0) for (int rep = 1; rep < R_PM0; ++rep) phase_post_mix(F, l, R, (const float*)(F.ws + WS_P));
#else
            phase_post_mix(F, l, l == 0 ? R : RL, F.XM());
#endif
        }
        if (l == 1) SEAM(pb + 6);
        if (IN(pb + 7)) { if (l == 1) { MKF(); phase_moe_assign(F); } }
        SEAM(pb + 7);
        if (IN(pb + 8)) {
#if DBG_LEVEL >= 2
            for (int rep = 0; rep < R_UP; ++rep) {
            if (l == 0) { SchedUp S; S.G = opq_s((int)gridDim.x); S.c = opq_s((int)blockIdx.x); S.ws = opq(args.ws); pg8::gemm_stream((LAS unsigned char*)lds, S); }
            else { SchedMoeUp S; S.G = opq_s((int)gridDim.x); S.c = opq_s((int)blockIdx.x); S.mt.ws = opq(args.ws); S.nt_ = *(const volatile int*)S.mt.ntiles(); pg8::gemm_stream((LAS unsigned char*)lds, S); } }
#endif
        }
        SEAM(pb + 8);
        if (IN(pb + 9)) {
#if DBG_LEVEL >= 2
            if (l == 0) { SchedDown S; S.G = opq_s((int)gridDim.x); S.c = opq_s((int)blockIdx.x); S.l = 0; S.ws = opq(args.ws); pg8::gemm_stream((LAS unsigned char*)lds, S); }
            else { SchedMoeDown S; S.G = opq_s((int)gridDim.x); S.c = opq_s((int)blockIdx.x); S.mt.ws = opq(args.ws); S.Dst = (bf16*)args.out; S.nt_ = *(const volatile int*)S.mt.ntiles(); for (int rep = 0; rep < R_MDN; ++rep) pg8::gemm_stream((LAS unsigned char*)lds, S); }
#else
            MKF();
            if (l == 0) phase_scale_rows(F, l, false);
            else { for (size_t i = (size_t)F.vcu * 512 + F.tid; i < (size_t)RL * D / 4; i += (size_t)F.G * 512) ((v4u*)F.out)[i] = (v4u){0u, 0u, 0u, 0u}; }
#endif
        }
        SEAM(pb + 9);
        if (IN(pb + 10)) { MKF(); phase_final(F, l); if (l == 0) for (int rep = 1; rep < R_FIN0; ++rep) phase_final(F, l); if (l == 0) { __syncthreads(); for (int rep = 0; rep < R_CONV; ++rep) convert_layer_weights(F, 1); } }
        if (l == 0) SEAM(pb + 10);
    }
__global__ void __launch_bounds__(NWAVES * 64, 2) mega_fwd(Args args) {
    extern __shared__ __attribute__((aligned(16))) unsigned char lds[];
    {   LAS unsigned char* L = (LAS unsigned char*)lds; const int tid = threadIdx.x;
        for (int u = tid; u < (LDS_BYTES - LDSCTL_OFF) / 4; u += NWAVES * 64) ((LAS unsigned*)(L + LDSCTL_OFF))[u] = 0u;
        __syncthreads();
        if (tid == 0) {
#pragma unroll
            for (int i = 0; i < 30; ++i) *(LAS unsigned long long*)(L + INTAB_OFF + 8 * i) = (unsigned long long)args.in[i]; }
        __syncthreads();
        (void)xcd_barrier_post((unsigned*)((gu32*)(args.ws + WS_CTL) + CW_BAR) + args.li * XCD_BAR_WORDS, (volatile LAS unsigned*)(L + MISC_OFF) + 8);
    }
    if (IN(0)) { MKF(); for (int rep = 0; rep < R_PRO; ++rep) { build_tables(F); convert_layer_weights(F, 0); __syncthreads(); ada_phase(F); } }
    SEAM(0);
    if (IN(1)) { MKF(); for (int rep = 0; rep < R_PRO; ++rep) phase_ln_mod(F, 0); }
    SEAM(1);
    layer_body<0>(args, lds);
    layer_body<1>(args, lds);
}
#undef IN
#undef SEAM


extern "C" void kernel_launch(void* const* d_in, const int* in_sizes, int n_in, void* d_out, int out_size, void* d_ws, size_t ws_size, hipStream_t stream) {
    static int grid = 0;
    if (grid == 0) {
        if (n_in != 30 || out_size != RL * D || ws_size < WS_END) { fprintf(stderr, "kernel_launch: unexpected problem (n_in %d out %d ws %zu)\n", n_in, out_size, ws_size); grid = -1; return; }
        int dev = 0, cus = 0;
        if (hipGetDevice(&dev) != hipSuccess || hipDeviceGetAttribute(&cus, hipDeviceAttributeMultiprocessorCount, dev) != hipSuccess) { grid = -1; return; }
        if (hipFuncSetAttribute((const void*)mega_fwd, hipFuncAttributeMaxDynamicSharedMemorySize, LDS_BYTES) != hipSuccess) { fprintf(stderr, "kernel_launch: hipFuncSetAttribute failed\n"); grid = -1; return; }
        int per_cu = 0; (void)hipOccupancyMaxActiveBlocksPerMultiprocessor(&per_cu, (const void*)mega_fwd, NWAVES * 64, LDS_BYTES); (void)hipGetLastError();
        grid = cus;
        if (per_cu < 1) fprintf(stderr, "kernel_launch: occupancy query says %d\n", per_cu);
    }
    if (grid < 0) return;
    if (hipMemsetAsync((char*)d_ws + WS_CTL, 0, CTL_ZERO_BYTES, stream) != hipSuccess) return;
    Args a{};
    for (int i = 0; i < 30; ++i) a.in[i] = (const float*)d_in[i];
    a.out = (float*)d_out; a.ws = (unsigned char*)d_ws;
#if MK_N_LAUNCHES == 1
    a.ph_lo = 0; a.ph_hi = N_PHASES; a.li = 0;
    hipLaunchKernelGGL(mega_fwd, dim3(grid), dim3(NWAVES * 64), LDS_BYTES, stream, a);
#else
    for (int k = 0; k < N_PHASES; ++k) { a.ph_lo = k; a.ph_hi = k + 1; a.li = 0; hipLaunchKernelGGL(mega_fwd, dim3(grid), dim3(NWAVES * 64), LDS_BYTES, stream, a); }
#endif
}
```

```cpp
#include <hip/hip_runtime.h>
#include <hip/hip_bf16.h>
#include <cstdio>
#include <cstdint>

#ifndef MK_N_LAUNCHES
#define MK_N_LAUNCHES 1
#endif
#ifndef DBG_LEVEL
#define DBG_LEVEL 99
#endif

#define GAS __attribute__((address_space(1)))
#define LAS __attribute__((address_space(3)))
typedef unsigned short bf16;
typedef unsigned v4u __attribute__((ext_vector_type(4)));
typedef unsigned v2u __attribute__((ext_vector_type(2)));
typedef float f32x4 __attribute__((ext_vector_type(4)));
typedef float f32x2 __attribute__((ext_vector_type(2)));
typedef short bf16x8 __attribute__((ext_vector_type(8)));
typedef float f32x16 __attribute__((ext_vector_type(16)));
typedef GAS unsigned gu32;
#define RLX_AGENT __ATOMIC_RELAXED, __HIP_MEMORY_SCOPE_AGENT
#define LDS_WAIT() asm volatile("s_waitcnt lgkmcnt(0)" ::: "memory")
#define VM_WAIT() asm volatile("s_waitcnt vmcnt(0)" ::: "memory")

constexpr int D = 1024, NB = 2, T = 16384, CTX = 256;
constexpr int RL = NB * T;
constexpr int R = RL + NB * CTX;
constexpr int NPAN = R / 256, NPAN_L = RL / 256;
constexpr int NIN = 3120;
constexpr int NP = 3072;
constexpr int TC_MLQ = 0, TC_MLK = 256, TC_MLV = 512, TC_MLO = 768, TC_FT = 1024, TC_GQQ = 1280, TC_GQK = 1792, TC_GQV = 1920,
              TC_GLQ = 2048, TC_GLK = 2304, TC_GLV = 2560, TC_GLR = 2816;
constexpr int SMP = 64;
constexpr int FFD = 2816, NEXP = 8, FFE = 1408;
constexpr float LN_EPS = 1e-6f;
constexpr float ALPHA = 1.4142135623730951f;
constexpr int NCH = 260;
constexpr int NCHAIN = 16;
constexpr float C2Q = 0.125f * 1.4426950408889634f;

constexpr size_t MiB = 1u << 20;
constexpr size_t WS_CTL = 0, CTL_ZERO_BYTES = 128 * 1024;
constexpr size_t WS_ADA = 1 * MiB;
constexpr size_t WS_TAB = WS_ADA + 256 * 1024;
constexpr size_t WS_ROPE_C = WS_TAB, WS_ROPE_S = WS_TAB + 16384, WS_DFT_C = WS_TAB + 32768, WS_DFT_S = WS_DFT_C + 32768;
constexpr size_t WS_MOE = 2 * MiB;
constexpr size_t WS_XC = 4 * MiB;
constexpr size_t WS_SM = 6 * MiB;
constexpr size_t WS_SCAL = 15 * MiB;
constexpr size_t WS_W = 20 * MiB;
constexpr size_t W_IN = 0, W_GATE = W_IN + (size_t)3328 * 1024 * 2, W_OUT = W_GATE + (size_t)4096 * 1024 * 2,
                 W_BML = W_OUT + (size_t)1024 * 1024 * 2, W_BFT = W_BML + (size_t)1024 * 256 * 2, W_BAT = W_BFT + (size_t)1024 * 512 * 2,
                 W_BGL = W_BAT + (size_t)1024 * 512 * 2, W_FFN = W_BGL + (size_t)1024 * 256 * 2;
constexpr size_t W_FFD_GU = W_FFN, W_FFD_D = W_FFN + (size_t)5632 * 1024 * 2;
constexpr size_t W_MOE_GU = W_FFN, W_MOE_D = W_FFN + (size_t)8 * 2816 * 1024 * 2;
constexpr size_t W_END = W_MOE_D + (size_t)8 * 1024 * 1408 * 2;
static_assert(W_END <= 86 * MiB, "weights region");
constexpr size_t WS_H = 106 * MiB;
constexpr size_t WS_P = 172 * MiB;
constexpr size_t WS_XM = 368 * MiB;
constexpr size_t WS_UQ = 498 * MiB;
constexpr size_t WS_PA = 502 * MiB;
constexpr size_t WS_DP = 506 * MiB;
constexpr size_t WS_END = 510 * MiB;
static_assert(WS_H + (size_t)R * 1024 * 2 <= WS_P && WS_P + (size_t)R * NP * 2 <= WS_XM && WS_XM + (size_t)R * 1024 * 4 <= WS_END, "ws map");
constexpr size_t XO_MLC = 0;
constexpr size_t XO_GLS = 33 * MiB;
constexpr size_t XO_MIX = 0;
constexpr size_t XO_IM1 = 68 * MiB;
constexpr size_t XO_GST = 65 * MiB;
constexpr size_t XO_FT = 97 * MiB + 512 * 1024;
static_assert(XO_FT + (size_t)R * 512 * 2 <= (size_t)R * 1024 * 4 && XO_GST + 32 * MiB <= XO_FT && XO_IM1 + 16 * MiB <= XO_FT && XO_GLS + 33 * MiB <= XO_IM1, "XM overlays");
constexpr size_t SC_MLN = 0;
constexpr size_t SC_MLA = SC_MLN + (size_t)16 * 260 * 64 * 4;
constexpr size_t SC_MLB = SC_MLA + 16 * 260 * 4;
constexpr size_t SC_MLM = SC_MLB + 16 * 260 * 4;
constexpr size_t SC_GLD = SC_MLM + 16 * 260 * 4;
static_assert(SC_GLD + (size_t)16 * 260 * 64 * 4 <= 5 * MiB, "scal");
constexpr int MOE_MAXT = 264;
constexpr size_t MO_TOK = 0;
constexpr size_t MO_DST = MO_TOK + (size_t)MOE_MAXT * 256 * 4;
constexpr size_t MO_SEL = MO_DST + (size_t)MOE_MAXT * 256 * 4;
static_assert(MO_SEL + (size_t)RL * 16 <= 2 * MiB, "moe tables");
constexpr int CW_QUEUE = 2048  , CW_TMO = 0, CW_CODE = 1, CW_BAR = 4096, CW_MOECNT = 16384  , CW_MOECUR = 16384 + 8 * 64;
static_assert((CW_MOECUR + 8 * 64) * 4 <= (int)CTL_ZERO_BYTES && (CW_BAR + 3456) * 4 <= (int)CTL_ZERO_BYTES, "control words inside the per-call memset");
#define XB_TMO      128
#define XB_XCNT(j)  (256  + 64 * (j))
#define XB_XSUB(j)  (1280 + 64 * (j))
#define XB_XGEN(j)  (2304 + 64 * (j))
#define XB_TOP      3328
#define XB_TOPGEN   3392
#define XCD_BAR_WORDS 3456
#define XB_SPIN_CAP (1u << 18)

constexpr int RING_BYTES = 131072, LDSCTL_OFF = RING_BYTES, MISC_OFF = LDSCTL_OFF + 320, LDS_BYTES = 147456;
constexpr int NWAVES = 8;

#ifndef PROF_WG
#define PROF_WG 0
#endif
#ifndef PROF_MASK
#define PROF_MASK 0u
#endif
#define PROF_LDS lds
#define PROF_TICK(k) do { if (PROF_MASK != 0u && blockIdx.x == PROF_WG && threadIdx.x == 0) { volatile LAS unsigned long long* pw_ = (volatile LAS unsigned long long*)((LAS unsigned char*)PROF_LDS + MISC_OFF + 64); \
        const unsigned long long now_ = __builtin_amdgcn_s_memrealtime(); if ((PROF_MASK >> (k)) & 1u) pw_[1] += now_ - pw_[0]; pw_[0] = now_; if ((k) < 24) pw_[2] = (unsigned long long)((k) + 1); } } while (0)
#ifndef PROF_SEL
#define PROF_SEL -1
#endif
#define PROF_GEMM_ON() ((PROF_MASK & 0xE0000000u) != 0u && (PROF_SEL < 0 || (((volatile LAS unsigned long long*)((LAS unsigned char*)PROF_LDS + MISC_OFF + 64))[2] >= 2ull && (int)((((volatile LAS unsigned long long*)((LAS unsigned char*)PROF_LDS + MISC_OFF + 64))[2] - 2ull) % 11ull) == PROF_SEL)))
#define PROF_SPAN_BEGIN() do { if (PROF_MASK != 0u && blockIdx.x == PROF_WG && threadIdx.x == 0) { volatile LAS unsigned long long* pw_ = (volatile LAS unsigned long long*)((LAS unsigned char*)PROF_LDS + MISC_OFF + 64); pw_[0] = __builtin_amdgcn_s_memrealtime(); } } while (0)
template <class T_> __device__ __forceinline__ T_* opq(T_* p) { asm volatile("" : "+s"(p)); return p; }
__device__ __forceinline__ int opq_s(int v) { asm volatile("" : "+s"(v)); return v; }
__device__ __forceinline__ int opq_v(int v) { asm volatile("" : "+v"(v)); return v; }
__device__ __forceinline__ unsigned f2bf(float f) { unsigned u = __builtin_bit_cast(unsigned, f); return (u + 0x7fffu + ((u >> 16) & 1u)) >> 16; }
typedef __bf16 hwbf16x2 __attribute__((ext_vector_type(2)));
__device__ __forceinline__ unsigned pk2(float lo, float hi) { const f32x2 v = {lo, hi}; return __builtin_bit_cast(unsigned, __builtin_convertvector(v, hwbf16x2)); }
__device__ __forceinline__ float bflo(unsigned w) { return __uint_as_float(w << 16); }
__device__ __forceinline__ float bfhi(unsigned w) { return __uint_as_float(w & 0xffff0000u); }
__device__ __forceinline__ float bf2f(bf16 b) { return __uint_as_float((unsigned)b << 16); }
__device__ __forceinline__ void unpack8(const v4u a, float (&x)[8]) { x[0] = bflo(a.x); x[1] = bfhi(a.x); x[2] = bflo(a.y); x[3] = bfhi(a.y); x[4] = bflo(a.z); x[5] = bfhi(a.z); x[6] = bflo(a.w); x[7] = bfhi(a.w); }
__device__ __forceinline__ v4u pack8(const float (&x)[8]) { v4u w; w.x = pk2(x[0], x[1]); w.y = pk2(x[2], x[3]); w.z = pk2(x[4], x[5]); w.w = pk2(x[6], x[7]); return w; }
template <int CTRL> __device__ __forceinline__ float dpp_get(float v) { return __builtin_bit_cast(float, __builtin_amdgcn_update_dpp(0, __builtin_bit_cast(int, v), CTRL, 0xF, 0xF, true)); }
__device__ __forceinline__ float wave_sum(float v) {
    v += dpp_get<0xB1>(v);
    v += dpp_get<0x4E>(v);
    v += dpp_get<0x141>(v);
    v += dpp_get<0x140>(v);
    { const auto rr = __builtin_amdgcn_permlane16_swap(__float_as_uint(v), __float_as_uint(v), false, false); v = __uint_as_float(rr[0]) + __uint_as_float(rr[1]); }
    { const auto rr = __builtin_amdgcn_permlane32_swap(__float_as_uint(v), __float_as_uint(v), false, false); v = __uint_as_float(rr[0]) + __uint_as_float(rr[1]); }
    return v;
}
__device__ __forceinline__ float xor16_32_sum(float v) {
    { const auto rr = __builtin_amdgcn_permlane16_swap(__float_as_uint(v), __float_as_uint(v), false, false); v = __uint_as_float(rr[0]) + __uint_as_float(rr[1]); }
    { const auto rr = __builtin_amdgcn_permlane32_swap(__float_as_uint(v), __float_as_uint(v), false, false); v = __uint_as_float(rr[0]) + __uint_as_float(rr[1]); }
    return v; }
__device__ __forceinline__ float sigm(float x) { return __builtin_amdgcn_rcpf(1.f + __expf(-x)); }
__device__ __forceinline__ float logsig(float a) { return fminf(a, 0.f) - __logf(1.f + __expf(-fabsf(a))); }

__device__ __forceinline__ unsigned xb_ld(unsigned* p)              { return __hip_atomic_load(p, __ATOMIC_RELAXED, __HIP_MEMORY_SCOPE_AGENT); }
__device__ __forceinline__ unsigned xb_add(unsigned* p, unsigned v) { return __hip_atomic_fetch_add(p, v, __ATOMIC_RELAXED, __HIP_MEMORY_SCOPE_AGENT); }
__device__ __forceinline__ unsigned xb_xcc_id() { return (unsigned)__builtin_amdgcn_s_getreg((3 << 11) | 20) & 0xFu; }
#define XB_SPIN(cond, bar) do { unsigned _sp = 0; while (cond) { __builtin_amdgcn_s_sleep(1); \
    if ((++_sp & 255u) == 0u) { if (xb_ld(&(bar)[XB_TMO])) break; if (_sp > XB_SPIN_CAP) { atomicAdd(&(bar)[XB_TMO], 1u); break; } } } } while (0)
struct XcdBarrier { unsigned* bar; unsigned x; volatile LAS unsigned* st; };
__device__ __forceinline__ XcdBarrier xcd_barrier_post(unsigned* bar, volatile LAS unsigned* st) {
    XcdBarrier b; b.bar = bar; b.x = xb_xcc_id(); b.st = st;
    if (threadIdx.x == 0) (void)xb_add(&bar[XB_XCNT(b.x)], 1u);
    return b;
}
__device__ __forceinline__ void xcd_barrier_complete(unsigned* bar, unsigned x, unsigned& nloc, unsigned& nx) {
    const unsigned G = gridDim.x * gridDim.y * gridDim.z;
    unsigned sum, cnt, mine, sp = 0u;
    for (;;) {
        sum = 0u; cnt = 0u; mine = 0u;
#pragma unroll
        for (unsigned j = 0; j < 16; ++j) { const unsigned c = xb_ld(&bar[XB_XCNT(j)]); sum += c; cnt += (c > 0u) ? 1u : 0u; mine = (j == x) ? c : mine; }
        if (sum == G) break;
        __builtin_amdgcn_s_sleep(1);
        if ((++sp & 255u) == 0u) { if (xb_ld(&bar[XB_TMO])) break; if (sp > XB_SPIN_CAP) { atomicAdd(&bar[XB_TMO], 1u); break; } }
    }
    nloc = mine > 0u ? mine : 1u; nx = cnt > 0u ? cnt : 1u;
}
__device__ __forceinline__ void xcd_barrier(const XcdBarrier& b) {
    asm volatile("s_waitcnt vmcnt(0)" ::: "memory");
    __syncthreads();
    if (threadIdx.x == 0) {
        unsigned* bar = b.bar;
        __builtin_amdgcn_s_waitcnt(0);
        unsigned nloc = b.st[0], nx = b.st[1];
        if (nloc == 0u) { xcd_barrier_complete(bar, b.x, nloc, nx); b.st[0] = nloc; b.st[1] = nx; }
        const unsigned old = xb_add(&bar[XB_XSUB(b.x)], 1u);
        const unsigned gen = old / nloc;
        if (old + 1u == (gen + 1u) * nloc) {
            __builtin_amdgcn_fence(__ATOMIC_RELEASE, "agent");
            asm volatile("s_waitcnt vmcnt(0)" ::: "memory");
            const unsigned og = xb_add(&bar[XB_TOP], 1u);
            const unsigned tg = og / nx;
            if (og + 1u == (tg + 1u) * nx) xb_add(&bar[XB_TOPGEN], 1u);
            else XB_SPIN(xb_ld(&bar[XB_TOPGEN]) == tg, bar);
            __builtin_amdgcn_fence(__ATOMIC_ACQUIRE, "agent");
            xb_add(&bar[XB_XGEN(b.x)], 1u);
            asm volatile("s_waitcnt vmcnt(0)" ::: "memory");
        } else {
            XB_SPIN(xb_ld(&bar[XB_XGEN(b.x)]) == gen, bar);
            __builtin_amdgcn_fence(__ATOMIC_ACQUIRE, "agent");
            asm volatile("s_waitcnt vmcnt(0)" ::: "memory");
        }
    }
    __syncthreads();
}
namespace pg8 {
constexpr int BM = 256, BK = 64, HALF = 128, HTB = HALF * BK * 2, STAGE_BYTES = 8 * HTB, NXCD = 8, WGM = 8;
__host__ __device__ __forceinline__ int lds_byte(int r, int c) { const int st = (r >> 4) * 2 + (c >> 5), rr = r & 15, cc = c & 31, ob = rr * 64 + cc * 2; return st * 1024 + (ob ^ (((ob >> 9) & 1) << 5)); }
__host__ __device__ __forceinline__ void stage_rc(int b, int& R_, int& C_) { const int st = b / 1024, sb = b % 1024, swz = sb ^ (((sb >> 9) & 1) << 5); R_ = (st >> 1) * 16 + swz / 64; C_ = (st & 1) * 32 + (swz % 64) / 2; }
__host__ __device__ __forceinline__ int perm32(int rho) { const int n = rho >> 4, i = rho & 15; return 8 * (i >> 2) + 4 * n + (i & 3); }
struct GU { unsigned ao, bo; unsigned lda, ldb; int nt; int pm, pn, kind, aux; };
__device__ __forceinline__ bool tile_of(long L, int nM, int nN, int& pm, int& pn) {
    const int nwg = nM * nN; if (L >= nwg) return false;
    int wgid = (int)L; { const int q = nwg / NXCD, r = nwg % NXCD, xcd = wgid % NXCD, off = wgid / NXCD; wgid = (xcd < r ? xcd * (q + 1) : r * (q + 1) + (xcd - r) * q) + off; }
    const int nig = WGM * nN, gid = wgid / nig, fm = gid * WGM, gsz = (nM - fm) < WGM ? (nM - fm) : WGM;
    pm = fm + ((wgid % nig) % gsz); pn = (wgid % nig) / gsz; return true;
}
__device__ __forceinline__ unsigned cvt_pk_bf16(float lo, float hi) { return pk2(lo, hi); }

template <class S>
__device__ __forceinline__ void gemm_stream(LAS unsigned char* lds, const S& sch) {
    const int tid = opq_v((int)threadIdx.x), wid = __builtin_amdgcn_readfirstlane(tid >> 6), lane = tid & 63, wr = wid >> 2, wc = wid & 3, fr = lane & 15, fq = lane >> 4;
    const unsigned ldsw = (unsigned)wid * 1024u;
    const int aoff = lds_byte(wr * 64 + fr, fq * 8), boff = lds_byte(wc * 32 + fr, fq * 8);
#define PG8_SA(b, h) (((b) * 2 + (h)) * HTB)
#define PG8_SB(b, h) ((4 + (b) * 2 + (h)) * HTB)
#define PG8_STG(bufoff, soff, o0, o1) do { \
        __builtin_amdgcn_raw_ptr_buffer_load_lds(rs, (LAS unsigned*)(lds + (bufoff) + ldsw), 16, (o0), (soff), 0, 0); \
        __builtin_amdgcn_raw_ptr_buffer_load_lds(rs, (LAS unsigned*)(lds + (bufoff) + ldsw + 8192), 16, (o1), (soff), 0, 0); } while (0)
#define PG8_LDA(dst, b, h) do { _Pragma("unroll") for (int m = 0; m < 4; ++m) _Pragma("unroll") for (int k = 0; k < 2; ++k) dst[m][k] = *(const LAS bf16x8*)(lds + PG8_SA(b, h) + aoff + m * 2048 + k * 1024); } while (0)
#define PG8_LDB(dst, b, h) do { _Pragma("unroll") for (int n = 0; n < 2; ++n) _Pragma("unroll") for (int k = 0; k < 2; ++k) dst[n][k] = *(const LAS bf16x8*)(lds + PG8_SB(b, h) + boff + n * 2048 + k * 1024); } while (0)
#define PG8_MMA(ai, bj, At, Bt) do { __builtin_amdgcn_s_setprio(1); _Pragma("unroll") for (int m = 0; m < 4; ++m) _Pragma("unroll") for (int n = 0; n < 2; ++n) _Pragma("unroll") for (int k = 0; k < 2; ++k) \
        acc[ai][bj][m][n] = __builtin_amdgcn_mfma_f32_16x16x32_bf16(Bt[n][k], At[m][k], acc[ai][bj][m][n], 0, 0, 0); __builtin_amdgcn_s_setprio(0); } while (0)
#define PG8_WAIT_V(n) asm volatile("s_waitcnt vmcnt(" #n ")" ::: "memory")
#define PG8_WAIT_L(n) asm volatile("s_waitcnt lgkmcnt(" #n ")" ::: "memory")
#define PG8_BAR __builtin_amdgcn_s_barrier()
#define PG8_SCHED __builtin_amdgcn_sched_barrier(0)
#define PG8_SETUP(u, oA, oB, hB) do { _Pragma("unroll") for (int i = 0; i < 2; ++i) { \
        int R_, C_; stage_rc(tid * 16 + i * 8192, R_, C_); const unsigned RA_ = (unsigned)R_, RB_ = (unsigned)(S::PERM ? ((R_ & ~31) + perm32(R_ & 31)) : R_), CB_ = (unsigned)C_ * 2u; \
        if constexpr (S::GATHER) { oA[0][i] = sch.arow(u, (int)RA_) + CB_; oA[1][i] = sch.arow(u, (int)RA_ + 128) + CB_; } \
        else { oA[0][i] = RA_ * (u).lda + CB_; oA[1][i] = oA[0][i] + 128u * (u).lda; } \
        oB[i] = RB_ * (u).ldb + CB_; } hB = 128u * (u).ldb; } while (0)
    GU cur, nxt; int ui = 0;
    if (!sch.next(0, cur)) return;
    f32x4 acc[2][2][4][2];
#pragma unroll
    for (int a = 0; a < 2; ++a)
#pragma unroll
        for (int b = 0; b < 2; ++b)
#pragma unroll
            for (int m = 0; m < 4; ++m)
#pragma unroll
                for (int n = 0; n < 2; ++n) acc[a][b][m][n] = (f32x4){0.f, 0.f, 0.f, 0.f};
    bf16x8 At[4][2], B0[2][2], B1[2][2];
    const __amdgpu_buffer_rsrc_t rs = __builtin_amdgcn_make_buffer_rsrc((void*)sch.wsbase(), (short)0, (int)WS_END, 0x00020000);
    unsigned oA[2][2], oB[2]; unsigned hB;
    PG8_SETUP(cur, oA, oB, hB);
    unsigned cA = cur.ao, cB = cur.bo;
    PG8_STG(PG8_SB(0, 0), cB, oB[0], oB[1]); PG8_STG(PG8_SB(0, 1), cB + hB, oB[0], oB[1]); PG8_STG(PG8_SA(0, 0), cA, oA[0][0], oA[0][1]); PG8_STG(PG8_SA(0, 1), cA, oA[1][0], oA[1][1]);
    if (wr == 1) PG8_BAR;
    PG8_WAIT_V(2); PG8_BAR;
    PG8_STG(PG8_SB(1, 0), cB + 128, oB[0], oB[1]); PG8_STG(PG8_SA(1, 0), cA + 128, oA[0][0], oA[0][1]); PG8_STG(PG8_SB(1, 1), cB + hB + 128, oB[0], oB[1]);
    PG8_WAIT_V(6); PG8_BAR;
    if (PROF_GEMM_ON()) { PROF_TICK(31); }
    for (;;) {
        const bool has_next = sch.next(ui + 1, nxt);
        unsigned gA[2][2];
        if constexpr (S::GATHER) { if (has_next) {
#pragma unroll
            for (int i = 0; i < 2; ++i) { int R_, C_; stage_rc(tid * 16 + i * 8192, R_, C_); gA[0][i] = sch.arow(nxt, R_) + (unsigned)C_ * 2u; gA[1][i] = sch.arow(nxt, R_ + 128) + (unsigned)C_ * 2u; } } }
        const int nt = cur.nt;
        for (int t = 0; t < nt; t += 2) {
            const bool last = (t == nt - 2);
            const unsigned a1 = cA + (unsigned)(t + 1) * 128u;
            PG8_LDB(B0, 0, 0); PG8_LDB(B1, 0, 1); PG8_SCHED; PG8_LDA(At, 0, 0); PG8_STG(PG8_SA(1, 1), a1, oA[1][0], oA[1][1]);
            PG8_WAIT_V(8); PG8_WAIT_L(0); PG8_BAR; PG8_MMA(0, 0, At, B0); PG8_MMA(0, 1, At, B1); PG8_BAR; PG8_SCHED;
            unsigned a2 = cA + (unsigned)(t + 2) * 128u, b2 = cB + (unsigned)(t + 2) * 128u;
            if (last) { a2 = cA; b2 = cB;
                if (has_next) { a2 = nxt.ao; b2 = nxt.bo;
                    if constexpr (S::GATHER) { oA[0][0] = gA[0][0]; oA[0][1] = gA[0][1]; oA[1][0] = gA[1][0]; oA[1][1] = gA[1][1];
#pragma unroll
                        for (int i = 0; i < 2; ++i) { int R_, C_; stage_rc(tid * 16 + i * 8192, R_, C_); const unsigned RB_ = (unsigned)(S::PERM ? ((R_ & ~31) + perm32(R_ & 31)) : R_); oB[i] = RB_ * nxt.ldb + (unsigned)C_ * 2u; }
                        hB = 128u * nxt.ldb; }
                    else { PG8_SETUP(nxt, oA, oB, hB); } } }
            const unsigned a3 = a2 + 128u, b3 = b2 + 128u;
            PG8_LDA(At, 0, 1); PG8_STG(PG8_SB(0, 0), b2, oB[0], oB[1]); PG8_STG(PG8_SB(0, 1), b2 + hB, oB[0], oB[1]); PG8_STG(PG8_SA(0, 0), a2, oA[0][0], oA[0][1]);
            PG8_WAIT_V(8); PG8_WAIT_L(0); PG8_BAR; PG8_MMA(1, 0, At, B0); PG8_MMA(1, 1, At, B1); PG8_BAR; PG8_SCHED;
            PG8_LDB(B0, 1, 0); PG8_LDB(B1, 1, 1); PG8_SCHED; PG8_LDA(At, 1, 0); PG8_STG(PG8_SA(0, 1), a2, oA[1][0], oA[1][1]);
            PG8_WAIT_V(8); PG8_WAIT_L(0); PG8_BAR; PG8_MMA(0, 0, At, B0); PG8_MMA(0, 1, At, B1); PG8_BAR; PG8_SCHED;
            PG8_LDA(At, 1, 1); PG8_STG(PG8_SB(1, 0), b3, oB[0], oB[1]); PG8_STG(PG8_SB(1, 1), b3 + hB, oB[0], oB[1]); PG8_STG(PG8_SA(1, 0), a3, oA[0][0], oA[0][1]);
            PG8_WAIT_V(8); PG8_WAIT_L(0); PG8_BAR; PG8_MMA(1, 0, At, B0); PG8_MMA(1, 1, At, B1); PG8_BAR; PG8_SCHED;
        }
        if (wr == 0) PG8_BAR;
        { const bool pon_ = PROF_GEMM_ON(); if (pon_) { PROF_TICK(29); } sch.epi(acc, cur, wr, wc, fr, fq); if (pon_) { asm volatile("s_waitcnt vmcnt(0)" ::: "memory"); PROF_TICK(30); } }
        if (!has_next) break;
#pragma unroll
        for (int a = 0; a < 2; ++a)
#pragma unroll
            for (int b = 0; b < 2; ++b)
#pragma unroll
                for (int m = 0; m < 4; ++m)
#pragma unroll
                    for (int n = 0; n < 2; ++n) acc[a][b][m][n] = (f32x4){0.f, 0.f, 0.f, 0.f};
        cur = nxt; cA = cur.ao; cB = cur.bo; ++ui;
        if (wr == 1) PG8_BAR;
    }
    PG8_WAIT_V(0);
    PG8_BAR;
#undef PG8_SA
#undef PG8_SB
#undef PG8_STG
#undef PG8_LDA
#undef PG8_LDB
#undef PG8_MMA
#undef PG8_WAIT_V
#undef PG8_WAIT_L
#undef PG8_BAR
#undef PG8_SCHED
#undef PG8_SETUP
}
}
struct Args { const float* in[30]; float* out; unsigned char* ws; int ph_lo, ph_hi, li, pad; };
constexpr int INTAB_OFF = LDSCTL_OFF + 512;
constexpr int TILE_E_OFF = LDSCTL_OFF + 1024;
struct InTab { LAS unsigned char* lds;
    __device__ __forceinline__ const float* operator[](int i) const { return (const float*)(*(const LAS unsigned long long*)(lds + INTAB_OFF + 8 * i)); } };
struct Frame {
    LAS unsigned char* lds; volatile LAS unsigned* MISC;
    int tid, lane, wave, vcu, G;
    InTab in; float* out; unsigned char* ws;
    __device__ __forceinline__ gu32* ctl() const { return (gu32*)(ws + WS_CTL); }
    __device__ __forceinline__ bf16* H() const { return (bf16*)(ws + WS_H); }
    __device__ __forceinline__ bf16* P() const { return (bf16*)(ws + WS_P); }
    __device__ __forceinline__ float* XM() const { return (float*)(ws + WS_XM); }
    __device__ __forceinline__ float* XC() const { return (float*)(ws + WS_XC); }
    __device__ __forceinline__ float* SM() const { return (float*)(ws + WS_SM); }
    __device__ __forceinline__ float* ADA() const { return (float*)(ws + WS_ADA); }
};
enum { I_X = 0, I_C, I_CTX, I_CCTX, I_WADA, I_BADA, I_WIN, I_MLGB, I_MLNG, I_GQQG, I_GQKG, I_GLW2, I_GLB2, I_GLNG, I_WBR, I_WGATE, I_BGATE, I_WOUT,
       I_LN1G, I_LN1B, I_LN2G, I_LN2B, I_FFDWG, I_FFDWU, I_FFDWD, I_MOEWR, I_MOEBR, I_MOEWG, I_MOEWU, I_MOEWD };
__device__ __forceinline__ int set_of_panel(int pm) { return pm < 64 ? 0 : (pm < 128 ? 1 : 2); }
__device__ __forceinline__ int set_of_row(int r) { return r < T ? 0 : (r < RL ? 1 : 2); }
__device__ __forceinline__ const float* ada_vec(const Frame& F, int l, int set, int k) { return F.ADA() + ((size_t)(l * 3 + set) * 6 + k) * D; }
__device__ __forceinline__ const float* xin_row(const Frame& F, int l, int r) {
    if (l == 0) return r < RL ? F.in[I_X] + (size_t)r * D : F.in[I_CTX] + (size_t)(r - RL) * D;
    return r < RL ? F.out + (size_t)r * D : F.XC() + (size_t)(r - RL) * D;
}

typedef pg8::GU GU;
struct SchedBase { int G, c; };
struct SchedIn : SchedBase {
    static constexpr bool PERM = true, GATHER = false;
    unsigned char* ws;
    __device__ __forceinline__ bool next(int i, GU& u) const {
        if (!pg8::tile_of((long)i * G + c, NPAN, 13, u.pm, u.pn)) return false;
        u.ao = (unsigned)WS_H + (unsigned)u.pm * 256u * D * 2u; u.lda = D * 2; u.bo = (unsigned)(WS_W + W_IN) + (unsigned)u.pn * 256u * D * 2u; u.ldb = D * 2; u.nt = D / 64; return true; }
    __device__ __forceinline__ unsigned char* wsbase() const { return ws; }
    __device__ __forceinline__ void epi(const f32x4 (&acc)[2][2][4][2], const GU& u, int wr, int wc, int fr, int fq) const {
        const int row0 = u.pm * 256 + wr * 64 + fr; bf16* P = (bf16*)(ws + WS_P); float* SM = (float*)(ws + WS_SM);
        if (u.pn < 12) {
#pragma unroll
            for (int ai = 0; ai < 2; ++ai)
#pragma unroll
                for (int m = 0; m < 4; ++m) { bf16* rowp = P + (size_t)(row0 + ai * 128 + m * 16) * NP + u.pn * 256 + wc * 32 + 8 * fq;
#pragma unroll
                    for (int bj = 0; bj < 2; ++bj) { const f32x4 v0 = acc[ai][bj][m][0], v1 = acc[ai][bj][m][1];
                        v4u w; w.x = pg8::cvt_pk_bf16(v0[0], v0[1]); w.y = pg8::cvt_pk_bf16(v0[2], v0[3]); w.z = pg8::cvt_pk_bf16(v1[0], v1[1]); w.w = pg8::cvt_pk_bf16(v1[2], v1[3]);
                        *(GAS v4u*)(rowp + bj * 128) = w; } }
        } else if (wc < 2) {
            const int col = wc * 32 + 8 * fq;
#pragma unroll
            for (int ai = 0; ai < 2; ++ai)
#pragma unroll
                for (int m = 0; m < 4; ++m) { float* rowp = SM + (size_t)(row0 + ai * 128 + m * 16) * SMP + col;
                    *(GAS f32x4*)(rowp) = acc[ai][0][m][0]; *(GAS f32x4*)(rowp + 4) = acc[ai][0][m][1]; }
        }
    }
};
struct SchedMerge : SchedBase {
    static constexpr bool PERM = true, GATHER = false;
    int npan; unsigned char* ws; const float* bgate;
    __device__ __forceinline__ bool next(int i, GU& u) const {
        const int njl = (NPAN_L * 4 - c + G - 1) / G;
        int j;
        if (i < 8 * njl) { pg8::tile_of((long)(i >> 3) * G + c, NPAN_L, 4, u.pm, u.pn); const int sub = i & 7; j = sub >> 1; u.kind = sub & 1; u.aux = j; }
        else { if (npan == NPAN_L) return false; const int qi = i - 8 * njl, qj = c + (qi >> 1) * G; if (qj >= 32) return false;
            u.pm = NPAN_L + (qj >> 4); u.pn = (qj >> 2) & 3; j = qj & 3; u.kind = qi & 1; u.aux = j + (u.kind ? 4 : 0); }
        unsigned ao, bo; unsigned la, lb; int nt;
        if (u.kind == 0) { ao = (unsigned)WS_H + (unsigned)u.pm * 256u * D * 2u; la = D * 2; bo = (unsigned)(WS_W + W_GATE) + ((unsigned)j * 1024u + u.pn * 256u) * D * 2u; lb = D * 2; nt = 16; }
        else { const bool isP = (j != 1); const int tc = (j == 0) ? TC_MLO : (j == 2 ? TC_GQQ : TC_GLR); const int kk = (j == 1 || j == 2) ? 512 : 256;
            ao = isP ? (unsigned)WS_P + ((unsigned)u.pm * 256u * NP + tc) * 2u : (unsigned)(WS_XM + XO_FT) + (unsigned)u.pm * 256u * 512u * 2u; la = isP ? NP * 2 : 1024;
            const unsigned wo = (unsigned)((j == 0) ? W_BML : (j == 1 ? W_BFT : (j == 2 ? W_BAT : W_BGL)));
            bo = (unsigned)WS_W + wo + (unsigned)u.pn * 256u * kk * 2u; lb = kk * 2; nt = kk / 64; }
        u.ao = ao; u.bo = bo; u.lda = la; u.ldb = lb; u.nt = nt;
        return true; }
    __device__ __forceinline__ unsigned char* wsbase() const { return ws; }
    __device__ __forceinline__ void epi(const f32x4 (&acc)[2][2][4][2], const GU& u, int wr, int wc, int fr, int fq) const {
        const int tid = threadIdx.x; v4u* sp_ = (v4u*)(ws + WS_XM + XO_GST) + (size_t)blockIdx.x * 8192 + tid;
        if (u.kind == 0) {
            const float* bp = bgate + u.aux * 1024 + u.pn * 256 + wc * 32 + 8 * fq;
#pragma unroll
            for (int ai = 0; ai < 2; ++ai)
#pragma unroll
                for (int m = 0; m < 4; ++m)
#pragma unroll
                    for (int bj = 0; bj < 2; ++bj) { const f32x4 v0 = acc[ai][bj][m][0] + *(const GAS f32x4*)(bp + bj * 128), v1 = acc[ai][bj][m][1] + *(const GAS f32x4*)(bp + bj * 128 + 4);
                        v4u w; w.x = pg8::cvt_pk_bf16(sigm(v0[0]), sigm(v0[1])); w.y = pg8::cvt_pk_bf16(sigm(v0[2]), sigm(v0[3])); w.z = pg8::cvt_pk_bf16(sigm(v1[0]), sigm(v1[1])); w.w = pg8::cvt_pk_bf16(sigm(v1[2]), sigm(v1[3]));
                        *(GAS v4u*)sp_ = w; sp_ += 512; asm volatile("" : "+v"(sp_) :: "memory"); }
        } else {
            bf16* rowp = (u.aux < 4 ? (bf16*)(ws + WS_XM + XO_MIX) + (size_t)(u.pm * 256) * D : (bf16*)(ws + WS_UQ) + ((size_t)(u.aux - 4) * 512 + (u.pm - NPAN_L) * 256) * D) + (size_t)(wr * 64 + fr) * D + u.pn * 256 + wc * 32 + 8 * fq;
            const bool accum = (u.aux > 0 && u.aux < 4);
            bf16* nxp = rowp; v4u g_n = *(const GAS v4u*)sp_; v4u p_n = (v4u){0u, 0u, 0u, 0u}; if (accum) p_n = *(const GAS v4u*)nxp;
#pragma unroll
            for (int e = 0; e < 16; ++e) { const int ai = e >> 3, m = (e >> 1) & 3, bj = e & 1;
                const v4u g = g_n, p = p_n; bf16* curp = nxp;
                if (e < 15) { sp_ += 512; asm volatile("" : "+v"(sp_)); nxp += (bj == 0) ? 128 : ((m == 3 ? 80 : 16) * D - 128); asm volatile("" : "+v"(nxp));
                    g_n = *(const GAS v4u*)sp_; if (accum) p_n = *(const GAS v4u*)nxp; }
                const f32x4 a0 = acc[ai][bj][m][0], a1 = acc[ai][bj][m][1];
                const float o0 = bflo(g.x) * a0[0] + bflo(p.x), o1 = bfhi(g.x) * a0[1] + bfhi(p.x), o2 = bflo(g.y) * a0[2] + bflo(p.y), o3 = bfhi(g.y) * a0[3] + bfhi(p.y);
                const float o4 = bflo(g.z) * a1[0] + bflo(p.z), o5 = bfhi(g.z) * a1[1] + bfhi(p.z), o6 = bflo(g.w) * a1[2] + bflo(p.w), o7 = bfhi(g.w) * a1[3] + bfhi(p.w);
                v4u w; w.x = pg8::cvt_pk_bf16(o0, o1); w.y = pg8::cvt_pk_bf16(o2, o3); w.z = pg8::cvt_pk_bf16(o4, o5); w.w = pg8::cvt_pk_bf16(o6, o7);
                *(GAS v4u*)curp = w; }
        }
    }
};
struct SchedOut : SchedBase {
    static constexpr bool PERM = false, GATHER = false;
    int npan, l; unsigned char* ws; const float* xlat; const float* xctx;
    __device__ __forceinline__ bool next(int i, GU& u) const {
        const int nul = (NPAN_L * 4 - c + G - 1) / G;
        if (i < nul) { pg8::tile_of((long)i * G + c, NPAN_L, 4, u.pm, u.pn); u.ao = (unsigned)(WS_XM + XO_MIX) + (unsigned)u.pm * 256u * D * 2u; }
        else { if (npan == NPAN_L) return false; const int q = c + (i - nul) * G; if (q >= 8) return false; u.pm = NPAN_L + (q >> 2); u.pn = q & 3; u.ao = (unsigned)WS_PA + (unsigned)q * 524288u; }
        u.lda = D * 2; u.bo = (unsigned)(WS_W + W_OUT) + (unsigned)u.pn * 256u * D * 2u; u.ldb = D * 2; u.nt = 16; return true; }
    __device__ __forceinline__ unsigned char* wsbase() const { return ws; }
    __device__ __forceinline__ void epi(const f32x4 (&acc)[2][2][4][2], const GU& u, int wr, int wc, int fr, int fq) const {
        const int r0 = u.pm * 256, col0 = u.pn * 256 + wc * 32 + 4 * fq, rl = wr * 64 + fr; const float* ada = (const float*)(ws + WS_ADA); float* XM = (float*)(ws + WS_P);
        const float* xs = r0 < RL ? xlat + (size_t)r0 * D : xctx + (size_t)(r0 - RL) * D; const float* gv = ada + ((size_t)(l * 3 + set_of_panel(u.pm)) * 6 + 2) * D + col0;
        f32x4 gg[2][2];
#pragma unroll
        for (int bj = 0; bj < 2; ++bj)
#pragma unroll
            for (int n = 0; n < 2; ++n) gg[bj][n] = *(const GAS f32x4*)(gv + bj * 128 + n * 16);
        const float* xp = xs + (size_t)rl * D + col0; float* op = XM + (size_t)(r0 + rl) * D + col0;
        f32x4 xq[4][4];
#pragma unroll
        for (int g = 0; g < 4; ++g) { xq[g][0] = *(const GAS f32x4*)(xp); xq[g][1] = *(const GAS f32x4*)(xp + 16); xq[g][2] = *(const GAS f32x4*)(xp + 128); xq[g][3] = *(const GAS f32x4*)(xp + 144);
            xp += (g == 3 ? 80 : 16) * D; asm volatile("" : "+v"(xp)); }
#pragma unroll
        for (int g = 0; g < 8; ++g) { const int ai = g >> 2, m = g & 3;
            const f32x4 x00 = xq[g & 3][0], x01 = xq[g & 3][1], x10 = xq[g & 3][2], x11 = xq[g & 3][3]; float* oc = op;
            if (g < 4) { xq[g & 3][0] = *(const GAS f32x4*)(xp); xq[g & 3][1] = *(const GAS f32x4*)(xp + 16); xq[g & 3][2] = *(const GAS f32x4*)(xp + 128); xq[g & 3][3] = *(const GAS f32x4*)(xp + 144);
                xp += 16 * D; asm volatile("" : "+v"(xp)); }
            if (g < 7) { op += (m == 3 ? 80 : 16) * D; asm volatile("" : "+v"(op)); }
            *(GAS f32x4*)(oc) = x00 * ALPHA + gg[0][0] * acc[ai][0][m][0]; *(GAS f32x4*)(oc + 16) = x01 * ALPHA + gg[0][1] * acc[ai][0][m][1];
            *(GAS f32x4*)(oc + 128) = x10 * ALPHA + gg[1][0] * acc[ai][1][m][0]; *(GAS f32x4*)(oc + 144) = x11 * ALPHA + gg[1][1] * acc[ai][1][m][1]; }
    }
};
__device__ __forceinline__ void swiglu_store(const f32x4 (&acc)[2][2][4][2], bf16* ACT, size_t pitch, int row0, int hid0, int wc, int fq) {
#pragma unroll
    for (int ai = 0; ai < 2; ++ai)
#pragma unroll
        for (int m = 0; m < 4; ++m) { bf16* rowp = ACT + (size_t)(row0 + ai * 128 + m * 16) * pitch + hid0 + wc * 16 + 4 * fq;
#pragma unroll
            for (int bj = 0; bj < 2; ++bj) { const f32x4 g = acc[ai][bj][m][0], uu = acc[ai][bj][m][1];
                v2u w; w.x = pg8::cvt_pk_bf16(g[0] * sigm(g[0]) * uu[0], g[1] * sigm(g[1]) * uu[1]); w.y = pg8::cvt_pk_bf16(g[2] * sigm(g[2]) * uu[2], g[3] * sigm(g[3]) * uu[3]);
                *(GAS v2u*)(rowp + bj * 64) = w; } }
}
struct SchedUp : SchedBase {
    static constexpr bool PERM = true, GATHER = false;
    unsigned char* ws;
    __device__ __forceinline__ bool next(int i, GU& u) const {
        if (!pg8::tile_of((long)i * G + c, NPAN, 22, u.pm, u.pn)) return false;
        u.ao = (unsigned)WS_H + (unsigned)u.pm * 256u * D * 2u; u.lda = D * 2; u.bo = (unsigned)(WS_W + W_FFD_GU) + (unsigned)u.pn * 256u * D * 2u; u.ldb = D * 2; u.nt = 16; return true; }
    __device__ __forceinline__ unsigned char* wsbase() const { return ws; }
    __device__ __forceinline__ void epi(const f32x4 (&acc)[2][2][4][2], const GU& u, int wr, int wc, int fr, int fq) const {
        swiglu_store(acc, (bf16*)(ws + WS_P), FFD, u.pm * 256 + wr * 64 + fr, u.pn * 128, wc, fq); }
};
struct SchedDown : SchedBase {
    static constexpr bool PERM = false, GATHER = false;
    int l; unsigned char* ws;
    __device__ __forceinline__ bool next(int i, GU& u) const {
        const int nul = (NPAN_L * 4 - c + G - 1) / G; u.aux = 0; u.nt = FFD / 64; unsigned ko = 0;
        if (i < nul) pg8::tile_of((long)i * G + c, NPAN_L, 4, u.pm, u.pn);
        else { const int q = c + (i - nul) * G; if (q >= 16) return false; u.pm = NPAN_L + (q >> 3); u.pn = (q >> 1) & 3; u.aux = 1 + (q & 1); u.nt = FFD / 128; ko = (unsigned)(q & 1) * (FFD / 128) * 128u; }
        u.ao = (unsigned)WS_P + (unsigned)u.pm * 256u * FFD * 2u + ko; u.lda = FFD * 2; u.bo = (unsigned)(WS_W + W_FFD_D) + (unsigned)u.pn * 256u * FFD * 2u + ko; u.ldb = FFD * 2; return true; }
    __device__ __forceinline__ unsigned char* wsbase() const { return ws; }
    __device__ __forceinline__ void epi(const f32x4 (&acc)[2][2][4][2], const GU& u, int wr, int wc, int fr, int fq) const {
        const int col0 = u.pn * 256 + wc * 32 + 4 * fq, row0 = u.pm * 256 + wr * 64 + fr; const float* ada = (const float*)(ws + WS_ADA); float* XM = (float*)(ws + WS_XM);
        if (u.aux) { float* dp = (float*)(ws + WS_DP) + ((size_t)(u.aux - 1) * 512 + (row0 - RL)) * D + col0;
#pragma unroll
            for (int ai = 0; ai < 2; ++ai)
#pragma unroll
                for (int m = 0; m < 4; ++m)
#pragma unroll
                    for (int bj = 0; bj < 2; ++bj)
#pragma unroll
                        for (int n = 0; n < 2; ++n) *(GAS f32x4*)(dp + (size_t)(ai * 128 + m * 16) * D + bj * 128 + n * 16) = acc[ai][bj][m][n];
            return; }
        const float* gv = ada + ((size_t)(l * 3 + set_of_panel(u.pm)) * 6 + 5) * D + col0;
        f32x4 gg[2][2];
#pragma unroll
        for (int bj = 0; bj < 2; ++bj)
#pragma unroll
            for (int n = 0; n < 2; ++n) gg[bj][n] = *(const GAS f32x4*)(gv + bj * 128 + n * 16);
        const float* xp = XM + (size_t)row0 * D + col0; float* op = XM + (size_t)row0 * D + col0;
        f32x4 xq[4][4];
#pragma unroll
        for (int g = 0; g < 4; ++g) { xq[g][0] = *(const GAS f32x4*)(xp); xq[g][1] = *(const GAS f32x4*)(xp + 16); xq[g][2] = *(const GAS f32x4*)(xp + 128); xq[g][3] = *(const GAS f32x4*)(xp + 144);
            xp += (g == 3 ? 80 : 16) * D; asm volatile("" : "+v"(xp)); }
#pragma unroll
        for (int g = 0; g < 8; ++g) { const int ai = g >> 2, m = g & 3;
            const f32x4 x00 = xq[g & 3][0], x01 = xq[g & 3][1], x10 = xq[g & 3][2], x11 = xq[g & 3][3]; float* oc = op;
            if (g < 4) { xq[g & 3][0] = *(const GAS f32x4*)(xp); xq[g & 3][1] = *(const GAS f32x4*)(xp + 16); xq[g & 3][2] = *(const GAS f32x4*)(xp + 128); xq[g & 3][3] = *(const GAS f32x4*)(xp + 144);
                xp += 16 * D; asm volatile("" : "+v"(xp)); }
            if (g < 7) { op += (m == 3 ? 80 : 16) * D; asm volatile("" : "+v"(op)); }
            *(GAS f32x4*)(oc) = x00 * ALPHA + gg[0][0] * acc[ai][0][m][0]; *(GAS f32x4*)(oc + 16) = x01 * ALPHA + gg[0][1] * acc[ai][0][m][1];
            *(GAS f32x4*)(oc + 128) = x10 * ALPHA + gg[1][0] * acc[ai][1][m][0]; *(GAS f32x4*)(oc + 144) = x11 * ALPHA + gg[1][1] * acc[ai][1][m][1]; }
    }
};
struct MoeTabs { unsigned char* ws; LAS unsigned char* lds;
    __device__ __forceinline__ int tile_e_lds(int t) const { return ((const LAS int*)(lds + TILE_E_OFF))[t]; }
    __device__ __forceinline__ const int* tok() const { return (const int*)(ws + WS_MOE + MO_TOK); }
    __device__ __forceinline__ const int* dst() const { return (const int*)(ws + WS_MOE + MO_DST); }
    __device__ __forceinline__ const int* tile_e() const { return (const int*)(ws + WS_MOE + MO_SEL + (size_t)RL * 16); }
    __device__ __forceinline__ const int* ntiles() const { return tile_e() + 512; } };
struct SchedMoeUp : SchedBase {
    static constexpr bool PERM = true, GATHER = true;
    MoeTabs mt; int nt_;
    __device__ __forceinline__ bool next(int i, GU& u) const {
        if (!pg8::tile_of((long)i * G + c, nt_, 11, u.pm, u.pn)) return false;
        const int e = mt.tile_e_lds(u.pm); u.aux = e;
        u.ao = (unsigned)WS_H; u.lda = D * 2; u.bo = (unsigned)(WS_W + W_MOE_GU) + ((unsigned)e * 2816u + u.pn * 256u) * D * 2u; u.ldb = D * 2; u.nt = 16; return true; }
    __device__ __forceinline__ unsigned char* wsbase() const { return mt.ws; }
    __device__ __forceinline__ unsigned arow(const GU& u, int r) const { return (unsigned)((const GAS int*)mt.tok())[u.pm * 256 + r] * (unsigned)(D * 2); }
    __device__ __forceinline__ void epi(const f32x4 (&acc)[2][2][4][2], const GU& u, int wr, int wc, int fr, int fq) const {
        swiglu_store(acc, (bf16*)(mt.ws + WS_P), FFE, u.pm * 256 + wr * 64 + fr, u.pn * 128, wc, fq); }
};
struct SchedMoeDown : SchedBase {
    static constexpr bool PERM = true, GATHER = false;
    MoeTabs mt; bf16* Dst; int nt_;
    __device__ __forceinline__ bool next(int i, GU& u) const {
        if (!pg8::tile_of((long)i * G + c, nt_, 4, u.pm, u.pn)) return false;
        const int e = mt.tile_e_lds(u.pm);
        u.ao = (unsigned)WS_P + (unsigned)u.pm * 256u * FFE * 2u; u.lda = FFE * 2; u.bo = (unsigned)(WS_W + W_MOE_D) + ((unsigned)e * 1024u + u.pn * 256u) * FFE * 2u; u.ldb = FFE * 2; u.nt = FFE / 64; return true; }
    __device__ __forceinline__ unsigned char* wsbase() const { return mt.ws; }
    __device__ __forceinline__ void epi(const f32x4 (&acc)[2][2][4][2], const GU& u, int wr, int wc, int fr, int fq) const {
        const int srow0 = u.pm * 256 + wr * 64 + fr;
#pragma unroll
        for (int ai = 0; ai < 2; ++ai)
#pragma unroll
            for (int m = 0; m < 4; ++m) { asm volatile("" ::: "memory"); const int d = ((const GAS int*)mt.dst())[srow0 + ai * 128 + m * 16];
                if (d >= 0) { bf16* rowp = Dst + (size_t)d * D + u.pn * 256 + wc * 32 + 8 * fq;
#pragma unroll
                    for (int bj = 0; bj < 2; ++bj) { const f32x4 v0 = acc[ai][bj][m][0], v1 = acc[ai][bj][m][1];
                        v4u w; w.x = pg8::cvt_pk_bf16(v0[0], v0[1]); w.y = pg8::cvt_pk_bf16(v0[2], v0[3]); w.z = pg8::cvt_pk_bf16(v1[0], v1[1]); w.w = pg8::cvt_pk_bf16(v1[2], v1[3]);
                        *(GAS v4u*)(rowp + bj * 128) = w; } } }
    }
};
struct CvSeg { int first, K, nblk, ldw, kind; unsigned dst; const float* a; const float* b; };
constexpr int CVSEG_OFF = 12288, CVTOT_OFF = CVSEG_OFF + 2040;
#define RFL(x) __builtin_amdgcn_readfirstlane(x)
__device__ __forceinline__ const float* rfl_ptr(const float* p) { const unsigned long long v = (unsigned long long)p; const unsigned lo = RFL((unsigned)v), hi = RFL((unsigned)(v >> 32)); return (const float*)(((unsigned long long)hi << 32) | lo); }
__device__ __forceinline__ const float* cv_src(int kind, const float* a, const float* b, int n) {
    if (kind == 0) return a + n;
    if (kind == 1) { int o;
        if (n < 1024) o = n; else if (n < 1280) o = 1040 + (n - 1024); else if (n < 1792) o = 1296 + (n - 1280); else if (n < 2048) o = 1808 + (n - 1792);
        else if (n < 3072) o = 2064 + (n - 2048); else { const int j = n - 3072; if (j < 16) o = 1024 + j; else if (j < 48) o = 3088 + (j - 16); else return nullptr; }
        return a + o; }
    const int hid = (n >> 8) * 128 + ((n & 255) >> 3) * 4 + (n & 3); const long dlt = (n & 4) ? (long)(b - a) : 0l; return a + dlt + hid; }

__device__ __forceinline__ void convert_layer_weights(const Frame& F, int l) {
    unsigned char* wb = F.ws + WS_W;
    LAS CvSeg* seg = (LAS CvSeg*)(F.lds + CVSEG_OFF);
    const float* wbr = F.in[I_WBR] + (size_t)l * 1280 * D;
    __syncthreads();
    if (F.tid == 0) { int ns = 0, tot = 0;
#define CV_ADD(K_, N_, LDW_, KIND_, DST_, A_, B_) do { LAS CvSeg* g_ = seg + ns; g_->first = tot; g_->K = (K_); g_->nblk = (N_) / 32; g_->ldw = (LDW_); g_->kind = (KIND_); g_->dst = (unsigned)(DST_); g_->a = (A_); g_->b = (B_); tot += ((K_) / 64) * ((N_) / 32); ++ns; } while (0)
        CV_ADD(D, 3328, NIN, 1, W_IN, F.in[I_WIN] + (size_t)l * D * NIN, (const float*)nullptr);
        CV_ADD(D, 4096, 4096, 0, W_GATE, F.in[I_WGATE] + (size_t)l * D * 4096, (const float*)nullptr);
        CV_ADD(D, D, D, 0, W_OUT, F.in[I_WOUT] + (size_t)l * D * D, (const float*)nullptr);
        CV_ADD(256, D, D, 0, W_BML, wbr, (const float*)nullptr);
        CV_ADD(512, D, D, 0, W_BAT, wbr + (size_t)512 * D, (const float*)nullptr);
        CV_ADD(256, D, D, 0, W_BGL, wbr + (size_t)1024 * D, (const float*)nullptr);
        if (l == 0) { CV_ADD(D, 2 * FFD, FFD, 2, W_FFD_GU, F.in[I_FFDWG], F.in[I_FFDWU]); CV_ADD(FFD, D, D, 0, W_FFD_D, F.in[I_FFDWD], (const float*)nullptr); }
        else { const float* wg = F.in[I_MOEWG]; const float* wu = F.in[I_MOEWU]; const float* wd = F.in[I_MOEWD];
            for (int e = 0; e < NEXP; ++e) { CV_ADD(D, 2 * FFE, FFE, 2, W_MOE_GU + (size_t)e * 2816 * D * 2, wg + (size_t)e * D * FFE, wu + (size_t)e * D * FFE);
                CV_ADD(FFE, D, D, 0, W_MOE_D + (size_t)e * 1024 * FFE * 2, wd + (size_t)e * FFE * D, (const float*)nullptr); } }
#undef CV_ADD
        seg[ns].first = tot; *(LAS int*)(F.lds + CVTOT_OFF) = tot; }
    __syncthreads();
    {   const int total = RFL(*(const LAS int*)(F.lds + CVTOT_OFF));
        LAS float* scr = (LAS float*)(F.lds + F.wave * 16384);
        const int gw = F.vcu * NWAVES + F.wave, NGW = F.G * NWAVES, lane = F.lane;
        int s = 0, nK = 0, nkb = 0, nnb = 0; unsigned ndst = 0u;
        float tn[32];
#define CV_FETCH(it_) do { while ((it_) >= RFL(seg[s + 1].first)) ++s; const int loc_ = (it_) - RFL(seg[s].first), nblk_ = RFL(seg[s].nblk); nkb = loc_ / nblk_; nnb = loc_ - nkb * nblk_; nK = RFL(seg[s].K); ndst = RFL(seg[s].dst); \
        const int ldw_ = RFL(seg[s].ldw), kind_ = RFL(seg[s].kind); const float* a_ = rfl_ptr(seg[s].a); const float* b_ = rfl_ptr(seg[s].b); \
        const float* src_ = cv_src(kind_, a_, b_, 32 * nnb + (lane & 31)); \
        _Pragma("unroll") for (int i = 0; i < 32; ++i) { const int kk = 2 * i + (lane >> 5); tn[i] = src_ ? ((const GAS float*)src_)[(size_t)(64 * nkb + kk) * ldw_] : 0.f; } } while (0)
        if (gw < total) CV_FETCH(gw);
        for (int it = gw; it < total; it += NGW) {
            const int K = nK, k0 = 64 * nkb, n0 = 32 * nnb; bf16* WT = (bf16*)(wb + ndst);
            float tv[32];
#pragma unroll
            for (int i = 0; i < 32; ++i) tv[i] = tn[i];
            if (it + NGW < total) CV_FETCH(it + NGW);
#pragma unroll
            for (int i = 0; i < 32; ++i) { const int kk = 2 * i + (lane >> 5); scr[kk * 33 + (lane & 31)] = tv[i]; }
            LDS_WAIT(); asm volatile("" ::: "memory");
            const int c = lane & 7;
#pragma unroll
            for (int j = 0; j < 4; ++j) { const int n = (lane >> 3) + 8 * j; const LAS float* sq = scr + (8 * c) * 33 + n;
                v4u o; o.x = pk2(sq[0 * 33], sq[1 * 33]); o.y = pk2(sq[2 * 33], sq[3 * 33]); o.z = pk2(sq[4 * 33], sq[5 * 33]); o.w = pk2(sq[6 * 33], sq[7 * 33]);
                *(GAS v4u*)(WT + (size_t)(n0 + n) * K + k0 + 8 * c) = o; }
            LDS_WAIT(); asm volatile("" ::: "memory");
        }
#undef CV_FETCH
    }
    { bf16* WT = (bf16*)(wb + W_BFT); const float* src = wbr + (size_t)256 * D;
      LAS f32x2* tcs = (LAS f32x2*)(F.lds + 131072 - 512);
      __syncthreads(); if (F.tid < 64) { const float ph = (float)F.tid * (1.f / 32.f); tcs[F.tid] = (f32x2){cospif(ph), sinpif(ph)}; } __syncthreads();
      if (F.tid < 256) for (int idx = F.vcu * 256 + F.tid; idx < 4 * 16 * 1024; idx += F.G * 256) { const int n = idx & 1023, c0 = ((idx >> 10) & 15) * 4, g = idx >> 14;
          float ac[4] = {0.f, 0.f, 0.f, 0.f}, as[4] = {0.f, 0.f, 0.f, 0.f};
#pragma unroll 1
          for (int q = 0; q < 4; ++q) { float v[16];
#pragma unroll
              for (int kk = 0; kk < 16; ++kk) v[kk] = ((const GAS float*)src)[(size_t)(64 * g + 16 * q + kk) * D + n];
#pragma unroll
              for (int kk = 0; kk < 16; ++kk) {
#pragma unroll
                  for (int j = 0; j < 4; ++j) { const f32x2 t = tcs[((16 * q + kk) * (c0 + j)) & 63]; ac[j] += t.x * v[kk]; as[j] += t.y * v[kk]; } } }
          bf16* o = WT + (size_t)n * 512 + g * 64 + c0;
          *(GAS v2u*)o = (v2u){pk2(ac[0] * 0.125f, ac[1] * 0.125f), pk2(ac[2] * 0.125f, ac[3] * 0.125f)};
          *(GAS v2u*)(o + 256) = (v2u){pk2(as[0] * 0.125f, as[1] * 0.125f), pk2(as[2] * 0.125f, as[3] * 0.125f)}; }
      __syncthreads(); }
}
__device__ __forceinline__ void build_tables(const Frame& F) {
    const int gt = F.vcu * 512 + F.tid, NT_ = F.G * 512;
    float* rc = (float*)(F.ws + WS_ROPE_C); float* rs = (float*)(F.ws + WS_ROPE_S);
    for (int i = gt; i < 256 * 16; i += NT_) { const int pos = i >> 4, p = i & 15;
        double inv = (p & 3) == 0 ? 1.0 : ((p & 3) == 1 ? 0.5623413251903491 : ((p & 3) == 2 ? 0.31622776601683794 : 0.17782794100389228));
        for (int q = 0; q < (p >> 2); ++q) inv *= 0.1;
        const float angf = (float)pos * (float)inv;
        double xr = (double)angf * 0.3183098861837907; xr -= 2.0 * rint(xr * 0.5);
        rc[i] = cospif((float)xr); rs[i] = sinpif((float)xr); }
    bf16* dc = (bf16*)(F.ws + WS_DFT_C); bf16* ds = (bf16*)(F.ws + WS_DFT_S);
    for (int i = gt; i < 128 * 128; i += NT_) { const int j = i >> 7, k = i & 127; const float ph = (float)((j * k) & 127) * (1.f / 64.f); dc[i] = (bf16)f2bf(cospif(ph)); ds[i] = (bf16)f2bf(sinpif(ph)); }
}
__device__ __forceinline__ void ada_phase(const Frame& F) {
    LAS float* sc = (LAS float*)(F.lds);
    LAS float* red = (LAS float*)(F.lds + 16384);
    for (int i = F.tid; i < 3 * D; i += 512) { const int s = i >> 10, k = i & 1023; const float v = s < 2 ? F.in[I_C][s * D + k] : F.in[I_CCTX][k]; sc[i] = v * sigm(v); }
    __syncthreads();
    for (int task = F.vcu; task < 2 * 96; task += F.G) { const int l = task / 96, cb = task % 96, col = cb * 64 + F.lane;
        const float* w = F.in[I_WADA] + (size_t)l * D * 6144 + col; float a0 = 0.f, a1 = 0.f, a2 = 0.f;
        const int kb = F.wave * 128;
#pragma unroll 32
        for (int k = 0; k < 128; ++k) { const float wv = ((const GAS float*)w)[(size_t)(kb + k) * 6144]; a0 += sc[kb + k] * wv; a1 += sc[D + kb + k] * wv; a2 += sc[2 * D + kb + k] * wv; }
        red[(F.wave * 3 + 0) * 64 + F.lane] = a0; red[(F.wave * 3 + 1) * 64 + F.lane] = a1; red[(F.wave * 3 + 2) * 64 + F.lane] = a2;
        __syncthreads();
        if (F.tid < 192) { const int s = F.tid >> 6, ln = F.tid & 63; float t = 0.f;
#pragma unroll
            for (int w8 = 0; w8 < 8; ++w8) t += red[(w8 * 3 + s) * 64 + ln];
            F.ADA()[(size_t)(l * 3 + s) * 6144 + cb * 64 + ln] = t + F.in[I_BADA][(size_t)l * 6144 + cb * 64 + ln]; }
        __syncthreads();
    }
}
struct Row16 { f32x4 v[4]; };
__device__ __forceinline__ Row16 ld_row(const float* p, int lane) { Row16 r; const GAS f32x4* q = (const GAS f32x4*)p + lane;
#pragma unroll
    for (int j = 0; j < 4; ++j) r.v[j] = q[64 * j];
    return r; }
__device__ __forceinline__ void st_row(float* p, int lane, const Row16& r) { GAS f32x4* q = (GAS f32x4*)p + lane;
#pragma unroll
    for (int j = 0; j < 4; ++j) q[64 * j] = r.v[j]; }
__device__ __forceinline__ void ln_norm(Row16& r) {
    float s = 0.f;
#pragma unroll
    for (int j = 0; j < 4; ++j) s += (r.v[j].x + r.v[j].y) + (r.v[j].z + r.v[j].w);
    const float mean = wave_sum(s) * (1.f / D); float s2 = 0.f;
#pragma unroll
    for (int j = 0; j < 4; ++j) { r.v[j] = r.v[j] - mean; s2 += (r.v[j].x * r.v[j].x + r.v[j].y * r.v[j].y) + (r.v[j].z * r.v[j].z + r.v[j].w * r.v[j].w); }
    const float rstd = 1.f / sqrtf(wave_sum(s2) * (1.f / D) + LN_EPS);
#pragma unroll
    for (int j = 0; j < 4; ++j) r.v[j] = r.v[j] * rstd;
}
__device__ __forceinline__ void affine(Row16& r, const float* g, const float* b, int lane, bool one_plus) {
    const Row16 gg = ld_row(g, lane), bb = ld_row(b, lane);
#pragma unroll
    for (int j = 0; j < 4; ++j) r.v[j] = r.v[j] * (one_plus ? gg.v[j] + 1.0f : gg.v[j]) + bb.v[j];
}
__device__ __forceinline__ void affine_r(Row16& r, const Row16& gg, const Row16& bb, bool one_plus) {
#pragma unroll
    for (int j = 0; j < 4; ++j) r.v[j] = r.v[j] * (one_plus ? gg.v[j] + 1.0f : gg.v[j]) + bb.v[j];
}
__device__ __forceinline__ void st_row_bf16(bf16* p, int lane, const Row16& r) { GAS v2u* q = (GAS v2u*)p + lane;
#pragma unroll
    for (int j = 0; j < 4; ++j) { v2u w; w.x = pk2(r.v[j].x, r.v[j].y); w.y = pk2(r.v[j].z, r.v[j].w); q[64 * j] = w; } }
__device__ __forceinline__ void phase_ln_mod(const Frame& F, int l) {
    const int gw = F.vcu * NWAVES + F.wave, NGW = F.G * NWAVES;
    Row16 nx; if (gw < R) nx = ld_row(xin_row(F, l, gw), F.lane);
    int cs = -1; Row16 asc, ash;
    for (int r = gw; r < R; r += NGW) { Row16 x = nx; if (r + NGW < R) nx = ld_row(xin_row(F, l, r + NGW), F.lane);
        ln_norm(x); const int s = set_of_row(r); if (s != cs) { cs = s; asc = ld_row(ada_vec(F, l, s, 1), F.lane); ash = ld_row(ada_vec(F, l, s, 0), F.lane); }
        affine_r(x, asc, ash, true); st_row_bf16(F.H() + (size_t)r * D, F.lane, x); }
}
__device__ __forceinline__ void phase_qk(const Frame& F, int l, bool dry = false) {
    const int gw = F.vcu * NWAVES + F.wave, NGW = F.G * NWAVES, lane = F.lane, hd = lane >> 2, qd = lane & 3;
    const float* rc = (const float*)(F.ws + WS_ROPE_C); const float* rs = (const float*)(F.ws + WS_ROPE_S);
    const float* gq = F.in[I_GQQG] + l * 64; const float* gk = F.in[I_GQKG] + l * 64;
    const int coff = (hd < 8 ? TC_GQQ + hd * 64 : TC_GQK + (hd - 8) * 64) + qd * 16;
    float gl_[16];
    { const float* g = (hd < 8 ? gq : gk) + qd * 16;
#pragma unroll
        for (int i = 0; i < 16; ++i) gl_[i] = ((const GAS float*)g)[i]; }
    v4u na = {0u, 0u, 0u, 0u}, nb = {0u, 0u, 0u, 0u};
    if (gw < R && hd < 10) { const bf16* p0 = F.P() + (size_t)gw * NP + coff; na = *(const GAS v4u*)p0; nb = *(const GAS v4u*)(p0 + 8); }
    for (int r = gw; r < R; r += NGW) {
        float x[16]; bf16* p = F.P() + (size_t)r * NP + coff;
        const v4u a = na, b = nb;
        if (r + NGW < R && hd < 10) { const bf16* p1 = F.P() + (size_t)(r + NGW) * NP + coff; na = *(const GAS v4u*)p1; nb = *(const GAS v4u*)(p1 + 8); }
        float ss = 0.f;
        if (hd < 10) {
            x[0] = bflo(a.x); x[1] = bfhi(a.x); x[2] = bflo(a.y); x[3] = bfhi(a.y); x[4] = bflo(a.z); x[5] = bfhi(a.z); x[6] = bflo(a.w); x[7] = bfhi(a.w);
            x[8] = bflo(b.x); x[9] = bfhi(b.x); x[10] = bflo(b.y); x[11] = bfhi(b.y); x[12] = bflo(b.z); x[13] = bfhi(b.z); x[14] = bflo(b.w); x[15] = bfhi(b.w);
#pragma unroll
            for (int i = 0; i < 16; ++i) ss += x[i] * x[i]; }
        else {
#pragma unroll
            for (int i = 0; i < 16; ++i) x[i] = 0.f; }
        ss += dpp_get<0xB1>(ss); ss += dpp_get<0x4E>(ss);
        const float rstd = __builtin_amdgcn_rsqf(ss * (1.f / 64.f) + LN_EPS);
#pragma unroll
        for (int i = 0; i < 16; ++i) x[i] = x[i] * rstd * gl_[i];
        float y[16];
#pragma unroll
        for (int i = 0; i < 16; ++i) y[i] = dpp_get<0xB1>(x[i]);
        if (r < RL) { const int t = r & (T - 1), pos = (qd >> 1) ? (t & 63) : (t >> 6); const GAS f32x4* c4 = (const GAS f32x4*)(rc + pos * 16); const GAS f32x4* s4 = (const GAS f32x4*)(rs + pos * 16);
            const f32x4 cv[4] = {c4[0], c4[1], c4[2], c4[3]}, sv[4] = {s4[0], s4[1], s4[2], s4[3]};
#pragma unroll
            for (int i = 0; i < 16; ++i) { const float c = cv[i >> 2][i & 3], s = sv[i >> 2][i & 3]; x[i] = (qd & 1) ? (y[i] * s + x[i] * c) : (x[i] * c - y[i] * s); } }
        if (hd < 8) {
#pragma unroll
            for (int i = 0; i < 16; ++i) x[i] *= C2Q; }
        if (hd < 10 && !dry) { v4u a, b; a.x = pk2(x[0], x[1]); a.y = pk2(x[2], x[3]); a.z = pk2(x[4], x[5]); a.w = pk2(x[6], x[7]); b.x = pk2(x[8], x[9]); b.y = pk2(x[10], x[11]); b.z = pk2(x[12], x[13]); b.w = pk2(x[14], x[15]);
            *(GAS v4u*)p = a; *(GAS v4u*)(p + 8) = b; }
    }
}
__device__ __forceinline__ void build_ctx_panels(const Frame& F) {
    const int q = (int)blockIdx.x; if (q >= 8) return;
    const bf16* uq = (const bf16*)(F.ws + WS_UQ) + (size_t)(q >> 2) * 256 * D; bf16* pa = (bf16*)(F.ws + WS_PA) + (size_t)q * 256 * D;
    for (int idx = F.tid; idx < 256 * D / 8; idx += 512) { float a[8], t[8]; unpack8(*(const v4u*)(uq + (size_t)idx * 8), a);
#pragma unroll
        for (int j = 1; j < 4; ++j) { unpack8(*(const v4u*)(uq + (size_t)j * 512 * D + (size_t)idx * 8), t);
#pragma unroll
            for (int e = 0; e < 8; ++e) a[e] += t[e]; }
        *(v4u*)(pa + (size_t)idx * 8) = pack8(a); }
    asm volatile("s_waitcnt vmcnt(0)" ::: "memory"); __syncthreads();
}
__device__ __forceinline__ void phase_post_mix(const Frame& F, int l, int nrows, const float* T1) {
    const int gw = F.vcu * NWAVES + F.wave, NGW = F.G * NWAVES, lane = F.lane;
    volatile LAS int* hist = (volatile LAS int*)(F.lds + 1024);
    float brv[8];
#pragma unroll
    for (int e = 0; e < 8; ++e) brv[e] = (l == 1) ? ((const GAS float*)F.in[I_MOEBR])[e] : 0.f;
    if (l == 1) { if (F.tid < 8) hist[F.tid] = 0; __syncthreads(); }
    const Row16 g1 = ld_row(F.in[I_LN1G] + l * D, lane), b1 = ld_row(F.in[I_LN1B] + l * D, lane);
    int cs = -1; Row16 asc, ash;
    LAS float* wrl = (LAS float*)(F.lds + 4096);
    if (l == 1) { for (int i = F.tid; i < D * 8 / 4; i += 512) *(LAS f32x4*)(wrl + i * 4) = *(const GAS f32x4*)(F.in[I_MOEWR] + i * 4); __syncthreads(); }
    Row16 nx; if (gw < nrows) nx = ld_row(T1 + (size_t)gw * D, lane);
    for (int r = gw; r < nrows; r += NGW) {
        Row16 x = nx; if (r + NGW < nrows) nx = ld_row(T1 + (size_t)(r + NGW) * D, lane);
        ln_norm(x); affine_r(x, g1, b1, false);
        st_row(F.XM() + (size_t)r * D, lane, x);
        ln_norm(x); const int s = set_of_row(r); if (s != cs) { cs = s; asc = ld_row(ada_vec(F, l, s, 4), lane); ash = ld_row(ada_vec(F, l, s, 3), lane); }
        affine_r(x, asc, ash, true);
        st_row_bf16(F.H() + (size_t)r * D, lane, x);
        if (l == 1) {
            float lg[8];
#pragma unroll
            for (int e = 0; e < 8; ++e) lg[e] = 0.f;
#pragma unroll
            for (int j = 0; j < 4; ++j)
#pragma unroll
                for (int q = 0; q < 4; ++q) { const float xv = x.v[j][q]; const LAS f32x4* wp = (const LAS f32x4*)(wrl + (256 * j + 4 * lane + q) * 8); const f32x4 w0 = wp[0], w1 = wp[1];
                    lg[0] += xv * w0.x; lg[1] += xv * w0.y; lg[2] += xv * w0.z; lg[3] += xv * w0.w; lg[4] += xv * w1.x; lg[5] += xv * w1.y; lg[6] += xv * w1.z; lg[7] += xv * w1.w; }
#pragma unroll
            for (int e = 0; e < 8; ++e) lg[e] = wave_sum(lg[e]);
            int i0 = 0; float b0 = lg[0] + brv[0];
#pragma unroll
            for (int e = 1; e < 8; ++e) { const float v = lg[e] + brv[e]; if (v > b0) { b0 = v; i0 = e; } }
            int i1 = (i0 == 0) ? 1 : 0; float b1 = (i0 == 0) ? lg[1] + brv[1] : lg[0] + brv[0];
#pragma unroll
            for (int e = 1; e < 8; ++e) { const float v = lg[e] + brv[e]; if (e != i0 && v > b1) { b1 = v; i1 = e; } }
            float l0 = 0.f, l1 = 0.f;
#pragma unroll
            for (int e = 0; e < 8; ++e) { l0 = (e == i0) ? lg[e] : l0; l1 = (e == i1) ? lg[e] : l1; }
            const float mx = fmaxf(l0, l1), e0 = __expf(l0 - mx), e1 = __expf(l1 - mx), inv = 1.f / (e0 + e1);
            if (lane == 0) { GAS v4u* sel = (GAS v4u*)(F.ws + WS_MOE + MO_SEL) + (size_t)r; *sel = (v4u){(unsigned)i0, (unsigned)i1, __float_as_uint(e0 * inv), __float_as_uint(e1 * inv)};
                __hip_atomic_fetch_add((LAS int*)&hist[i0], 1, __ATOMIC_RELAXED, __HIP_MEMORY_SCOPE_WORKGROUP); __hip_atomic_fetch_add((LAS int*)&hist[i1], 1, __ATOMIC_RELAXED, __HIP_MEMORY_SCOPE_WORKGROUP); }
        }
    }
    if (l == 1) { __syncthreads(); if (F.tid < 8) __hip_atomic_fetch_add((unsigned*)(F.ctl() + CW_MOECNT + 64 * F.tid), (unsigned)hist[F.tid], RLX_AGENT); }
}
__device__ __forceinline__ void phase_moe_assign(const Frame& F) {
    volatile LAS int* L = (volatile LAS int*)(F.lds + 1024);
    int* tok = (int*)(F.ws + WS_MOE + MO_TOK); int* dst = (int*)(F.ws + WS_MOE + MO_DST); int* tile_e = (int*)(F.ws + WS_MOE + MO_SEL + (size_t)RL * 16); int* ntl = tile_e + 512;
    if (F.tid < 8) L[F.tid] = 0;
    if (F.tid == 0) { int base = 0;
        for (int e = 0; e < 8; ++e) { const int c = (int)__hip_atomic_load((unsigned*)(F.ctl() + CW_MOECNT + 64 * e), RLX_AGENT); const int tl = (c + 255) >> 8; L[16 + e] = base * 256; L[24 + e] = c;
            if (blockIdx.x == 0) for (int q = 0; q < tl; ++q) tile_e[base + q] = e;
            base += tl; }
        if (blockIdx.x == 0) ntl[0] = base; }
    __syncthreads();
    const int wg = F.vcu; int e = 0, rank = 0, token = 0, k = 0; const bool act = F.tid < 256 && wg * 128 < RL;
    for (int w0 = wg; w0 * 128 < RL; w0 += F.G) {
        if (F.tid < 256) { token = w0 * 128 + (F.tid >> 1); k = F.tid & 1; e = ((const GAS int*)(F.ws + WS_MOE + MO_SEL))[(size_t)token * 4 + k]; rank = __hip_atomic_fetch_add((LAS int*)&L[e], 1, __ATOMIC_RELAXED, __HIP_MEMORY_SCOPE_WORKGROUP); }
        __syncthreads();
        if (F.tid < 8) { L[8 + F.tid] = (int)__hip_atomic_fetch_add((unsigned*)(F.ctl() + CW_MOECUR + 64 * F.tid), (unsigned)L[F.tid], RLX_AGENT); }
        __syncthreads();
        if (F.tid < 256) { const int slot = L[16 + e] + L[8 + e] + rank; tok[slot] = token; dst[slot] = token * 2 + k; }
        __syncthreads();
        if (F.tid < 8) L[F.tid] = 0;
        __syncthreads();
    }
    (void)act;
    if (wg < 8) { const int c = L[24 + wg], tl = (c + 255) >> 8, b = L[16 + wg]; for (int s = c + F.tid; s < tl * 256; s += 512) { tok[b + s] = 0; dst[b + s] = -1; } }
}
__device__ __forceinline__ void phase_final(const Frame& F, int l) {
    const int gw = F.vcu * NWAVES + F.wave, NGW = F.G * NWAVES, lane = F.lane;
    if (l == 0) {
        const Row16 g2 = ld_row(F.in[I_LN2G], lane), b2 = ld_row(F.in[I_LN2B], lane); int cs = -1; Row16 asc, ash;
        Row16 nx; if (gw < R) nx = ld_row(F.XM() + (size_t)gw * D, lane);
        for (int r = gw; r < R; r += NGW) {
            Row16 x = nx; if (r + NGW < R) nx = ld_row(F.XM() + (size_t)(r + NGW) * D, lane);
            if (r >= RL) { const float* dp = (const float*)(F.ws + WS_DP) + (size_t)(r - RL) * D; const Row16 p0 = ld_row(dp, lane), p1 = ld_row(dp + (size_t)512 * D, lane), g5 = ld_row(ada_vec(F, 0, 2, 5), lane);
#pragma unroll
                for (int j = 0; j < 4; ++j) x.v[j] = x.v[j] * ALPHA + g5.v[j] * (p0.v[j] + p1.v[j]); }
            ln_norm(x); affine_r(x, g2, b2, false);
            st_row(r < RL ? F.out + (size_t)r * D : F.XC() + (size_t)(r - RL) * D, lane, x);
            ln_norm(x); const int s = set_of_row(r); if (s != cs) { cs = s; asc = ld_row(ada_vec(F, 1, s, 1), lane); ash = ld_row(ada_vec(F, 1, s, 0), lane); }
            affine_r(x, asc, ash, true);
            st_row_bf16(F.H() + (size_t)r * D, lane, x); }
    } else {
        const Row16 g2 = ld_row(F.in[I_LN2G] + D, lane), b2 = ld_row(F.in[I_LN2B] + D, lane); int cs = -1; Row16 g5;
        Row16 nx; v2u na[4], nb[4]; float nw0 = 0.f, nw1 = 0.f;
#define FIN_LOAD(rr) do { const GAS float* sel_ = (const GAS float*)(F.ws + WS_MOE + MO_SEL) + (size_t)(rr) * 4; nw0 = sel_[2]; nw1 = sel_[3]; \
            const bf16* d0_ = (const bf16*)F.out + (size_t)(rr) * 2 * D; const GAS v2u* q0_ = (const GAS v2u*)d0_ + lane; const GAS v2u* q1_ = (const GAS v2u*)(d0_ + D) + lane; \
            nx = ld_row(F.XM() + (size_t)(rr) * D, lane); _Pragma("unroll") for (int j = 0; j < 4; ++j) { na[j] = q0_[64 * j]; nb[j] = q1_[64 * j]; } } while (0)
        if (gw < RL) FIN_LOAD(gw);
        for (int r = gw; r < RL; r += NGW) {
            Row16 x = nx; v2u a4[4], b4[4]; const float w0 = nw0, w1 = nw1;
#pragma unroll
            for (int j = 0; j < 4; ++j) { a4[j] = na[j]; b4[j] = nb[j]; }
            if (r + NGW < RL) FIN_LOAD(r + NGW);
            { const int s = set_of_row(r); if (s != cs) { cs = s; g5 = ld_row(ada_vec(F, 1, s, 5), lane); } }
#pragma unroll
            for (int j = 0; j < 4; ++j) { const v2u a = a4[j], b = b4[j];
                f32x4 f; f.x = w0 * bflo(a.x) + w1 * bflo(b.x); f.y = w0 * bfhi(a.x) + w1 * bfhi(b.x); f.z = w0 * bflo(a.y) + w1 * bflo(b.y); f.w = w0 * bfhi(a.y) + w1 * bfhi(b.y);
                x.v[j] = x.v[j] * ALPHA + g5.v[j] * f; }
            ln_norm(x); affine_r(x, g2, b2, false);
            st_row(F.out + (size_t)r * D, lane, x); }
#undef FIN_LOAD
    }
}
__device__ __forceinline__ void lds_barrier() { asm volatile("s_waitcnt lgkmcnt(0)\n\ts_barrier" ::: "memory"); }
constexpr int PT = 72;
typedef LAS bf16* ltile;
__device__ __forceinline__ bf16x8 ldfrag(const LAS bf16* t, int row, int k0, int pitch) { return *(const LAS bf16x8*)(t + row * pitch + k0); }
template <int KD, int PX, int PY>
__device__ __forceinline__ f32x4 mmt(f32x4 acc, const LAS bf16* X, int x0, const LAS bf16* Y, int y0, int fr, int fq) {
#pragma unroll
    for (int kk = 0; kk < KD; kk += 32) acc = __builtin_amdgcn_mfma_f32_16x16x32_bf16(ldfrag(X, x0 + fr, kk + 8 * fq, PX), ldfrag(Y, y0 + fr, kk + 8 * fq, PY), acc, 0, 0, 0);
    return acc;
}
typedef short s16x4_t __attribute__((ext_vector_type(4)));
__device__ __forceinline__ bf16x8 ldfrag_tr(const LAS bf16* X, int k0, int n0, int pitch, int lane) {
    const int fq = lane >> 4, q = (lane & 15) >> 2, p = lane & 3;
    const LAS bf16* a = X + (k0 + 8 * fq + q) * pitch + n0 + 4 * p;
    const s16x4_t lo = __builtin_bit_cast(s16x4_t, __builtin_amdgcn_ds_read_tr16_b64_v4i16((LAS s16x4_t*)a));
    const s16x4_t hi = __builtin_bit_cast(s16x4_t, __builtin_amdgcn_ds_read_tr16_b64_v4i16((LAS s16x4_t*)(a + 4 * pitch)));
    return (bf16x8){lo[0], lo[1], lo[2], lo[3], hi[0], hi[1], hi[2], hi[3]};
}
template <int KD, int PX, int PY>
__device__ __forceinline__ f32x4 mmt_tx(f32x4 acc, const LAS bf16* XR, int x0, const LAS bf16* Y, int y0, int fr, int fq, int lane) {
#pragma unroll
    for (int kk = 0; kk < KD; kk += 32) acc = __builtin_amdgcn_mfma_f32_16x16x32_bf16(ldfrag_tr(XR, kk, x0, PX, lane), ldfrag(Y, y0 + fr, kk + 8 * fq, PY), acc, 0, 0, 0);
    return acc;
}
template <int KD, int PX, int PY>
__device__ __forceinline__ f32x4 mmt_txy(f32x4 acc, const LAS bf16* XR, int x0, const LAS bf16* YR, int y0, int lane) {
#pragma unroll
    for (int kk = 0; kk < KD; kk += 32) acc = __builtin_amdgcn_mfma_f32_16x16x32_bf16(ldfrag_tr(XR, kk, x0, PX, lane), ldfrag_tr(YR, kk, y0, PY, lane), acc, 0, 0, 0);
    return acc;
}
template <int CTRL, int RMASK> __device__ __forceinline__ float dpp_or(float v, float ident) { return __builtin_bit_cast(float, __builtin_amdgcn_update_dpp(__builtin_bit_cast(int, ident), __builtin_bit_cast(int, v), CTRL, RMASK, 0xF, false)); }
__device__ __forceinline__ float wave_incl_scan_add(float v, int lane) {
    v += dpp_or<0x111, 0xF>(v, 0.f); v += dpp_or<0x112, 0xF>(v, 0.f); v += dpp_or<0x114, 0xF>(v, 0.f); v += dpp_or<0x118, 0xF>(v, 0.f);
    v += dpp_or<0x142, 0xA>(v, 0.f); v += dpp_or<0x143, 0xC>(v, 0.f);
    return v; }
__device__ __forceinline__ float wave_incl_scan_max(float v, int lane) {
    const float NI = -INFINITY;
    v = fmaxf(v, dpp_or<0x111, 0xF>(v, NI)); v = fmaxf(v, dpp_or<0x112, 0xF>(v, NI)); v = fmaxf(v, dpp_or<0x114, 0xF>(v, NI)); v = fmaxf(v, dpp_or<0x118, 0xF>(v, NI));
    v = fmaxf(v, dpp_or<0x142, 0xA>(v, NI)); v = fmaxf(v, dpp_or<0x143, 0xC>(v, NI));
    return v; }
__device__ __forceinline__ float wave_max(float v) {
    v = fmaxf(v, dpp_get<0xB1>(v)); v = fmaxf(v, dpp_get<0x4E>(v)); v = fmaxf(v, dpp_get<0x141>(v)); v = fmaxf(v, dpp_get<0x140>(v));
    { const auto rr = __builtin_amdgcn_permlane16_swap(__float_as_uint(v), __float_as_uint(v), false, false); v = fmaxf(__uint_as_float(rr[0]), __uint_as_float(rr[1])); }
    { const auto rr = __builtin_amdgcn_permlane32_swap(__float_as_uint(v), __float_as_uint(v), false, false); v = fmaxf(__uint_as_float(rr[0]), __uint_as_float(rr[1])); }
    return v; }

constexpr int DIRB = 65536;
constexpr int L_QS = 0, L_KS = 9216, L_VT = 18432, L_WS = 27648, L_CS = 36864, L_VEC = 48384, L_AF = 49408, L_PRE = 53504, L_G = 27648, L_HB = 0;
struct ScanPtrs { bf16* Cst; float* Nst; float* Amx; float* Bl; float* Mst; bf16* Gst; float* Gld; };
__device__ __forceinline__ int chunk_row0(int b, int tc) { return tc < 4 ? RL + b * CTX + tc * 64 : b * T + (tc - 4) * 64; }
__device__ __forceinline__ int chunk_pos(int tc, int d) { return d == 0 ? tc : (tc < 4 ? 3 - tc : 263 - tc); }

struct ScanRegs { v4u q0, q1, k0, k1, v0, v1, st0, st1; f32x4 nv0, nv1, af; v2u og0, og1, og2, og3; float gi, gf, mc; };
#define SR_SEL2(R, f, rep) ((rep) == 0 ? (R).f##0 : (R).f##1)
struct UnitId { int fam, b, head, tc; };
__device__ __forceinline__ bool unit_decode(int u, UnitId& id) { if (u >= 2 * 2080) return false; id.fam = ((u >> 8) + u) & 1;   const int rem = u >> 1; id.b = rem / 1040; id.head = (rem / 260) & 3; id.tc = rem % 260; return true; }
__device__ __forceinline__ bool unit_decode_q(int q, int l, bool out, UnitId& id) {
    if (out && l == 1) { if (q >= 2 * 2048) return false; id.fam = q & 1; const int rem = q >> 1; id.b = rem >> 10; id.head = (rem >> 8) & 3; id.tc = 4 + (rem & 255); return true; }
    if (q >= 2 * 2080) return false; id.fam = q & 1; const int rem = q >> 1; id.b = rem / 1040; id.head = (rem / 260) & 3; id.tc = rem % 260; return true; }
template <bool OUT>
__device__ __forceinline__ void scan_fetch(const Frame& F, int l, const UnitId& id, const ScanPtrs& sp, ScanRegs& R_) {
    const int tid = F.tid, d = tid >> 8, ht = tid & 255, lane = F.lane, hw = F.wave & 3;
    const int row0 = chunk_row0(id.b, id.tc), pos = chunk_pos(id.tc, d), chain = (id.b * 4 + id.head) * 2 + d; const size_t slot = (size_t)chain * NCH + pos;
    const bool ml = id.fam == 0;
#define SF_ONE(rep, QF, KF, VF, SF) { const int q = ht + 256 * rep, i = q >> 3, c8 = q & 7, tok = d ? 63 - i : i; \
        const bf16* rp = F.P() + (size_t)(row0 + tok) * NP + id.head * 64 + c8 * 8; \
        if (OUT) R_.QF = *(const GAS v4u*)(rp + (ml ? TC_MLQ : TC_GLQ)); \
        R_.KF = *(const GAS v4u*)(rp + (ml ? TC_MLK : TC_GLK)); R_.VF = *(const GAS v4u*)(rp + (ml ? TC_MLV : TC_GLV)); \
        if (OUT) { const bf16* Cg = (ml ? sp.Cst : sp.Gst) + slot * 4096; R_.SF = *(const GAS v4u*)(Cg + (q >> 3) * 64 + c8 * 8); } }
    SF_ONE(0, q0, k0, v0, st0) SF_ONE(1, q1, k1, v1, st1)
#undef SF_ONE
    { const int tok = d ? 63 - lane : lane; const float* sm = F.SM() + (size_t)(row0 + tok) * SMP + d * 8 + id.head; R_.gi = ((const GAS float*)sm)[0]; R_.gf = ((const GAS float*)sm)[4]; }
    R_.mc = 0.f; R_.nv0 = (f32x4){0.f, 0.f, 0.f, 0.f}; R_.nv1 = R_.nv0;
    if (OUT) { R_.mc = ((const GAS float*)sp.Mst)[slot]; const float* np_ = sp.Nst + slot * 64 + (ht & 7) * 8; R_.nv0 = *(const f32x4*)np_; R_.nv1 = *(const GAS f32x4*)(np_ + 4); }
    { const int i = ht >> 2, q4 = ht & 3, tok = d ? 63 - i : i; R_.af = *(const GAS f32x4*)(F.SM() + (size_t)(row0 + tok) * SMP + 16 + d * 16 + q4 * 4); }
    R_.og0 = (v2u){0u, 0u}; R_.og1 = R_.og0; R_.og2 = R_.og0; R_.og3 = R_.og0;
    if (!OUT) { R_.q0 = (v4u){0u, 0u, 0u, 0u}; R_.q1 = R_.q0; R_.st0 = R_.q0; R_.st1 = R_.q0; }
    if (OUT) { const int fr = lane & 15, fq = lane >> 4, t = 16 * hw + fr; const bf16* op = F.P() + (size_t)(row0 + t) * NP + (ml ? TC_MLO : TC_GLR) + id.head * 64;
        R_.og0 = *(const GAS v2u*)(op + 4 * fq); R_.og1 = *(const GAS v2u*)(op + 16 + 4 * fq); R_.og2 = *(const GAS v2u*)(op + 32 + 4 * fq); R_.og3 = *(const GAS v2u*)(op + 48 + 4 * fq); }
}
__device__ __forceinline__ void gla_build_g(const Frame& F, int l, int head, int d, const f32x4 af, LAS unsigned char* base, int ht) {
    LAS float* AF = (LAS float*)(base + L_AF); LAS float* G = (LAS float*)(base + L_G); LAS float* PRE = (LAS float*)(base + L_PRE);
    { const int i = ht >> 2, q4 = ht & 3; *(LAS f32x4*)(AF + i * 16 + q4 * 4) = af; }
    lds_barrier();
    const int k = ht & 63, tq = ht >> 6;
    const float* w2 = F.in[I_GLW2] + ((size_t)(l * 2 + d) * 16) * 256 + head * 64 + k; const float bb = ((const GAS float*)F.in[I_GLB2])[(size_t)(l * 2 + d) * 256 + head * 64 + k];
    float w[16];
#pragma unroll
    for (int r = 0; r < 16; ++r) w[r] = ((const GAS float*)w2)[(size_t)r * 256];
    float run = 0.f;
#pragma unroll 4
    for (int ii = 0; ii < 16; ++ii) { const int i = 16 * tq + ii; float a = bb;
        const f32x4 f0 = *(const LAS f32x4*)(AF + i * 16), f1 = *(const LAS f32x4*)(AF + i * 16 + 4), f2 = *(const LAS f32x4*)(AF + i * 16 + 8), f3 = *(const LAS f32x4*)(AF + i * 16 + 12);
        a += f0.x * w[0] + f0.y * w[1] + f0.z * w[2] + f0.w * w[3]; a += f1.x * w[4] + f1.y * w[5] + f1.z * w[6] + f1.w * w[7];
        a += f2.x * w[8] + f2.y * w[9] + f2.z * w[10] + f2.w * w[11]; a += f3.x * w[12] + f3.y * w[13] + f3.z * w[14] + f3.w * w[15];
        run += logsig(a) * (1.f / 16.f); G[i * 65 + k] = run; }
    PRE[tq * 64 + k] = run;
    lds_barrier();
    float off = 0.f;
#pragma unroll
    for (int q = 0; q < 3; ++q) off += (q < tq) ? PRE[q * 64 + k] : 0.f;
    if (tq > 0) { for (int ii = 0; ii < 16; ++ii) G[(16 * tq + ii) * 65 + k] += off; }
    lds_barrier();
}
__device__ __forceinline__ void ml_gates(const Frame& F, int l, int head, int d, float gi, float gf, int lane, float& a, float& bcum) {
    const float* gb = F.in[I_MLGB] + (size_t)l * 16 + d * 8 + head;
    const float li = gi + ((const GAS float*)gb)[0], lf = logsig(gf + ((const GAS float*)gb)[4]);
    bcum = wave_incl_scan_add(lf, lane); a = li - bcum;
}
template <bool IS_ML>
__device__ __forceinline__ void scan_local_unit(const Frame& F, int l, int b, int head, int tc, const ScanPtrs& sp, const ScanRegs& R_) {
    const int tid = F.tid, d = tid >> 8, ht = tid & 255, hw = F.wave & 3, lane = F.lane, fr = lane & 15, fq = lane >> 4;
    LAS unsigned char* base = F.lds + d * DIRB;
    LAS bf16* Kt = (LAS bf16*)(base + L_KS); LAS bf16* Vt = (LAS bf16*)(base + L_VT); LAS float* vec = (LAS float*)(base + L_VEC);
    const int pos = chunk_pos(tc, d), chain = (b * 4 + head) * 2 + d; const size_t slot = (size_t)chain * NCH + pos;
    if constexpr (IS_ML) {
        if (hw == 0) { float a, bc; ml_gates(F, l, head, d, R_.gi, R_.gf, lane, a, bc); const float amax = wave_max(a); vec[lane] = __expf(a - amax);
            if (lane == 63) { ((GAS float*)sp.Amx)[slot] = amax; ((GAS float*)sp.Bl)[slot] = bc; } }
        lds_barrier();
    } else { gla_build_g(F, l, head, d, R_.af, base, ht); }
    const LAS float* G = (const LAS float*)(base + L_G);
#pragma unroll
    for (int rep = 0; rep < 2; ++rep) { const int q = ht + 256 * rep, i = q >> 3, c8 = q & 7;
        float kx[8], vx[8]; unpack8(SR_SEL2(R_, k, rep), kx); unpack8(SR_SEL2(R_, v, rep), vx);
        const float wsi = IS_ML ? vec[i] : 1.f;
#pragma unroll
        for (int e = 0; e < 8; ++e) { kx[e] = IS_ML ? kx[e] * 0.125f : kx[e] * __expf(-G[i * 65 + c8 * 8 + e]); vx[e] *= wsi; }
        *(LAS v4u*)(Kt + i * PT + c8 * 8) = pack8(kx); *(LAS v4u*)(Vt + i * PT + c8 * 8) = pack8(vx); }
    if (!IS_ML && ht < 64) ((GAS float*)sp.Gld)[slot * 64 + ht] = __expf(G[63 * 65 + ht]);
    lds_barrier();
    bf16* Cg = (IS_ML ? sp.Cst : sp.Gst) + slot * 4096;
#pragma unroll
    for (int kt = 0; kt < 4; ++kt) { f32x4 acc = {0.f, 0.f, 0.f, 0.f}; acc = mmt_txy<64, PT, PT>(acc, Kt, 16 * kt, Vt, 16 * hw, lane);
        v2u w; w.x = pk2(acc[0], acc[1]); w.y = pk2(acc[2], acc[3]); *(GAS v2u*)(Cg + (size_t)(16 * hw + fr) * 64 + 16 * kt + 4 * fq) = w; }
    if (IS_ML && ht < 64) { float s_ = 0.f; for (int i = 0; i < 64; ++i) s_ += bf2f(Kt[i * PT + ht]) * vec[i]; ((GAS float*)sp.Nst)[slot * 64 + ht] = s_; }
    lds_barrier();
}
template <bool IS_ML>
__device__ __forceinline__ void scan_chain(const Frame& F, int chain, int quarter, const ScanPtrs& sp, bool dry = false) {
    const int tid = F.tid, k0 = (tid & 7) * 8;
    LAS float* LA = (LAS float*)(F.lds);
    if constexpr (IS_ML) { for (int p = tid; p < NCH; p += 512) { LA[p] = ((const GAS float*)sp.Amx)[(size_t)chain * NCH + p]; LA[512 + p] = ((const GAS float*)sp.Bl)[(size_t)chain * NCH + p]; } }
    else { for (int q = tid; q < NCH * 16; q += 512) *(LAS f32x4*)(LA + q * 4) = *(const GAS f32x4*)(sp.Gld + (size_t)chain * NCH * 64 + q * 4); }
    __syncthreads();
    if (tid < 128) {
    float S[8]; float nst = 0.f, m = 0.f;
#pragma unroll
    for (int e = 0; e < 8; ++e) S[e] = 0.f;
    bf16* Cb = (IS_ML ? sp.Cst : sp.Gst) + (size_t)chain * NCH * 4096 + (size_t)quarter * 1024 + (size_t)tid * 8;
    const bool own_n = IS_ML && quarter == 0 && tid < 64;
    constexpr int GS = 20;
    v4u cn[GS]; float nn[GS];
#pragma unroll
    for (int j = 0; j < GS; ++j) nn[j] = 0.f;
#define SC_LOAD(g) do { _Pragma("unroll") for (int j = 0; j < GS; ++j) { cn[j] = *(const GAS v4u*)(Cb + (size_t)((g) * GS + j) * 4096); \
        if (own_n) nn[j] = ((const GAS float*)sp.Nst)[((size_t)chain * NCH + (g) * GS + j) * 64 + tid]; } } while (0)
    SC_LOAD(0);
    for (int g = 0; g < NCH / GS; ++g) {
        v4u cc[GS]; float nc[GS];
#pragma unroll
        for (int j = 0; j < GS; ++j) { cc[j] = cn[j]; nc[j] = nn[j]; }
        if (g + 1 < NCH / GS) SC_LOAD(g + 1);
#pragma unroll
        for (int j = 0; j < GS; ++j) { const int pp = g * GS + j; const size_t p = (size_t)chain * NCH + pp;
            if (!dry) *(GAS v4u*)(Cb + (size_t)pp * 4096) = pack8(S);
            float x[8]; unpack8(cc[j], x);
            if constexpr (IS_ML) {
                if (own_n && !dry) ((GAS float*)sp.Nst)[p * 64 + tid] = nst;
                if (quarter == 0 && tid == 0 && !dry) ((GAS float*)sp.Mst)[p] = m;
                const float am = LA[pp], bl = LA[512 + pp];
                const float mx = fmaxf(m, am), fa = __expf(m - mx), fb = __expf(am - mx);
#pragma unroll
                for (int e = 0; e < 8; ++e) S[e] = fa * S[e] + fb * x[e];
                nst = fa * nst + fb * nc[j]; m = bl + mx;
            } else {
                const f32x4 e0 = *(const LAS f32x4*)(LA + pp * 64 + k0), e1 = *(const LAS f32x4*)(LA + pp * 64 + k0 + 4);
                const float dd[8] = {e0.x, e0.y, e0.z, e0.w, e1.x, e1.y, e1.z, e1.w};
#pragma unroll
                for (int e = 0; e < 8; ++e) S[e] = dd[e] * (S[e] + x[e]);
            }
        }
    }
#undef SC_LOAD
    if (dry && S[0] == 1.2345e-33f) sp.Mst[0] = nst + m;
    }
    __syncthreads();
}
template <bool IS_ML>
__device__ __forceinline__ void scan_out_unit(const Frame& F, int l, int b, int head, int tc, const ScanPtrs& sp, const ScanRegs& R_, bool dry = false) {
    const int tid = F.tid, d = tid >> 8, ht = tid & 255, hw = F.wave & 3, lane = F.lane, fr = lane & 15, fq = lane >> 4;
    LAS unsigned char* base = F.lds + d * DIRB;
    LAS bf16* Qs = (LAS bf16*)(base + L_QS); LAS bf16* Ks = (LAS bf16*)(base + L_KS); LAS bf16* Vt = (LAS bf16*)(base + L_VT); LAS bf16* Ws = (LAS bf16*)(base + L_WS); LAS bf16* Cs = (LAS bf16*)(base + L_CS);
    LAS float* vec = (LAS float*)(base + L_VEC);
    const int row0 = chunk_row0(b, tc), pos = chunk_pos(tc, d), chain = (b * 4 + head) * 2 + d; const size_t slot = (size_t)chain * NCH + pos;
    float m_c = 0.f;
    if constexpr (IS_ML) {
        m_c = R_.mc;
        if (hw == 0) { float a, bc; ml_gates(F, l, head, d, R_.gi, R_.gf, lane, a, bc); const float cm = wave_incl_scan_max(a, lane); vec[lane] = a; vec[64 + lane] = fmaxf(m_c, cm); vec[128 + lane] = bc; }
    } else { gla_build_g(F, l, head, d, R_.af, base, ht); }
    const LAS float* G = (const LAS float*)(base + L_G);
#pragma unroll
    for (int rep = 0; rep < 2; ++rep) { const int q = ht + 256 * rep, i = q >> 3, c8 = q & 7;
        float qx[8], kx[8], vx[8]; unpack8(SR_SEL2(R_, q, rep), qx); unpack8(SR_SEL2(R_, k, rep), kx); unpack8(SR_SEL2(R_, v, rep), vx);
#pragma unroll
        for (int e = 0; e < 8; ++e) {
            if constexpr (IS_ML) { kx[e] *= 0.125f; } else { const float g = G[i * 65 + c8 * 8 + e]; qx[e] *= 0.125f * __expf(g); kx[e] *= __expf(-g); }
        }
        *(LAS v4u*)(Qs + i * PT + c8 * 8) = pack8(qx); *(LAS v4u*)(Ks + i * PT + c8 * 8) = pack8(kx); *(LAS v4u*)(Vt + i * PT + c8 * 8) = pack8(vx); }
    if constexpr (!IS_ML) lds_barrier();
    {
#pragma unroll
        for (int rep = 0; rep < 2; ++rep) { const int q = ht + 256 * rep, v = q >> 3, c8 = q & 7; *(LAS v4u*)(Cs + v * PT + c8 * 8) = SR_SEL2(R_, st, rep); }
        if constexpr (IS_ML) { if (ht < 128) { const int rr = 64 + (ht >> 3), c8 = ht & 7; const bool isn = (rr == 64);
            const float x[8] = {isn ? R_.nv0.x : 0.f, isn ? R_.nv0.y : 0.f, isn ? R_.nv0.z : 0.f, isn ? R_.nv0.w : 0.f, isn ? R_.nv1.x : 0.f, isn ? R_.nv1.y : 0.f, isn ? R_.nv1.z : 0.f, isn ? R_.nv1.w : 0.f};
            *(LAS v4u*)(Cs + rr * PT + c8 * 8) = pack8(x); } }
    }
    lds_barrier();
    const int t = 16 * hw + fr; float rs = 0.f;
    const float Mt = IS_ML ? vec[64 + t] : 0.f;
#pragma unroll
    for (int st = 0; st < 4; ++st) {
        v2u w; w.x = 0u; w.y = 0u;
        if (st <= hw) { f32x4 acc = {0.f, 0.f, 0.f, 0.f}; acc = mmt<64, PT, PT>(acc, Ks, 16 * st, Qs, 16 * hw, fr, fq);
            float o[4];
#pragma unroll
            for (int r = 0; r < 4; ++r) { const int s = 16 * st + 4 * fq + r; float wg = (s <= t) ? 1.f : 0.f; if constexpr (IS_ML) wg = (s <= t) ? __expf(vec[s] - Mt) : 0.f; o[r] = wg * acc[r]; rs += o[r]; }
            w.x = pk2(o[0], o[1]); w.y = pk2(o[2], o[3]); }
        *(LAS v2u*)(Ws + t * PT + 16 * st + 4 * fq) = w; }
    rs = xor16_32_sum(rs);
    float h[4][4]; float wi = 1.f, dn = 1.f;
    if constexpr (IS_ML) { f32x4 an = {0.f, 0.f, 0.f, 0.f}; an = mmt<64, PT, PT>(an, Cs, 64, Qs, 16 * hw, fr, fq); const float nq = xor16_32_sum(an[0]);
        wi = __expf(m_c - Mt); const float den = rs + wi * nq; dn = 1.f / fmaxf(fabsf(den), __expf(-(vec[128 + t] + Mt))); }
#pragma unroll
    for (int vt = 0; vt < 4; ++vt) { f32x4 ai = {0.f, 0.f, 0.f, 0.f}, ac = {0.f, 0.f, 0.f, 0.f};
        ai = mmt_tx<64, PT, PT>(ai, Vt, 16 * vt, Ws, 16 * hw, fr, fq, lane); ac = mmt<64, PT, PT>(ac, Cs, 16 * vt, Qs, 16 * hw, fr, fq);
#pragma unroll
        for (int r = 0; r < 4; ++r) h[vt][r] = (ai[r] + wi * ac[r]) * dn; }
    lds_barrier();
    LAS float* HB = (LAS float*)(F.lds + DIRB + L_HB);
    if (d == 1) {
#pragma unroll
        for (int vt = 0; vt < 4; ++vt)
#pragma unroll
            for (int r = 0; r < 4; ++r) HB[(63 - t) * 65 + 16 * vt + 4 * fq + r] = h[vt][r]; }
    lds_barrier();
    if (d == 0) {
        float s1 = 0.f;
#pragma unroll
        for (int vt = 0; vt < 4; ++vt)
#pragma unroll
            for (int r = 0; r < 4; ++r) { h[vt][r] += HB[t * 65 + 16 * vt + 4 * fq + r]; s1 += IS_ML ? h[vt][r] : h[vt][r] * h[vt][r]; }
        s1 = xor16_32_sum(s1);
        float mean = 0.f, rstd;
        if constexpr (IS_ML) { mean = s1 * (1.f / 64.f); float s2 = 0.f;
#pragma unroll
            for (int vt = 0; vt < 4; ++vt)
#pragma unroll
                for (int r = 0; r < 4; ++r) { const float dd = h[vt][r] - mean; s2 += dd * dd; }
            s2 = xor16_32_sum(s2); rstd = 1.f / sqrtf(s2 * (1.f / 64.f) + LN_EPS);
        } else rstd = 1.f / sqrtf(s1 * (1.f / 64.f) + LN_EPS);
        const float* ng = F.in[IS_ML ? I_MLNG : I_GLNG] + (size_t)l * 256 + head * 64;
        bf16* op = F.P() + (size_t)(row0 + t) * NP + (IS_ML ? TC_MLO : TC_GLR) + head * 64;
#pragma unroll
        for (int vt = 0; vt < 4; ++vt) { const int c = 16 * vt + 4 * fq; const v2u gp = (vt == 0) ? R_.og0 : (vt == 1 ? R_.og1 : (vt == 2 ? R_.og2 : R_.og3)); const f32x4 gn = *(const GAS f32x4*)(ng + c);
            const float gt[4] = {bflo(gp.x), bfhi(gp.x), bflo(gp.y), bfhi(gp.y)}; float y[4];
#pragma unroll
            for (int r = 0; r < 4; ++r) { const float gate = IS_ML ? sigm(gt[r]) : gt[r] * sigm(gt[r]); y[r] = (h[vt][r] - mean) * rstd * gn[r] * gate; }
            v2u w; w.x = pk2(y[0], y[1]); w.y = pk2(y[2], y[3]); if (!dry) *(GAS v2u*)(op + c) = w; }
    }
    lds_barrier();
}
constexpr int DP = 136;
constexpr int LF_C = 0, LF_S = 34816, LF_XR = 69632, LF_XI = 69632 + 18432;
__device__ __forceinline__ void dft_load_mats(const Frame& F) {
    LAS bf16* CM = (LAS bf16*)(F.lds + LF_C); LAS bf16* SMt = (LAS bf16*)(F.lds + LF_S);
    const bf16* gc = (const bf16*)(F.ws + WS_DFT_C); const bf16* gs = (const bf16*)(F.ws + WS_DFT_S);
    for (int q = F.tid; q < 128 * 16; q += 512) { const int j = q >> 4, c8 = q & 15; *(LAS v4u*)(CM + j * DP + c8 * 8) = *(const GAS v4u*)(gc + j * 128 + c8 * 8); *(LAS v4u*)(SMt + j * DP + c8 * 8) = *(const GAS v4u*)(gs + j * 128 + c8 * 8); }
    __syncthreads();
}
template <int STEP>
__device__ __forceinline__ void dft_unit(const Frame& F, int b, int idx, int slab, bf16* IM1, bf16* FT, bool dry = false) {
    LAS bf16* CM = (LAS bf16*)(F.lds + LF_C); LAS bf16* SMt = (LAS bf16*)(F.lds + LF_S); LAS bf16* XR = (LAS bf16*)(F.lds + LF_XR); LAS bf16* XI = (LAS bf16*)(F.lds + LF_XI);
    const int tid = F.tid, lane = F.lane, fr = lane & 15, fq = lane >> 4, w = F.wave;
#pragma unroll
    for (int rep = 0; rep < 2; ++rep) { const int q = tid + 512 * rep, i = q >> 3, c8 = q & 7;
        const int row = (STEP == 1) ? b * T + 128 * i + idx : b * T + 128 * idx + i;
        *(LAS v4u*)(XR + i * PT + c8 * 8) = *(const GAS v4u*)(F.P() + (size_t)row * NP + TC_FT + slab * 64 + c8 * 8);
        if (STEP == 2) *(LAS v4u*)(XI + i * PT + c8 * 8) = *(const GAS v4u*)(IM1 + (size_t)row * 256 + slab * 64 + c8 * 8); }
    lds_barrier();
    const int j = 16 * w + fr;
#pragma unroll
    for (int ct = 0; ct < 4; ++ct) {
        f32x4 dr = {0.f, 0.f, 0.f, 0.f}, p1 = {0.f, 0.f, 0.f, 0.f}, p2 = {0.f, 0.f, 0.f, 0.f};
        dr = mmt_tx<128, PT, DP>(dr, XR, 16 * ct, CM, 16 * w, fr, fq, lane); p2 = mmt_tx<128, PT, DP>(p2, XR, 16 * ct, SMt, 16 * w, fr, fq, lane);
        if (STEP == 2) { dr = mmt_tx<128, PT, DP>(dr, XI, 16 * ct, SMt, 16 * w, fr, fq, lane); p1 = mmt_tx<128, PT, DP>(p1, XI, 16 * ct, CM, 16 * w, fr, fq, lane); }
        float orr[4], oi[4];
        if (STEP == 1) { const float ph = (float)((j * idx) & 16383) * (1.f / 8192.f); const float cs = cospif(ph), sn = sinpif(ph);
#pragma unroll
            for (int r = 0; r < 4; ++r) { const float di = -p2[r]; orr[r] = dr[r] * cs + di * sn; oi[r] = di * cs - dr[r] * sn; }
            const int orow = b * T + 128 * j + idx;
            v2u wr_, wi_; wr_.x = pk2(orr[0], orr[1]); wr_.y = pk2(orr[2], orr[3]); wi_.x = pk2(oi[0], oi[1]); wi_.y = pk2(oi[2], oi[3]);
            if (!dry) { *(GAS v2u*)(F.P() + (size_t)orow * NP + TC_FT + slab * 64 + 16 * ct + 4 * fq) = wr_; *(GAS v2u*)(IM1 + (size_t)orow * 256 + slab * 64 + 16 * ct + 4 * fq) = wi_; }
        } else {
#pragma unroll
            for (int r = 0; r < 4; ++r) { orr[r] = dr[r] * (1.f / 128.f); oi[r] = (p1[r] - p2[r]) * (1.f / 128.f); }
            const int orow = b * T + idx + 128 * j;
            v2u wr_, wi_; wr_.x = pk2(orr[0], orr[1]); wr_.y = pk2(orr[2], orr[3]); wi_.x = pk2(oi[0], oi[1]); wi_.y = pk2(oi[2], oi[3]);
            if (!dry) { *(GAS v2u*)(FT + (size_t)orow * 512 + slab * 64 + 16 * ct + 4 * fq) = wr_; *(GAS v2u*)(FT + (size_t)orow * 512 + 256 + slab * 64 + 16 * ct + 4 * fq) = wi_; }
        } }
    lds_barrier();
}
__device__ __forceinline__ void ctx_dft(const Frame& F, bf16* FT, int widx, int nw) {
    LAS float* ct = (LAS float*)(F.lds + LF_XR); LAS float* st = ct + 256;
    if (F.tid < 256) { const float ph = (float)F.tid * (1.f / 128.f); ct[F.tid] = cospif(ph); st[F.tid] = sinpif(ph); }
    __syncthreads();
    for (int o = widx * 512 + F.tid; o < NB * 256 * 256; o += nw * 512) { const int col = o & 255, k = (o >> 8) & 255, b = o >> 16;
        const bf16* up = F.P() + (size_t)(RL + b * CTX) * NP + TC_FT + col; float re = 0.f, im = 0.f;
        for (int t = 0; t < 256; ++t) { const float u = bf2f(((const GAS bf16*)up)[(size_t)t * NP]); const int a = (k * t) & 255; re += u * ct[a]; im -= u * st[a]; }
        bf16* op = FT + (size_t)(RL + b * CTX + k) * 512 + col; op[0] = (bf16)f2bf(re * 0.0625f); op[256] = (bf16)f2bf(im * 0.0625f); }
    __syncthreads();
}
namespace attn_body {
using bf16=__hip_bfloat16;
using bf16x8=__attribute__((ext_vector_type(8)))short;
using s16x4=__attribute__((ext_vector_type(4)))short;
using f32x16=__attribute__((ext_vector_type(16)))float;
using u32x4=__attribute__((ext_vector_type(4)))unsigned;
constexpr int D=64,DM=3072;
constexpr int NW=8,QBLK=32,QB=QBLK*NW,KVBLK=64;
constexpr int ATTN_PITCH=DM, ATTN_UNIT_ROWS=QB;
__device__ __forceinline__ int crow(int r,int hi){return (r&3)+8*(r>>2)+4*hi;}
#define SBAR() __builtin_amdgcn_sched_barrier(0)
__device__ __forceinline__ void cmask(f32x16&p0,f32x16&p1,int jb,int qrel,int hi){
  const float NEG=-INFINITY; int kb=64*jb+4*hi;
  #pragma unroll
  for(int r=0;r<16;++r){int kv=kb+(r&3)+8*(r>>2); if(kv>qrel)p0[r]=NEG; if(kv+32>qrel)p1[r]=NEG;}
}

constexpr int NSLOT=3, SLOTB=8192;
constexpr int LDS_K=0, LDS_V=NSLOT*SLOTB, LDS_WS=2*NSLOT*SLOTB, LDS_OST=LDS_WS+NW*64*4, LDS_BYTES=LDS_OST+NW*4096;
constexpr float C2=0.125f*1.4426950408889634f;
__device__ __forceinline__ void glds16(const void*gsrc,unsigned lds_dst){unsigned keep;
  asm volatile("s_mov_b32 %0, m0\n\ts_mov_b32 m0, %2\n\ts_nop 0\n\tglobal_load_lds_dwordx4 %1, off\n\ts_mov_b32 m0, %0":"=&s"(keep):"v"(gsrc),"s"(lds_dst):"memory");}
__device__ __forceinline__ float max3f(float a,float b,float c){float r;asm("v_max3_f32 %0, %1, %2, %3":"=v"(r):"v"(a),"v"(b),"v"(c));return r;}
__device__ __forceinline__ float max2f(float a,float b){float r;asm("v_max_f32_e32 %0, %1, %2":"=v"(r):"v"(a),"v"(b));return r;}
__device__ __forceinline__ float fadd_s(float a,float b){float r;asm("v_add_f32_e32 %0, %1, %2":"=v"(r):"v"(a),"v"(b));return r;}
__device__ __forceinline__ float fsub_s(float a,float b){float r;asm("v_sub_f32_e32 %0, %1, %2":"=v"(r):"v"(a),"v"(b));return r;}
typedef float f32x2_t __attribute__((ext_vector_type(2))); typedef __bf16 bf16x2_t __attribute__((ext_vector_type(2)));
__device__ __forceinline__ unsigned cvtpk_s(float lo,float hi){f32x2_t v={lo,hi};bf16x2_t b=__builtin_convertvector(v,bf16x2_t);return __builtin_bit_cast(unsigned,b);}
#define WAIT_BAR(N) asm volatile("s_waitcnt vmcnt(" #N ") lgkmcnt(0)\n\ts_barrier":::"memory")

__device__ __forceinline__ void qkt(f32x16&p0,f32x16&p1,const char*Kslot,const bf16x8*qr,const f32x16&negm,int r32,int hi){
  const char*kb=Kslot+hi*1024+r32*16;
  #pragma unroll
  for(int d0=0;d0<4;++d0){
    const bf16x8 b0=*reinterpret_cast<const bf16x8*>(kb+d0*2048);
    const bf16x8 b1=*reinterpret_cast<const bf16x8*>(kb+d0*2048+512);
    if(d0==0){p0=__builtin_amdgcn_mfma_f32_32x32x16_bf16(b0,qr[0],negm,0,0,0);p1=__builtin_amdgcn_mfma_f32_32x32x16_bf16(b1,qr[0],negm,0,0,0);}
    else{p0=__builtin_amdgcn_mfma_f32_32x32x16_bf16(b0,qr[d0],p0,0,0,0);p1=__builtin_amdgcn_mfma_f32_32x32x16_bf16(b1,qr[d0],p1,0,0,0);}}
}
typedef __attribute__((address_space(3))) const char* lds_cptr;
typedef short v4i16_t __attribute__((ext_vector_type(4)));
__device__ __forceinline__ void kload8(bf16x8*kf,lds_cptr kp){
  kf[0]=*(const __attribute__((address_space(3))) bf16x8*)(kp);      kf[1]=*(const __attribute__((address_space(3))) bf16x8*)(kp+512);
  kf[2]=*(const __attribute__((address_space(3))) bf16x8*)(kp+2048); kf[3]=*(const __attribute__((address_space(3))) bf16x8*)(kp+2560);
  kf[4]=*(const __attribute__((address_space(3))) bf16x8*)(kp+4096); kf[5]=*(const __attribute__((address_space(3))) bf16x8*)(kp+4608);
  kf[6]=*(const __attribute__((address_space(3))) bf16x8*)(kp+6144); kf[7]=*(const __attribute__((address_space(3))) bf16x8*)(kp+6656);
}
__device__ __forceinline__ void kload2(bf16x8*kf,lds_cptr kp,int j){ kf[2*j]=*(const __attribute__((address_space(3))) bf16x8*)(kp+j*2048); kf[2*j+1]=*(const __attribute__((address_space(3))) bf16x8*)(kp+j*2048+512); }
__device__ __forceinline__ s16x4 vtr(lds_cptr p){ return __builtin_bit_cast(s16x4,__builtin_amdgcn_ds_read_tr16_b64_v4i16((__attribute__((address_space(3))) v4i16_t*)p)); }
__device__ __forceinline__ float rowmax(const f32x16&p0,const f32x16&p1){
  float a=max3f(p0[0],p0[1],p1[0]),b=max3f(p0[2],p0[3],p1[1]);a=max3f(a,p1[2],p1[3]);
  #pragma unroll
  for(int r=4;r<16;r+=4){a=max3f(a,p0[r],p0[r+1]);b=max3f(b,p0[r+2],p0[r+3]);a=max3f(a,p1[r],p1[r+1]);b=max3f(b,p1[r+2],p1[r+3]);}
  const float m=max2f(a,b);
  auto rr=__builtin_amdgcn_permlane32_swap(__float_as_uint(m),__float_as_uint(m),false,false);
  return max2f(__uint_as_float(rr[0]),__uint_as_float(rr[1]));
}
__device__ __forceinline__ void pv(f32x16*o,int vb,bf16x8 pa0,bf16x8 pa1,bf16x8 pa2,bf16x8 pa3){
  #pragma unroll
  for(int d0=0;d0<2;++d0){s16x4 lo[4],hi[4];
    #pragma unroll
    for(int ks=0;ks<4;++ks){
      asm volatile("ds_read_b64_tr_b16 %0,%1 offset:%c2":"=&v"(lo[ks]):"v"(vb),"i"(d0*4096+ks*1024):"memory");
      asm volatile("ds_read_b64_tr_b16 %0,%1 offset:%c2":"=&v"(hi[ks]):"v"(vb),"i"(d0*4096+ks*1024+512):"memory");}
    asm volatile("s_waitcnt lgkmcnt(0)":::"memory");SBAR();
    #define PK(k) (bf16x8){lo[k][0],lo[k][1],lo[k][2],lo[k][3],hi[k][0],hi[k][1],hi[k][2],hi[k][3]}
    o[d0]=__builtin_amdgcn_mfma_f32_32x32x16_bf16(pa0,PK(0),o[d0],0,0,0);
    o[d0]=__builtin_amdgcn_mfma_f32_32x32x16_bf16(pa1,PK(1),o[d0],0,0,0);
    o[d0]=__builtin_amdgcn_mfma_f32_32x32x16_bf16(pa2,PK(2),o[d0],0,0,0);
    o[d0]=__builtin_amdgcn_mfma_f32_32x32x16_bf16(pa3,PK(3),o[d0],0,0,0);
    #undef PK
  }
}

#ifndef ATTN_STORE16
#define ATTN_STORE16(p,v) (*(u32x4*)(p)=(v))
#endif
template<int THRL> __device__ __forceinline__ void attn_unit(const bf16*Qw0,const bf16*__restrict__ KL,const bf16*__restrict__ VL,const bf16*__restrict__ KC,const bf16*__restrict__ VC,int nlt,const int NT,bf16*Ow0,char*shm,const float MB){
  const int tid=threadIdx.x,lane=tid&63,r32=lane&31,hi=lane>>5; const int wid=__builtin_amdgcn_readfirstlane(tid>>6);
  const bf16*Qw=Qw0+(long)(wid*QBLK)*DM;
  const unsigned lds0=(unsigned)(uintptr_t)shm;
  float*wsf=(float*)(shm+LDS_WS)+wid*64;
  const long kvo_k=(long)lane*DM+wid*8; const bf16*ksrcL=KL+kvo_k; const bf16*ksrcC=KC+kvo_k-(long)nlt*KVBLK*DM;
  const long kvo_v=(long)(16*(wid&3)+(lane>>2))*DM+(wid>>2)*32+(lane&3)*8; const bf16*vsrcL=VL+kvo_v; const bf16*vsrcC=VC+kvo_v-(long)nlt*KVBLK*DM;
  const unsigned kdst=lds0+LDS_K+wid*1024, vdst=lds0+LDS_V+wid*1024;
  #define DMA_K(t,slot) glds16(((t)<nlt?ksrcL:ksrcC)+(long)(t)*KVBLK*DM,(unsigned)__builtin_amdgcn_readfirstlane(kdst+(slot)))
  #define DMA_V(t,slot) glds16(((t)<nlt?vsrcL:vsrcC)+(long)(t)*KVBLK*DM,(unsigned)__builtin_amdgcn_readfirstlane(vdst+(slot)))
  const int vb0=(int)(lds0+LDS_V)+((lane>>4)&1)*32+(lane&3)*8+(4*hi+((lane&15)>>2))*64;
  const char*Kbase=shm+LDS_K; bf16x8 kf[8];
  const lds_cptr shm3=(lds_cptr)shm; const lds_cptr kp0=shm3+LDS_K+hi*1024+r32*16; const lds_cptr vp0=shm3+LDS_V+((lane>>4)&1)*32+(lane&3)*8+(4*hi+((lane&15)>>2))*64;
  DMA_K(0,0);DMA_V(0,0);DMA_K(1,SLOTB);
  bf16x8 qr[4];
  #pragma unroll
  for(int d0=0;d0<4;++d0)qr[d0]=*reinterpret_cast<const bf16x8*>(&Qw[(long)r32*DM+d0*16+hi*8]);
  float l_reg=0.f;f32x16 o[2];o[0]=f32x16{};o[1]=f32x16{};f32x16 negm;
  #pragma unroll
  for(int r=0;r<16;++r)negm[r]=-MB;
  asm volatile("":"+v"(negm));
  #define CMASK(P0,P1,t) do{}while(0)
  #define START(P0,P1) do{ _Pragma("unroll") for(int r=0;r<16;++r)P0[r]=__builtin_amdgcn_exp2f(P0[r]); }while(0)
  #define RESC() do{}while(0)
  f32x16 pA0,pA1,pB0,pB1;
  int sl_prev=0,sl_cur=0,sl_next=SLOTB;
  #define ROT() do{sl_prev=sl_cur;sl_cur=sl_next;sl_next=(sl_next==(NSLOT-1)*SLOTB)?0:sl_next+SLOTB;}while(0)
  DMA_K(2,2*SLOTB);
  WAIT_BAR(3);
  qkt(pA0,pA1,Kbase,qr,negm,r32,hi);asm volatile("s_nop 15\n\ts_nop 7":"+v"(pA0),"+v"(pA1));CMASK(pA0,pA1,0);
  START(pA0,pA1);
  _Pragma("unroll") for(int r=0;r<16;++r)pA1[r]=__builtin_amdgcn_exp2f(pA1[r]);
  WAIT_BAR(0);
  DMA_K(3,0);DMA_V(1,SLOTB);
  ROT();
  kload8(kf,kp0+sl_cur);
  WAIT_BAR(2);
  s16x4 vlo[8],vhi[8]; u32x4 pw0,pw1,pw2,pw3;
  #define PKW(P,B) cvtpk_s(P[B],P[B+1])
  #define PAF(k) __builtin_bit_cast(bf16x8,pw##k)
  #define VFR(i) (bf16x8){vlo[i][0],vlo[i][1],vlo[i][2],vlo[i][3],vhi[i][0],vhi[i][1],vhi[i][2],vhi[i][3]}
  #define PIN(x) asm volatile("":"+v"(x))
  #define MX3(a,b,c) __builtin_fmaxf(__builtin_fmaxf((a),(b)),(c))
  #define GAPA(MF,A0,A1,A2,A3,W0,W1,PW) do{ MF; sacc+=A0; sacc+=A1; sacc+=A2; sacc+=A3; PIN(sacc); W0; W1; PIN(PW); SBAR(); }while(0)
  #define EX(v) __builtin_amdgcn_exp2f(v)
  #define GAPB(MF,X,B) do{ MF; X[B]=EX(X[B]); X[B+1]=EX(X[B+1]); X[B+2]=EX(X[B+2]); X[B+3]=EX(X[B+3]); PIN(X); SBAR(); }while(0)
  #define VRD(i) do{ vlo[i]=vtr(vp_+(((i)>>2)*4096+((i)&3)*1024)); vhi[i]=vtr(vp_+(((i)>>2)*4096+((i)&3)*1024+512)); }while(0)
  #define KRD(G,j) do{ if(G){ kload2(kf,kp0+sl_next,j); SBAR(); } }while(0)
  #define STEP(C0,C1,P0,P1,t,GK,GV,GL) do{ SBAR(); \
    const lds_cptr vp_=vp0+sl_prev; \
    VRD(0); SBAR(); float sacc=(P0[0]+P0[1]); \
    GAPA(C0=__builtin_amdgcn_mfma_f32_32x32x16_bf16(kf[0],qr[0],negm,0,0,0), P0[2],P0[3],P0[4],P0[5],     pw0[0]=PKW(P0,0), pw0[1]=PKW(P0,2), pw0); \
    VRD(4); SBAR(); GAPA(C1=__builtin_amdgcn_mfma_f32_32x32x16_bf16(kf[1],qr[0],negm,0,0,0), P0[6],P0[7],P0[8],P0[9],     pw0[2]=PKW(P0,4), pw0[3]=PKW(P0,6), pw0); \
    VRD(1); SBAR(); GAPA(C0=__builtin_amdgcn_mfma_f32_32x32x16_bf16(kf[2],qr[1],C0,0,0,0),   P0[10],P0[11],P0[12],P0[13], pw1[0]=PKW(P0,8), pw1[1]=PKW(P0,10), pw1); \
    VRD(5); SBAR(); GAPA(C1=__builtin_amdgcn_mfma_f32_32x32x16_bf16(kf[3],qr[1],C1,0,0,0),   P0[14],P0[15],P1[0],P1[1],   pw1[2]=PKW(P0,12),pw1[3]=PKW(P0,14), pw1); \
    VRD(2); SBAR(); GAPA(C0=__builtin_amdgcn_mfma_f32_32x32x16_bf16(kf[4],qr[2],C0,0,0,0),   P1[2],P1[3],P1[4],P1[5],     pw2[0]=PKW(P1,0), pw2[1]=PKW(P1,2), pw2); \
    VRD(6); SBAR(); GAPA(C1=__builtin_amdgcn_mfma_f32_32x32x16_bf16(kf[5],qr[2],C1,0,0,0),   P1[6],P1[7],P1[8],P1[9],     pw2[2]=PKW(P1,4), pw2[3]=PKW(P1,6), pw2); \
    VRD(3); SBAR(); GAPA(C0=__builtin_amdgcn_mfma_f32_32x32x16_bf16(kf[6],qr[3],C0,0,0,0),   P1[10],P1[11],P1[12],P1[13], pw3[0]=PKW(P1,8), pw3[1]=PKW(P1,10), pw3); \
    VRD(7); SBAR(); GAPA(C1=__builtin_amdgcn_mfma_f32_32x32x16_bf16(kf[7],qr[3],C1,0,0,0),   P1[14],P1[15],0.f,0.f,       pw3[2]=PKW(P1,12),pw3[3]=PKW(P1,14), pw3); \
    l_reg+=sacc; \
    if(GK){DMA_K((t)+3,sl_cur);} if(GV){DMA_V((t)+1,sl_next);} \
    CMASK(C0,C1,t); \
    SBAR(); \
    GAPB(o[0]=__builtin_amdgcn_mfma_f32_32x32x16_bf16(PAF(0),VFR(0),o[0],0,0,0), C0,0); \
    GAPB(o[1]=__builtin_amdgcn_mfma_f32_32x32x16_bf16(PAF(0),VFR(4),o[1],0,0,0), C0,4); \
    KRD(GL,0); GAPB(o[0]=__builtin_amdgcn_mfma_f32_32x32x16_bf16(PAF(1),VFR(1),o[0],0,0,0), C0,8); \
    KRD(GL,1); GAPB(o[1]=__builtin_amdgcn_mfma_f32_32x32x16_bf16(PAF(1),VFR(5),o[1],0,0,0), C0,12); \
    KRD(GL,2); GAPB(o[0]=__builtin_amdgcn_mfma_f32_32x32x16_bf16(PAF(2),VFR(2),o[0],0,0,0), C1,0); \
    KRD(GL,3); GAPB(o[1]=__builtin_amdgcn_mfma_f32_32x32x16_bf16(PAF(2),VFR(6),o[1],0,0,0), C1,4); \
    GAPB(o[0]=__builtin_amdgcn_mfma_f32_32x32x16_bf16(PAF(3),VFR(3),o[0],0,0,0), C1,8); \
    GAPB(o[1]=__builtin_amdgcn_mfma_f32_32x32x16_bf16(PAF(3),VFR(7),o[1],0,0,0), C1,12); \
    }while(0)
  int t=1;
  #undef CMASK
  #define CMASK(P0,P1,t) do{}while(0)
  for(;t+5<NT;t+=2){
    STEP(pB0,pB1,pA0,pA1,t,true,true,true);     WAIT_BAR(2); RESC(); ROT();
    STEP(pA0,pA1,pB0,pB1,t+1,true,true,true);   WAIT_BAR(2); RESC(); ROT();
  }
  #undef CMASK
  #define CMASK(P0,P1,t) do{}while(0)
  #define ENDW(tt) do{ if((tt)+3<NT){WAIT_BAR(2);} else if((tt)+2<NT){WAIT_BAR(1);} else {WAIT_BAR(0);} }while(0)
  for(;t+1<NT;t+=2){
    STEP(pB0,pB1,pA0,pA1,t,(t+3<NT),(t+1<NT),(t+1<NT));       ENDW(t);   RESC(); ROT();
    STEP(pA0,pA1,pB0,pB1,t+1,(t+4<NT),(t+2<NT),(t+2<NT));     ENDW(t+1); RESC(); ROT();
  }
  STEP(pB0,pB1,pA0,pA1,NT-1,false,false,false); RESC();
  { float sacc=pB0[0]+pB0[1]; _Pragma("unroll") for(int r=2;r<16;++r)sacc+=pB0[r]; _Pragma("unroll") for(int r=0;r<16;++r)sacc+=pB1[r]; l_reg+=sacc;
    pw0=(u32x4){PKW(pB0,0),PKW(pB0,2),PKW(pB0,4),PKW(pB0,6)};pw1=(u32x4){PKW(pB0,8),PKW(pB0,10),PKW(pB0,12),PKW(pB0,14)};pw2=(u32x4){PKW(pB1,0),PKW(pB1,2),PKW(pB1,4),PKW(pB1,6)};pw3=(u32x4){PKW(pB1,8),PKW(pB1,10),PKW(pB1,12),PKW(pB1,14)};
    SBAR(); pv(o,vb0+sl_cur,PAF(0),PAF(1),PAF(2),PAF(3)); }
  #undef PKW
  #undef PAF
  #undef VFR
  #undef PIN
  #undef MX3
  #undef GAPA
  #undef GAPB
  #undef EX
  #undef VRD
  #undef KRD
  #undef STEP
  #undef ENDW
  {auto rr=__builtin_amdgcn_permlane32_swap(__float_as_uint(l_reg),__float_as_uint(l_reg),false,false);l_reg=__uint_as_float(rr[0])+__uint_as_float(rr[1]);}
  if(hi==0)wsf[32+r32]=l_reg;asm volatile("s_waitcnt lgkmcnt(0)":::"memory");
  float rli[16];
  #pragma unroll
  for(int r=0;r<16;++r)rli[r]=__builtin_amdgcn_rcpf(wsf[32+crow(r,hi)]);
  bf16*Ow=Ow0+(long)(wid*QBLK)*DM;
  { bf16*stg=(bf16*)(shm+LDS_OST)+wid*2048;
    #pragma unroll
    for(int r=0;r<16;++r){const int orow=crow(r,hi);
      #pragma unroll
      for(int d0=0;d0<2;++d0)stg[orow*64+d0*32+r32]=__float2bfloat16(o[d0][r]*rli[r]);}
    asm volatile("s_waitcnt lgkmcnt(0)":::"memory");
    #pragma unroll
    for(int i=0;i<4;++i){const int row=i*8+(lane>>3),ch=lane&7; const u32x4 v=*(const u32x4*)(stg+row*64+ch*8); ATTN_STORE16(Ow+(long)row*DM+ch*8,v);} }
  asm volatile("s_waitcnt lgkmcnt(0)\n\ts_barrier":::"memory");
  #undef DMA_K
  #undef DMA_V
  #undef CMASK
  #undef START
  #undef RESC
  #undef ROT
}
constexpr int ATTN_LDS_BYTES=LDS_BYTES;
#undef SBAR
#undef WAIT_BAR
}

constexpr int PH_PER_LAYER = 11, PH_L0 = 2, N_PHASES = PH_L0 + 2 * PH_PER_LAYER;
__device__ __forceinline__ void phase_scale_rows(const Frame& F, int l, bool from_x) {
    const int gw = F.vcu * NWAVES + F.wave, NGW = F.G * NWAVES;
    for (int r = gw; r < R; r += NGW) { Row16 x = ld_row(from_x ? xin_row(F, l, r) : F.XM() + (size_t)r * D, F.lane);
#pragma unroll
        for (int j = 0; j < 4; ++j) x.v[j] = x.v[j] * ALPHA;
        st_row(F.XM() + (size_t)r * D, F.lane, x); }
}
__device__ __forceinline__ Frame make_frame(unsigned char* lds_, unsigned char* ws, float* out) {
    Frame F; F.lds = (LAS unsigned char*)lds_; F.MISC = (volatile LAS unsigned*)(F.lds + MISC_OFF);
    F.tid = opq_v((int)threadIdx.x); F.lane = F.tid & 63; F.wave = __builtin_amdgcn_readfirstlane(F.tid >> 6);
    F.G = opq_s((int)gridDim.x); { const int bx = opq_s((int)blockIdx.x); F.vcu = (F.G % 8 == 0) ? (bx % 8) * (F.G / 8) + bx / 8 : bx; }
    F.ws = opq(ws); F.out = opq(out); F.in.lds = F.lds; return F; }
#ifndef PHM
#define PHM 0xFF
#endif
#ifndef R_IN
#define R_IN 1
#endif
#ifndef R_LOC
#define R_LOC 1
#endif
#ifndef R_MRG
#define R_MRG 1
#endif
#ifndef R_OUT
#define R_OUT 1
#endif
#ifndef R_UP
#define R_UP 1
#endif
#ifndef R_ATT
#define R_ATT 0
#endif
#ifndef D_OUTU
#define D_OUTU 0
#endif
#ifndef D_CHAIN
#define D_CHAIN 0
#endif
#ifndef D_DFT
#define D_DFT 0
#endif
#ifndef D_QK
#define D_QK 0
#endif
#ifndef R_FIN0
#define R_FIN0 1
#endif
#ifndef R_PM0
#define R_PM0 1
#endif
#ifndef R_MDN
#define R_MDN 1
#endif
#ifndef X_BAR
#define X_BAR 0
#endif
#ifndef R_CONV
#define R_CONV 1
#endif
#ifndef R_PRO
#define R_PRO 1
#endif
#define MKF() Frame F = make_frame(lds, args.ws, args.out)
#define IN(k) (args.ph_lo <= (k) && (k) < args.ph_hi)
#define SEAM(k) do { if (IN(k) && IN((k) + 1)) { XcdBarrier bar_; bar_.bar = (unsigned*)((gu32*)(opq(args.ws) + WS_CTL) + CW_BAR) + args.li * XCD_BAR_WORDS; bar_.x = xb_xcc_id(); \
        bar_.st = (volatile LAS unsigned*)((LAS unsigned char*)lds + MISC_OFF) + 8; xcd_barrier(bar_); if (X_BAR) xcd_barrier(bar_); } PROF_TICK(k); } while (0)
#define xm (F.ws + WS_XM)
#define P_IM1 ((bf16*)(xm + XO_IM1))
#define P_FT ((bf16*)(xm + XO_FT))
#define MK_SP() ScanPtrs sp; sp.Cst = (bf16*)(xm + XO_MLC); sp.Gst = (bf16*)(xm + XO_GLS); sp.Nst = (float*)(F.ws + WS_SCAL + SC_MLN); sp.Amx = (float*)(F.ws + WS_SCAL + SC_MLA); sp.Bl = (float*)(F.ws + WS_SCAL + SC_MLB); sp.Mst = (float*)(F.ws + WS_SCAL + SC_MLM); sp.Gld = (float*)(F.ws + WS_SCAL + SC_GLD)

template <int l> __device__ __forceinline__ void layer_body(const Args& args, unsigned char* lds) {
        const int pb = PH_L0 + l * PH_PER_LAYER;
        if (IN(pb + 0)) {
#if DBG_LEVEL >= 3 && (PHM & 1)
            for (int rep = 0; rep < R_IN; ++rep) { SchedIn S; S.G = opq_s((int)gridDim.x); S.c = opq_s((int)blockIdx.x); S.ws = opq(args.ws);
            pg8::gemm_stream((LAS unsigned char*)lds, S); }
#endif
        }
        SEAM(pb + 0);
        if (IN(pb + 1)) {
#if DBG_LEVEL >= 3 && (PHM & 2)
            MKF(); MK_SP(); phase_qk(F, l); for (int rep = 0; rep < D_QK; ++rep) phase_qk(F, l, __builtin_amdgcn_readfirstlane(opq_v(1)) != 0);
            __syncthreads(); PROF_TICK(24);
            dft_load_mats(F);
            for (int u = F.vcu; u < 1024; u += F.G) dft_unit<1>(F, u >> 9, (u >> 2) & 127, u & 3, P_IM1, P_FT);
            for (int rep = 0; rep < D_DFT; ++rep) for (int u = F.vcu; u < 1024; u += F.G) dft_unit<1>(F, u >> 9, (u >> 2) & 127, u & 3, P_IM1, P_FT, __builtin_amdgcn_readfirstlane(opq_v(1)) != 0);
            __syncthreads(); PROF_TICK(25);
            {
                volatile LAS int* qs = (volatile LAS int*)(F.lds + MISC_OFF + 96); unsigned* qh = (unsigned*)(F.ctl() + CW_QUEUE + (l * 2 + 0) * 64);
                if (F.tid == 0) { qs[2] = (int)__hip_atomic_fetch_add(qh, 1u, RLX_AGENT); qs[3] = (int)__hip_atomic_fetch_add(qh, 1u, RLX_AGENT); }
                __syncthreads();
                UnitId id, idn; ScanRegs RA, RB; int u = qs[2], un = qs[3]; bool ok = unit_decode_q(u, l, false, id), okn = unit_decode_q(un, l, false, idn); int par = 0;
                if (ok) scan_fetch<false>(F, l, id, sp, RA);
                while (ok) {
                    if (okn) scan_fetch<false>(F, l, idn, sp, RB);
                    if (F.tid == 0) qs[par] = (int)__hip_atomic_fetch_add(qh, 1u, RLX_AGENT);
                    if (id.fam == 0) scan_local_unit<true>(F, l, id.b, id.head, id.tc, sp, RA); else scan_local_unit<false>(F, l, id.b, id.head, id.tc, sp, RA);
                    const int u2 = qs[par]; par ^= 1;
                    RA = RB; id = idn; ok = okn; okn = unit_decode_q(u2, l, false, idn); }
            }
            __syncthreads(); PROF_TICK(26);
#endif
        }
        SEAM(pb + 1);
        if (IN(pb + 2)) {
#if DBG_LEVEL >= 3 && (PHM & 4)
            MKF(); MK_SP(); const bool split = F.G >= 256; const int nsc = split ? 128 : F.G;
            if (F.vcu < nsc) for (int rep = 0; rep <= D_CHAIN; ++rep) for (int cq = F.vcu; cq < 128; cq += nsc) { const bool dry = __builtin_amdgcn_readfirstlane(opq_v(rep)) != 0; const int c = cq >> 2, qt = cq & 3;
                if (c < 16) scan_chain<true>(F, c, qt, sp, dry); else scan_chain<false>(F, c - 16, qt, sp, dry); }
            if (F.vcu < nsc) {
                asm volatile("s_waitcnt vmcnt(0)" ::: "memory"); __syncthreads();
                if (F.tid == 0) { unsigned nj = 0u; for (int cq = F.vcu; cq < 128; cq += nsc) ++nj; __builtin_amdgcn_fence(__ATOMIC_RELEASE, "agent"); asm volatile("s_waitcnt vmcnt(0)" ::: "memory");
                    (void)xb_add((unsigned*)(F.ctl() + CW_QUEUE + (4 + l) * 64), nj); } }
            PROF_TICK(27);
            if (!split || F.vcu >= nsc) { const int widx = split ? F.vcu - nsc : F.vcu, nw = split ? F.G - nsc : F.G;
                dft_load_mats(F);
                for (int rep = 0; rep <= D_DFT; ++rep) for (int u = widx; u < 1024; u += nw) dft_unit<2>(F, u >> 9, (u >> 2) & 127, u & 3, P_IM1, P_FT, __builtin_amdgcn_readfirstlane(opq_v(rep)) != 0);
                PROF_TICK(28); if (l == 0) ctx_dft(F, P_FT, widx, nw); PROF_TICK(29); }
            __syncthreads();
#endif
        }
        PROF_TICK(pb + 2);
        if (IN(pb + 3)) {
#if DBG_LEVEL >= 3 && (PHM & 24)
#if (PHM & 8)
            {   MKF(); typedef attn_body::bf16 abf; abf* Pb = (abf*)F.P();
                const float MB = fminf(C2Q * 64.f * wave_max(fabsf(F.in[I_GQQG][l * 64 + F.lane])) * wave_max(fabsf(F.in[I_GQKG][l * 64 + F.lane])), 40.f);
                for (int i = 0;; ++i) { const int U = i * F.G + F.vcu; if (U >= 1024) break;
                    const int combo = (U >> 6) & 3, hg = (U >> 8) & 3, qb = U & 63, b = combo >> 1, kvh = combo & 1, h = kvh * 4 + hg;
                    abf* q = Pb + (size_t)(b * T + qb * 256) * NP + TC_GQQ + h * 64; const abf* kl = Pb + (size_t)(b * T) * NP + TC_GQK + kvh * 64; const abf* kc = Pb + (size_t)(RL + b * CTX) * NP + TC_GQK + kvh * 64;
                    attn_body::attn_unit<8>(q, kl, kl + (TC_GQV - TC_GQK), kc, kc + (TC_GQV - TC_GQK), 256, 260, q, (char*)lds, MB); }
                for (int rep = 0; rep < R_ATT; ++rep)
                for (int i = 0;; ++i) { const int U = i * F.G + F.vcu; if (U >= 1024) break;
                    const int combo = (U >> 6) & 3, hg = (U >> 8) & 3, qb = U & 63, b = combo >> 1, kvh = combo & 1, h = kvh * 4 + hg;
                    abf* q = Pb + (size_t)(b * T + qb * 256) * NP + TC_MLQ + (h & 3) * 64; const abf* kl = Pb + (size_t)(b * T) * NP + TC_GQK + kvh * 64; const abf* kc = Pb + (size_t)(RL + b * CTX) * NP + TC_GQK + kvh * 64;
                    attn_body::attn_unit<8>(q, kl, kl + (TC_GQV - TC_GQK), kc, kc + (TC_GQV - TC_GQK), 256, 260, Pb + (size_t)(b * T + qb * 256) * NP + TC_FT + (h & 3) * 64, (char*)lds, MB); }
                if (l == 0 && F.vcu < 16) { const int b = F.vcu >> 3, h = F.vcu & 7, kvh = h >> 2;
                    abf* q = Pb + (size_t)(RL + b * CTX) * NP + TC_GQQ + h * 64; const abf* kc = Pb + (size_t)(RL + b * CTX) * NP + TC_GQK + kvh * 64;
                    attn_body::attn_unit<8>(q, kc, kc + (TC_GQV - TC_GQK), kc, kc + (TC_GQV - TC_GQK), 4, 4, q, (char*)lds, MB); }
            }
#endif
            __syncthreads(); PROF_TICK(31);
#if (PHM & 16)
            {   MKF(); MK_SP();
                {
                    const bool dry = false;
                    if (F.tid == 0) { unsigned* cc_ = (unsigned*)(F.ctl() + CW_QUEUE + (4 + l) * 64); unsigned* bar_ = (unsigned*)((gu32*)(F.ws + WS_CTL) + CW_BAR) + args.li * XCD_BAR_WORDS;
                        XB_SPIN(xb_ld(cc_) < 128u, bar_); __builtin_amdgcn_fence(__ATOMIC_ACQUIRE, "agent"); asm volatile("s_waitcnt vmcnt(0)" ::: "memory"); }
                    __syncthreads();
                    volatile LAS int* qs = (volatile LAS int*)(F.lds + MISC_OFF + 96); unsigned* qh = (unsigned*)(F.ctl() + CW_QUEUE + (l * 2 + 1) * 64);
                    if (F.tid == 0) { qs[2] = (int)__hip_atomic_fetch_add(qh, 1u, RLX_AGENT); qs[3] = (int)__hip_atomic_fetch_add(qh, 1u, RLX_AGENT); }
                    __syncthreads();
                    UnitId id, idn; ScanRegs RA, RB; int u = qs[2], un = qs[3]; bool ok = unit_decode_q(u, l, true, id), okn = unit_decode_q(un, l, true, idn); int par = 0;
                    if (ok) scan_fetch<true>(F, l, id, sp, RA);
                    while (ok) {
                        if (okn) scan_fetch<true>(F, l, idn, sp, RB);
                        if (F.tid == 0) qs[par] = (int)__hip_atomic_fetch_add(qh, 1u, RLX_AGENT);
                        if (id.fam == 0) scan_out_unit<true>(F, l, id.b, id.head, id.tc, sp, RA, dry); else scan_out_unit<false>(F, l, id.b, id.head, id.tc, sp, RA, dry);
                        const int u2 = qs[par]; par ^= 1;
                        RA = RB; id = idn; ok = okn; okn = unit_decode_q(u2, l, true, idn); }
                }
            }
#endif
#endif
        }
        SEAM(pb + 3);
        if (IN(pb + 4)) {
#if DBG_LEVEL >= 3 && (PHM & 32)
            for (int rep = 0; rep < R_MRG; ++rep) { SchedMerge S; S.G = opq_s((int)gridDim.x); S.c = opq_s((int)blockIdx.x); S.npan = (l == 0) ? NPAN : NPAN_L; S.ws = opq(args.ws); S.bgate = args.in[I_BGATE] + (size_t)l * 4096;
            pg8::gemm_stream((LAS unsigned char*)lds, S); }
#endif
        }
        SEAM(pb + 4);
        if (IN(pb + 5)) {
#if DBG_LEVEL >= 3 && (PHM & 64)
            SchedOut S; S.G = opq_s((int)gridDim.x); S.c = opq_s((int)blockIdx.x); S.npan = (l == 0) ? NPAN : NPAN_L; S.l = l; S.ws = opq(args.ws); S.xlat = (l == 0) ? args.in[I_X] : args.out; S.xctx = (l == 0) ? args.in[I_CTX] : (const float*)(args.ws + WS_XC);
            if (l == 0) { MKF(); build_ctx_panels(F); }
            for (int rep = 0; rep < R_OUT; ++rep) pg8::gemm_stream((LAS unsigned char*)lds, S);
#else
            MKF(); phase_scale_rows(F, l, true);
#endif
        }
        SEAM(pb + 5);
        if (IN(pb + 6)) { MKF();
#if DBG_LEVEL >= 3 && (PHM & 64)
            phase_post_mix(F, l, l == 0 ? R : RL, (const float*)(F.ws + WS_P)); if (l == 0) for (int rep = 1; rep < R_PM0; ++rep) phase_post_mix(F, l, R, (const float*)(F.ws + WS_P));
#else
            phase_post_mix(F, l, l == 0 ? R : RL, F.XM());
#endif
        }
        if (l == 1) SEAM(pb + 6);
        if (IN(pb + 7)) { if (l == 1) { MKF(); phase_moe_assign(F); } }
        SEAM(pb + 7);
        if (IN(pb + 8)) {
#if DBG_LEVEL >= 2
            for (int rep = 0; rep < R_UP; ++rep) {
            if (l == 0) { SchedUp S; S.G = opq_s((int)gridDim.x); S.c = opq_s((int)blockIdx.x); S.ws = opq(args.ws); pg8::gemm_stream((LAS unsigned char*)lds, S); }
            else { SchedMoeUp S; S.G = opq_s((int)gridDim.x); S.c = opq_s((int)blockIdx.x); S.mt.ws = opq(args.ws); S.mt.lds = (LAS unsigned char*)lds; S.nt_ = *(const volatile int*)S.mt.ntiles();
                for (int t_ = threadIdx.x; t_ < MOE_MAXT; t_ += 512) ((LAS int*)((LAS unsigned char*)lds + TILE_E_OFF))[t_] = ((const GAS int*)S.mt.tile_e())[t_]; __syncthreads(); pg8::gemm_stream((LAS unsigned char*)lds, S); } }
#endif
        }
        SEAM(pb + 8);
        if (IN(pb + 9)) {
#if DBG_LEVEL >= 2
            if (l == 0) { SchedDown S; S.G = opq_s((int)gridDim.x); S.c = opq_s((int)blockIdx.x); S.l = 0; S.ws = opq(args.ws); pg8::gemm_stream((LAS unsigned char*)lds, S); }
            else { SchedMoeDown S; S.G = opq_s((int)gridDim.x); S.c = opq_s((int)blockIdx.x); S.mt.ws = opq(args.ws); S.mt.lds = (LAS unsigned char*)lds; S.Dst = (bf16*)args.out; S.nt_ = *(const volatile int*)S.mt.ntiles();
                for (int t_ = threadIdx.x; t_ < MOE_MAXT; t_ += 512) ((LAS int*)((LAS unsigned char*)lds + TILE_E_OFF))[t_] = ((const GAS int*)S.mt.tile_e())[t_]; __syncthreads(); for (int rep = 0; rep < R_MDN; ++rep) pg8::gemm_stream((LAS unsigned char*)lds, S); }
#else
            MKF();
            if (l == 0) phase_scale_rows(F, l, false);
            else { for (size_t i = (size_t)F.vcu * 512 + F.tid; i < (size_t)RL * D / 4; i += (size_t)F.G * 512) ((v4u*)F.out)[i] = (v4u){0u, 0u, 0u, 0u}; }
#endif
        }
        SEAM(pb + 9);
        if (IN(pb + 10)) { MKF(); phase_final(F, l); if (l == 0) for (int rep = 1; rep < R_FIN0; ++rep) phase_final(F, l); __syncthreads(); PROF_TICK(28); if (l == 0) { for (int rep = 0; rep < R_CONV; ++rep) convert_layer_weights(F, 1); } }
        if (l == 0) SEAM(pb + 10);
    }
__global__ void __launch_bounds__(NWAVES * 64, 2) mega_fwd(Args args) {
    extern __shared__ __attribute__((aligned(16))) unsigned char lds[];
    {   LAS unsigned char* L = (LAS unsigned char*)lds; const int tid = threadIdx.x;
        for (int u = tid; u < (LDS_BYTES - LDSCTL_OFF) / 4; u += NWAVES * 64) ((LAS unsigned*)(L + LDSCTL_OFF))[u] = 0u;
        __syncthreads();
        if (tid == 0) {
#pragma unroll
            for (int i = 0; i < 30; ++i) *(LAS unsigned long long*)(L + INTAB_OFF + 8 * i) = (unsigned long long)args.in[i]; }
        __syncthreads();
        if (PROF_MASK != 0u && blockIdx.x == PROF_WG && tid == 0) { volatile LAS unsigned long long* pw_ = (volatile LAS unsigned long long*)(L + MISC_OFF + 64); pw_[0] = __builtin_amdgcn_s_memrealtime(); pw_[1] = 0ull; }
        (void)xcd_barrier_post((unsigned*)((gu32*)(args.ws + WS_CTL) + CW_BAR) + args.li * XCD_BAR_WORDS, (volatile LAS unsigned*)(L + MISC_OFF) + 8);
    }
    if (IN(0)) { MKF(); for (int rep = 0; rep < R_PRO; ++rep) { build_tables(F); convert_layer_weights(F, 0); __syncthreads(); PROF_TICK(27); ada_phase(F); } }
    SEAM(0);
    if (IN(1)) { MKF(); for (int rep = 0; rep < R_PRO; ++rep) phase_ln_mod(F, 0); }
    SEAM(1);
    layer_body<0>(args, lds);
    layer_body<1>(args, lds);
    PROF_TICK(N_PHASES - 1);
    if (PROF_MASK != 0u && blockIdx.x == PROF_WG && threadIdx.x == 0) { volatile LAS unsigned long long* pw_ = (volatile LAS unsigned long long*)((LAS unsigned char*)lds + MISC_OFF + 64);
        const unsigned long long t0_ = pw_[0], w_ = 4ull * pw_[1]; while (__builtin_amdgcn_s_memrealtime() - t0_ < w_) __builtin_amdgcn_s_sleep(8); }
}
#undef IN
#undef SEAM


extern "C" void kernel_launch(void* const* d_in, const int* in_sizes, int n_in, void* d_out, int out_size, void* d_ws, size_t ws_size, hipStream_t stream) {
    static int grid = 0;
    if (grid == 0) {
        if (n_in != 30 || out_size != RL * D || ws_size < WS_END) { fprintf(stderr, "kernel_launch: unexpected problem (n_in %d out %d ws %zu)\n", n_in, out_size, ws_size); grid = -1; return; }
        int dev = 0, cus = 0;
        if (hipGetDevice(&dev) != hipSuccess || hipDeviceGetAttribute(&cus, hipDeviceAttributeMultiprocessorCount, dev) != hipSuccess) { grid = -1; return; }
        if (hipFuncSetAttribute((const void*)mega_fwd, hipFuncAttributeMaxDynamicSharedMemorySize, LDS_BYTES) != hipSuccess) { fprintf(stderr, "kernel_launch: hipFuncSetAttribute failed\n"); grid = -1; return; }
        int per_cu = 0; (void)hipOccupancyMaxActiveBlocksPerMultiprocessor(&per_cu, (const void*)mega_fwd, NWAVES * 64, LDS_BYTES); (void)hipGetLastError();
        grid = cus;
        if (per_cu < 1) fprintf(stderr, "kernel_launch: occupancy query says %d\n", per_cu);
    }
    if (grid < 0) return;
    if (hipMemsetAsync((char*)d_ws + WS_CTL, 0, CTL_ZERO_BYTES, stream) != hipSuccess) return;
    Args a{};
    for (int i = 0; i < 30; ++i) a.in[i] = (const float*)d_in[i];
    a.out = (float*)d_out; a.ws = (unsigned char*)d_ws;
#if MK_N_LAUNCHES == 1
    a.ph_lo = 0; a.ph_hi = N_PHASES; a.li = 0;
    hipLaunchKernelGGL(mega_fwd, dim3(grid), dim3(NWAVES * 64), LDS_BYTES, stream, a);
#else
    for (int k = 0; k < N_PHASES; ++k) { a.ph_lo = k; a.ph_hi = k + 1; a.li = 0; hipLaunchKernelGGL(mega_fwd, dim3(grid), dim3(NWAVES * 64), LDS_BYTES, stream, a); }
#endif
}
```

```cpp
#include <hip/hip_runtime.h>
#include <hip/hip_bf16.h>
#include <cstdio>
#include <cstdint>

#ifndef MK_N_LAUNCHES
#define MK_N_LAUNCHES 1
#endif
#ifndef DBG_LEVEL
#define DBG_LEVEL 99
#endif

#define GAS __attribute__((address_space(1)))
#define LAS __attribute__((address_space(3)))
typedef unsigned short bf16;
typedef unsigned v4u __attribute__((ext_vector_type(4)));
typedef unsigned v2u __attribute__((ext_vector_type(2)));
typedef float f32x4 __attribute__((ext_vector_type(4)));
typedef float f32x2 __attribute__((ext_vector_type(2)));
typedef short bf16x8 __attribute__((ext_vector_type(8)));
typedef float f32x16 __attribute__((ext_vector_type(16)));
typedef GAS unsigned gu32;
#define RLX_AGENT __ATOMIC_RELAXED, __HIP_MEMORY_SCOPE_AGENT
#define LDS_WAIT() asm volatile("s_waitcnt lgkmcnt(0)" ::: "memory")
#define VM_WAIT() asm volatile("s_waitcnt vmcnt(0)" ::: "memory")

constexpr int D = 1024, NB = 2, T = 16384, CTX = 256;
constexpr int RL = NB * T;
constexpr int R = RL + NB * CTX;
constexpr int NPAN = R / 256, NPAN_L = RL / 256;
constexpr int NIN = 3120;
constexpr int NP = 3072;
constexpr int TC_MLQ = 0, TC_MLK = 256, TC_MLV = 512, TC_MLO = 768, TC_FT = 1024, TC_GQQ = 1280, TC_GQK = 1792, TC_GQV = 1920,
              TC_GLQ = 2048, TC_GLK = 2304, TC_GLV = 2560, TC_GLR = 2816;
constexpr int SMP = 64;
constexpr int FFD = 2816, NEXP = 8, FFE = 1408;
constexpr float LN_EPS = 1e-6f;
constexpr float ALPHA = 1.4142135623730951f;
constexpr int NCH = 260;
constexpr int NCHAIN = 16;
constexpr float C2Q = 0.125f * 1.4426950408889634f;

constexpr size_t MiB = 1u << 20;
constexpr size_t WS_CTL = 0, CTL_ZERO_BYTES = 128 * 1024;
constexpr size_t WS_ADA = 1 * MiB;
constexpr size_t WS_TAB = WS_ADA + 256 * 1024;
constexpr size_t WS_ROPE_C = WS_TAB, WS_ROPE_S = WS_TAB + 16384, WS_DFT_C = WS_TAB + 32768, WS_DFT_S = WS_DFT_C + 32768;
constexpr size_t WS_MOE = 2 * MiB;
constexpr size_t WS_XC = 4 * MiB;
constexpr size_t WS_SM = 6 * MiB;
constexpr size_t WS_SCAL = 15 * MiB;
constexpr size_t WS_W = 20 * MiB;
constexpr size_t W_IN = 0, W_GATE = W_IN + (size_t)3328 * 1024 * 2, W_OUT = W_GATE + (size_t)4096 * 1024 * 2,
                 W_BML = W_OUT + (size_t)1024 * 1024 * 2, W_BFT = W_BML + (size_t)1024 * 256 * 2, W_BAT = W_BFT + (size_t)1024 * 512 * 2,
                 W_BGL = W_BAT + (size_t)1024 * 512 * 2, W_FFN = W_BGL + (size_t)1024 * 256 * 2;
constexpr size_t W_FFD_GU = W_FFN, W_FFD_D = W_FFN + (size_t)5632 * 1024 * 2;
constexpr size_t W_MOE_GU = W_FFN, W_MOE_D = W_FFN + (size_t)8 * 2816 * 1024 * 2;
constexpr size_t W_END = W_MOE_D + (size_t)8 * 1024 * 1408 * 2;
static_assert(W_END <= 86 * MiB, "weights region");
constexpr size_t WS_H = 106 * MiB;
constexpr size_t WS_P = 172 * MiB;
constexpr size_t WS_XM = 368 * MiB;
constexpr size_t WS_UQ = 498 * MiB;
constexpr size_t WS_PA = 502 * MiB;
constexpr size_t WS_DP = 506 * MiB;
constexpr size_t WS_END = 510 * MiB;
static_assert(WS_H + (size_t)R * 1024 * 2 <= WS_P && WS_P + (size_t)R * NP * 2 <= WS_XM && WS_XM + (size_t)R * 1024 * 4 <= WS_END, "ws map");
constexpr size_t XO_MLC = 0;
constexpr size_t XO_GLS = 33 * MiB;
constexpr size_t XO_MIX = 0;
constexpr size_t XO_IM1 = 68 * MiB;
constexpr size_t XO_GST = 65 * MiB;
constexpr size_t XO_FT = 97 * MiB + 512 * 1024;
static_assert(XO_FT + (size_t)R * 512 * 2 <= (size_t)R * 1024 * 4 && XO_GST + 32 * MiB <= XO_FT && XO_IM1 + 16 * MiB <= XO_FT && XO_GLS + 33 * MiB <= XO_IM1, "XM overlays");
constexpr size_t SC_MLN = 0;
constexpr size_t SC_MLA = SC_MLN + (size_t)16 * 260 * 64 * 4;
constexpr size_t SC_MLB = SC_MLA + 16 * 260 * 4;
constexpr size_t SC_MLM = SC_MLB + 16 * 260 * 4;
constexpr size_t SC_GLD = SC_MLM + 16 * 260 * 4;
static_assert(SC_GLD + (size_t)16 * 260 * 64 * 4 <= 5 * MiB, "scal");
constexpr int MOE_MAXT = 264;
constexpr size_t MO_TOK = 0;
constexpr size_t MO_DST = MO_TOK + (size_t)MOE_MAXT * 256 * 4;
constexpr size_t MO_SEL = MO_DST + (size_t)MOE_MAXT * 256 * 4;
static_assert(MO_SEL + (size_t)RL * 16 <= 2 * MiB, "moe tables");
constexpr int CW_QUEUE = 2048  , CW_TMO = 0, CW_CODE = 1, CW_BAR = 4096, CW_MOECNT = 16384  , CW_MOECUR = 16384 + 8 * 64;
static_assert((CW_MOECUR + 8 * 64) * 4 <= (int)CTL_ZERO_BYTES && (CW_BAR + 3456) * 4 <= (int)CTL_ZERO_BYTES, "control words inside the per-call memset");
#define XB_TMO      128
#define XB_XCNT(j)  (256  + 64 * (j))
#define XB_XSUB(j)  (1280 + 64 * (j))
#define XB_XGEN(j)  (2304 + 64 * (j))
#define XB_TOP      3328
#define XB_TOPGEN   3392
#define XCD_BAR_WORDS 3456
#define XB_SPIN_CAP (1u << 18)

constexpr int RING_BYTES = 131072, LDSCTL_OFF = RING_BYTES, MISC_OFF = LDSCTL_OFF + 320, LDS_BYTES = 147456;
constexpr int NWAVES = 8;

#ifndef PROF_WG
#define PROF_WG 0
#endif
#ifndef PROF_MASK
#define PROF_MASK 0u
#endif
#define PROF_LDS lds
#define PROF_TICK(k) do { if (PROF_MASK != 0u && blockIdx.x == PROF_WG && threadIdx.x == 0) { volatile LAS unsigned long long* pw_ = (volatile LAS unsigned long long*)((LAS unsigned char*)PROF_LDS + MISC_OFF + 64); \
        const unsigned long long now_ = __builtin_amdgcn_s_memrealtime(); if ((PROF_MASK >> (k)) & 1u) pw_[1] += now_ - pw_[0]; pw_[0] = now_; if ((k) < 24) pw_[2] = (unsigned long long)((k) + 1); } } while (0)
#ifndef PROF_SEL
#define PROF_SEL -1
#endif
#define PROF_GEMM_ON() ((PROF_MASK & 0xE0000000u) != 0u && (PROF_SEL < 0 || (((volatile LAS unsigned long long*)((LAS unsigned char*)PROF_LDS + MISC_OFF + 64))[2] >= 2ull && (int)((((volatile LAS unsigned long long*)((LAS unsigned char*)PROF_LDS + MISC_OFF + 64))[2] - 2ull) % 11ull) == PROF_SEL)))
#define PROF_SPAN_BEGIN() do { if (PROF_MASK != 0u && blockIdx.x == PROF_WG && threadIdx.x == 0) { volatile LAS unsigned long long* pw_ = (volatile LAS unsigned long long*)((LAS unsigned char*)PROF_LDS + MISC_OFF + 64); pw_[0] = __builtin_amdgcn_s_memrealtime(); } } while (0)
template <class T_> __device__ __forceinline__ T_* opq(T_* p) { asm volatile("" : "+s"(p)); return p; }
__device__ __forceinline__ int opq_s(int v) { asm volatile("" : "+s"(v)); return v; }
__device__ __forceinline__ int opq_v(int v) { asm volatile("" : "+v"(v)); return v; }
__device__ __forceinline__ unsigned f2bf(float f) { unsigned u = __builtin_bit_cast(unsigned, f); return (u + 0x7fffu + ((u >> 16) & 1u)) >> 16; }
typedef __bf16 hwbf16x2 __attribute__((ext_vector_type(2)));
__device__ __forceinline__ unsigned pk2(float lo, float hi) { const f32x2 v = {lo, hi}; return __builtin_bit_cast(unsigned, __builtin_convertvector(v, hwbf16x2)); }
__device__ __forceinline__ float bflo(unsigned w) { return __uint_as_float(w << 16); }
__device__ __forceinline__ float bfhi(unsigned w) { return __uint_as_float(w & 0xffff0000u); }
__device__ __forceinline__ float bf2f(bf16 b) { return __uint_as_float((unsigned)b << 16); }
__device__ __forceinline__ void unpack8(const v4u a, float (&x)[8]) { x[0] = bflo(a.x); x[1] = bfhi(a.x); x[2] = bflo(a.y); x[3] = bfhi(a.y); x[4] = bflo(a.z); x[5] = bfhi(a.z); x[6] = bflo(a.w); x[7] = bfhi(a.w); }
__device__ __forceinline__ v4u pack8(const float (&x)[8]) { v4u w; w.x = pk2(x[0], x[1]); w.y = pk2(x[2], x[3]); w.z = pk2(x[4], x[5]); w.w = pk2(x[6], x[7]); return w; }
template <int CTRL> __device__ __forceinline__ float dpp_get(float v) { return __builtin_bit_cast(float, __builtin_amdgcn_update_dpp(0, __builtin_bit_cast(int, v), CTRL, 0xF, 0xF, true)); }
__device__ __forceinline__ float wave_sum(float v) {
    v += dpp_get<0xB1>(v);
    v += dpp_get<0x4E>(v);
    v += dpp_get<0x141>(v);
    v += dpp_get<0x140>(v);
    { const auto rr = __builtin_amdgcn_permlane16_swap(__float_as_uint(v), __float_as_uint(v), false, false); v = __uint_as_float(rr[0]) + __uint_as_float(rr[1]); }
    { const auto rr = __builtin_amdgcn_permlane32_swap(__float_as_uint(v), __float_as_uint(v), false, false); v = __uint_as_float(rr[0]) + __uint_as_float(rr[1]); }
    return v;
}
__device__ __forceinline__ float xor16_32_sum(float v) {
    { const auto rr = __builtin_amdgcn_permlane16_swap(__float_as_uint(v), __float_as_uint(v), false, false); v = __uint_as_float(rr[0]) + __uint_as_float(rr[1]); }
    { const auto rr = __builtin_amdgcn_permlane32_swap(__float_as_uint(v), __float_as_uint(v), false, false); v = __uint_as_float(rr[0]) + __uint_as_float(rr[1]); }
    return v; }
__device__ __forceinline__ float sigm(float x) { return __builtin_amdgcn_rcpf(1.f + __expf(-x)); }
__device__ __forceinline__ float logsig(float a) { return fminf(a, 0.f) - __logf(1.f + __expf(-fabsf(a))); }

__device__ __forceinline__ unsigned xb_ld(unsigned* p)              { return __hip_atomic_load(p, __ATOMIC_RELAXED, __HIP_MEMORY_SCOPE_AGENT); }
__device__ __forceinline__ unsigned xb_add(unsigned* p, unsigned v) { return __hip_atomic_fetch_add(p, v, __ATOMIC_RELAXED, __HIP_MEMORY_SCOPE_AGENT); }
__device__ __forceinline__ unsigned xb_xcc_id() { return (unsigned)__builtin_amdgcn_s_getreg((3 << 11) | 20) & 0xFu; }
#define XB_SPIN(cond, bar) do { unsigned _sp = 0; while (cond) { __builtin_amdgcn_s_sleep(1); \
    if ((++_sp & 255u) == 0u) { if (xb_ld(&(bar)[XB_TMO])) break; if (_sp > XB_SPIN_CAP) { atomicAdd(&(bar)[XB_TMO], 1u); break; } } } } while (0)
struct XcdBarrier { unsigned* bar; unsigned x; volatile LAS unsigned* st; };
__device__ __forceinline__ XcdBarrier xcd_barrier_post(unsigned* bar, volatile LAS unsigned* st) {
    XcdBarrier b; b.bar = bar; b.x = xb_xcc_id(); b.st = st;
    if (threadIdx.x == 0) (void)xb_add(&bar[XB_XCNT(b.x)], 1u);
    return b;
}
__device__ __forceinline__ void xcd_barrier_complete(unsigned* bar, unsigned x, unsigned& nloc, unsigned& nx) {
    const unsigned G = gridDim.x * gridDim.y * gridDim.z;
    unsigned sum, cnt, mine, sp = 0u;
    for (;;) {
        sum = 0u; cnt = 0u; mine = 0u;
#pragma unroll
        for (unsigned j = 0; j < 16; ++j) { const unsigned c = xb_ld(&bar[XB_XCNT(j)]); sum += c; cnt += (c > 0u) ? 1u : 0u; mine = (j == x) ? c : mine; }
        if (sum == G) break;
        __builtin_amdgcn_s_sleep(1);
        if ((++sp & 255u) == 0u) { if (xb_ld(&bar[XB_TMO])) break; if (sp > XB_SPIN_CAP) { atomicAdd(&bar[XB_TMO], 1u); break; } }
    }
    nloc = mine > 0u ? mine : 1u; nx = cnt > 0u ? cnt : 1u;
}
__device__ __forceinline__ void xcd_barrier(const XcdBarrier& b) {
    asm volatile("s_waitcnt vmcnt(0)" ::: "memory");
    __syncthreads();
    if (threadIdx.x == 0) {
        unsigned* bar = b.bar;
        __builtin_amdgcn_s_waitcnt(0);
        unsigned nloc = b.st[0], nx = b.st[1];
        if (nloc == 0u) { xcd_barrier_complete(bar, b.x, nloc, nx); b.st[0] = nloc; b.st[1] = nx; }
        const unsigned old = xb_add(&bar[XB_XSUB(b.x)], 1u);
        const unsigned gen = old / nloc;
        if (old + 1u == (gen + 1u) * nloc) {
            __builtin_amdgcn_fence(__ATOMIC_RELEASE, "agent");
            asm volatile("s_waitcnt vmcnt(0)" ::: "memory");
            const unsigned og = xb_add(&bar[XB_TOP], 1u);
            const unsigned tg = og / nx;
            if (og + 1u == (tg + 1u) * nx) xb_add(&bar[XB_TOPGEN], 1u);
            else XB_SPIN(xb_ld(&bar[XB_TOPGEN]) == tg, bar);
            __builtin_amdgcn_fence(__ATOMIC_ACQUIRE, "agent");
            xb_add(&bar[XB_XGEN(b.x)], 1u);
            asm volatile("s_waitcnt vmcnt(0)" ::: "memory");
        } else {
            XB_SPIN(xb_ld(&bar[XB_XGEN(b.x)]) == gen, bar);
            __builtin_amdgcn_fence(__ATOMIC_ACQUIRE, "agent");
            asm volatile("s_waitcnt vmcnt(0)" ::: "memory");
        }
    }
    __syncthreads();
}
namespace pg8 {
constexpr int BM = 256, BK = 64, HALF = 128, HTB = HALF * BK * 2, STAGE_BYTES = 8 * HTB, NXCD = 8, WGM = 8;
__host__ __device__ __forceinline__ int lds_byte(int r, int c) { const int st = (r >> 4) * 2 + (c >> 5), rr = r & 15, cc = c & 31, ob = rr * 64 + cc * 2; return st * 1024 + (ob ^ (((ob >> 9) & 1) << 5)); }
__host__ __device__ __forceinline__ void stage_rc(int b, int& R_, int& C_) { const int st = b / 1024, sb = b % 1024, swz = sb ^ (((sb >> 9) & 1) << 5); R_ = (st >> 1) * 16 + swz / 64; C_ = (st & 1) * 32 + (swz % 64) / 2; }
__host__ __device__ __forceinline__ int perm32(int rho) { const int n = rho >> 4, i = rho & 15; return 8 * (i >> 2) + 4 * n + (i & 3); }
struct GU { unsigned ao, bo; unsigned lda, ldb; int nt; int pm, pn, kind, aux; };
__device__ __forceinline__ bool tile_of(long L, int nM, int nN, int& pm, int& pn) {
    const int nwg = nM * nN; if (L >= nwg) return false;
    int wgid = (int)L; { const int q = nwg / NXCD, r = nwg % NXCD, xcd = wgid % NXCD, off = wgid / NXCD; wgid = (xcd < r ? xcd * (q + 1) : r * (q + 1) + (xcd - r) * q) + off; }
    const int nig = WGM * nN, gid = wgid / nig, fm = gid * WGM, gsz = (nM - fm) < WGM ? (nM - fm) : WGM;
    pm = fm + ((wgid % nig) % gsz); pn = (wgid % nig) / gsz; return true;
}
__device__ __forceinline__ unsigned cvt_pk_bf16(float lo, float hi) { return pk2(lo, hi); }

template <class S>
__device__ __forceinline__ void gemm_stream(LAS unsigned char* lds, const S& sch) {
    const int tid = opq_v((int)threadIdx.x), wid = __builtin_amdgcn_readfirstlane(tid >> 6), lane = tid & 63, wr = wid >> 2, wc = wid & 3, fr = lane & 15, fq = lane >> 4;
    const unsigned ldsw = (unsigned)wid * 1024u;
    const int aoff = lds_byte(wr * 64 + fr, fq * 8), boff = lds_byte(wc * 32 + fr, fq * 8);
#define PG8_SA(b, h) (((b) * 2 + (h)) * HTB)
#define PG8_SB(b, h) ((4 + (b) * 2 + (h)) * HTB)
#define PG8_STG(bufoff, soff, o0, o1) do { \
        __builtin_amdgcn_raw_ptr_buffer_load_lds(rs, (LAS unsigned*)(lds + (bufoff) + ldsw), 16, (o0), (soff), 0, 0); \
        __builtin_amdgcn_raw_ptr_buffer_load_lds(rs, (LAS unsigned*)(lds + (bufoff) + ldsw + 8192), 16, (o1), (soff), 0, 0); } while (0)
#define PG8_LDA(dst, b, h) do { _Pragma("unroll") for (int m = 0; m < 4; ++m) _Pragma("unroll") for (int k = 0; k < 2; ++k) dst[m][k] = *(const LAS bf16x8*)(lds + PG8_SA(b, h) + aoff + m * 2048 + k * 1024); } while (0)
#define PG8_LDB(dst, b, h) do { _Pragma("unroll") for (int n = 0; n < 2; ++n) _Pragma("unroll") for (int k = 0; k < 2; ++k) dst[n][k] = *(const LAS bf16x8*)(lds + PG8_SB(b, h) + boff + n * 2048 + k * 1024); } while (0)
#define PG8_MMA(ai, bj, At, Bt) do { __builtin_amdgcn_s_setprio(1); _Pragma("unroll") for (int m = 0; m < 4; ++m) _Pragma("unroll") for (int n = 0; n < 2; ++n) _Pragma("unroll") for (int k = 0; k < 2; ++k) \
        acc[ai][bj][m][n] = __builtin_amdgcn_mfma_f32_16x16x32_bf16(Bt[n][k], At[m][k], acc[ai][bj][m][n], 0, 0, 0); __builtin_amdgcn_s_setprio(0); } while (0)
#define PG8_WAIT_V(n) asm volatile("s_waitcnt vmcnt(" #n ")" ::: "memory")
#define PG8_WAIT_L(n) asm volatile("s_waitcnt lgkmcnt(" #n ")" ::: "memory")
#define PG8_BAR __builtin_amdgcn_s_barrier()
#define PG8_SCHED __builtin_amdgcn_sched_barrier(0)
#define PG8_SETUP(u, oA, oB, hB) do { _Pragma("unroll") for (int i = 0; i < 2; ++i) { \
        int R_, C_; stage_rc(tid * 16 + i * 8192, R_, C_); const unsigned RA_ = (unsigned)R_, RB_ = (unsigned)(S::PERM ? ((R_ & ~31) + perm32(R_ & 31)) : R_), CB_ = (unsigned)C_ * 2u; \
        if constexpr (S::GATHER) { oA[0][i] = sch.arow(u, (int)RA_) + CB_; oA[1][i] = sch.arow(u, (int)RA_ + 128) + CB_; } \
        else { oA[0][i] = RA_ * (u).lda + CB_; oA[1][i] = oA[0][i] + 128u * (u).lda; } \
        oB[i] = RB_ * (u).ldb + CB_; } hB = 128u * (u).ldb; } while (0)
    GU cur, nxt; int ui = 0;
    if (!sch.next(0, cur)) return;
    f32x4 acc[2][2][4][2];
#pragma unroll
    for (int a = 0; a < 2; ++a)
#pragma unroll
        for (int b = 0; b < 2; ++b)
#pragma unroll
            for (int m = 0; m < 4; ++m)
#pragma unroll
                for (int n = 0; n < 2; ++n) acc[a][b][m][n] = (f32x4){0.f, 0.f, 0.f, 0.f};
    bf16x8 At[4][2], B0[2][2], B1[2][2];
    const __amdgpu_buffer_rsrc_t rs = __builtin_amdgcn_make_buffer_rsrc((void*)sch.wsbase(), (short)0, (int)WS_END, 0x00020000);
    unsigned oA[2][2], oB[2]; unsigned hB;
    PG8_SETUP(cur, oA, oB, hB);
    unsigned cA = cur.ao, cB = cur.bo;
    PG8_STG(PG8_SB(0, 0), cB, oB[0], oB[1]); PG8_STG(PG8_SB(0, 1), cB + hB, oB[0], oB[1]); PG8_STG(PG8_SA(0, 0), cA, oA[0][0], oA[0][1]); PG8_STG(PG8_SA(0, 1), cA, oA[1][0], oA[1][1]);
    if (wr == 1) PG8_BAR;
    PG8_WAIT_V(2); PG8_BAR;
    PG8_STG(PG8_SB(1, 0), cB + 128, oB[0], oB[1]); PG8_STG(PG8_SA(1, 0), cA + 128, oA[0][0], oA[0][1]); PG8_STG(PG8_SB(1, 1), cB + hB + 128, oB[0], oB[1]);
    PG8_WAIT_V(6); PG8_BAR;
    if (PROF_GEMM_ON()) { PROF_TICK(31); }
    for (;;) {
        const bool has_next = sch.next(ui + 1, nxt);
        unsigned gA[2][2];
        if constexpr (S::GATHER) { if (has_next) {
#pragma unroll
            for (int i = 0; i < 2; ++i) { int R_, C_; stage_rc(tid * 16 + i * 8192, R_, C_); gA[0][i] = sch.arow(nxt, R_) + (unsigned)C_ * 2u; gA[1][i] = sch.arow(nxt, R_ + 128) + (unsigned)C_ * 2u; } } }
        const int nt = cur.nt;
        for (int t = 0; t < nt; t += 2) {
            const bool last = (t == nt - 2);
            const unsigned a1 = cA + (unsigned)(t + 1) * 128u;
            PG8_LDB(B0, 0, 0); PG8_LDB(B1, 0, 1); PG8_SCHED; PG8_LDA(At, 0, 0); PG8_STG(PG8_SA(1, 1), a1, oA[1][0], oA[1][1]);
            PG8_WAIT_V(8); PG8_WAIT_L(0); PG8_BAR; PG8_MMA(0, 0, At, B0); PG8_MMA(0, 1, At, B1); PG8_BAR; PG8_SCHED;
            unsigned a2 = cA + (unsigned)(t + 2) * 128u, b2 = cB + (unsigned)(t + 2) * 128u;
            if (last) { a2 = cA; b2 = cB;
                if (has_next) { a2 = nxt.ao; b2 = nxt.bo;
                    if constexpr (S::GATHER) { oA[0][0] = gA[0][0]; oA[0][1] = gA[0][1]; oA[1][0] = gA[1][0]; oA[1][1] = gA[1][1];
#pragma unroll
                        for (int i = 0; i < 2; ++i) { int R_, C_; stage_rc(tid * 16 + i * 8192, R_, C_); const unsigned RB_ = (unsigned)(S::PERM ? ((R_ & ~31) + perm32(R_ & 31)) : R_); oB[i] = RB_ * nxt.ldb + (unsigned)C_ * 2u; }
                        hB = 128u * nxt.ldb; }
                    else { PG8_SETUP(nxt, oA, oB, hB); } } }
            const unsigned a3 = a2 + 128u, b3 = b2 + 128u;
            PG8_LDA(At, 0, 1); PG8_STG(PG8_SB(0, 0), b2, oB[0], oB[1]); PG8_STG(PG8_SB(0, 1), b2 + hB, oB[0], oB[1]); PG8_STG(PG8_SA(0, 0), a2, oA[0][0], oA[0][1]);
            PG8_WAIT_V(8); PG8_WAIT_L(0); PG8_BAR; PG8_MMA(1, 0, At, B0); PG8_MMA(1, 1, At, B1); PG8_BAR; PG8_SCHED;
            PG8_LDB(B0, 1, 0); PG8_LDB(B1, 1, 1); PG8_SCHED; PG8_LDA(At, 1, 0); PG8_STG(PG8_SA(0, 1), a2, oA[1][0], oA[1][1]);
            PG8_WAIT_V(8); PG8_WAIT_L(0); PG8_BAR; PG8_MMA(0, 0, At, B0); PG8_MMA(0, 1, At, B1); PG8_BAR; PG8_SCHED;
            PG8_LDA(At, 1, 1); PG8_STG(PG8_SB(1, 0), b3, oB[0], oB[1]); PG8_STG(PG8_SB(1, 1), b3 + hB, oB[0], oB[1]); PG8_STG(PG8_SA(1, 0), a3, oA[0][0], oA[0][1]);
            PG8_WAIT_V(8); PG8_WAIT_L(0); PG8_BAR; PG8_MMA(1, 0, At, B0); PG8_MMA(1, 1, At, B1); PG8_BAR; PG8_SCHED;
        }
        if (wr == 0) PG8_BAR;
        { const bool pon_ = PROF_GEMM_ON(); if (pon_) { PROF_TICK(29); } sch.epi(acc, cur, wr, wc, fr, fq); if (pon_) { asm volatile("s_waitcnt vmcnt(0)" ::: "memory"); PROF_TICK(30); } }
        if (!has_next) break;
#pragma unroll
        for (int a = 0; a < 2; ++a)
#pragma unroll
            for (int b = 0; b < 2; ++b)
#pragma unroll
                for (int m = 0; m < 4; ++m)
#pragma unroll
                    for (int n = 0; n < 2; ++n) acc[a][b][m][n] = (f32x4){0.f, 0.f, 0.f, 0.f};
        cur = nxt; cA = cur.ao; cB = cur.bo; ++ui;
        if (wr == 1) PG8_BAR;
    }
    PG8_WAIT_V(0);
    PG8_BAR;
#undef PG8_SA
#undef PG8_SB
#undef PG8_STG
#undef PG8_LDA
#undef PG8_LDB
#undef PG8_MMA
#undef PG8_WAIT_V
#undef PG8_WAIT_L
#undef PG8_BAR
#undef PG8_SCHED
#undef PG8_SETUP
}
}
struct Args { const float* in[30]; float* out; unsigned char* ws; int ph_lo, ph_hi, li, pad; };
constexpr int INTAB_OFF = LDSCTL_OFF + 512;
constexpr int TILE_E_OFF = LDSCTL_OFF + 1024;
struct InTab { LAS unsigned char* lds;
    __device__ __forceinline__ const float* operator[](int i) const { return (const float*)(*(const LAS unsigned long long*)(lds + INTAB_OFF + 8 * i)); } };
struct Frame {
    LAS unsigned char* lds; volatile LAS unsigned* MISC;
    int tid, lane, wave, vcu, G;
    InTab in; float* out; unsigned char* ws;
    __device__ __forceinline__ gu32* ctl() const { return (gu32*)(ws + WS_CTL); }
    __device__ __forceinline__ bf16* H() const { return (bf16*)(ws + WS_H); }
    __device__ __forceinline__ bf16* P() const { return (bf16*)(ws + WS_P); }
    __device__ __forceinline__ float* XM() const { return (float*)(ws + WS_XM); }
    __device__ __forceinline__ float* XC() const { return (float*)(ws + WS_XC); }
    __device__ __forceinline__ float* SM() const { return (float*)(ws + WS_SM); }
    __device__ __forceinline__ float* ADA() const { return (float*)(ws + WS_ADA); }
};
enum { I_X = 0, I_C, I_CTX, I_CCTX, I_WADA, I_BADA, I_WIN, I_MLGB, I_MLNG, I_GQQG, I_GQKG, I_GLW2, I_GLB2, I_GLNG, I_WBR, I_WGATE, I_BGATE, I_WOUT,
       I_LN1G, I_LN1B, I_LN2G, I_LN2B, I_FFDWG, I_FFDWU, I_FFDWD, I_MOEWR, I_MOEBR, I_MOEWG, I_MOEWU, I_MOEWD };
__device__ __forceinline__ int set_of_panel(int pm) { return pm < 64 ? 0 : (pm < 128 ? 1 : 2); }
__device__ __forceinline__ int set_of_row(int r) { return r < T ? 0 : (r < RL ? 1 : 2); }
__device__ __forceinline__ const float* ada_vec(const Frame& F, int l, int set, int k) { return F.ADA() + ((size_t)(l * 3 + set) * 6 + k) * D; }
__device__ __forceinline__ const float* xin_row(const Frame& F, int l, int r) {
    if (l == 0) return r < RL ? F.in[I_X] + (size_t)r * D : F.in[I_CTX] + (size_t)(r - RL) * D;
    return r < RL ? F.out + (size_t)r * D : F.XC() + (size_t)(r - RL) * D;
}

typedef pg8::GU GU;
struct SchedBase { int G, c; };
struct SchedIn : SchedBase {
    static constexpr bool PERM = true, GATHER = false;
    unsigned char* ws;
    __device__ __forceinline__ bool next(int i, GU& u) const {
        if (!pg8::tile_of((long)i * G + c, NPAN, 13, u.pm, u.pn)) return false;
        u.ao = (unsigned)WS_H + (unsigned)u.pm * 256u * D * 2u; u.lda = D * 2; u.bo = (unsigned)(WS_W + W_IN) + (unsigned)u.pn * 256u * D * 2u; u.ldb = D * 2; u.nt = D / 64; return true; }
    __device__ __forceinline__ unsigned char* wsbase() const { return ws; }
    __device__ __forceinline__ void epi(const f32x4 (&acc)[2][2][4][2], const GU& u, int wr, int wc, int fr, int fq) const {
        const int row0 = u.pm * 256 + wr * 64 + fr; bf16* P = (bf16*)(ws + WS_P); float* SM = (float*)(ws + WS_SM);
        if (u.pn < 12) {
#pragma unroll
            for (int ai = 0; ai < 2; ++ai)
#pragma unroll
                for (int m = 0; m < 4; ++m) { bf16* rowp = P + (size_t)(row0 + ai * 128 + m * 16) * NP + u.pn * 256 + wc * 32 + 8 * fq;
#pragma unroll
                    for (int bj = 0; bj < 2; ++bj) { const f32x4 v0 = acc[ai][bj][m][0], v1 = acc[ai][bj][m][1];
                        v4u w; w.x = pg8::cvt_pk_bf16(v0[0], v0[1]); w.y = pg8::cvt_pk_bf16(v0[2], v0[3]); w.z = pg8::cvt_pk_bf16(v1[0], v1[1]); w.w = pg8::cvt_pk_bf16(v1[2], v1[3]);
                        *(GAS v4u*)(rowp + bj * 128) = w; } }
        } else if (wc < 2) {
            const int col = wc * 32 + 8 * fq;
#pragma unroll
            for (int ai = 0; ai < 2; ++ai)
#pragma unroll
                for (int m = 0; m < 4; ++m) { float* rowp = SM + (size_t)(row0 + ai * 128 + m * 16) * SMP + col;
                    *(GAS f32x4*)(rowp) = acc[ai][0][m][0]; *(GAS f32x4*)(rowp + 4) = acc[ai][0][m][1]; }
        }
    }
};
struct SchedMerge : SchedBase {
    static constexpr bool PERM = true, GATHER = false;
    int npan; unsigned char* ws; const float* bgate;
    __device__ __forceinline__ bool next(int i, GU& u) const {
        const int njl = (NPAN_L * 4 - c + G - 1) / G;
        int j;
        if (i < 8 * njl) { pg8::tile_of((long)(i >> 3) * G + c, NPAN_L, 4, u.pm, u.pn); const int sub = i & 7; j = sub >> 1; u.kind = sub & 1; u.aux = j; }
        else { if (npan == NPAN_L) return false; const int qi = i - 8 * njl, qj = c + (qi >> 1) * G; if (qj >= 32) return false;
            u.pm = NPAN_L + (qj >> 4); u.pn = (qj >> 2) & 3; j = qj & 3; u.kind = qi & 1; u.aux = j + (u.kind ? 4 : 0); }
        unsigned ao, bo; unsigned la, lb; int nt;
        if (u.kind == 0) { ao = (unsigned)WS_H + (unsigned)u.pm * 256u * D * 2u; la = D * 2; bo = (unsigned)(WS_W + W_GATE) + ((unsigned)j * 1024u + u.pn * 256u) * D * 2u; lb = D * 2; nt = 16; }
        else { const bool isP = (j != 1); const int tc = (j == 0) ? TC_MLO : (j == 2 ? TC_GQQ : TC_GLR); const int kk = (j == 1 || j == 2) ? 512 : 256;
            ao = isP ? (unsigned)WS_P + ((unsigned)u.pm * 256u * NP + tc) * 2u : (unsigned)(WS_XM + XO_FT) + (unsigned)u.pm * 256u * 512u * 2u; la = isP ? NP * 2 : 1024;
            const unsigned wo = (unsigned)((j == 0) ? W_BML : (j == 1 ? W_BFT : (j == 2 ? W_BAT : W_BGL)));
            bo = (unsigned)WS_W + wo + (unsigned)u.pn * 256u * kk * 2u; lb = kk * 2; nt = kk / 64; }
        u.ao = ao; u.bo = bo; u.lda = la; u.ldb = lb; u.nt = nt;
        return true; }
    __device__ __forceinline__ unsigned char* wsbase() const { return ws; }
    __device__ __forceinline__ void epi(const f32x4 (&acc)[2][2][4][2], const GU& u, int wr, int wc, int fr, int fq) const {
        const int tid = threadIdx.x; v4u* sp_ = (v4u*)(ws + WS_XM + XO_GST) + (size_t)blockIdx.x * 8192 + tid;
        if (u.kind == 0) {
            const float* bp = bgate + u.aux * 1024 + u.pn * 256 + wc * 32 + 8 * fq;
#pragma unroll
            for (int ai = 0; ai < 2; ++ai)
#pragma unroll
                for (int m = 0; m < 4; ++m)
#pragma unroll
                    for (int bj = 0; bj < 2; ++bj) { const f32x4 v0 = acc[ai][bj][m][0] + *(const GAS f32x4*)(bp + bj * 128), v1 = acc[ai][bj][m][1] + *(const GAS f32x4*)(bp + bj * 128 + 4);
                        v4u w; w.x = pg8::cvt_pk_bf16(sigm(v0[0]), sigm(v0[1])); w.y = pg8::cvt_pk_bf16(sigm(v0[2]), sigm(v0[3])); w.z = pg8::cvt_pk_bf16(sigm(v1[0]), sigm(v1[1])); w.w = pg8::cvt_pk_bf16(sigm(v1[2]), sigm(v1[3]));
                        *(GAS v4u*)sp_ = w; sp_ += 512; asm volatile("" : "+v"(sp_) :: "memory"); }
        } else {
            bf16* rowp = (u.aux < 4 ? (bf16*)(ws + WS_XM + XO_MIX) + (size_t)(u.pm * 256) * D : (bf16*)(ws + WS_UQ) + ((size_t)(u.aux - 4) * 512 + (u.pm - NPAN_L) * 256) * D) + (size_t)(wr * 64 + fr) * D + u.pn * 256 + wc * 32 + 8 * fq;
            const bool accum = (u.aux > 0 && u.aux < 4);
            bf16* nxp = rowp; v4u g_n = *(const GAS v4u*)sp_; v4u p_n = (v4u){0u, 0u, 0u, 0u}; if (accum) p_n = *(const GAS v4u*)nxp;
#pragma unroll
            for (int e = 0; e < 16; ++e) { const int ai = e >> 3, m = (e >> 1) & 3, bj = e & 1;
                const v4u g = g_n, p = p_n; bf16* curp = nxp;
                if (e < 15) { sp_ += 512; asm volatile("" : "+v"(sp_)); nxp += (bj == 0) ? 128 : ((m == 3 ? 80 : 16) * D - 128); asm volatile("" : "+v"(nxp));
                    g_n = *(const GAS v4u*)sp_; if (accum) p_n = *(const GAS v4u*)nxp; }
                const f32x4 a0 = acc[ai][bj][m][0], a1 = acc[ai][bj][m][1];
                const float o0 = bflo(g.x) * a0[0] + bflo(p.x), o1 = bfhi(g.x) * a0[1] + bfhi(p.x), o2 = bflo(g.y) * a0[2] + bflo(p.y), o3 = bfhi(g.y) * a0[3] + bfhi(p.y);
                const float o4 = bflo(g.z) * a1[0] + bflo(p.z), o5 = bfhi(g.z) * a1[1] + bfhi(p.z), o6 = bflo(g.w) * a1[2] + bflo(p.w), o7 = bfhi(g.w) * a1[3] + bfhi(p.w);
                v4u w; w.x = pg8::cvt_pk_bf16(o0, o1); w.y = pg8::cvt_pk_bf16(o2, o3); w.z = pg8::cvt_pk_bf16(o4, o5); w.w = pg8::cvt_pk_bf16(o6, o7);
                *(GAS v4u*)curp = w; }
        }
    }
};
struct SchedOut : SchedBase {
    static constexpr bool PERM = false, GATHER = false;
    int npan, l; unsigned char* ws; const float* xlat; const float* xctx;
    __device__ __forceinline__ bool next(int i, GU& u) const {
        const int nul = (NPAN_L * 4 - c + G - 1) / G;
        if (i < nul) { pg8::tile_of((long)i * G + c, NPAN_L, 4, u.pm, u.pn); u.ao = (unsigned)(WS_XM + XO_MIX) + (unsigned)u.pm * 256u * D * 2u; }
        else { if (npan == NPAN_L) return false; const int q = c + (i - nul) * G; if (q >= 8) return false; u.pm = NPAN_L + (q >> 2); u.pn = q & 3; u.ao = (unsigned)WS_PA + (unsigned)q * 524288u; }
        u.lda = D * 2; u.bo = (unsigned)(WS_W + W_OUT) + (unsigned)u.pn * 256u * D * 2u; u.ldb = D * 2; u.nt = 16; return true; }
    __device__ __forceinline__ unsigned char* wsbase() const { return ws; }
    __device__ __forceinline__ void epi(const f32x4 (&acc)[2][2][4][2], const GU& u, int wr, int wc, int fr, int fq) const {
        const int r0 = u.pm * 256, col0 = u.pn * 256 + wc * 32 + 4 * fq, rl = wr * 64 + fr; const float* ada = (const float*)(ws + WS_ADA); float* XM = (float*)(ws + WS_P);
        const float* xs = r0 < RL ? xlat + (size_t)r0 * D : xctx + (size_t)(r0 - RL) * D; const float* gv = ada + ((size_t)(l * 3 + set_of_panel(u.pm)) * 6 + 2) * D + col0;
        f32x4 gg[2][2];
#pragma unroll
        for (int bj = 0; bj < 2; ++bj)
#pragma unroll
            for (int n = 0; n < 2; ++n) gg[bj][n] = *(const GAS f32x4*)(gv + bj * 128 + n * 16);
        const float* xp = xs + (size_t)rl * D + col0; float* op = XM + (size_t)(r0 + rl) * D + col0;
        f32x4 xq[4][4];
#pragma unroll
        for (int g = 0; g < 4; ++g) { xq[g][0] = *(const GAS f32x4*)(xp); xq[g][1] = *(const GAS f32x4*)(xp + 16); xq[g][2] = *(const GAS f32x4*)(xp + 128); xq[g][3] = *(const GAS f32x4*)(xp + 144);
            xp += (g == 3 ? 80 : 16) * D; asm volatile("" : "+v"(xp)); }
#pragma unroll
        for (int g = 0; g < 8; ++g) { const int ai = g >> 2, m = g & 3;
            const f32x4 x00 = xq[g & 3][0], x01 = xq[g & 3][1], x10 = xq[g & 3][2], x11 = xq[g & 3][3]; float* oc = op;
            if (g < 4) { xq[g & 3][0] = *(const GAS f32x4*)(xp); xq[g & 3][1] = *(const GAS f32x4*)(xp + 16); xq[g & 3][2] = *(const GAS f32x4*)(xp + 128); xq[g & 3][3] = *(const GAS f32x4*)(xp + 144);
                xp += 16 * D; asm volatile("" : "+v"(xp)); }
            if (g < 7) { op += (m == 3 ? 80 : 16) * D; asm volatile("" : "+v"(op)); }
            *(GAS f32x4*)(oc) = x00 * ALPHA + gg[0][0] * acc[ai][0][m][0]; *(GAS f32x4*)(oc + 16) = x01 * ALPHA + gg[0][1] * acc[ai][0][m][1];
            *(GAS f32x4*)(oc + 128) = x10 * ALPHA + gg[1][0] * acc[ai][1][m][0]; *(GAS f32x4*)(oc + 144) = x11 * ALPHA + gg[1][1] * acc[ai][1][m][1]; }
    }
};
__device__ __forceinline__ void swiglu_store(const f32x4 (&acc)[2][2][4][2], bf16* ACT, size_t pitch, int row0, int hid0, int wc, int fq) {
#pragma unroll
    for (int ai = 0; ai < 2; ++ai)
#pragma unroll
        for (int m = 0; m < 4; ++m) { bf16* rowp = ACT + (size_t)(row0 + ai * 128 + m * 16) * pitch + hid0 + wc * 16 + 4 * fq;
#pragma unroll
            for (int bj = 0; bj < 2; ++bj) { const f32x4 g = acc[ai][bj][m][0], uu = acc[ai][bj][m][1];
                v2u w; w.x = pg8::cvt_pk_bf16(g[0] * sigm(g[0]) * uu[0], g[1] * sigm(g[1]) * uu[1]); w.y = pg8::cvt_pk_bf16(g[2] * sigm(g[2]) * uu[2], g[3] * sigm(g[3]) * uu[3]);
                *(GAS v2u*)(rowp + bj * 64) = w; } }
}
struct SchedUp : SchedBase {
    static constexpr bool PERM = true, GATHER = false;
    unsigned char* ws;
    __device__ __forceinline__ bool next(int i, GU& u) const {
        if (!pg8::tile_of((long)i * G + c, NPAN, 22, u.pm, u.pn)) return false;
        u.ao = (unsigned)WS_H + (unsigned)u.pm * 256u * D * 2u; u.lda = D * 2; u.bo = (unsigned)(WS_W + W_FFD_GU) + (unsigned)u.pn * 256u * D * 2u; u.ldb = D * 2; u.nt = 16; return true; }
    __device__ __forceinline__ unsigned char* wsbase() const { return ws; }
    __device__ __forceinline__ void epi(const f32x4 (&acc)[2][2][4][2], const GU& u, int wr, int wc, int fr, int fq) const {
        swiglu_store(acc, (bf16*)(ws + WS_P), FFD, u.pm * 256 + wr * 64 + fr, u.pn * 128, wc, fq); }
};
struct SchedDown : SchedBase {
    static constexpr bool PERM = false, GATHER = false;
    int l; unsigned char* ws;
    __device__ __forceinline__ bool next(int i, GU& u) const {
        const int nul = (NPAN_L * 4 - c + G - 1) / G; u.aux = 0; u.nt = FFD / 64; unsigned ko = 0;
        if (i < nul) pg8::tile_of((long)i * G + c, NPAN_L, 4, u.pm, u.pn);
        else { const int q = c + (i - nul) * G; if (q >= 16) return false; u.pm = NPAN_L + (q >> 3); u.pn = (q >> 1) & 3; u.aux = 1 + (q & 1); u.nt = FFD / 128; ko = (unsigned)(q & 1) * (FFD / 128) * 128u; }
        u.ao = (unsigned)WS_P + (unsigned)u.pm * 256u * FFD * 2u + ko; u.lda = FFD * 2; u.bo = (unsigned)(WS_W + W_FFD_D) + (unsigned)u.pn * 256u * FFD * 2u + ko; u.ldb = FFD * 2; return true; }
    __device__ __forceinline__ unsigned char* wsbase() const { return ws; }
    __device__ __forceinline__ void epi(const f32x4 (&acc)[2][2][4][2], const GU& u, int wr, int wc, int fr, int fq) const {
        const int col0 = u.pn * 256 + wc * 32 + 4 * fq, row0 = u.pm * 256 + wr * 64 + fr; const float* ada = (const float*)(ws + WS_ADA); float* XM = (float*)(ws + WS_XM);
        if (u.aux) { float* dp = (float*)(ws + WS_DP) + ((size_t)(u.aux - 1) * 512 + (row0 - RL)) * D + col0;
#pragma unroll
            for (int ai = 0; ai < 2; ++ai)
#pragma unroll
                for (int m = 0; m < 4; ++m)
#pragma unroll
                    for (int bj = 0; bj < 2; ++bj)
#pragma unroll
                        for (int n = 0; n < 2; ++n) *(GAS f32x4*)(dp + (size_t)(ai * 128 + m * 16) * D + bj * 128 + n * 16) = acc[ai][bj][m][n];
            return; }
        const float* gv = ada + ((size_t)(l * 3 + set_of_panel(u.pm)) * 6 + 5) * D + col0;
        f32x4 gg[2][2];
#pragma unroll
        for (int bj = 0; bj < 2; ++bj)
#pragma unroll
            for (int n = 0; n < 2; ++n) gg[bj][n] = *(const GAS f32x4*)(gv + bj * 128 + n * 16);
        const float* xp = XM + (size_t)row0 * D + col0; float* op = XM + (size_t)row0 * D + col0;
        f32x4 xq[4][4];
#pragma unroll
        for (int g = 0; g < 4; ++g) { xq[g][0] = *(const GAS f32x4*)(xp); xq[g][1] = *(const GAS f32x4*)(xp + 16); xq[g][2] = *(const GAS f32x4*)(xp + 128); xq[g][3] = *(const GAS f32x4*)(xp + 144);
            xp += (g == 3 ? 80 : 16) * D; asm volatile("" : "+v"(xp)); }
#pragma unroll
        for (int g = 0; g < 8; ++g) { const int ai = g >> 2, m = g & 3;
            const f32x4 x00 = xq[g & 3][0], x01 = xq[g & 3][1], x10 = xq[g & 3][2], x11 = xq[g & 3][3]; float* oc = op;
            if (g < 4) { xq[g & 3][0] = *(const GAS f32x4*)(xp); xq[g & 3][1] = *(const GAS f32x4*)(xp + 16); xq[g & 3][2] = *(const GAS f32x4*)(xp + 128); xq[g & 3][3] = *(const GAS f32x4*)(xp + 144);
                xp += 16 * D; asm volatile("" : "+v"(xp)); }
            if (g < 7) { op += (m == 3 ? 80 : 16) * D; asm volatile("" : "+v"(op)); }
            *(GAS f32x4*)(oc) = x00 * ALPHA + gg[0][0] * acc[ai][0][m][0]; *(GAS f32x4*)(oc + 16) = x01 * ALPHA + gg[0][1] * acc[ai][0][m][1];
            *(GAS f32x4*)(oc + 128) = x10 * ALPHA + gg[1][0] * acc[ai][1][m][0]; *(GAS f32x4*)(oc + 144) = x11 * ALPHA + gg[1][1] * acc[ai][1][m][1]; }
    }
};
struct MoeTabs { unsigned char* ws; LAS unsigned char* lds;
    __device__ __forceinline__ int tile_e_lds(int t) const { return ((const LAS int*)(lds + TILE_E_OFF))[t]; }
    __device__ __forceinline__ const int* tok() const { return (const int*)(ws + WS_MOE + MO_TOK); }
    __device__ __forceinline__ const int* dst() const { return (const int*)(ws + WS_MOE + MO_DST); }
    __device__ __forceinline__ const int* tile_e() const { return (const int*)(ws + WS_MOE + MO_SEL + (size_t)RL * 16); }
    __device__ __forceinline__ const int* ntiles() const { return tile_e() + 512; } };
struct SchedMoeUp : SchedBase {
    static constexpr bool PERM = true, GATHER = true;
    MoeTabs mt; int nt_;
    __device__ __forceinline__ bool next(int i, GU& u) const {
        if (!pg8::tile_of((long)i * G + c, nt_, 11, u.pm, u.pn)) return false;
        const int e = mt.tile_e_lds(u.pm); u.aux = e;
        u.ao = (unsigned)WS_H; u.lda = D * 2; u.bo = (unsigned)(WS_W + W_MOE_GU) + ((unsigned)e * 2816u + u.pn * 256u) * D * 2u; u.ldb = D * 2; u.nt = 16; return true; }
    __device__ __forceinline__ unsigned char* wsbase() const { return mt.ws; }
    __device__ __forceinline__ unsigned arow(const GU& u, int r) const { return (unsigned)((const GAS int*)mt.tok())[u.pm * 256 + r] * (unsigned)(D * 2); }
    __device__ __forceinline__ void epi(const f32x4 (&acc)[2][2][4][2], const GU& u, int wr, int wc, int fr, int fq) const {
        swiglu_store(acc, (bf16*)(mt.ws + WS_P), FFE, u.pm * 256 + wr * 64 + fr, u.pn * 128, wc, fq); }
};
struct SchedMoeDown : SchedBase {
    static constexpr bool PERM = true, GATHER = false;
    MoeTabs mt; bf16* Dst; int nt_;
    __device__ __forceinline__ bool next(int i, GU& u) const {
        if (!pg8::tile_of((long)i * G + c, nt_, 4, u.pm, u.pn)) return false;
        const int e = mt.tile_e_lds(u.pm);
        u.ao = (unsigned)WS_P + (unsigned)u.pm * 256u * FFE * 2u; u.lda = FFE * 2; u.bo = (unsigned)(WS_W + W_MOE_D) + ((unsigned)e * 1024u + u.pn * 256u) * FFE * 2u; u.ldb = FFE * 2; u.nt = FFE / 64; return true; }
    __device__ __forceinline__ unsigned char* wsbase() const { return mt.ws; }
    __device__ __forceinline__ void epi(const f32x4 (&acc)[2][2][4][2], const GU& u, int wr, int wc, int fr, int fq) const {
        const int srow0 = u.pm * 256 + wr * 64 + fr;
#pragma unroll
        for (int ai = 0; ai < 2; ++ai)
#pragma unroll
            for (int m = 0; m < 4; ++m) { asm volatile("" ::: "memory"); const int d = ((const GAS int*)mt.dst())[srow0 + ai * 128 + m * 16];
                if (d >= 0) { bf16* rowp = Dst + (size_t)d * D + u.pn * 256 + wc * 32 + 8 * fq;
#pragma unroll
                    for (int bj = 0; bj < 2; ++bj) { const f32x4 v0 = acc[ai][bj][m][0], v1 = acc[ai][bj][m][1];
                        v4u w; w.x = pg8::cvt_pk_bf16(v0[0], v0[1]); w.y = pg8::cvt_pk_bf16(v0[2], v0[3]); w.z = pg8::cvt_pk_bf16(v1[0], v1[1]); w.w = pg8::cvt_pk_bf16(v1[2], v1[3]);
                        *(GAS v4u*)(rowp + bj * 128) = w; } } }
    }
};
struct CvSeg { int first, K, nblk, ldw, kind; unsigned dst; const float* a; const float* b; };
constexpr int CVSEG_OFF = 12288, CVTOT_OFF = CVSEG_OFF + 2040;
#define RFL(x) __builtin_amdgcn_readfirstlane(x)
__device__ __forceinline__ const float* rfl_ptr(const float* p) { const unsigned long long v = (unsigned long long)p; const unsigned lo = RFL((unsigned)v), hi = RFL((unsigned)(v >> 32)); return (const float*)(((unsigned long long)hi << 32) | lo); }
__device__ __forceinline__ const float* cv_src(int kind, const float* a, const float* b, int n) {
    if (kind == 0) return a + n;
    if (kind == 1) { int o;
        if (n < 1024) o = n; else if (n < 1280) o = 1040 + (n - 1024); else if (n < 1792) o = 1296 + (n - 1280); else if (n < 2048) o = 1808 + (n - 1792);
        else if (n < 3072) o = 2064 + (n - 2048); else { const int j = n - 3072; if (j < 16) o = 1024 + j; else if (j < 48) o = 3088 + (j - 16); else return nullptr; }
        return a + o; }
    const int hid = (n >> 8) * 128 + ((n & 255) >> 3) * 4 + (n & 3); const long dlt = (n & 4) ? (long)(b - a) : 0l; return a + dlt + hid; }

__device__ __forceinline__ void convert_layer_weights(const Frame& F, int l) {
    unsigned char* wb = F.ws + WS_W;
    LAS CvSeg* seg = (LAS CvSeg*)(F.lds + CVSEG_OFF);
    const float* wbr = F.in[I_WBR] + (size_t)l * 1280 * D;
    __syncthreads();
    if (F.tid == 0) { int ns = 0, tot = 0;
#define CV_ADD(K_, N_, LDW_, KIND_, DST_, A_, B_) do { LAS CvSeg* g_ = seg + ns; g_->first = tot; g_->K = (K_); g_->nblk = (N_) / 32; g_->ldw = (LDW_); g_->kind = (KIND_); g_->dst = (unsigned)(DST_); g_->a = (A_); g_->b = (B_); tot += ((K_) / 64) * ((N_) / 32); ++ns; } while (0)
        CV_ADD(D, 3328, NIN, 1, W_IN, F.in[I_WIN] + (size_t)l * D * NIN, (const float*)nullptr);
        CV_ADD(D, 4096, 4096, 0, W_GATE, F.in[I_WGATE] + (size_t)l * D * 4096, (const float*)nullptr);
        CV_ADD(D, D, D, 0, W_OUT, F.in[I_WOUT] + (size_t)l * D * D, (const float*)nullptr);
        CV_ADD(256, D, D, 0, W_BML, wbr, (const float*)nullptr);
        CV_ADD(512, D, D, 0, W_BAT, wbr + (size_t)512 * D, (const float*)nullptr);
        CV_ADD(256, D, D, 0, W_BGL, wbr + (size_t)1024 * D, (const float*)nullptr);
        if (l == 0) { CV_ADD(D, 2 * FFD, FFD, 2, W_FFD_GU, F.in[I_FFDWG], F.in[I_FFDWU]); CV_ADD(FFD, D, D, 0, W_FFD_D, F.in[I_FFDWD], (const float*)nullptr); }
        else { const float* wg = F.in[I_MOEWG]; const float* wu = F.in[I_MOEWU]; const float* wd = F.in[I_MOEWD];
            for (int e = 0; e < NEXP; ++e) { CV_ADD(D, 2 * FFE, FFE, 2, W_MOE_GU + (size_t)e * 2816 * D * 2, wg + (size_t)e * D * FFE, wu + (size_t)e * D * FFE);
                CV_ADD(FFE, D, D, 0, W_MOE_D + (size_t)e * 1024 * FFE * 2, wd + (size_t)e * FFE * D, (const float*)nullptr); } }
#undef CV_ADD
        seg[ns].first = tot; *(LAS int*)(F.lds + CVTOT_OFF) = tot; }
    __syncthreads();
    {   const int total = RFL(*(const LAS int*)(F.lds + CVTOT_OFF));
        LAS float* scr = (LAS float*)(F.lds + F.wave * 16384);
        const int gw = F.vcu * NWAVES + F.wave, NGW = F.G * NWAVES, lane = F.lane;
        int s = 0, nK = 0, nkb = 0, nnb = 0; unsigned ndst = 0u;
        float tn[32];
#define CV_FETCH(it_) do { while ((it_) >= RFL(seg[s + 1].first)) ++s; const int loc_ = (it_) - RFL(seg[s].first), nblk_ = RFL(seg[s].nblk); nkb = loc_ / nblk_; nnb = loc_ - nkb * nblk_; nK = RFL(seg[s].K); ndst = RFL(seg[s].dst); \
        const int ldw_ = RFL(seg[s].ldw), kind_ = RFL(seg[s].kind); const float* a_ = rfl_ptr(seg[s].a); const float* b_ = rfl_ptr(seg[s].b); \
        const float* src_ = cv_src(kind_, a_, b_, 32 * nnb + (lane & 31)); \
        _Pragma("unroll") for (int i = 0; i < 32; ++i) { const int kk = 2 * i + (lane >> 5); tn[i] = src_ ? ((const GAS float*)src_)[(size_t)(64 * nkb + kk) * ldw_] : 0.f; } } while (0)
        if (gw < total) CV_FETCH(gw);
        for (int it = gw; it < total; it += NGW) {
            const int K = nK, k0 = 64 * nkb, n0 = 32 * nnb; bf16* WT = (bf16*)(wb + ndst);
            float tv[32];
#pragma unroll
            for (int i = 0; i < 32; ++i) tv[i] = tn[i];
            if (it + NGW < total) CV_FETCH(it + NGW);
#pragma unroll
            for (int i = 0; i < 32; ++i) { const int kk = 2 * i + (lane >> 5); scr[kk * 33 + (lane & 31)] = tv[i]; }
            LDS_WAIT(); asm volatile("" ::: "memory");
            const int c = lane & 7;
#pragma unroll
            for (int j = 0; j < 4; ++j) { const int n = (lane >> 3) + 8 * j; const LAS float* sq = scr + (8 * c) * 33 + n;
                v4u o; o.x = pk2(sq[0 * 33], sq[1 * 33]); o.y = pk2(sq[2 * 33], sq[3 * 33]); o.z = pk2(sq[4 * 33], sq[5 * 33]); o.w = pk2(sq[6 * 33], sq[7 * 33]);
                *(GAS v4u*)(WT + (size_t)(n0 + n) * K + k0 + 8 * c) = o; }
            LDS_WAIT(); asm volatile("" ::: "memory");
        }
#undef CV_FETCH
    }
    { bf16* WT = (bf16*)(wb + W_BFT); const float* src = wbr + (size_t)256 * D;
      LAS f32x2* tcs = (LAS f32x2*)(F.lds + 131072 - 512);
      __syncthreads(); if (F.tid < 64) { const float ph = (float)F.tid * (1.f / 32.f); tcs[F.tid] = (f32x2){cospif(ph), sinpif(ph)}; } __syncthreads();
      if (F.tid < 256) for (int idx = F.vcu * 256 + F.tid; idx < 4 * 16 * 1024; idx += F.G * 256) { const int n = idx & 1023, c0 = ((idx >> 10) & 15) * 4, g = idx >> 14;
          float ac[4] = {0.f, 0.f, 0.f, 0.f}, as[4] = {0.f, 0.f, 0.f, 0.f};
#pragma unroll 1
          for (int q = 0; q < 4; ++q) { float v[16];
#pragma unroll
              for (int kk = 0; kk < 16; ++kk) v[kk] = ((const GAS float*)src)[(size_t)(64 * g + 16 * q + kk) * D + n];
#pragma unroll
              for (int kk = 0; kk < 16; ++kk) {
#pragma unroll
                  for (int j = 0; j < 4; ++j) { const f32x2 t = tcs[((16 * q + kk) * (c0 + j)) & 63]; ac[j] += t.x * v[kk]; as[j] += t.y * v[kk]; } } }
          bf16* o = WT + (size_t)n * 512 + g * 64 + c0;
          *(GAS v2u*)o = (v2u){pk2(ac[0] * 0.125f, ac[1] * 0.125f), pk2(ac[2] * 0.125f, ac[3] * 0.125f)};
          *(GAS v2u*)(o + 256) = (v2u){pk2(as[0] * 0.125f, as[1] * 0.125f), pk2(as[2] * 0.125f, as[3] * 0.125f)}; }
      __syncthreads(); }
}
__device__ __forceinline__ void build_tables(const Frame& F) {
    const int gt = F.vcu * 512 + F.tid, NT_ = F.G * 512;
    float* rc = (float*)(F.ws + WS_ROPE_C); float* rs = (float*)(F.ws + WS_ROPE_S);
    for (int i = gt; i < 256 * 16; i += NT_) { const int pos = i >> 4, p = i & 15;
        double inv = (p & 3) == 0 ? 1.0 : ((p & 3) == 1 ? 0.5623413251903491 : ((p & 3) == 2 ? 0.31622776601683794 : 0.17782794100389228));
        for (int q = 0; q < (p >> 2); ++q) inv *= 0.1;
        const float angf = (float)pos * (float)inv;
        double xr = (double)angf * 0.3183098861837907; xr -= 2.0 * rint(xr * 0.5);
        rc[i] = cospif((float)xr); rs[i] = sinpif((float)xr); }
    bf16* dc = (bf16*)(F.ws + WS_DFT_C); bf16* ds = (bf16*)(F.ws + WS_DFT_S);
    for (int i = gt; i < 128 * 128; i += NT_) { const int j = i >> 7, k = i & 127; const float ph = (float)((j * k) & 127) * (1.f / 64.f); dc[i] = (bf16)f2bf(cospif(ph)); ds[i] = (bf16)f2bf(sinpif(ph)); }
}
__device__ __forceinline__ void ada_phase(const Frame& F) {
    LAS float* sc = (LAS float*)(F.lds);
    LAS float* red = (LAS float*)(F.lds + 16384);
    for (int i = F.tid; i < 3 * D; i += 512) { const int s = i >> 10, k = i & 1023; const float v = s < 2 ? F.in[I_C][s * D + k] : F.in[I_CCTX][k]; sc[i] = v * sigm(v); }
    __syncthreads();
    for (int task = F.vcu; task < 2 * 96; task += F.G) { const int l = task / 96, cb = task % 96, col = cb * 64 + F.lane;
        const float* w = F.in[I_WADA] + (size_t)l * D * 6144 + col; float a0 = 0.f, a1 = 0.f, a2 = 0.f;
        const int kb = F.wave * 128;
#pragma unroll 32
        for (int k = 0; k < 128; ++k) { const float wv = ((const GAS float*)w)[(size_t)(kb + k) * 6144]; a0 += sc[kb + k] * wv; a1 += sc[D + kb + k] * wv; a2 += sc[2 * D + kb + k] * wv; }
        red[(F.wave * 3 + 0) * 64 + F.lane] = a0; red[(F.wave * 3 + 1) * 64 + F.lane] = a1; red[(F.wave * 3 + 2) * 64 + F.lane] = a2;
        __syncthreads();
        if (F.tid < 192) { const int s = F.tid >> 6, ln = F.tid & 63; float t = 0.f;
#pragma unroll
            for (int w8 = 0; w8 < 8; ++w8) t += red[(w8 * 3 + s) * 64 + ln];
            F.ADA()[(size_t)(l * 3 + s) * 6144 + cb * 64 + ln] = t + F.in[I_BADA][(size_t)l * 6144 + cb * 64 + ln]; }
        __syncthreads();
    }
}
struct Row16 { f32x4 v[4]; };
__device__ __forceinline__ Row16 ld_row(const float* p, int lane) { Row16 r; const GAS f32x4* q = (const GAS f32x4*)p + lane;
#pragma unroll
    for (int j = 0; j < 4; ++j) r.v[j] = q[64 * j];
    return r; }
__device__ __forceinline__ void st_row(float* p, int lane, const Row16& r) { GAS f32x4* q = (GAS f32x4*)p + lane;
#pragma unroll
    for (int j = 0; j < 4; ++j) q[64 * j] = r.v[j]; }
__device__ __forceinline__ void ln_norm(Row16& r) {
    float s = 0.f;
#pragma unroll
    for (int j = 0; j < 4; ++j) s += (r.v[j].x + r.v[j].y) + (r.v[j].z + r.v[j].w);
    const float mean = wave_sum(s) * (1.f / D); float s2 = 0.f;
#pragma unroll
    for (int j = 0; j < 4; ++j) { r.v[j] = r.v[j] - mean; s2 += (r.v[j].x * r.v[j].x + r.v[j].y * r.v[j].y) + (r.v[j].z * r.v[j].z + r.v[j].w * r.v[j].w); }
    const float rstd = 1.f / sqrtf(wave_sum(s2) * (1.f / D) + LN_EPS);
#pragma unroll
    for (int j = 0; j < 4; ++j) r.v[j] = r.v[j] * rstd;
}
__device__ __forceinline__ void affine(Row16& r, const float* g, const float* b, int lane, bool one_plus) {
    const Row16 gg = ld_row(g, lane), bb = ld_row(b, lane);
#pragma unroll
    for (int j = 0; j < 4; ++j) r.v[j] = r.v[j] * (one_plus ? gg.v[j] + 1.0f : gg.v[j]) + bb.v[j];
}
__device__ __forceinline__ void affine_r(Row16& r, const Row16& gg, const Row16& bb, bool one_plus) {
#pragma unroll
    for (int j = 0; j < 4; ++j) r.v[j] = r.v[j] * (one_plus ? gg.v[j] + 1.0f : gg.v[j]) + bb.v[j];
}
__device__ __forceinline__ void st_row_bf16(bf16* p, int lane, const Row16& r) { GAS v2u* q = (GAS v2u*)p + lane;
#pragma unroll
    for (int j = 0; j < 4; ++j) { v2u w; w.x = pk2(r.v[j].x, r.v[j].y); w.y = pk2(r.v[j].z, r.v[j].w); q[64 * j] = w; } }
__device__ __forceinline__ void phase_ln_mod(const Frame& F, int l) {
    const int gw = F.vcu * NWAVES + F.wave, NGW = F.G * NWAVES;
    Row16 nx; if (gw < R) nx = ld_row(xin_row(F, l, gw), F.lane);
    int cs = -1; Row16 asc, ash;
    for (int r = gw; r < R; r += NGW) { Row16 x = nx; if (r + NGW < R) nx = ld_row(xin_row(F, l, r + NGW), F.lane);
        ln_norm(x); const int s = set_of_row(r); if (s != cs) { cs = s; asc = ld_row(ada_vec(F, l, s, 1), F.lane); ash = ld_row(ada_vec(F, l, s, 0), F.lane); }
        affine_r(x, asc, ash, true); st_row_bf16(F.H() + (size_t)r * D, F.lane, x); }
}
__device__ __forceinline__ void phase_qk(const Frame& F, int l, bool dry = false) {
    const int gw = F.vcu * NWAVES + F.wave, NGW = F.G * NWAVES, lane = F.lane, hd = lane >> 2, qd = lane & 3;
    const float* rc = (const float*)(F.ws + WS_ROPE_C); const float* rs = (const float*)(F.ws + WS_ROPE_S);
    const float* gq = F.in[I_GQQG] + l * 64; const float* gk = F.in[I_GQKG] + l * 64;
    const int coff = (hd < 8 ? TC_GQQ + hd * 64 : TC_GQK + (hd - 8) * 64) + qd * 16;
    float gl_[16];
    { const float* g = (hd < 8 ? gq : gk) + qd * 16;
#pragma unroll
        for (int i = 0; i < 16; ++i) gl_[i] = ((const GAS float*)g)[i]; }
    v4u na = {0u, 0u, 0u, 0u}, nb = {0u, 0u, 0u, 0u};
    if (gw < R && hd < 10) { const bf16* p0 = F.P() + (size_t)gw * NP + coff; na = *(const GAS v4u*)p0; nb = *(const GAS v4u*)(p0 + 8); }
    for (int r = gw; r < R; r += NGW) {
        float x[16]; bf16* p = F.P() + (size_t)r * NP + coff;
        const v4u a = na, b = nb;
        if (r + NGW < R && hd < 10) { const bf16* p1 = F.P() + (size_t)(r + NGW) * NP + coff; na = *(const GAS v4u*)p1; nb = *(const GAS v4u*)(p1 + 8); }
        float ss = 0.f;
        if (hd < 10) {
            x[0] = bflo(a.x); x[1] = bfhi(a.x); x[2] = bflo(a.y); x[3] = bfhi(a.y); x[4] = bflo(a.z); x[5] = bfhi(a.z); x[6] = bflo(a.w); x[7] = bfhi(a.w);
            x[8] = bflo(b.x); x[9] = bfhi(b.x); x[10] = bflo(b.y); x[11] = bfhi(b.y); x[12] = bflo(b.z); x[13] = bfhi(b.z); x[14] = bflo(b.w); x[15] = bfhi(b.w);
#pragma unroll
            for (int i = 0; i < 16; ++i) ss += x[i] * x[i]; }
        else {
#pragma unroll
            for (int i = 0; i < 16; ++i) x[i] = 0.f; }
        ss += dpp_get<0xB1>(ss); ss += dpp_get<0x4E>(ss);
        const float rstd = __builtin_amdgcn_rsqf(ss * (1.f / 64.f) + LN_EPS);
#pragma unroll
        for (int i = 0; i < 16; ++i) x[i] = x[i] * rstd * gl_[i];
        float y[16];
#pragma unroll
        for (int i = 0; i < 16; ++i) y[i] = dpp_get<0xB1>(x[i]);
        if (r < RL) { const int t = r & (T - 1), pos = (qd >> 1) ? (t & 63) : (t >> 6); const GAS f32x4* c4 = (const GAS f32x4*)(rc + pos * 16); const GAS f32x4* s4 = (const GAS f32x4*)(rs + pos * 16);
            const f32x4 cv[4] = {c4[0], c4[1], c4[2], c4[3]}, sv[4] = {s4[0], s4[1], s4[2], s4[3]};
#pragma unroll
            for (int i = 0; i < 16; ++i) { const float c = cv[i >> 2][i & 3], s = sv[i >> 2][i & 3]; x[i] = (qd & 1) ? (y[i] * s + x[i] * c) : (x[i] * c - y[i] * s); } }
        if (hd < 8) {
#pragma unroll
            for (int i = 0; i < 16; ++i) x[i] *= C2Q; }
        if (hd < 10 && !dry) { v4u a, b; a.x = pk2(x[0], x[1]); a.y = pk2(x[2], x[3]); a.z = pk2(x[4], x[5]); a.w = pk2(x[6], x[7]); b.x = pk2(x[8], x[9]); b.y = pk2(x[10], x[11]); b.z = pk2(x[12], x[13]); b.w = pk2(x[14], x[15]);
            *(GAS v4u*)p = a; *(GAS v4u*)(p + 8) = b; }
    }
}
__device__ __forceinline__ void build_ctx_panels(const Frame& F) {
    const int q = (int)blockIdx.x; if (q >= 8) return;
    const bf16* uq = (const bf16*)(F.ws + WS_UQ) + (size_t)(q >> 2) * 256 * D; bf16* pa = (bf16*)(F.ws + WS_PA) + (size_t)q * 256 * D;
    for (int idx = F.tid; idx < 256 * D / 8; idx += 512) { float a[8], t[8]; unpack8(*(const v4u*)(uq + (size_t)idx * 8), a);
#pragma unroll
        for (int j = 1; j < 4; ++j) { unpack8(*(const v4u*)(uq + (size_t)j * 512 * D + (size_t)idx * 8), t);
#pragma unroll
            for (int e = 0; e < 8; ++e) a[e] += t[e]; }
        *(v4u*)(pa + (size_t)idx * 8) = pack8(a); }
    asm volatile("s_waitcnt vmcnt(0)" ::: "memory"); __syncthreads();
}
__device__ __forceinline__ void phase_post_mix(const Frame& F, int l, int nrows, const float* T1) {
    const int gw = F.vcu * NWAVES + F.wave, NGW = F.G * NWAVES, lane = F.lane;
    volatile LAS int* hist = (volatile LAS int*)(F.lds + 1024);
    float brv[8];
#pragma unroll
    for (int e = 0; e < 8; ++e) brv[e] = (l == 1) ? ((const GAS float*)F.in[I_MOEBR])[e] : 0.f;
    if (l == 1) { if (F.tid < 8) hist[F.tid] = 0; __syncthreads(); }
    const Row16 g1 = ld_row(F.in[I_LN1G] + l * D, lane), b1 = ld_row(F.in[I_LN1B] + l * D, lane);
    int cs = -1; Row16 asc, ash;
    LAS float* wrl = (LAS float*)(F.lds + 4096);
    if (l == 1) { for (int i = F.tid; i < D * 8 / 4; i += 512) *(LAS f32x4*)(wrl + i * 4) = *(const GAS f32x4*)(F.in[I_MOEWR] + i * 4); __syncthreads(); }
    Row16 nx; if (gw < nrows) nx = ld_row(T1 + (size_t)gw * D, lane);
    for (int r = gw; r < nrows; r += NGW) {
        Row16 x = nx; if (r + NGW < nrows) nx = ld_row(T1 + (size_t)(r + NGW) * D, lane);
        ln_norm(x); affine_r(x, g1, b1, false);
        st_row(F.XM() + (size_t)r * D, lane, x);
        ln_norm(x); const int s = set_of_row(r); if (s != cs) { cs = s; asc = ld_row(ada_vec(F, l, s, 4), lane); ash = ld_row(ada_vec(F, l, s, 3), lane); }
        affine_r(x, asc, ash, true);
        st_row_bf16(F.H() + (size_t)r * D, lane, x);
        if (l == 1) {
            float lg[8];
#pragma unroll
            for (int e = 0; e < 8; ++e) lg[e] = 0.f;
#pragma unroll
            for (int j = 0; j < 4; ++j)
#pragma unroll
                for (int q = 0; q < 4; ++q) { const float xv = x.v[j][q]; const LAS f32x4* wp = (const LAS f32x4*)(wrl + (256 * j + 4 * lane + q) * 8); const f32x4 w0 = wp[0], w1 = wp[1];
                    lg[0] += xv * w0.x; lg[1] += xv * w0.y; lg[2] += xv * w0.z; lg[3] += xv * w0.w; lg[4] += xv * w1.x; lg[5] += xv * w1.y; lg[6] += xv * w1.z; lg[7] += xv * w1.w; }
#pragma unroll
            for (int e = 0; e < 8; ++e) lg[e] = wave_sum(lg[e]);
            int i0 = 0; float b0 = lg[0] + brv[0];
#pragma unroll
            for (int e = 1; e < 8; ++e) { const float v = lg[e] + brv[e]; if (v > b0) { b0 = v; i0 = e; } }
            int i1 = (i0 == 0) ? 1 : 0; float b1 = (i0 == 0) ? lg[1] + brv[1] : lg[0] + brv[0];
#pragma unroll
            for (int e = 1; e < 8; ++e) { const float v = lg[e] + brv[e]; if (e != i0 && v > b1) { b1 = v; i1 = e; } }
            float l0 = 0.f, l1 = 0.f;
#pragma unroll
            for (int e = 0; e < 8; ++e) { l0 = (e == i0) ? lg[e] : l0; l1 = (e == i1) ? lg[e] : l1; }
            const float mx = fmaxf(l0, l1), e0 = __expf(l0 - mx), e1 = __expf(l1 - mx), inv = 1.f / (e0 + e1);
            if (lane == 0) { GAS v4u* sel = (GAS v4u*)(F.ws + WS_MOE + MO_SEL) + (size_t)r; *sel = (v4u){(unsigned)i0, (unsigned)i1, __float_as_uint(e0 * inv), __float_as_uint(e1 * inv)};
                __hip_atomic_fetch_add((LAS int*)&hist[i0], 1, __ATOMIC_RELAXED, __HIP_MEMORY_SCOPE_WORKGROUP); __hip_atomic_fetch_add((LAS int*)&hist[i1], 1, __ATOMIC_RELAXED, __HIP_MEMORY_SCOPE_WORKGROUP); }
        }
    }
    if (l == 1) { __syncthreads(); if (F.tid < 8) __hip_atomic_fetch_add((unsigned*)(F.ctl() + CW_MOECNT + 64 * F.tid), (unsigned)hist[F.tid], RLX_AGENT); }
}
__device__ __forceinline__ void phase_moe_assign(const Frame& F) {
    volatile LAS int* L = (volatile LAS int*)(F.lds + 1024);
    int* tok = (int*)(F.ws + WS_MOE + MO_TOK); int* dst = (int*)(F.ws + WS_MOE + MO_DST); int* tile_e = (int*)(F.ws + WS_MOE + MO_SEL + (size_t)RL * 16); int* ntl = tile_e + 512;
    if (F.tid < 8) L[F.tid] = 0;
    if (F.tid == 0) { int base = 0;
        for (int e = 0; e < 8; ++e) { const int c = (int)__hip_atomic_load((unsigned*)(F.ctl() + CW_MOECNT + 64 * e), RLX_AGENT); const int tl = (c + 255) >> 8; L[16 + e] = base * 256; L[24 + e] = c;
            if (blockIdx.x == 0) for (int q = 0; q < tl; ++q) tile_e[base + q] = e;
            base += tl; }
        if (blockIdx.x == 0) ntl[0] = base; }
    __syncthreads();
    const int wg = F.vcu; int e = 0, rank = 0, token = 0, k = 0; const bool act = F.tid < 256 && wg * 128 < RL;
    for (int w0 = wg; w0 * 128 < RL; w0 += F.G) {
        if (F.tid < 256) { token = w0 * 128 + (F.tid >> 1); k = F.tid & 1; e = ((const GAS int*)(F.ws + WS_MOE + MO_SEL))[(size_t)token * 4 + k]; rank = __hip_atomic_fetch_add((LAS int*)&L[e], 1, __ATOMIC_RELAXED, __HIP_MEMORY_SCOPE_WORKGROUP); }
        __syncthreads();
        if (F.tid < 8) { L[8 + F.tid] = (int)__hip_atomic_fetch_add((unsigned*)(F.ctl() + CW_MOECUR + 64 * F.tid), (unsigned)L[F.tid], RLX_AGENT); }
        __syncthreads();
        if (F.tid < 256) { const int slot = L[16 + e] + L[8 + e] + rank; tok[slot] = token; dst[slot] = token * 2 + k; }
        __syncthreads();
        if (F.tid < 8) L[F.tid] = 0;
        __syncthreads();
    }
    (void)act;
    if (wg < 8) { const int c = L[24 + wg], tl = (c + 255) >> 8, b = L[16 + wg]; for (int s = c + F.tid; s < tl * 256; s += 512) { tok[b + s] = 0; dst[b + s] = -1; } }
}
__device__ __forceinline__ void phase_final(const Frame& F, int l) {
    const int gw = F.vcu * NWAVES + F.wave, NGW = F.G * NWAVES, lane = F.lane;
    if (l == 0) {
        const Row16 g2 = ld_row(F.in[I_LN2G], lane), b2 = ld_row(F.in[I_LN2B], lane); int cs = -1; Row16 asc, ash;
        Row16 nx; if (gw < R) nx = ld_row(F.XM() + (size_t)gw * D, lane);
        for (int r = gw; r < R; r += NGW) {
            Row16 x = nx; if (r + NGW < R) nx = ld_row(F.XM() + (size_t)(r + NGW) * D, lane);
            if (r >= RL) { const float* dp = (const float*)(F.ws + WS_DP) + (size_t)(r - RL) * D; const Row16 p0 = ld_row(dp, lane), p1 = ld_row(dp + (size_t)512 * D, lane), g5 = ld_row(ada_vec(F, 0, 2, 5), lane);
#pragma unroll
                for (int j = 0; j < 4; ++j) x.v[j] = x.v[j] * ALPHA + g5.v[j] * (p0.v[j] + p1.v[j]); }
            ln_norm(x); affine_r(x, g2, b2, false);
            st_row(r < RL ? F.out + (size_t)r * D : F.XC() + (size_t)(r - RL) * D, lane, x);
            ln_norm(x); const int s = set_of_row(r); if (s != cs) { cs = s; asc = ld_row(ada_vec(F, 1, s, 1), lane); ash = ld_row(ada_vec(F, 1, s, 0), lane); }
            affine_r(x, asc, ash, true);
            st_row_bf16(F.H() + (size_t)r * D, lane, x); }
    } else {
        const Row16 g2 = ld_row(F.in[I_LN2G] + D, lane), b2 = ld_row(F.in[I_LN2B] + D, lane); int cs = -1; Row16 g5;
        Row16 nx; v2u na[4], nb[4]; float nw0 = 0.f, nw1 = 0.f;
#define FIN_LOAD(rr) do { const GAS float* sel_ = (const GAS float*)(F.ws + WS_MOE + MO_SEL) + (size_t)(rr) * 4; nw0 = sel_[2]; nw1 = sel_[3]; \
            const bf16* d0_ = (const bf16*)F.out + (size_t)(rr) * 2 * D; const GAS v2u* q0_ = (const GAS v2u*)d0_ + lane; const GAS v2u* q1_ = (const GAS v2u*)(d0_ + D) + lane; \
            nx = ld_row(F.XM() + (size_t)(rr) * D, lane); _Pragma("unroll") for (int j = 0; j < 4; ++j) { na[j] = q0_[64 * j]; nb[j] = q1_[64 * j]; } } while (0)
        if (gw < RL) FIN_LOAD(gw);
        for (int r = gw; r < RL; r += NGW) {
            Row16 x = nx; v2u a4[4], b4[4]; const float w0 = nw0, w1 = nw1;
#pragma unroll
            for (int j = 0; j < 4; ++j) { a4[j] = na[j]; b4[j] = nb[j]; }
            if (r + NGW < RL) FIN_LOAD(r + NGW);
            { const int s = set_of_row(r); if (s != cs) { cs = s; g5 = ld_row(ada_vec(F, 1, s, 5), lane); } }
#pragma unroll
            for (int j = 0; j < 4; ++j) { const v2u a = a4[j], b = b4[j];
                f32x4 f; f.x = w0 * bflo(a.x) + w1 * bflo(b.x); f.y = w0 * bfhi(a.x) + w1 * bfhi(b.x); f.z = w0 * bflo(a.y) + w1 * bflo(b.y); f.w = w0 * bfhi(a.y) + w1 * bfhi(b.y);
                x.v[j] = x.v[j] * ALPHA + g5.v[j] * f; }
            ln_norm(x); affine_r(x, g2, b2, false);
            st_row(F.out + (size_t)r * D, lane, x); }
#undef FIN_LOAD
    }
}
__device__ __forceinline__ void lds_barrier() { asm volatile("s_waitcnt lgkmcnt(0)\n\ts_barrier" ::: "memory"); }
constexpr int PT = 72;
typedef LAS bf16* ltile;
__device__ __forceinline__ bf16x8 ldfrag(const LAS bf16* t, int row, int k0, int pitch) { return *(const LAS bf16x8*)(t + row * pitch + k0); }
template <int KD, int PX, int PY>
__device__ __forceinline__ f32x4 mmt(f32x4 acc, const LAS bf16* X, int x0, const LAS bf16* Y, int y0, int fr, int fq) {
#pragma unroll
    for (int kk = 0; kk < KD; kk += 32) acc = __builtin_amdgcn_mfma_f32_16x16x32_bf16(ldfrag(X, x0 + fr, kk + 8 * fq, PX), ldfrag(Y, y0 + fr, kk + 8 * fq, PY), acc, 0, 0, 0);
    return acc;
}
typedef short s16x4_t __attribute__((ext_vector_type(4)));
__device__ __forceinline__ bf16x8 ldfrag_tr(const LAS bf16* X, int k0, int n0, int pitch, int lane) {
    const int fq = lane >> 4, q = (lane & 15) >> 2, p = lane & 3;
    const LAS bf16* a = X + (k0 + 8 * fq + q) * pitch + n0 + 4 * p;
    const s16x4_t lo = __builtin_bit_cast(s16x4_t, __builtin_amdgcn_ds_read_tr16_b64_v4i16((LAS s16x4_t*)a));
    const s16x4_t hi = __builtin_bit_cast(s16x4_t, __builtin_amdgcn_ds_read_tr16_b64_v4i16((LAS s16x4_t*)(a + 4 * pitch)));
    return (bf16x8){lo[0], lo[1], lo[2], lo[3], hi[0], hi[1], hi[2], hi[3]};
}
template <int KD, int PX, int PY>
__device__ __forceinline__ f32x4 mmt_tx(f32x4 acc, const LAS bf16* XR, int x0, const LAS bf16* Y, int y0, int fr, int fq, int lane) {
#pragma unroll
    for (int kk = 0; kk < KD; kk += 32) acc = __builtin_amdgcn_mfma_f32_16x16x32_bf16(ldfrag_tr(XR, kk, x0, PX, lane), ldfrag(Y, y0 + fr, kk + 8 * fq, PY), acc, 0, 0, 0);
    return acc;
}
template <int KD, int PX, int PY>
__device__ __forceinline__ f32x4 mmt_txy(f32x4 acc, const LAS bf16* XR, int x0, const LAS bf16* YR, int y0, int lane) {
#pragma unroll
    for (int kk = 0; kk < KD; kk += 32) acc = __builtin_amdgcn_mfma_f32_16x16x32_bf16(ldfrag_tr(XR, kk, x0, PX, lane), ldfrag_tr(YR, kk, y0, PY, lane), acc, 0, 0, 0);
    return acc;
}
template <int CTRL, int RMASK> __device__ __forceinline__ float dpp_or(float v, float ident) { return __builtin_bit_cast(float, __builtin_amdgcn_update_dpp(__builtin_bit_cast(int, ident), __builtin_bit_cast(int, v), CTRL, RMASK, 0xF, false)); }
__device__ __forceinline__ float wave_incl_scan_add(float v, int lane) {
    v += dpp_or<0x111, 0xF>(v, 0.f); v += dpp_or<0x112, 0xF>(v, 0.f); v += dpp_or<0x114, 0xF>(v, 0.f); v += dpp_or<0x118, 0xF>(v, 0.f);
    v += dpp_or<0x142, 0xA>(v, 0.f); v += dpp_or<0x143, 0xC>(v, 0.f);
    return v; }
__device__ __forceinline__ float wave_incl_scan_max(float v, int lane) {
    const float NI = -INFINITY;
    v = fmaxf(v, dpp_or<0x111, 0xF>(v, NI)); v = fmaxf(v, dpp_or<0x112, 0xF>(v, NI)); v = fmaxf(v, dpp_or<0x114, 0xF>(v, NI)); v = fmaxf(v, dpp_or<0x118, 0xF>(v, NI));
    v = fmaxf(v, dpp_or<0x142, 0xA>(v, NI)); v = fmaxf(v, dpp_or<0x143, 0xC>(v, NI));
    return v; }
__device__ __forceinline__ float wave_max(float v) {
    v = fmaxf(v, dpp_get<0xB1>(v)); v = fmaxf(v, dpp_get<0x4E>(v)); v = fmaxf(v, dpp_get<0x141>(v)); v = fmaxf(v, dpp_get<0x140>(v));
    { const auto rr = __builtin_amdgcn_permlane16_swap(__float_as_uint(v), __float_as_uint(v), false, false); v = fmaxf(__uint_as_float(rr[0]), __uint_as_float(rr[1])); }
    { const auto rr = __builtin_amdgcn_permlane32_swap(__float_as_uint(v), __float_as_uint(v), false, false); v = fmaxf(__uint_as_float(rr[0]), __uint_as_float(rr[1])); }
    return v; }

constexpr int DIRB = 65536;
constexpr int L_QS = 0, L_KS = 9216, L_VT = 18432, L_WS = 27648, L_CS = 36864, L_VEC = 48384, L_AF = 49408, L_PRE = 53504, L_G = 27648, L_HB = 0;
struct ScanPtrs { bf16* Cst; float* Nst; float* Amx; float* Bl; float* Mst; bf16* Gst; float* Gld; };
__device__ __forceinline__ int chunk_row0(int b, int tc) { return tc < 4 ? RL + b * CTX + tc * 64 : b * T + (tc - 4) * 64; }
__device__ __forceinline__ int chunk_pos(int tc, int d) { return d == 0 ? tc : (tc < 4 ? 3 - tc : 263 - tc); }

struct ScanRegs { v4u q0, q1, k0, k1, v0, v1, st0, st1; f32x4 nv0, nv1, af; v2u og0, og1, og2, og3; float gi, gf, mc; };
#define SR_SEL2(R, f, rep) ((rep) == 0 ? (R).f##0 : (R).f##1)
struct UnitId { int fam, b, head, tc; };
__device__ __forceinline__ bool unit_decode(int u, UnitId& id) { if (u >= 2 * 2080) return false; id.fam = ((u >> 8) + u) & 1;   const int rem = u >> 1; id.b = rem / 1040; id.head = (rem / 260) & 3; id.tc = rem % 260; return true; }
__device__ __forceinline__ bool unit_decode_q(int q, int l, bool out, UnitId& id) {
    if (out && l == 1) { if (q >= 2 * 2048) return false; id.fam = q & 1; const int rem = q >> 1; id.b = rem >> 10; id.head = (rem >> 8) & 3; id.tc = 4 + (rem & 255); return true; }
    if (q >= 2 * 2080) return false; id.fam = q & 1; const int rem = q >> 1; id.b = rem / 1040; id.head = (rem / 260) & 3; id.tc = rem % 260; return true; }
template <bool OUT>
__device__ __forceinline__ void scan_fetch(const Frame& F, int l, const UnitId& id, const ScanPtrs& sp, ScanRegs& R_) {
    const int tid = F.tid, d = tid >> 8, ht = tid & 255, lane = F.lane, hw = F.wave & 3;
    const int row0 = chunk_row0(id.b, id.tc), pos = chunk_pos(id.tc, d), chain = (id.b * 4 + id.head) * 2 + d; const size_t slot = (size_t)chain * NCH + pos;
    const bool ml = id.fam == 0;
#define SF_ONE(rep, QF, KF, VF, SF) { const int q = ht + 256 * rep, i = q >> 3, c8 = q & 7, tok = d ? 63 - i : i; \
        const bf16* rp = F.P() + (size_t)(row0 + tok) * NP + id.head * 64 + c8 * 8; \
        if (OUT) R_.QF = *(const GAS v4u*)(rp + (ml ? TC_MLQ : TC_GLQ)); \
        R_.KF = *(const GAS v4u*)(rp + (ml ? TC_MLK : TC_GLK)); R_.VF = *(const GAS v4u*)(rp + (ml ? TC_MLV : TC_GLV)); \
        if (OUT) { const bf16* Cg = (ml ? sp.Cst : sp.Gst) + slot * 4096; R_.SF = *(const GAS v4u*)(Cg + (q >> 3) * 64 + c8 * 8); } }
    SF_ONE(0, q0, k0, v0, st0) SF_ONE(1, q1, k1, v1, st1)
#undef SF_ONE
    { const int tok = d ? 63 - lane : lane; const float* sm = F.SM() + (size_t)(row0 + tok) * SMP + d * 8 + id.head; R_.gi = ((const GAS float*)sm)[0]; R_.gf = ((const GAS float*)sm)[4]; }
    R_.mc = 0.f; R_.nv0 = (f32x4){0.f, 0.f, 0.f, 0.f}; R_.nv1 = R_.nv0;
    if (OUT) { R_.mc = ((const GAS float*)sp.Mst)[slot]; const float* np_ = sp.Nst + slot * 64 + (ht & 7) * 8; R_.nv0 = *(const f32x4*)np_; R_.nv1 = *(const GAS f32x4*)(np_ + 4); }
    { const int i = ht >> 2, q4 = ht & 3, tok = d ? 63 - i : i; R_.af = *(const GAS f32x4*)(F.SM() + (size_t)(row0 + tok) * SMP + 16 + d * 16 + q4 * 4); }
    R_.og0 = (v2u){0u, 0u}; R_.og1 = R_.og0; R_.og2 = R_.og0; R_.og3 = R_.og0;
    if (!OUT) { R_.q0 = (v4u){0u, 0u, 0u, 0u}; R_.q1 = R_.q0; R_.st0 = R_.q0; R_.st1 = R_.q0; }
    if (OUT) { const int fr = lane & 15, fq = lane >> 4, t = 16 * hw + fr; const bf16* op = F.P() + (size_t)(row0 + t) * NP + (ml ? TC_MLO : TC_GLR) + id.head * 64;
        R_.og0 = *(const GAS v2u*)(op + 4 * fq); R_.og1 = *(const GAS v2u*)(op + 16 + 4 * fq); R_.og2 = *(const GAS v2u*)(op + 32 + 4 * fq); R_.og3 = *(const GAS v2u*)(op + 48 + 4 * fq); }
}
__device__ __forceinline__ void gla_build_g(const Frame& F, int l, int head, int d, const f32x4 af, LAS unsigned char* base, int ht) {
    LAS float* AF = (LAS float*)(base + L_AF); LAS float* G = (LAS float*)(base + L_G); LAS float* PRE = (LAS float*)(base + L_PRE);
    { const int i = ht >> 2, q4 = ht & 3; *(LAS f32x4*)(AF + i * 16 + q4 * 4) = af; }
    lds_barrier();
    const int k = ht & 63, tq = ht >> 6;
    const float* w2 = F.in[I_GLW2] + ((size_t)(l * 2 + d) * 16) * 256 + head * 64 + k; const float bb = ((const GAS float*)F.in[I_GLB2])[(size_t)(l * 2 + d) * 256 + head * 64 + k];
    float w[16];
#pragma unroll
    for (int r = 0; r < 16; ++r) w[r] = ((const GAS float*)w2)[(size_t)r * 256];
    float run = 0.f;
#pragma unroll 4
    for (int ii = 0; ii < 16; ++ii) { const int i = 16 * tq + ii; float a = bb;
        const f32x4 f0 = *(const LAS f32x4*)(AF + i * 16), f1 = *(const LAS f32x4*)(AF + i * 16 + 4), f2 = *(const LAS f32x4*)(AF + i * 16 + 8), f3 = *(const LAS f32x4*)(AF + i * 16 + 12);
        a += f0.x * w[0] + f0.y * w[1] + f0.z * w[2] + f0.w * w[3]; a += f1.x * w[4] + f1.y * w[5] + f1.z * w[6] + f1.w * w[7];
        a += f2.x * w[8] + f2.y * w[9] + f2.z * w[10] + f2.w * w[11]; a += f3.x * w[12] + f3.y * w[13] + f3.z * w[14] + f3.w * w[15];
        run += logsig(a) * (1.f / 16.f); G[i * 65 + k] = run; }
    PRE[tq * 64 + k] = run;
    lds_barrier();
    float off = 0.f;
#pragma unroll
    for (int q = 0; q < 3; ++q) off += (q < tq) ? PRE[q * 64 + k] : 0.f;
    if (tq > 0) { for (int ii = 0; ii < 16; ++ii) G[(16 * tq + ii) * 65 + k] += off; }
    lds_barrier();
}
__device__ __forceinline__ void ml_gates(const Frame& F, int l, int head, int d, float gi, float gf, int lane, float& a, float& bcum) {
    const float* gb = F.in[I_MLGB] + (size_t)l * 16 + d * 8 + head;
    const float li = gi + ((const GAS float*)gb)[0], lf = logsig(gf + ((const GAS float*)gb)[4]);
    bcum = wave_incl_scan_add(lf, lane); a = li - bcum;
}
template <bool IS_ML>
__device__ __forceinline__ void scan_local_unit(const Frame& F, int l, int b, int head, int tc, const ScanPtrs& sp, const ScanRegs& R_) {
    const int tid = F.tid, d = tid >> 8, ht = tid & 255, hw = F.wave & 3, lane = F.lane, fr = lane & 15, fq = lane >> 4;
    LAS unsigned char* base = F.lds + d * DIRB;
    LAS bf16* Kt = (LAS bf16*)(base + L_KS); LAS bf16* Vt = (LAS bf16*)(base + L_VT); LAS float* vec = (LAS float*)(base + L_VEC);
    const int pos = chunk_pos(tc, d), chain = (b * 4 + head) * 2 + d; const size_t slot = (size_t)chain * NCH + pos;
    if constexpr (IS_ML) {
        if (hw == 0) { float a, bc; ml_gates(F, l, head, d, R_.gi, R_.gf, lane, a, bc); const float amax = wave_max(a); vec[lane] = __expf(a - amax);
            if (lane == 63) { ((GAS float*)sp.Amx)[slot] = amax; ((GAS float*)sp.Bl)[slot] = bc; } }
        lds_barrier();
    } else { gla_build_g(F, l, head, d, R_.af, base, ht); }
    const LAS float* G = (const LAS float*)(base + L_G);
#pragma unroll
    for (int rep = 0; rep < 2; ++rep) { const int q = ht + 256 * rep, i = q >> 3, c8 = q & 7;
        float kx[8], vx[8]; unpack8(SR_SEL2(R_, k, rep), kx); unpack8(SR_SEL2(R_, v, rep), vx);
        const float wsi = IS_ML ? vec[i] : 1.f;
#pragma unroll
        for (int e = 0; e < 8; ++e) { kx[e] = IS_ML ? kx[e] * 0.125f : kx[e] * __expf(-G[i * 65 + c8 * 8 + e]); vx[e] *= wsi; }
        *(LAS v4u*)(Kt + i * PT + c8 * 8) = pack8(kx); *(LAS v4u*)(Vt + i * PT + c8 * 8) = pack8(vx); }
    if (!IS_ML && ht < 64) ((GAS float*)sp.Gld)[slot * 64 + ht] = __expf(G[63 * 65 + ht]);
    lds_barrier();
    bf16* Cg = (IS_ML ? sp.Cst : sp.Gst) + slot * 4096;
#pragma unroll
    for (int kt = 0; kt < 4; ++kt) { f32x4 acc = {0.f, 0.f, 0.f, 0.f}; acc = mmt_txy<64, PT, PT>(acc, Kt, 16 * kt, Vt, 16 * hw, lane);
        v2u w; w.x = pk2(acc[0], acc[1]); w.y = pk2(acc[2], acc[3]); *(GAS v2u*)(Cg + (size_t)(16 * hw + fr) * 64 + 16 * kt + 4 * fq) = w; }
    if (IS_ML && ht < 64) { float s_ = 0.f; for (int i = 0; i < 64; ++i) s_ += bf2f(Kt[i * PT + ht]) * vec[i]; ((GAS float*)sp.Nst)[slot * 64 + ht] = s_; }
    lds_barrier();
}
template <bool IS_ML>
__device__ __forceinline__ void scan_chain(const Frame& F, int chain, int quarter, const ScanPtrs& sp, bool dry = false) {
    const int tid = F.tid, k0 = (tid & 7) * 8;
    LAS float* LA = (LAS float*)(F.lds);
    if constexpr (IS_ML) { for (int p = tid; p < NCH; p += 512) { LA[p] = ((const GAS float*)sp.Amx)[(size_t)chain * NCH + p]; LA[512 + p] = ((const GAS float*)sp.Bl)[(size_t)chain * NCH + p]; } }
    else { for (int q = tid; q < NCH * 16; q += 512) *(LAS f32x4*)(LA + q * 4) = *(const GAS f32x4*)(sp.Gld + (size_t)chain * NCH * 64 + q * 4); }
    __syncthreads();
    if (tid < 128) {
    float S[8]; float nst = 0.f, m = 0.f;
#pragma unroll
    for (int e = 0; e < 8; ++e) S[e] = 0.f;
    bf16* Cb = (IS_ML ? sp.Cst : sp.Gst) + (size_t)chain * NCH * 4096 + (size_t)quarter * 1024 + (size_t)tid * 8;
    const bool own_n = IS_ML && quarter == 0 && tid < 64;
    constexpr int GS = 20;
    v4u cn[GS]; float nn[GS];
#pragma unroll
    for (int j = 0; j < GS; ++j) nn[j] = 0.f;
#define SC_LOAD(g) do { _Pragma("unroll") for (int j = 0; j < GS; ++j) { cn[j] = *(const GAS v4u*)(Cb + (size_t)((g) * GS + j) * 4096); \
        if (own_n) nn[j] = ((const GAS float*)sp.Nst)[((size_t)chain * NCH + (g) * GS + j) * 64 + tid]; } } while (0)
    SC_LOAD(0);
    for (int g = 0; g < NCH / GS; ++g) {
        v4u cc[GS]; float nc[GS];
#pragma unroll
        for (int j = 0; j < GS; ++j) { cc[j] = cn[j]; nc[j] = nn[j]; }
        if (g + 1 < NCH / GS) SC_LOAD(g + 1);
#pragma unroll
        for (int j = 0; j < GS; ++j) { const int pp = g * GS + j; const size_t p = (size_t)chain * NCH + pp;
            if (!dry) *(GAS v4u*)(Cb + (size_t)pp * 4096) = pack8(S);
            float x[8]; unpack8(cc[j], x);
            if constexpr (IS_ML) {
                if (own_n && !dry) ((GAS float*)sp.Nst)[p * 64 + tid] = nst;
                if (quarter == 0 && tid == 0 && !dry) ((GAS float*)sp.Mst)[p] = m;
                const float am = LA[pp], bl = LA[512 + pp];
                const float mx = fmaxf(m, am), fa = __expf(m - mx), fb = __expf(am - mx);
#pragma unroll
                for (int e = 0; e < 8; ++e) S[e] = fa * S[e] + fb * x[e];
                nst = fa * nst + fb * nc[j]; m = bl + mx;
            } else {
                const f32x4 e0 = *(const LAS f32x4*)(LA + pp * 64 + k0), e1 = *(const LAS f32x4*)(LA + pp * 64 + k0 + 4);
                const float dd[8] = {e0.x, e0.y, e0.z, e0.w, e1.x, e1.y, e1.z, e1.w};
#pragma unroll
                for (int e = 0; e < 8; ++e) S[e] = dd[e] * (S[e] + x[e]);
            }
        }
    }
#undef SC_LOAD
    if (dry && S[0] == 1.2345e-33f) sp.Mst[0] = nst + m;
    }
    __syncthreads();
}
template <bool IS_ML>
__device__ __forceinline__ void scan_out_unit(const Frame& F, int l, int b, int head, int tc, const ScanPtrs& sp, const ScanRegs& R_, bool dry = false) {
    const int tid = F.tid, d = tid >> 8, ht = tid & 255, hw = F.wave & 3, lane = F.lane, fr = lane & 15, fq = lane >> 4;
    LAS unsigned char* base = F.lds + d * DIRB;
    LAS bf16* Qs = (LAS bf16*)(base + L_QS); LAS bf16* Ks = (LAS bf16*)(base + L_KS); LAS bf16* Vt = (LAS bf16*)(base + L_VT); LAS bf16* Ws = (LAS bf16*)(base + L_WS); LAS bf16* Cs = (LAS bf16*)(base + L_CS);
    LAS float* vec = (LAS float*)(base + L_VEC);
    const int row0 = chunk_row0(b, tc), pos = chunk_pos(tc, d), chain = (b * 4 + head) * 2 + d; const size_t slot = (size_t)chain * NCH + pos;
    float m_c = 0.f;
    if constexpr (IS_ML) {
        m_c = R_.mc;
        if (hw == 0) { float a, bc; ml_gates(F, l, head, d, R_.gi, R_.gf, lane, a, bc); const float cm = wave_incl_scan_max(a, lane); vec[lane] = a; vec[64 + lane] = fmaxf(m_c, cm); vec[128 + lane] = bc; }
    } else { gla_build_g(F, l, head, d, R_.af, base, ht); }
    const LAS float* G = (const LAS float*)(base + L_G);
#pragma unroll
    for (int rep = 0; rep < 2; ++rep) { const int q = ht + 256 * rep, i = q >> 3, c8 = q & 7;
        float qx[8], kx[8], vx[8]; unpack8(SR_SEL2(R_, q, rep), qx); unpack8(SR_SEL2(R_, k, rep), kx); unpack8(SR_SEL2(R_, v, rep), vx);
#pragma unroll
        for (int e = 0; e < 8; ++e) {
            if constexpr (IS_ML) { kx[e] *= 0.125f; } else { const float g = G[i * 65 + c8 * 8 + e]; qx[e] *= 0.125f * __expf(g); kx[e] *= __expf(-g); }
        }
        *(LAS v4u*)(Qs + i * PT + c8 * 8) = pack8(qx); *(LAS v4u*)(Ks + i * PT + c8 * 8) = pack8(kx); *(LAS v4u*)(Vt + i * PT + c8 * 8) = pack8(vx); }
    if constexpr (!IS_ML) lds_barrier();
    {
#pragma unroll
        for (int rep = 0; rep < 2; ++rep) { const int q = ht + 256 * rep, v = q >> 3, c8 = q & 7; *(LAS v4u*)(Cs + v * PT + c8 * 8) = SR_SEL2(R_, st, rep); }
        if constexpr (IS_ML) { if (ht < 128) { const int rr = 64 + (ht >> 3), c8 = ht & 7; const bool isn = (rr == 64);
            const float x[8] = {isn ? R_.nv0.x : 0.f, isn ? R_.nv0.y : 0.f, isn ? R_.nv0.z : 0.f, isn ? R_.nv0.w : 0.f, isn ? R_.nv1.x : 0.f, isn ? R_.nv1.y : 0.f, isn ? R_.nv1.z : 0.f, isn ? R_.nv1.w : 0.f};
            *(LAS v4u*)(Cs + rr * PT + c8 * 8) = pack8(x); } }
    }
    lds_barrier();
    const int t = 16 * hw + fr; float rs = 0.f;
    const float Mt = IS_ML ? vec[64 + t] : 0.f;
#pragma unroll
    for (int st = 0; st < 4; ++st) {
        v2u w; w.x = 0u; w.y = 0u;
        if (st <= hw) { f32x4 acc = {0.f, 0.f, 0.f, 0.f}; acc = mmt<64, PT, PT>(acc, Ks, 16 * st, Qs, 16 * hw, fr, fq);
            float o[4];
#pragma unroll
            for (int r = 0; r < 4; ++r) { const int s = 16 * st + 4 * fq + r; float wg = (s <= t) ? 1.f : 0.f; if constexpr (IS_ML) wg = (s <= t) ? __expf(vec[s] - Mt) : 0.f; o[r] = wg * acc[r]; rs += o[r]; }
            w.x = pk2(o[0], o[1]); w.y = pk2(o[2], o[3]); }
        *(LAS v2u*)(Ws + t * PT + 16 * st + 4 * fq) = w; }
    rs = xor16_32_sum(rs);
    float h[4][4]; float wi = 1.f, dn = 1.f;
    if constexpr (IS_ML) { f32x4 an = {0.f, 0.f, 0.f, 0.f}; an = mmt<64, PT, PT>(an, Cs, 64, Qs, 16 * hw, fr, fq); const float nq = xor16_32_sum(an[0]);
        wi = __expf(m_c - Mt); const float den = rs + wi * nq; dn = 1.f / fmaxf(fabsf(den), __expf(-(vec[128 + t] + Mt))); }
#pragma unroll
    for (int vt = 0; vt < 4; ++vt) { f32x4 ai = {0.f, 0.f, 0.f, 0.f}, ac = {0.f, 0.f, 0.f, 0.f};
        ai = mmt_tx<64, PT, PT>(ai, Vt, 16 * vt, Ws, 16 * hw, fr, fq, lane); ac = mmt<64, PT, PT>(ac, Cs, 16 * vt, Qs, 16 * hw, fr, fq);
#pragma unroll
        for (int r = 0; r < 4; ++r) h[vt][r] = (ai[r] + wi * ac[r]) * dn; }
    lds_barrier();
    LAS float* HB = (LAS float*)(F.lds + DIRB + L_HB);
    if (d == 1) {
#pragma unroll
        for (int vt = 0; vt < 4; ++vt)
#pragma unroll
            for (int r = 0; r < 4; ++r) HB[(63 - t) * 65 + 16 * vt + 4 * fq + r] = h[vt][r]; }
    lds_barrier();
    if (d == 0) {
        float s1 = 0.f;
#pragma unroll
        for (int vt = 0; vt < 4; ++vt)
#pragma unroll
            for (int r = 0; r < 4; ++r) { h[vt][r] += HB[t * 65 + 16 * vt + 4 * fq + r]; s1 += IS_ML ? h[vt][r] : h[vt][r] * h[vt][r]; }
        s1 = xor16_32_sum(s1);
        float mean = 0.f, rstd;
        if constexpr (IS_ML) { mean = s1 * (1.f / 64.f); float s2 = 0.f;
#pragma unroll
            for (int vt = 0; vt < 4; ++vt)
#pragma unroll
                for (int r = 0; r < 4; ++r) { const float dd = h[vt][r] - mean; s2 += dd * dd; }
            s2 = xor16_32_sum(s2); rstd = 1.f / sqrtf(s2 * (1.f / 64.f) + LN_EPS);
        } else rstd = 1.f / sqrtf(s1 * (1.f / 64.f) + LN_EPS);
        const float* ng = F.in[IS_ML ? I_MLNG : I_GLNG] + (size_t)l * 256 + head * 64;
        bf16* op = F.P() + (size_t)(row0 + t) * NP + (IS_ML ? TC_MLO : TC_GLR) + head * 64;
#pragma unroll
        for (int vt = 0; vt < 4; ++vt) { const int c = 16 * vt + 4 * fq; const v2u gp = (vt == 0) ? R_.og0 : (vt == 1 ? R_.og1 : (vt == 2 ? R_.og2 : R_.og3)); const f32x4 gn = *(const GAS f32x4*)(ng + c);
            const float gt[4] = {bflo(gp.x), bfhi(gp.x), bflo(gp.y), bfhi(gp.y)}; float y[4];
#pragma unroll
            for (int r = 0; r < 4; ++r) { const float gate = IS_ML ? sigm(gt[r]) : gt[r] * sigm(gt[r]); y[r] = (h[vt][r] - mean) * rstd * gn[r] * gate; }
            v2u w; w.x = pk2(y[0], y[1]); w.y = pk2(y[2], y[3]); if (!dry) *(GAS v2u*)(op + c) = w; }
    }
    lds_barrier();
}
constexpr int DP = 136;
constexpr int LF_C = 0, LF_S = 34816, LF_XR = 69632, LF_XI = 69632 + 18432;
__device__ __forceinline__ void dft_load_mats(const Frame& F) {
    LAS bf16* CM = (LAS bf16*)(F.lds + LF_C); LAS bf16* SMt = (LAS bf16*)(F.lds + LF_S);
    const bf16* gc = (const bf16*)(F.ws + WS_DFT_C); const bf16* gs = (const bf16*)(F.ws + WS_DFT_S);
    for (int q = F.tid; q < 128 * 16; q += 512) { const int j = q >> 4, c8 = q & 15; *(LAS v4u*)(CM + j * DP + c8 * 8) = *(const GAS v4u*)(gc + j * 128 + c8 * 8); *(LAS v4u*)(SMt + j * DP + c8 * 8) = *(const GAS v4u*)(gs + j * 128 + c8 * 8); }
    __syncthreads();
}
template <int STEP>
__device__ __forceinline__ void dft_unit(const Frame& F, int b, int idx, int slab, bf16* IM1, bf16* FT, bool dry = false) {
    LAS bf16* CM = (LAS bf16*)(F.lds + LF_C); LAS bf16* SMt = (LAS bf16*)(F.lds + LF_S); LAS bf16* XR = (LAS bf16*)(F.lds + LF_XR); LAS bf16* XI = (LAS bf16*)(F.lds + LF_XI);
    const int tid = F.tid, lane = F.lane, fr = lane & 15, fq = lane >> 4, w = F.wave;
#pragma unroll
    for (int rep = 0; rep < 2; ++rep) { const int q = tid + 512 * rep, i = q >> 3, c8 = q & 7;
        const int row = (STEP == 1) ? b * T + 128 * i + idx : b * T + 128 * idx + i;
        *(LAS v4u*)(XR + i * PT + c8 * 8) = *(const GAS v4u*)(F.P() + (size_t)row * NP + TC_FT + slab * 64 + c8 * 8);
        if (STEP == 2) *(LAS v4u*)(XI + i * PT + c8 * 8) = *(const GAS v4u*)(IM1 + (size_t)row * 256 + slab * 64 + c8 * 8); }
    lds_barrier();
    const int j = 16 * w + fr;
#pragma unroll
    for (int ct = 0; ct < 4; ++ct) {
        f32x4 dr = {0.f, 0.f, 0.f, 0.f}, p1 = {0.f, 0.f, 0.f, 0.f}, p2 = {0.f, 0.f, 0.f, 0.f};
        dr = mmt_tx<128, PT, DP>(dr, XR, 16 * ct, CM, 16 * w, fr, fq, lane); p2 = mmt_tx<128, PT, DP>(p2, XR, 16 * ct, SMt, 16 * w, fr, fq, lane);
        if (STEP == 2) { dr = mmt_tx<128, PT, DP>(dr, XI, 16 * ct, SMt, 16 * w, fr, fq, lane); p1 = mmt_tx<128, PT, DP>(p1, XI, 16 * ct, CM, 16 * w, fr, fq, lane); }
        float orr[4], oi[4];
        if (STEP == 1) { const float ph = (float)((j * idx) & 16383) * (1.f / 8192.f); const float cs = cospif(ph), sn = sinpif(ph);
#pragma unroll
            for (int r = 0; r < 4; ++r) { const float di = -p2[r]; orr[r] = dr[r] * cs + di * sn; oi[r] = di * cs - dr[r] * sn; }
            const int orow = b * T + 128 * j + idx;
            v2u wr_, wi_; wr_.x = pk2(orr[0], orr[1]); wr_.y = pk2(orr[2], orr[3]); wi_.x = pk2(oi[0], oi[1]); wi_.y = pk2(oi[2], oi[3]);
            if (!dry) { *(GAS v2u*)(F.P() + (size_t)orow * NP + TC_FT + slab * 64 + 16 * ct + 4 * fq) = wr_; *(GAS v2u*)(IM1 + (size_t)orow * 256 + slab * 64 + 16 * ct + 4 * fq) = wi_; }
        } else {
#pragma unroll
            for (int r = 0; r < 4; ++r) { orr[r] = dr[r] * (1.f / 128.f); oi[r] = (p1[r] - p2[r]) * (1.f / 128.f); }
            const int orow = b * T + idx + 128 * j;
            v2u wr_, wi_; wr_.x = pk2(orr[0], orr[1]); wr_.y = pk2(orr[2], orr[3]); wi_.x = pk2(oi[0], oi[1]); wi_.y = pk2(oi[2], oi[3]);
            if (!dry) { *(GAS v2u*)(FT + (size_t)orow * 512 + slab * 64 + 16 * ct + 4 * fq) = wr_; *(GAS v2u*)(FT + (size_t)orow * 512 + 256 + slab * 64 + 16 * ct + 4 * fq) = wi_; }
        } }
    lds_barrier();
}
__device__ __forceinline__ void ctx_dft(const Frame& F, bf16* FT, int widx, int nw) {
    LAS float* ct = (LAS float*)(F.lds + LF_XR); LAS float* st = ct + 256;
    if (F.tid < 256) { const float ph = (float)F.tid * (1.f / 128.f); ct[F.tid] = cospif(ph); st[F.tid] = sinpif(ph); }
    __syncthreads();
    for (int o = widx * 512 + F.tid; o < NB * 256 * 256; o += nw * 512) { const int col = o & 255, k = (o >> 8) & 255, b = o >> 16;
        const bf16* up = F.P() + (size_t)(RL + b * CTX) * NP + TC_FT + col; float re = 0.f, im = 0.f;
        for (int t = 0; t < 256; ++t) { const float u = bf2f(((const GAS bf16*)up)[(size_t)t * NP]); const int a = (k * t) & 255; re += u * ct[a]; im -= u * st[a]; }
        bf16* op = FT + (size_t)(RL + b * CTX + k) * 512 + col; op[0] = (bf16)f2bf(re * 0.0625f); op[256] = (bf16)f2bf(im * 0.0625f); }
    __syncthreads();
}
namespace attn_body {
using bf16=__hip_bfloat16;
using bf16x8=__attribute__((ext_vector_type(8)))short;
using s16x4=__attribute__((ext_vector_type(4)))short;
using f32x16=__attribute__((ext_vector_type(16)))float;
using u32x4=__attribute__((ext_vector_type(4)))unsigned;
using f32x4a=__attribute__((ext_vector_type(4)))float;
constexpr int D=64,DM=3072;
constexpr int NW=8,QBLK=32,QB=QBLK*NW,KVBLK=64;
constexpr int ATTN_PITCH=DM, ATTN_UNIT_ROWS=QB;
__device__ __forceinline__ int crow(int r,int hi){return (r&3)+8*(r>>2)+4*hi;}
#define SBAR() __builtin_amdgcn_sched_barrier(0)
__device__ __forceinline__ void cmask(f32x16&p0,f32x16&p1,int jb,int qrel,int hi){
  const float NEG=-INFINITY; int kb=64*jb+4*hi;
  #pragma unroll
  for(int r=0;r<16;++r){int kv=kb+(r&3)+8*(r>>2); if(kv>qrel)p0[r]=NEG; if(kv+32>qrel)p1[r]=NEG;}
}

constexpr int NSLOT=3, SLOTB=8192;
constexpr int LDS_K=0, LDS_V=NSLOT*SLOTB, LDS_WS=2*NSLOT*SLOTB, LDS_OST=LDS_WS+NW*64*4, LDS_BYTES=LDS_OST+NW*4096;
constexpr float C2=0.125f*1.4426950408889634f;
__device__ __forceinline__ void glds16(const void*gsrc,unsigned lds_dst){unsigned keep;
  asm volatile("s_mov_b32 %0, m0\n\ts_mov_b32 m0, %2\n\ts_nop 0\n\tglobal_load_lds_dwordx4 %1, off\n\ts_mov_b32 m0, %0":"=&s"(keep):"v"(gsrc),"s"(lds_dst):"memory");}
__device__ __forceinline__ float max3f(float a,float b,float c){float r;asm("v_max3_f32 %0, %1, %2, %3":"=v"(r):"v"(a),"v"(b),"v"(c));return r;}
__device__ __forceinline__ float max2f(float a,float b){float r;asm("v_max_f32_e32 %0, %1, %2":"=v"(r):"v"(a),"v"(b));return r;}
__device__ __forceinline__ float fadd_s(float a,float b){float r;asm("v_add_f32_e32 %0, %1, %2":"=v"(r):"v"(a),"v"(b));return r;}
__device__ __forceinline__ float fsub_s(float a,float b){float r;asm("v_sub_f32_e32 %0, %1, %2":"=v"(r):"v"(a),"v"(b));return r;}
typedef float f32x2_t __attribute__((ext_vector_type(2))); typedef __bf16 bf16x2_t __attribute__((ext_vector_type(2)));
__device__ __forceinline__ unsigned cvtpk_s(float lo,float hi){f32x2_t v={lo,hi};bf16x2_t b=__builtin_convertvector(v,bf16x2_t);return __builtin_bit_cast(unsigned,b);}
#define WAIT_BAR(N) asm volatile("s_waitcnt vmcnt(" #N ") lgkmcnt(0)\n\ts_barrier":::"memory")

__device__ __forceinline__ void qkt(f32x16&p0,f32x16&p1,const char*Kslot,const bf16x8*qr,const f32x16&negm,int r32,int hi){
  const char*kb=Kslot+hi*1024+r32*16;
  #pragma unroll
  for(int d0=0;d0<4;++d0){
    const bf16x8 b0=*reinterpret_cast<const bf16x8*>(kb+d0*2048);
    const bf16x8 b1=*reinterpret_cast<const bf16x8*>(kb+d0*2048+512);
    if(d0==0){p0=__builtin_amdgcn_mfma_f32_32x32x16_bf16(b0,qr[0],negm,0,0,0);p1=__builtin_amdgcn_mfma_f32_32x32x16_bf16(b1,qr[0],negm,0,0,0);}
    else{p0=__builtin_amdgcn_mfma_f32_32x32x16_bf16(b0,qr[d0],p0,0,0,0);p1=__builtin_amdgcn_mfma_f32_32x32x16_bf16(b1,qr[d0],p1,0,0,0);}}
}
typedef __attribute__((address_space(3))) const char* lds_cptr;
typedef short v4i16_t __attribute__((ext_vector_type(4)));
__device__ __forceinline__ void kload8(bf16x8*kf,lds_cptr kp){
  kf[0]=*(const __attribute__((address_space(3))) bf16x8*)(kp);      kf[1]=*(const __attribute__((address_space(3))) bf16x8*)(kp+512);
  kf[2]=*(const __attribute__((address_space(3))) bf16x8*)(kp+2048); kf[3]=*(const __attribute__((address_space(3))) bf16x8*)(kp+2560);
  kf[4]=*(const __attribute__((address_space(3))) bf16x8*)(kp+4096); kf[5]=*(const __attribute__((address_space(3))) bf16x8*)(kp+4608);
  kf[6]=*(const __attribute__((address_space(3))) bf16x8*)(kp+6144); kf[7]=*(const __attribute__((address_space(3))) bf16x8*)(kp+6656);
}
__device__ __forceinline__ void kload2(bf16x8*kf,lds_cptr kp,int j){ kf[2*j]=*(const __attribute__((address_space(3))) bf16x8*)(kp+j*2048); kf[2*j+1]=*(const __attribute__((address_space(3))) bf16x8*)(kp+j*2048+512); }
__device__ __forceinline__ s16x4 vtr(lds_cptr p){ return __builtin_bit_cast(s16x4,__builtin_amdgcn_ds_read_tr16_b64_v4i16((__attribute__((address_space(3))) v4i16_t*)p)); }
__device__ __forceinline__ float rowmax(const f32x16&p0,const f32x16&p1){
  float a=max3f(p0[0],p0[1],p1[0]),b=max3f(p0[2],p0[3],p1[1]);a=max3f(a,p1[2],p1[3]);
  #pragma unroll
  for(int r=4;r<16;r+=4){a=max3f(a,p0[r],p0[r+1]);b=max3f(b,p0[r+2],p0[r+3]);a=max3f(a,p1[r],p1[r+1]);b=max3f(b,p1[r+2],p1[r+3]);}
  const float m=max2f(a,b);
  auto rr=__builtin_amdgcn_permlane32_swap(__float_as_uint(m),__float_as_uint(m),false,false);
  return max2f(__uint_as_float(rr[0]),__uint_as_float(rr[1]));
}
__device__ __forceinline__ void pv(f32x16*o,int vb,bf16x8 pa0,bf16x8 pa1,bf16x8 pa2,bf16x8 pa3){
  #pragma unroll
  for(int d0=0;d0<2;++d0){s16x4 lo[4],hi[4];
    #pragma unroll
    for(int ks=0;ks<4;++ks){
      asm volatile("ds_read_b64_tr_b16 %0,%1 offset:%c2":"=&v"(lo[ks]):"v"(vb),"i"(d0*4096+ks*1024):"memory");
      asm volatile("ds_read_b64_tr_b16 %0,%1 offset:%c2":"=&v"(hi[ks]):"v"(vb),"i"(d0*4096+ks*1024+512):"memory");}
    asm volatile("s_waitcnt lgkmcnt(0)":::"memory");SBAR();
    #define PK(k) (bf16x8){lo[k][0],lo[k][1],lo[k][2],lo[k][3],hi[k][0],hi[k][1],hi[k][2],hi[k][3]}
    o[d0]=__builtin_amdgcn_mfma_f32_32x32x16_bf16(pa0,PK(0),o[d0],0,0,0);
    o[d0]=__builtin_amdgcn_mfma_f32_32x32x16_bf16(pa1,PK(1),o[d0],0,0,0);
    o[d0]=__builtin_amdgcn_mfma_f32_32x32x16_bf16(pa2,PK(2),o[d0],0,0,0);
    o[d0]=__builtin_amdgcn_mfma_f32_32x32x16_bf16(pa3,PK(3),o[d0],0,0,0);
    #undef PK
  }
}

#ifndef ATTN_STORE16
#define ATTN_STORE16(p,v) (*(u32x4*)(p)=(v))
#endif
template<int THRL> __device__ __forceinline__ void attn_unit(const bf16*Qw0,const bf16*__restrict__ KL,const bf16*__restrict__ VL,const bf16*__restrict__ KC,const bf16*__restrict__ VC,int nlt,const int NT,bf16*Ow0,char*shm,const float MB){
  const int tid=threadIdx.x,lane=tid&63,r32=lane&31,hi=lane>>5; const int wid=__builtin_amdgcn_readfirstlane(tid>>6);
  const bf16*Qw=Qw0+(long)(wid*QBLK)*DM;
  const unsigned lds0=(unsigned)(uintptr_t)shm;
  float*wsf=(float*)(shm+LDS_WS)+wid*64;
  const long kvo_k=(long)lane*DM+wid*8; const bf16*ksrcL=KL+kvo_k; const bf16*ksrcC=KC+kvo_k-(long)nlt*KVBLK*DM;
  const long kvo_v=(long)(16*(wid&3)+(lane>>2))*DM+(wid>>2)*32+(lane&3)*8; const bf16*vsrcL=VL+kvo_v; const bf16*vsrcC=VC+kvo_v-(long)nlt*KVBLK*DM;
  const unsigned kdst=lds0+LDS_K+wid*1024, vdst=lds0+LDS_V+wid*1024;
  #define DMA_K(t,slot) glds16(((t)<nlt?ksrcL:ksrcC)+(long)(t)*KVBLK*DM,(unsigned)__builtin_amdgcn_readfirstlane(kdst+(slot)))
  #define DMA_V(t,slot) glds16(((t)<nlt?vsrcL:vsrcC)+(long)(t)*KVBLK*DM,(unsigned)__builtin_amdgcn_readfirstlane(vdst+(slot)))
  const int vb0=(int)(lds0+LDS_V)+((lane>>4)&1)*32+(lane&3)*8+(4*hi+((lane&15)>>2))*64;
  const char*Kbase=shm+LDS_K; bf16x8 kf[8];
  const lds_cptr shm3=(lds_cptr)shm; const lds_cptr kp0=shm3+LDS_K+hi*1024+r32*16; const lds_cptr vp0=shm3+LDS_V+((lane>>4)&1)*32+(lane&3)*8+(4*hi+((lane&15)>>2))*64;
  DMA_K(0,0);DMA_V(0,0);DMA_K(1,SLOTB);
  bf16x8 qr[4];
  #pragma unroll
  for(int d0=0;d0<4;++d0)qr[d0]=*reinterpret_cast<const bf16x8*>(&Qw[(long)r32*DM+d0*16+hi*8]);
  const short one_=((lane&15)<2&&(lane&15)==((lane>>4)&1))?(short)0x3F80:(short)0; bf16x8 sel={one_,one_,one_,one_,one_,one_,one_,one_}; asm volatile("":"+v"(sel));
  f32x4a lacc={0.f,0.f,0.f,0.f};
  f32x16 o[2];o[0]=f32x16{};o[1]=f32x16{};f32x16 negm;
  #pragma unroll
  for(int r=0;r<16;++r)negm[r]=-MB;
  asm volatile("":"+v"(negm));
  #define CMASK(P0,P1,t) do{}while(0)
  #define START(P0,P1) do{ _Pragma("unroll") for(int r=0;r<16;++r)P0[r]=__builtin_amdgcn_exp2f(P0[r]); }while(0)
  #define RESC() do{}while(0)
  f32x16 pA0,pA1,pB0,pB1;
  int sl_prev=0,sl_cur=0,sl_next=SLOTB;
  #define ROT() do{sl_prev=sl_cur;sl_cur=sl_next;sl_next=(sl_next==(NSLOT-1)*SLOTB)?0:sl_next+SLOTB;}while(0)
  DMA_K(2,2*SLOTB);
  WAIT_BAR(3);
  qkt(pA0,pA1,Kbase,qr,negm,r32,hi);asm volatile("s_nop 15\n\ts_nop 7":"+v"(pA0),"+v"(pA1));CMASK(pA0,pA1,0);
  START(pA0,pA1);
  _Pragma("unroll") for(int r=0;r<16;++r)pA1[r]=__builtin_amdgcn_exp2f(pA1[r]);
  WAIT_BAR(0);
  DMA_K(3,0);DMA_V(1,SLOTB);
  ROT();
  kload8(kf,kp0+sl_cur);
  WAIT_BAR(2);
  s16x4 vlo[8],vhi[8]; u32x4 pw0,pw1,pw2,pw3;
  #define PKW(P,B) cvtpk_s(P[B],P[B+1])
  #define PAF(k) __builtin_bit_cast(bf16x8,pw##k)
  #define VFR(i) (bf16x8){vlo[i][0],vlo[i][1],vlo[i][2],vlo[i][3],vhi[i][0],vhi[i][1],vhi[i][2],vhi[i][3]}
  #define PIN(x) asm volatile("":"+v"(x))
  #define MX3(a,b,c) __builtin_fmaxf(__builtin_fmaxf((a),(b)),(c))
  #define GAPA(MF,W0,W1,PW,EXTRA) do{ MF; W0; W1; PIN(PW); EXTRA; SBAR(); }while(0)
  #define LSUM(k) do{ lacc=__builtin_amdgcn_mfma_f32_16x16x32_bf16(sel,PAF(k),lacc,0,0,0); PIN(lacc); }while(0)
  #define NOX() do{}while(0)
  #define EX(v) __builtin_amdgcn_exp2f(v)
  #define GAPB(MF,X,B,EXTRA) do{ MF; X[B]=EX(X[B]); X[B+1]=EX(X[B+1]); X[B+2]=EX(X[B+2]); X[B+3]=EX(X[B+3]); PIN(X); EXTRA; SBAR(); }while(0)
  #define VRD(i) do{ vlo[i]=vtr(vp_+(((i)>>2)*4096+((i)&3)*1024)); vhi[i]=vtr(vp_+(((i)>>2)*4096+((i)&3)*1024+512)); }while(0)
  #define KRD(G,j) do{ if(G){ kload2(kf,kp0+sl_next,j); SBAR(); } }while(0)
  #define STEP(C0,C1,P0,P1,t,GK,GV,GL) do{ SBAR(); \
    const lds_cptr vp_=vp0+sl_prev; \
    VRD(0); SBAR(); \
    GAPA(C0=__builtin_amdgcn_mfma_f32_32x32x16_bf16(kf[0],qr[0],negm,0,0,0), pw0[0]=PKW(P0,0), pw0[1]=PKW(P0,2), pw0, NOX()); \
    VRD(4); SBAR(); GAPA(C1=__builtin_amdgcn_mfma_f32_32x32x16_bf16(kf[1],qr[0],negm,0,0,0), pw0[2]=PKW(P0,4), pw0[3]=PKW(P0,6), pw0, NOX()); \
    VRD(1); SBAR(); GAPA(C0=__builtin_amdgcn_mfma_f32_32x32x16_bf16(kf[2],qr[1],C0,0,0,0),   pw1[0]=PKW(P0,8), pw1[1]=PKW(P0,10), pw1, LSUM(0)); \
    VRD(5); SBAR(); GAPA(C1=__builtin_amdgcn_mfma_f32_32x32x16_bf16(kf[3],qr[1],C1,0,0,0),   pw1[2]=PKW(P0,12),pw1[3]=PKW(P0,14), pw1, NOX()); \
    VRD(2); SBAR(); GAPA(C0=__builtin_amdgcn_mfma_f32_32x32x16_bf16(kf[4],qr[2],C0,0,0,0),   pw2[0]=PKW(P1,0), pw2[1]=PKW(P1,2), pw2, LSUM(1)); \
    VRD(6); SBAR(); GAPA(C1=__builtin_amdgcn_mfma_f32_32x32x16_bf16(kf[5],qr[2],C1,0,0,0),   pw2[2]=PKW(P1,4), pw2[3]=PKW(P1,6), pw2, NOX()); \
    VRD(3); SBAR(); GAPA(C0=__builtin_amdgcn_mfma_f32_32x32x16_bf16(kf[6],qr[3],C0,0,0,0),   pw3[0]=PKW(P1,8), pw3[1]=PKW(P1,10), pw3, LSUM(2)); \
    VRD(7); SBAR(); GAPA(C1=__builtin_amdgcn_mfma_f32_32x32x16_bf16(kf[7],qr[3],C1,0,0,0),   pw3[2]=PKW(P1,12),pw3[3]=PKW(P1,14), pw3, NOX()); \
    if(GK){DMA_K((t)+3,sl_cur);} if(GV){DMA_V((t)+1,sl_next);} \
    CMASK(C0,C1,t); \
    SBAR(); \
    GAPB(o[0]=__builtin_amdgcn_mfma_f32_32x32x16_bf16(PAF(0),VFR(0),o[0],0,0,0), C0,0,NOX()); \
    GAPB(o[1]=__builtin_amdgcn_mfma_f32_32x32x16_bf16(PAF(0),VFR(4),o[1],0,0,0), C0,4,LSUM(3)); \
    KRD(GL,0); GAPB(o[0]=__builtin_amdgcn_mfma_f32_32x32x16_bf16(PAF(1),VFR(1),o[0],0,0,0), C0,8,NOX()); \
    KRD(GL,1); GAPB(o[1]=__builtin_amdgcn_mfma_f32_32x32x16_bf16(PAF(1),VFR(5),o[1],0,0,0), C0,12,NOX()); \
    KRD(GL,2); GAPB(o[0]=__builtin_amdgcn_mfma_f32_32x32x16_bf16(PAF(2),VFR(2),o[0],0,0,0), C1,0,NOX()); \
    KRD(GL,3); GAPB(o[1]=__builtin_amdgcn_mfma_f32_32x32x16_bf16(PAF(2),VFR(6),o[1],0,0,0), C1,4,NOX()); \
    GAPB(o[0]=__builtin_amdgcn_mfma_f32_32x32x16_bf16(PAF(3),VFR(3),o[0],0,0,0), C1,8,NOX()); \
    GAPB(o[1]=__builtin_amdgcn_mfma_f32_32x32x16_bf16(PAF(3),VFR(7),o[1],0,0,0), C1,12,NOX()); \
    }while(0)
  int t=1;
  #undef CMASK
  #define CMASK(P0,P1,t) do{}while(0)
  for(;t+5<NT;t+=2){
    STEP(pB0,pB1,pA0,pA1,t,true,true,true);     WAIT_BAR(2); RESC(); ROT();
    STEP(pA0,pA1,pB0,pB1,t+1,true,true,true);   WAIT_BAR(2); RESC(); ROT();
  }
  #undef CMASK
  #define CMASK(P0,P1,t) do{}while(0)
  #define ENDW(tt) do{ if((tt)+3<NT){WAIT_BAR(2);} else if((tt)+2<NT){WAIT_BAR(1);} else {WAIT_BAR(0);} }while(0)
  for(;t+1<NT;t+=2){
    STEP(pB0,pB1,pA0,pA1,t,(t+3<NT),(t+1<NT),(t+1<NT));       ENDW(t);   RESC(); ROT();
    STEP(pA0,pA1,pB0,pB1,t+1,(t+4<NT),(t+2<NT),(t+2<NT));     ENDW(t+1); RESC(); ROT();
  }
  STEP(pB0,pB1,pA0,pA1,NT-1,false,false,false); RESC();
  { pw0=(u32x4){PKW(pB0,0),PKW(pB0,2),PKW(pB0,4),PKW(pB0,6)};pw1=(u32x4){PKW(pB0,8),PKW(pB0,10),PKW(pB0,12),PKW(pB0,14)};pw2=(u32x4){PKW(pB1,0),PKW(pB1,2),PKW(pB1,4),PKW(pB1,6)};pw3=(u32x4){PKW(pB1,8),PKW(pB1,10),PKW(pB1,12),PKW(pB1,14)};
    LSUM(0); LSUM(1); LSUM(2); LSUM(3);
    SBAR(); pv(o,vb0+sl_cur,PAF(0),PAF(1),PAF(2),PAF(3)); }
  #undef PKW
  #undef PAF
  #undef VFR
  #undef PIN
  #undef MX3
  #undef GAPA
  #undef LSUM
  #undef NOX
  #undef GAPB
  #undef EX
  #undef VRD
  #undef KRD
  #undef STEP
  #undef ENDW
  if(lane<16){wsf[32+lane]=lacc[0];wsf[48+lane]=lacc[1];}asm volatile("s_waitcnt lgkmcnt(0)":::"memory");
  float rli[16];
  #pragma unroll
  for(int r=0;r<16;++r)rli[r]=__builtin_amdgcn_rcpf(wsf[32+crow(r,hi)]);
  bf16*Ow=Ow0+(long)(wid*QBLK)*DM;
  { bf16*stg=(bf16*)(shm+LDS_OST)+wid*2048;
    #pragma unroll
    for(int r=0;r<16;++r){const int orow=crow(r,hi);
      #pragma unroll
      for(int d0=0;d0<2;++d0)stg[orow*64+d0*32+r32]=__float2bfloat16(o[d0][r]*rli[r]);}
    asm volatile("s_waitcnt lgkmcnt(0)":::"memory");
    #pragma unroll
    for(int i=0;i<4;++i){const int row=i*8+(lane>>3),ch=lane&7; const u32x4 v=*(const u32x4*)(stg+row*64+ch*8); ATTN_STORE16(Ow+(long)row*DM+ch*8,v);} }
  asm volatile("s_waitcnt lgkmcnt(0)\n\ts_barrier":::"memory");
  #undef DMA_K
  #undef DMA_V
  #undef CMASK
  #undef START
  #undef RESC
  #undef ROT
}
constexpr int ATTN_LDS_BYTES=LDS_BYTES;
#undef SBAR
#undef WAIT_BAR
}

constexpr int PH_PER_LAYER = 11, PH_L0 = 2, N_PHASES = PH_L0 + 2 * PH_PER_LAYER;
__device__ __forceinline__ void phase_scale_rows(const Frame& F, int l, bool from_x) {
    const int gw = F.vcu * NWAVES + F.wave, NGW = F.G * NWAVES;
    for (int r = gw; r < R; r += NGW) { Row16 x = ld_row(from_x ? xin_row(F, l, r) : F.XM() + (size_t)r * D, F.lane);
#pragma unroll
        for (int j = 0; j < 4; ++j) x.v[j] = x.v[j] * ALPHA;
        st_row(F.XM() + (size_t)r * D, F.lane, x); }
}
__device__ __forceinline__ Frame make_frame(unsigned char* lds_, unsigned char* ws, float* out) {
    Frame F; F.lds = (LAS unsigned char*)lds_; F.MISC = (volatile LAS unsigned*)(F.lds + MISC_OFF);
    F.tid = opq_v((int)threadIdx.x); F.lane = F.tid & 63; F.wave = __builtin_amdgcn_readfirstlane(F.tid >> 6);
    F.G = opq_s((int)gridDim.x); { const int bx = opq_s((int)blockIdx.x); F.vcu = (F.G % 8 == 0) ? (bx % 8) * (F.G / 8) + bx / 8 : bx; }
    F.ws = opq(ws); F.out = opq(out); F.in.lds = F.lds; return F; }
#ifndef PHM
#define PHM 0xFF
#endif
#ifndef R_IN
#define R_IN 1
#endif
#ifndef R_LOC
#define R_LOC 1
#endif
#ifndef R_MRG
#define R_MRG 1
#endif
#ifndef R_OUT
#define R_OUT 1
#endif
#ifndef R_UP
#define R_UP 1
#endif
#ifndef R_ATT
#define R_ATT 0
#endif
#ifndef D_OUTU
#define D_OUTU 0
#endif
#ifndef D_CHAIN
#define D_CHAIN 0
#endif
#ifndef D_DFT
#define D_DFT 0
#endif
#ifndef D_QK
#define D_QK 0
#endif
#ifndef R_FIN0
#define R_FIN0 1
#endif
#ifndef R_PM0
#define R_PM0 1
#endif
#ifndef R_MDN
#define R_MDN 1
#endif
#ifndef X_BAR
#define X_BAR 0
#endif
#ifndef R_CONV
#define R_CONV 1
#endif
#ifndef R_PRO
#define R_PRO 1
#endif
#define MKF() Frame F = make_frame(lds, args.ws, args.out)
#define IN(k) (args.ph_lo <= (k) && (k) < args.ph_hi)
#define SEAM(k) do { if (IN(k) && IN((k) + 1)) { XcdBarrier bar_; bar_.bar = (unsigned*)((gu32*)(opq(args.ws) + WS_CTL) + CW_BAR) + args.li * XCD_BAR_WORDS; bar_.x = xb_xcc_id(); \
        bar_.st = (volatile LAS unsigned*)((LAS unsigned char*)lds + MISC_OFF) + 8; xcd_barrier(bar_); if (X_BAR) xcd_barrier(bar_); } PROF_TICK(k); } while (0)
#define xm (F.ws + WS_XM)
#define P_IM1 ((bf16*)(xm + XO_IM1))
#define P_FT ((bf16*)(xm + XO_FT))
#define MK_SP() ScanPtrs sp; sp.Cst = (bf16*)(xm + XO_MLC); sp.Gst = (bf16*)(xm + XO_GLS); sp.Nst = (float*)(F.ws + WS_SCAL + SC_MLN); sp.Amx = (float*)(F.ws + WS_SCAL + SC_MLA); sp.Bl = (float*)(F.ws + WS_SCAL + SC_MLB); sp.Mst = (float*)(F.ws + WS_SCAL + SC_MLM); sp.Gld = (float*)(F.ws + WS_SCAL + SC_GLD)

template <int l> __device__ __forceinline__ void layer_body(const Args& args, unsigned char* lds) {
        const int pb = PH_L0 + l * PH_PER_LAYER;
        if (IN(pb + 0)) {
#if DBG_LEVEL >= 3 && (PHM & 1)
            for (int rep = 0; rep < R_IN; ++rep) { SchedIn S; S.G = opq_s((int)gridDim.x); S.c = opq_s((int)blockIdx.x); S.ws = opq(args.ws);
            pg8::gemm_stream((LAS unsigned char*)lds, S); }
#endif
        }
        SEAM(pb + 0);
        if (IN(pb + 1)) {
#if DBG_LEVEL >= 3 && (PHM & 2)
            MKF(); MK_SP(); phase_qk(F, l); for (int rep = 0; rep < D_QK; ++rep) phase_qk(F, l, __builtin_amdgcn_readfirstlane(opq_v(1)) != 0);
            __syncthreads(); PROF_TICK(24);
            dft_load_mats(F);
            for (int u = F.vcu; u < 1024; u += F.G) dft_unit<1>(F, u >> 9, (u >> 2) & 127, u & 3, P_IM1, P_FT);
            for (int rep = 0; rep < D_DFT; ++rep) for (int u = F.vcu; u < 1024; u += F.G) dft_unit<1>(F, u >> 9, (u >> 2) & 127, u & 3, P_IM1, P_FT, __builtin_amdgcn_readfirstlane(opq_v(1)) != 0);
            __syncthreads(); PROF_TICK(25);
            {
                volatile LAS int* qs = (volatile LAS int*)(F.lds + MISC_OFF + 96); unsigned* qh = (unsigned*)(F.ctl() + CW_QUEUE + (l * 2 + 0) * 64);
                if (F.tid == 0) { qs[2] = (int)__hip_atomic_fetch_add(qh, 1u, RLX_AGENT); qs[3] = (int)__hip_atomic_fetch_add(qh, 1u, RLX_AGENT); }
                __syncthreads();
                UnitId id, idn; ScanRegs RA, RB; int u = qs[2], un = qs[3]; bool ok = unit_decode_q(u, l, false, id), okn = unit_decode_q(un, l, false, idn); int par = 0;
                if (ok) scan_fetch<false>(F, l, id, sp, RA);
                while (ok) {
                    if (okn) scan_fetch<false>(F, l, idn, sp, RB);
                    if (F.tid == 0) qs[par] = (int)__hip_atomic_fetch_add(qh, 1u, RLX_AGENT);
                    if (id.fam == 0) scan_local_unit<true>(F, l, id.b, id.head, id.tc, sp, RA); else scan_local_unit<false>(F, l, id.b, id.head, id.tc, sp, RA);
                    const int u2 = qs[par]; par ^= 1;
                    RA = RB; id = idn; ok = okn; okn = unit_decode_q(u2, l, false, idn); }
            }
            __syncthreads(); PROF_TICK(26);
#endif
        }
        SEAM(pb + 1);
        if (IN(pb + 2)) {
#if DBG_LEVEL >= 3 && (PHM & 4)
            MKF(); MK_SP(); const bool split = F.G >= 256; const int nsc = split ? 128 : F.G;
            if (F.vcu < nsc) for (int rep = 0; rep <= D_CHAIN; ++rep) for (int cq = F.vcu; cq < 128; cq += nsc) { const bool dry = __builtin_amdgcn_readfirstlane(opq_v(rep)) != 0; const int c = cq >> 2, qt = cq & 3;
                if (c < 16) scan_chain<true>(F, c, qt, sp, dry); else scan_chain<false>(F, c - 16, qt, sp, dry); }
            PROF_TICK(27);
            if (!split || F.vcu >= nsc) { const int widx = split ? F.vcu - nsc : F.vcu, nw = split ? F.G - nsc : F.G;
                dft_load_mats(F);
                for (int rep = 0; rep <= D_DFT; ++rep) for (int u = widx; u < 1024; u += nw) dft_unit<2>(F, u >> 9, (u >> 2) & 127, u & 3, P_IM1, P_FT, __builtin_amdgcn_readfirstlane(opq_v(rep)) != 0);
                PROF_TICK(28); if (l == 0) ctx_dft(F, P_FT, widx, nw); PROF_TICK(29); }
#endif
        }
        SEAM(pb + 2);
        if (IN(pb + 3)) {
#if DBG_LEVEL >= 3 && (PHM & 24)
#if (PHM & 8)
            {   MKF(); typedef attn_body::bf16 abf; abf* Pb = (abf*)F.P();
                const float MB = fminf(C2Q * 64.f * wave_max(fabsf(F.in[I_GQQG][l * 64 + F.lane])) * wave_max(fabsf(F.in[I_GQKG][l * 64 + F.lane])), 40.f);
                for (int i = 0;; ++i) { const int U = i * F.G + F.vcu; if (U >= 1024) break;
                    const int combo = (U >> 6) & 3, hg = (U >> 8) & 3, qb = U & 63, b = combo >> 1, kvh = combo & 1, h = kvh * 4 + hg;
                    abf* q = Pb + (size_t)(b * T + qb * 256) * NP + TC_GQQ + h * 64; const abf* kl = Pb + (size_t)(b * T) * NP + TC_GQK + kvh * 64; const abf* kc = Pb + (size_t)(RL + b * CTX) * NP + TC_GQK + kvh * 64;
                    attn_body::attn_unit<8>(q, kl, kl + (TC_GQV - TC_GQK), kc, kc + (TC_GQV - TC_GQK), 256, 260, q, (char*)lds, MB); }
                for (int rep = 0; rep < R_ATT; ++rep)
                for (int i = 0;; ++i) { const int U = i * F.G + F.vcu; if (U >= 1024) break;
                    const int combo = (U >> 6) & 3, hg = (U >> 8) & 3, qb = U & 63, b = combo >> 1, kvh = combo & 1, h = kvh * 4 + hg;
                    abf* q = Pb + (size_t)(b * T + qb * 256) * NP + TC_MLQ + (h & 3) * 64; const abf* kl = Pb + (size_t)(b * T) * NP + TC_GQK + kvh * 64; const abf* kc = Pb + (size_t)(RL + b * CTX) * NP + TC_GQK + kvh * 64;
                    attn_body::attn_unit<8>(q, kl, kl + (TC_GQV - TC_GQK), kc, kc + (TC_GQV - TC_GQK), 256, 260, Pb + (size_t)(b * T + qb * 256) * NP + TC_FT + (h & 3) * 64, (char*)lds, MB); }
                if (l == 0 && F.vcu < 16) { const int b = F.vcu >> 3, h = F.vcu & 7, kvh = h >> 2;
                    abf* q = Pb + (size_t)(RL + b * CTX) * NP + TC_GQQ + h * 64; const abf* kc = Pb + (size_t)(RL + b * CTX) * NP + TC_GQK + kvh * 64;
                    attn_body::attn_unit<8>(q, kc, kc + (TC_GQV - TC_GQK), kc, kc + (TC_GQV - TC_GQK), 4, 4, q, (char*)lds, MB); }
            }
#endif
            __syncthreads(); PROF_TICK(31);
#if (PHM & 16)
            {   MKF(); MK_SP();
                {
                    const bool dry = false;
                    volatile LAS int* qs = (volatile LAS int*)(F.lds + MISC_OFF + 96); unsigned* qh = (unsigned*)(F.ctl() + CW_QUEUE + (l * 2 + 1) * 64);
                    if (F.tid == 0) { qs[2] = (int)__hip_atomic_fetch_add(qh, 1u, RLX_AGENT); qs[3] = (int)__hip_atomic_fetch_add(qh, 1u, RLX_AGENT); }
                    __syncthreads();
                    UnitId id, idn; ScanRegs RA, RB; int u = qs[2], un = qs[3]; bool ok = unit_decode_q(u, l, true, id), okn = unit_decode_q(un, l, true, idn); int par = 0;
                    if (ok) scan_fetch<true>(F, l, id, sp, RA);
                    while (ok) {
                        if (okn) scan_fetch<true>(F, l, idn, sp, RB);
                        if (F.tid == 0) qs[par] = (int)__hip_atomic_fetch_add(qh, 1u, RLX_AGENT);
                        if (id.fam == 0) scan_out_unit<true>(F, l, id.b, id.head, id.tc, sp, RA, dry); else scan_out_unit<false>(F, l, id.b, id.head, id.tc, sp, RA, dry);
                        const int u2 = qs[par]; par ^= 1;
                        RA = RB; id = idn; ok = okn; okn = unit_decode_q(u2, l, true, idn); }
                }
            }
#endif
#endif
        }
        SEAM(pb + 3);
        if (IN(pb + 4)) {
#if DBG_LEVEL >= 3 && (PHM & 32)
            for (int rep = 0; rep < R_MRG; ++rep) { SchedMerge S; S.G = opq_s((int)gridDim.x); S.c = opq_s((int)blockIdx.x); S.npan = (l == 0) ? NPAN : NPAN_L; S.ws = opq(args.ws); S.bgate = args.in[I_BGATE] + (size_t)l * 4096;
            pg8::gemm_stream((LAS unsigned char*)lds, S); }
#endif
        }
        SEAM(pb + 4);
        if (IN(pb + 5)) {
#if DBG_LEVEL >= 3 && (PHM & 64)
            SchedOut S; S.G = opq_s((int)gridDim.x); S.c = opq_s((int)blockIdx.x); S.npan = (l == 0) ? NPAN : NPAN_L; S.l = l; S.ws = opq(args.ws); S.xlat = (l == 0) ? args.in[I_X] : args.out; S.xctx = (l == 0) ? args.in[I_CTX] : (const float*)(args.ws + WS_XC);
            if (l == 0) { MKF(); build_ctx_panels(F); }
            for (int rep = 0; rep < R_OUT; ++rep) pg8::gemm_stream((LAS unsigned char*)lds, S);
#else
            MKF(); phase_scale_rows(F, l, true);
#endif
        }
        SEAM(pb + 5);
        if (IN(pb + 6)) { MKF();
#if DBG_LEVEL >= 3 && (PHM & 64)
            phase_post_mix(F, l, l == 0 ? R : RL, (const float*)(F.ws + WS_P)); if (l == 0) for (int rep = 1; rep < R_PM0; ++rep) phase_post_mix(F, l, R, (const float*)(F.ws + WS_P));
#else
            phase_post_mix(F, l, l == 0 ? R : RL, F.XM());
#endif
        }
        if (l == 1) SEAM(pb + 6);
        if (IN(pb + 7)) { if (l == 1) { MKF(); phase_moe_assign(F); } }
        SEAM(pb + 7);
        if (IN(pb + 8)) {
#if DBG_LEVEL >= 2
            for (int rep = 0; rep < R_UP; ++rep) {
            if (l == 0) { SchedUp S; S.G = opq_s((int)gridDim.x); S.c = opq_s((int)blockIdx.x); S.ws = opq(args.ws); pg8::gemm_stream((LAS unsigned char*)lds, S); }
            else { SchedMoeUp S; S.G = opq_s((int)gridDim.x); S.c = opq_s((int)blockIdx.x); S.mt.ws = opq(args.ws); S.mt.lds = (LAS unsigned char*)lds; S.nt_ = *(const volatile int*)S.mt.ntiles();
                for (int t_ = threadIdx.x; t_ < MOE_MAXT; t_ += 512) ((LAS int*)((LAS unsigned char*)lds + TILE_E_OFF))[t_] = ((const GAS int*)S.mt.tile_e())[t_]; __syncthreads(); pg8::gemm_stream((LAS unsigned char*)lds, S); } }
#endif
        }
        SEAM(pb + 8);
        if (IN(pb + 9)) {
#if DBG_LEVEL >= 2
            if (l == 0) { SchedDown S; S.G = opq_s((int)gridDim.x); S.c = opq_s((int)blockIdx.x); S.l = 0; S.ws = opq(args.ws); pg8::gemm_stream((LAS unsigned char*)lds, S); }
            else { SchedMoeDown S; S.G = opq_s((int)gridDim.x); S.c = opq_s((int)blockIdx.x); S.mt.ws = opq(args.ws); S.mt.lds = (LAS unsigned char*)lds; S.Dst = (bf16*)args.out; S.nt_ = *(const volatile int*)S.mt.ntiles();
                for (int t_ = threadIdx.x; t_ < MOE_MAXT; t_ += 512) ((LAS int*)((LAS unsigned char*)lds + TILE_E_OFF))[t_] = ((const GAS int*)S.mt.tile_e())[t_]; __syncthreads(); for (int rep = 0; rep < R_MDN; ++rep) pg8::gemm_stream((LAS unsigned char*)lds, S); }
#else
            MKF();
            if (l == 0) phase_scale_rows(F, l, false);
            else { for (size_t i = (size_t)F.vcu * 512 + F.tid; i < (size_t)RL * D / 4; i += (size_t)F.G * 512) ((v4u*)F.out)[i] = (v4u){0u, 0u, 0u, 0u}; }
#endif
        }
        SEAM(pb + 9);
        if (IN(pb + 10)) { MKF(); phase_final(F, l); if (l == 0) for (int rep = 1; rep < R_FIN0; ++rep) phase_final(F, l); __syncthreads(); PROF_TICK(28); if (l == 0) { for (int rep = 0; rep < R_CONV; ++rep) convert_layer_weights(F, 1); } }
        if (l == 0) SEAM(pb + 10);
    }
__global__ void __launch_bounds__(NWAVES * 64, 2) mega_fwd(Args args) {
    extern __shared__ __attribute__((aligned(16))) unsigned char lds[];
    {   LAS unsigned char* L = (LAS unsigned char*)lds; const int tid = threadIdx.x;
        for (int u = tid; u < (LDS_BYTES - LDSCTL_OFF) / 4; u += NWAVES * 64) ((LAS unsigned*)(L + LDSCTL_OFF))[u] = 0u;
        __syncthreads();
        if (tid == 0) {
#pragma unroll
            for (int i = 0; i < 30; ++i) *(LAS unsigned long long*)(L + INTAB_OFF + 8 * i) = (unsigned long long)args.in[i]; }
        __syncthreads();
        if (PROF_MASK != 0u && blockIdx.x == PROF_WG && tid == 0) { volatile LAS unsigned long long* pw_ = (volatile LAS unsigned long long*)(L + MISC_OFF + 64); pw_[0] = __builtin_amdgcn_s_memrealtime(); pw_[1] = 0ull; }
        (void)xcd_barrier_post((unsigned*)((gu32*)(args.ws + WS_CTL) + CW_BAR) + args.li * XCD_BAR_WORDS, (volatile LAS unsigned*)(L + MISC_OFF) + 8);
    }
    if (IN(0)) { MKF(); for (int rep = 0; rep < R_PRO; ++rep) { build_tables(F); convert_layer_weights(F, 0); __syncthreads(); PROF_TICK(27); ada_phase(F); } }
    SEAM(0);
    if (IN(1)) { MKF(); for (int rep = 0; rep < R_PRO; ++rep) phase_ln_mod(F, 0); }
    SEAM(1);
    layer_body<0>(args, lds);
    layer_body<1>(args, lds);
    PROF_TICK(N_PHASES - 1);
    if (PROF_MASK != 0u && blockIdx.x == PROF_WG && threadIdx.x == 0) { volatile LAS unsigned long long* pw_ = (volatile LAS unsigned long long*)((LAS unsigned char*)lds + MISC_OFF + 64);
        const unsigned long long t0_ = pw_[0], w_ = 4ull * pw_[1]; while (__builtin_amdgcn_s_memrealtime() - t0_ < w_) __builtin_amdgcn_s_sleep(8); }
}
#undef IN
#undef SEAM


extern "C" void kernel_launch(void* const* d_in, const int* in_sizes, int n_in, void* d_out, int out_size, void* d_ws, size_t ws_size, hipStream_t stream) {
    static int grid = 0;
    if (grid == 0) {
        if (n_in != 30 || out_size != RL * D || ws_size < WS_END) { fprintf(stderr, "kernel_launch: unexpected problem (n_in %d out %d ws %zu)\n", n_in, out_size, ws_size); grid = -1; return; }
        int dev = 0, cus = 0;
        if (hipGetDevice(&dev) != hipSuccess || hipDeviceGetAttribute(&cus, hipDeviceAttributeMultiprocessorCount, dev) != hipSuccess) { grid = -1; return; }
        if (hipFuncSetAttribute((const void*)mega_fwd, hipFuncAttributeMaxDynamicSharedMemorySize, LDS_BYTES) != hipSuccess) { fprintf(stderr, "kernel_launch: hipFuncSetAttribute failed\n"); grid = -1; return; }
        int per_cu = 0; (void)hipOccupancyMaxActiveBlocksPerMultiprocessor(&per_cu, (const void*)mega_fwd, NWAVES * 64, LDS_BYTES); (void)hipGetLastError();
        grid = cus;
        if (per_cu < 1) fprintf(stderr, "kernel_launch: occupancy query says %d\n", per_cu);
    }
    if (grid < 0) return;
    if (hipMemsetAsync((char*)d_ws + WS_CTL, 0, CTL_ZERO_BYTES, stream) != hipSuccess) return;
    Args a{};
    for (int i = 0; i < 30; ++i) a.in[i] = (const float*)d_in[i];
    a.out = (float*)d_out; a.ws = (unsigned char*)d_ws;
#if MK_N_LAUNCHES == 1
    a.ph_lo = 0; a.ph_hi = N_PHASES; a.li = 0;
    hipLaunchKernelGGL(mega_fwd, dim3(grid), dim3(NWAVES * 64), LDS_BYTES, stream, a);
#else
    for (int k = 0; k < N_PHASES; ++k) { a.ph_lo = k; a.ph_hi = k + 1; a.li = 0; hipLaunchKernelGGL(mega_fwd, dim3(grid), dim3(NWAVES * 64), LDS_BYTES, stream, a); }
#endif
}
```

```cpp
#include <hip/hip_runtime.h>
#include <hip/hip_bf16.h>
#include <cstdio>
#include <cstdint>

#ifndef MK_N_LAUNCHES
#define MK_N_LAUNCHES 1
#endif
#ifndef DBG_LEVEL
#define DBG_LEVEL 99
#endif

#define GAS __attribute__((address_space(1)))
#define LAS __attribute__((address_space(3)))
typedef unsigned short bf16;
typedef unsigned v4u __attribute__((ext_vector_type(4)));
typedef unsigned v2u __attribute__((ext_vector_type(2)));
typedef float f32x4 __attribute__((ext_vector_type(4)));
typedef float f32x2 __attribute__((ext_vector_type(2)));
typedef short bf16x8 __attribute__((ext_vector_type(8)));
typedef float f32x16 __attribute__((ext_vector_type(16)));
typedef GAS unsigned gu32;
#define RLX_AGENT __ATOMIC_RELAXED, __HIP_MEMORY_SCOPE_AGENT
#define LDS_WAIT() asm volatile("s_waitcnt lgkmcnt(0)" ::: "memory")
#define VM_WAIT() asm volatile("s_waitcnt vmcnt(0)" ::: "memory")

constexpr int D = 1024, NB = 2, T = 16384, CTX = 256;
constexpr int RL = NB * T;
constexpr int R = RL + NB * CTX;
constexpr int NPAN = R / 256, NPAN_L = RL / 256;
constexpr int NIN = 3120;
constexpr int NP = 3072;
constexpr int TC_MLQ = 0, TC_MLK = 256, TC_MLV = 512, TC_MLO = 768, TC_FT = 1024, TC_GQQ = 1280, TC_GQK = 1792, TC_GQV = 1920,
              TC_GLQ = 2048, TC_GLK = 2304, TC_GLV = 2560, TC_GLR = 2816;
constexpr int SMP = 64;
constexpr int FFD = 2816, NEXP = 8, FFE = 1408;
constexpr float LN_EPS = 1e-6f;
constexpr float ALPHA = 1.4142135623730951f;
constexpr int NCH = 260;
constexpr int NCHAIN = 16;
constexpr float C2Q = 0.125f * 1.4426950408889634f;

constexpr size_t MiB = 1u << 20;
constexpr size_t WS_CTL = 0, CTL_ZERO_BYTES = 128 * 1024;
constexpr size_t WS_ADA = 1 * MiB;
constexpr size_t WS_TAB = WS_ADA + 256 * 1024;
constexpr size_t WS_ROPE_C = WS_TAB, WS_ROPE_S = WS_TAB + 16384, WS_DFT_C = WS_TAB + 32768, WS_DFT_S = WS_DFT_C + 32768;
constexpr size_t WS_MOE = 2 * MiB;
constexpr size_t WS_XC = 4 * MiB;
constexpr size_t WS_SM = 6 * MiB;
constexpr size_t WS_SCAL = 15 * MiB;
constexpr size_t WS_W = 20 * MiB;
constexpr size_t W_IN = 0, W_GATE = W_IN + (size_t)3328 * 1024 * 2, W_OUT = W_GATE + (size_t)4096 * 1024 * 2,
                 W_BML = W_OUT + (size_t)1024 * 1024 * 2, W_BFT = W_BML + (size_t)1024 * 256 * 2, W_BAT = W_BFT + (size_t)1024 * 512 * 2,
                 W_BGL = W_BAT + (size_t)1024 * 512 * 2, W_FFN = W_BGL + (size_t)1024 * 256 * 2;
constexpr size_t W_FFD_GU = W_FFN, W_FFD_D = W_FFN + (size_t)5632 * 1024 * 2;
constexpr size_t W_MOE_GU = W_FFN, W_MOE_D = W_FFN + (size_t)8 * 2816 * 1024 * 2;
constexpr size_t W_END = W_MOE_D + (size_t)8 * 1024 * 1408 * 2;
static_assert(W_END <= 86 * MiB, "weights region");
constexpr size_t WS_H = 106 * MiB;
constexpr size_t WS_P = 172 * MiB;
constexpr size_t WS_XM = 368 * MiB;
constexpr size_t WS_UQ = 498 * MiB;
constexpr size_t WS_PA = 502 * MiB;
constexpr size_t WS_DP = 506 * MiB;
constexpr size_t WS_END = 510 * MiB;
static_assert(WS_H + (size_t)R * 1024 * 2 <= WS_P && WS_P + (size_t)R * NP * 2 <= WS_XM && WS_XM + (size_t)R * 1024 * 4 <= WS_END, "ws map");
constexpr size_t XO_MLC = 0;
constexpr size_t XO_GLS = 33 * MiB;
constexpr size_t XO_MIX = 0;
constexpr size_t XO_IM1 = 68 * MiB;
constexpr size_t XO_GST = 65 * MiB;
constexpr size_t XO_FT = 97 * MiB + 512 * 1024;
static_assert(XO_FT + (size_t)R * 512 * 2 <= (size_t)R * 1024 * 4 && XO_GST + 32 * MiB <= XO_FT && XO_IM1 + 16 * MiB <= XO_FT && XO_GLS + 33 * MiB <= XO_IM1, "XM overlays");
constexpr size_t SC_MLN = 0;
constexpr size_t SC_MLA = SC_MLN + (size_t)16 * 260 * 64 * 4;
constexpr size_t SC_MLB = SC_MLA + 16 * 260 * 4;
constexpr size_t SC_MLM = SC_MLB + 16 * 260 * 4;
constexpr size_t SC_GLD = SC_MLM + 16 * 260 * 4;
static_assert(SC_GLD + (size_t)16 * 260 * 64 * 4 <= 5 * MiB, "scal");
constexpr int MOE_MAXT = 264;
constexpr size_t MO_TOK = 0;
constexpr size_t MO_DST = MO_TOK + (size_t)MOE_MAXT * 256 * 4;
constexpr size_t MO_SEL = MO_DST + (size_t)MOE_MAXT * 256 * 4;
static_assert(MO_SEL + (size_t)RL * 16 <= 2 * MiB, "moe tables");
constexpr int CW_QUEUE = 2048  , CW_TMO = 0, CW_CODE = 1, CW_BAR = 4096, CW_MOECNT = 16384  , CW_MOECUR = 16384 + 8 * 64;
static_assert((CW_MOECUR + 8 * 64) * 4 <= (int)CTL_ZERO_BYTES && (CW_BAR + 3456) * 4 <= (int)CTL_ZERO_BYTES, "control words inside the per-call memset");
#define XB_TMO      128
#define XB_XCNT(j)  (256  + 64 * (j))
#define XB_XSUB(j)  (1280 + 64 * (j))
#define XB_XGEN(j)  (2304 + 64 * (j))
#define XB_TOP      3328
#define XB_TOPGEN   3392
#define XCD_BAR_WORDS 3456
#define XB_SPIN_CAP (1u << 18)

constexpr int RING_BYTES = 131072, LDSCTL_OFF = RING_BYTES, MISC_OFF = LDSCTL_OFF + 320, LDS_BYTES = 147456;
constexpr int NWAVES = 8;

#ifndef PROF_WG
#define PROF_WG 0
#endif
#ifndef PROF_MASK
#define PROF_MASK 0u
#endif
#define PROF_LDS lds
#define PROF_TICK(k) do { if (PROF_MASK != 0u && blockIdx.x == PROF_WG && threadIdx.x == 0) { volatile LAS unsigned long long* pw_ = (volatile LAS unsigned long long*)((LAS unsigned char*)PROF_LDS + MISC_OFF + 64); \
        const unsigned long long now_ = __builtin_amdgcn_s_memrealtime(); if ((PROF_MASK >> (k)) & 1u) pw_[1] += now_ - pw_[0]; pw_[0] = now_; if ((k) < 24) pw_[2] = (unsigned long long)((k) + 1); } } while (0)
#ifndef PROF_SEL
#define PROF_SEL -1
#endif
#define PROF_GEMM_ON() ((PROF_MASK & 0xE0000000u) != 0u && (PROF_SEL < 0 || (((volatile LAS unsigned long long*)((LAS unsigned char*)PROF_LDS + MISC_OFF + 64))[2] >= 2ull && (int)((((volatile LAS unsigned long long*)((LAS unsigned char*)PROF_LDS + MISC_OFF + 64))[2] - 2ull) % 11ull) == PROF_SEL)))
#define PROF_SPAN_BEGIN() do { if (PROF_MASK != 0u && blockIdx.x == PROF_WG && threadIdx.x == 0) { volatile LAS unsigned long long* pw_ = (volatile LAS unsigned long long*)((LAS unsigned char*)PROF_LDS + MISC_OFF + 64); pw_[0] = __builtin_amdgcn_s_memrealtime(); } } while (0)
template <class T_> __device__ __forceinline__ T_* opq(T_* p) { asm volatile("" : "+s"(p)); return p; }
__device__ __forceinline__ int opq_s(int v) { asm volatile("" : "+s"(v)); return v; }
__device__ __forceinline__ int opq_v(int v) { asm volatile("" : "+v"(v)); return v; }
__device__ __forceinline__ unsigned f2bf(float f) { unsigned u = __builtin_bit_cast(unsigned, f); return (u + 0x7fffu + ((u >> 16) & 1u)) >> 16; }
typedef __bf16 hwbf16x2 __attribute__((ext_vector_type(2)));
__device__ __forceinline__ unsigned pk2(float lo, float hi) { const f32x2 v = {lo, hi}; return __builtin_bit_cast(unsigned, __builtin_convertvector(v, hwbf16x2)); }
__device__ __forceinline__ float bflo(unsigned w) { return __uint_as_float(w << 16); }
__device__ __forceinline__ float bfhi(unsigned w) { return __uint_as_float(w & 0xffff0000u); }
__device__ __forceinline__ float bf2f(bf16 b) { return __uint_as_float((unsigned)b << 16); }
__device__ __forceinline__ void unpack8(const v4u a, float (&x)[8]) { x[0] = bflo(a.x); x[1] = bfhi(a.x); x[2] = bflo(a.y); x[3] = bfhi(a.y); x[4] = bflo(a.z); x[5] = bfhi(a.z); x[6] = bflo(a.w); x[7] = bfhi(a.w); }
__device__ __forceinline__ v4u pack8(const float (&x)[8]) { v4u w; w.x = pk2(x[0], x[1]); w.y = pk2(x[2], x[3]); w.z = pk2(x[4], x[5]); w.w = pk2(x[6], x[7]); return w; }
template <int CTRL> __device__ __forceinline__ float dpp_get(float v) { return __builtin_bit_cast(float, __builtin_amdgcn_update_dpp(0, __builtin_bit_cast(int, v), CTRL, 0xF, 0xF, true)); }
__device__ __forceinline__ float wave_sum(float v) {
    v += dpp_get<0xB1>(v);
    v += dpp_get<0x4E>(v);
    v += dpp_get<0x141>(v);
    v += dpp_get<0x140>(v);
    { const auto rr = __builtin_amdgcn_permlane16_swap(__float_as_uint(v), __float_as_uint(v), false, false); v = __uint_as_float(rr[0]) + __uint_as_float(rr[1]); }
    { const auto rr = __builtin_amdgcn_permlane32_swap(__float_as_uint(v), __float_as_uint(v), false, false); v = __uint_as_float(rr[0]) + __uint_as_float(rr[1]); }
    return v;
}
__device__ __forceinline__ float xor16_32_sum(float v) {
    { const auto rr = __builtin_amdgcn_permlane16_swap(__float_as_uint(v), __float_as_uint(v), false, false); v = __uint_as_float(rr[0]) + __uint_as_float(rr[1]); }
    { const auto rr = __builtin_amdgcn_permlane32_swap(__float_as_uint(v), __float_as_uint(v), false, false); v = __uint_as_float(rr[0]) + __uint_as_float(rr[1]); }
    return v; }
__device__ __forceinline__ float sigm(float x) { return __builtin_amdgcn_rcpf(1.f + __expf(-x)); }
__device__ __forceinline__ float logsig(float a) { return fminf(a, 0.f) - __logf(1.f + __expf(-fabsf(a))); }

__device__ __forceinline__ unsigned xb_ld(unsigned* p)              { return __hip_atomic_load(p, __ATOMIC_RELAXED, __HIP_MEMORY_SCOPE_AGENT); }
__device__ __forceinline__ unsigned xb_add(unsigned* p, unsigned v) { return __hip_atomic_fetch_add(p, v, __ATOMIC_RELAXED, __HIP_MEMORY_SCOPE_AGENT); }
__device__ __forceinline__ unsigned xb_xcc_id() { return (unsigned)__builtin_amdgcn_s_getreg((3 << 11) | 20) & 0xFu; }
#define XB_SPIN(cond, bar) do { unsigned _sp = 0; while (cond) { __builtin_amdgcn_s_sleep(1); \
    if ((++_sp & 255u) == 0u) { if (xb_ld(&(bar)[XB_TMO])) break; if (_sp > XB_SPIN_CAP) { atomicAdd(&(bar)[XB_TMO], 1u); break; } } } } while (0)
struct XcdBarrier { unsigned* bar; unsigned x; volatile LAS unsigned* st; };
__device__ __forceinline__ XcdBarrier xcd_barrier_post(unsigned* bar, volatile LAS unsigned* st) {
    XcdBarrier b; b.bar = bar; b.x = xb_xcc_id(); b.st = st;
    if (threadIdx.x == 0) (void)xb_add(&bar[XB_XCNT(b.x)], 1u);
    return b;
}
__device__ __forceinline__ void xcd_barrier_complete(unsigned* bar, unsigned x, unsigned& nloc, unsigned& nx) {
    const unsigned G = gridDim.x * gridDim.y * gridDim.z;
    unsigned sum, cnt, mine, sp = 0u;
    for (;;) {
        sum = 0u; cnt = 0u; mine = 0u;
#pragma unroll
        for (unsigned j = 0; j < 16; ++j) { const unsigned c = xb_ld(&bar[XB_XCNT(j)]); sum += c; cnt += (c > 0u) ? 1u : 0u; mine = (j == x) ? c : mine; }
        if (sum == G) break;
        __builtin_amdgcn_s_sleep(1);
        if ((++sp & 255u) == 0u) { if (xb_ld(&bar[XB_TMO])) break; if (sp > XB_SPIN_CAP) { atomicAdd(&bar[XB_TMO], 1u); break; } }
    }
    nloc = mine > 0u ? mine : 1u; nx = cnt > 0u ? cnt : 1u;
}
__device__ __forceinline__ void xcd_barrier(const XcdBarrier& b) {
    asm volatile("s_waitcnt vmcnt(0)" ::: "memory");
    __syncthreads();
    if (threadIdx.x == 0) {
        unsigned* bar = b.bar;
        __builtin_amdgcn_s_waitcnt(0);
        unsigned nloc = b.st[0], nx = b.st[1];
        if (nloc == 0u) { xcd_barrier_complete(bar, b.x, nloc, nx); b.st[0] = nloc; b.st[1] = nx; }
        const unsigned old = xb_add(&bar[XB_XSUB(b.x)], 1u);
        const unsigned gen = old / nloc;
        if (old + 1u == (gen + 1u) * nloc) {
            __builtin_amdgcn_fence(__ATOMIC_RELEASE, "agent");
            asm volatile("s_waitcnt vmcnt(0)" ::: "memory");
            const unsigned og = xb_add(&bar[XB_TOP], 1u);
            const unsigned tg = og / nx;
            if (og + 1u == (tg + 1u) * nx) xb_add(&bar[XB_TOPGEN], 1u);
            else XB_SPIN(xb_ld(&bar[XB_TOPGEN]) == tg, bar);
            __builtin_amdgcn_fence(__ATOMIC_ACQUIRE, "agent");
            xb_add(&bar[XB_XGEN(b.x)], 1u);
            asm volatile("s_waitcnt vmcnt(0)" ::: "memory");
        } else {
            XB_SPIN(xb_ld(&bar[XB_XGEN(b.x)]) == gen, bar);
            __builtin_amdgcn_fence(__ATOMIC_ACQUIRE, "agent");
            asm volatile("s_waitcnt vmcnt(0)" ::: "memory");
        }
    }
    __syncthreads();
}
namespace pg8 {
constexpr int BM = 256, BK = 64, HALF = 128, HTB = HALF * BK * 2, STAGE_BYTES = 8 * HTB, NXCD = 8, WGM = 8;
__host__ __device__ __forceinline__ int lds_byte(int r, int c) { const int st = (r >> 4) * 2 + (c >> 5), rr = r & 15, cc = c & 31, ob = rr * 64 + cc * 2; return st * 1024 + (ob ^ (((ob >> 9) & 1) << 5)); }
__host__ __device__ __forceinline__ void stage_rc(int b, int& R_, int& C_) { const int st = b / 1024, sb = b % 1024, swz = sb ^ (((sb >> 9) & 1) << 5); R_ = (st >> 1) * 16 + swz / 64; C_ = (st & 1) * 32 + (swz % 64) / 2; }
__host__ __device__ __forceinline__ int perm32(int rho) { const int n = rho >> 4, i = rho & 15; return 8 * (i >> 2) + 4 * n + (i & 3); }
struct GU { unsigned ao, bo; unsigned lda, ldb; int nt; int pm, pn, kind, aux; };
__device__ __forceinline__ bool tile_of(long L, int nM, int nN, int& pm, int& pn) {
    const int nwg = nM * nN; if (L >= nwg) return false;
    int wgid = (int)L; { const int q = nwg / NXCD, r = nwg % NXCD, xcd = wgid % NXCD, off = wgid / NXCD; wgid = (xcd < r ? xcd * (q + 1) : r * (q + 1) + (xcd - r) * q) + off; }
    const int nig = WGM * nN, gid = wgid / nig, fm = gid * WGM, gsz = (nM - fm) < WGM ? (nM - fm) : WGM;
    pm = fm + ((wgid % nig) % gsz); pn = (wgid % nig) / gsz; return true;
}
__device__ __forceinline__ unsigned cvt_pk_bf16(float lo, float hi) { return pk2(lo, hi); }

template <class S>
__device__ __forceinline__ void gemm_stream(LAS unsigned char* lds, const S& sch) {
    const int tid = opq_v((int)threadIdx.x), wid = __builtin_amdgcn_readfirstlane(tid >> 6), lane = tid & 63, wr = wid >> 2, wc = wid & 3, fr = lane & 15, fq = lane >> 4;
    const unsigned ldsw = (unsigned)wid * 1024u;
    const int aoff = lds_byte(wr * 64 + fr, fq * 8), boff = lds_byte(wc * 32 + fr, fq * 8);
#define PG8_SA(b, h) (((b) * 2 + (h)) * HTB)
#define PG8_SB(b, h) ((4 + (b) * 2 + (h)) * HTB)
#define PG8_STG(bufoff, soff, o0, o1) do { \
        __builtin_amdgcn_raw_ptr_buffer_load_lds(rs, (LAS unsigned*)(lds + (bufoff) + ldsw), 16, (o0), (soff), 0, 0); \
        __builtin_amdgcn_raw_ptr_buffer_load_lds(rs, (LAS unsigned*)(lds + (bufoff) + ldsw + 8192), 16, (o1), (soff), 0, 0); } while (0)
#define PG8_LDA(dst, b, h) do { _Pragma("unroll") for (int m = 0; m < 4; ++m) _Pragma("unroll") for (int k = 0; k < 2; ++k) dst[m][k] = *(const LAS bf16x8*)(lds + PG8_SA(b, h) + aoff + m * 2048 + k * 1024); } while (0)
#define PG8_LDB(dst, b, h) do { _Pragma("unroll") for (int n = 0; n < 2; ++n) _Pragma("unroll") for (int k = 0; k < 2; ++k) dst[n][k] = *(const LAS bf16x8*)(lds + PG8_SB(b, h) + boff + n * 2048 + k * 1024); } while (0)
#define PG8_MMA(ai, bj, At, Bt) do { __builtin_amdgcn_s_setprio(1); _Pragma("unroll") for (int m = 0; m < 4; ++m) _Pragma("unroll") for (int n = 0; n < 2; ++n) _Pragma("unroll") for (int k = 0; k < 2; ++k) \
        acc[ai][bj][m][n] = __builtin_amdgcn_mfma_f32_16x16x32_bf16(Bt[n][k], At[m][k], acc[ai][bj][m][n], 0, 0, 0); __builtin_amdgcn_s_setprio(0); } while (0)
#define PG8_WAIT_V(n) asm volatile("s_waitcnt vmcnt(" #n ")" ::: "memory")
#define PG8_WAIT_L(n) asm volatile("s_waitcnt lgkmcnt(" #n ")" ::: "memory")
#define PG8_BAR __builtin_amdgcn_s_barrier()
#define PG8_SCHED __builtin_amdgcn_sched_barrier(0)
#define PG8_SETUP(u, oA, oB, hB) do { _Pragma("unroll") for (int i = 0; i < 2; ++i) { \
        int R_, C_; stage_rc(tid * 16 + i * 8192, R_, C_); const unsigned RA_ = (unsigned)R_, RB_ = (unsigned)(S::PERM ? ((R_ & ~31) + perm32(R_ & 31)) : R_), CB_ = (unsigned)C_ * 2u; \
        if constexpr (S::GATHER) { oA[0][i] = sch.arow(u, (int)RA_) + CB_; oA[1][i] = sch.arow(u, (int)RA_ + 128) + CB_; } \
        else { oA[0][i] = RA_ * (u).lda + CB_; oA[1][i] = oA[0][i] + 128u * (u).lda; } \
        oB[i] = RB_ * (u).ldb + CB_; } hB = 128u * (u).ldb; } while (0)
    GU cur, nxt; int ui = 0;
    if (!sch.next(0, cur)) return;
    f32x4 acc[2][2][4][2];
#pragma unroll
    for (int a = 0; a < 2; ++a)
#pragma unroll
        for (int b = 0; b < 2; ++b)
#pragma unroll
            for (int m = 0; m < 4; ++m)
#pragma unroll
                for (int n = 0; n < 2; ++n) acc[a][b][m][n] = (f32x4){0.f, 0.f, 0.f, 0.f};
    bf16x8 At[4][2], B0[2][2], B1[2][2];
    const __amdgpu_buffer_rsrc_t rs = __builtin_amdgcn_make_buffer_rsrc((void*)sch.wsbase(), (short)0, (int)WS_END, 0x00020000);
    unsigned oA[2][2], oB[2]; unsigned hB;
    PG8_SETUP(cur, oA, oB, hB);
    unsigned cA = cur.ao, cB = cur.bo;
    PG8_STG(PG8_SB(0, 0), cB, oB[0], oB[1]); PG8_STG(PG8_SB(0, 1), cB + hB, oB[0], oB[1]); PG8_STG(PG8_SA(0, 0), cA, oA[0][0], oA[0][1]); PG8_STG(PG8_SA(0, 1), cA, oA[1][0], oA[1][1]);
    if (wr == 1) PG8_BAR;
    PG8_WAIT_V(2); PG8_BAR;
    PG8_STG(PG8_SB(1, 0), cB + 128, oB[0], oB[1]); PG8_STG(PG8_SA(1, 0), cA + 128, oA[0][0], oA[0][1]); PG8_STG(PG8_SB(1, 1), cB + hB + 128, oB[0], oB[1]);
    PG8_WAIT_V(6); PG8_BAR;
    if (PROF_GEMM_ON()) { PROF_TICK(31); }
    for (;;) {
        const bool has_next = sch.next(ui + 1, nxt);
        unsigned gA[2][2];
        if constexpr (S::GATHER) { if (has_next) {
#pragma unroll
            for (int i = 0; i < 2; ++i) { int R_, C_; stage_rc(tid * 16 + i * 8192, R_, C_); gA[0][i] = sch.arow(nxt, R_) + (unsigned)C_ * 2u; gA[1][i] = sch.arow(nxt, R_ + 128) + (unsigned)C_ * 2u; } } }
        const int nt = cur.nt;
        for (int t = 0; t < nt; t += 2) {
            const bool last = (t == nt - 2);
            const unsigned a1 = cA + (unsigned)(t + 1) * 128u;
            PG8_LDB(B0, 0, 0); PG8_LDB(B1, 0, 1); PG8_SCHED; PG8_LDA(At, 0, 0); PG8_STG(PG8_SA(1, 1), a1, oA[1][0], oA[1][1]);
            PG8_WAIT_V(8); PG8_WAIT_L(0); PG8_BAR; PG8_MMA(0, 0, At, B0); PG8_MMA(0, 1, At, B1); PG8_BAR; PG8_SCHED;
            unsigned a2 = cA + (unsigned)(t + 2) * 128u, b2 = cB + (unsigned)(t + 2) * 128u;
            if (last) { a2 = cA; b2 = cB;
                if (has_next) { a2 = nxt.ao; b2 = nxt.bo;
                    if constexpr (S::GATHER) { oA[0][0] = gA[0][0]; oA[0][1] = gA[0][1]; oA[1][0] = gA[1][0]; oA[1][1] = gA[1][1];
#pragma unroll
                        for (int i = 0; i < 2; ++i) { int R_, C_; stage_rc(tid * 16 + i * 8192, R_, C_); const unsigned RB_ = (unsigned)(S::PERM ? ((R_ & ~31) + perm32(R_ & 31)) : R_); oB[i] = RB_ * nxt.ldb + (unsigned)C_ * 2u; }
                        hB = 128u * nxt.ldb; }
                    else { PG8_SETUP(nxt, oA, oB, hB); } } }
            const unsigned a3 = a2 + 128u, b3 = b2 + 128u;
            PG8_LDA(At, 0, 1); PG8_STG(PG8_SB(0, 0), b2, oB[0], oB[1]); PG8_STG(PG8_SB(0, 1), b2 + hB, oB[0], oB[1]); PG8_STG(PG8_SA(0, 0), a2, oA[0][0], oA[0][1]);
            PG8_WAIT_V(8); PG8_WAIT_L(0); PG8_BAR; PG8_MMA(1, 0, At, B0); PG8_MMA(1, 1, At, B1); PG8_BAR; PG8_SCHED;
            PG8_LDB(B0, 1, 0); PG8_LDB(B1, 1, 1); PG8_SCHED; PG8_LDA(At, 1, 0); PG8_STG(PG8_SA(0, 1), a2, oA[1][0], oA[1][1]);
            PG8_WAIT_V(8); PG8_WAIT_L(0); PG8_BAR; PG8_MMA(0, 0, At, B0); PG8_MMA(0, 1, At, B1); PG8_BAR; PG8_SCHED;
            PG8_LDA(At, 1, 1); PG8_STG(PG8_SB(1, 0), b3, oB[0], oB[1]); PG8_STG(PG8_SB(1, 1), b3 + hB, oB[0], oB[1]); PG8_STG(PG8_SA(1, 0), a3, oA[0][0], oA[0][1]);
            PG8_WAIT_V(8); PG8_WAIT_L(0); PG8_BAR; PG8_MMA(1, 0, At, B0); PG8_MMA(1, 1, At, B1); PG8_BAR; PG8_SCHED;
        }
        if (wr == 0) PG8_BAR;
        { const bool pon_ = PROF_GEMM_ON(); if (pon_) { PROF_TICK(29); } sch.epi(acc, cur, wr, wc, fr, fq); if (pon_) { asm volatile("s_waitcnt vmcnt(0)" ::: "memory"); PROF_TICK(30); } }
        if (!has_next) break;
#pragma unroll
        for (int a = 0; a < 2; ++a)
#pragma unroll
            for (int b = 0; b < 2; ++b)
#pragma unroll
                for (int m = 0; m < 4; ++m)
#pragma unroll
                    for (int n = 0; n < 2; ++n) acc[a][b][m][n] = (f32x4){0.f, 0.f, 0.f, 0.f};
        cur = nxt; cA = cur.ao; cB = cur.bo; ++ui;
        if (wr == 1) PG8_BAR;
    }
    PG8_WAIT_V(0);
    PG8_BAR;
#undef PG8_SA
#undef PG8_SB
#undef PG8_STG
#undef PG8_LDA
#undef PG8_LDB
#undef PG8_MMA
#undef PG8_WAIT_V
#undef PG8_WAIT_L
#undef PG8_BAR
#undef PG8_SCHED
#undef PG8_SETUP
}
}
struct Args { const float* in[30]; float* out; unsigned char* ws; int ph_lo, ph_hi, li, pad; };
constexpr int INTAB_OFF = LDSCTL_OFF + 512;
constexpr int TILE_E_OFF = LDSCTL_OFF + 1024;
struct InTab { LAS unsigned char* lds;
    __device__ __forceinline__ const float* operator[](int i) const { return (const float*)(*(const LAS unsigned long long*)(lds + INTAB_OFF + 8 * i)); } };
struct Frame {
    LAS unsigned char* lds; volatile LAS unsigned* MISC;
    int tid, lane, wave, vcu, G;
    InTab in; float* out; unsigned char* ws;
    __device__ __forceinline__ gu32* ctl() const { return (gu32*)(ws + WS_CTL); }
    __device__ __forceinline__ bf16* H() const { return (bf16*)(ws + WS_H); }
    __device__ __forceinline__ bf16* P() const { return (bf16*)(ws + WS_P); }
    __device__ __forceinline__ float* XM() const { return (float*)(ws + WS_XM); }
    __device__ __forceinline__ float* XC() const { return (float*)(ws + WS_XC); }
    __device__ __forceinline__ float* SM() const { return (float*)(ws + WS_SM); }
    __device__ __forceinline__ float* ADA() const { return (float*)(ws + WS_ADA); }
};
enum { I_X = 0, I_C, I_CTX, I_CCTX, I_WADA, I_BADA, I_WIN, I_MLGB, I_MLNG, I_GQQG, I_GQKG, I_GLW2, I_GLB2, I_GLNG, I_WBR, I_WGATE, I_BGATE, I_WOUT,
       I_LN1G, I_LN1B, I_LN2G, I_LN2B, I_FFDWG, I_FFDWU, I_FFDWD, I_MOEWR, I_MOEBR, I_MOEWG, I_MOEWU, I_MOEWD };
__device__ __forceinline__ int set_of_panel(int pm) { return pm < 64 ? 0 : (pm < 128 ? 1 : 2); }
__device__ __forceinline__ int set_of_row(int r) { return r < T ? 0 : (r < RL ? 1 : 2); }
__device__ __forceinline__ const float* ada_vec(const Frame& F, int l, int set, int k) { return F.ADA() + ((size_t)(l * 3 + set) * 6 + k) * D; }
__device__ __forceinline__ const float* xin_row(const Frame& F, int l, int r) {
    if (l == 0) return r < RL ? F.in[I_X] + (size_t)r * D : F.in[I_CTX] + (size_t)(r - RL) * D;
    return r < RL ? F.out + (size_t)r * D : F.XC() + (size_t)(r - RL) * D;
}

typedef pg8::GU GU;
struct SchedBase { int G, c; };
struct SchedIn : SchedBase {
    static constexpr bool PERM = true, GATHER = false;
    unsigned char* ws;
    __device__ __forceinline__ bool next(int i, GU& u) const {
        if (!pg8::tile_of((long)i * G + c, NPAN, 13, u.pm, u.pn)) return false;
        u.ao = (unsigned)WS_H + (unsigned)u.pm * 256u * D * 2u; u.lda = D * 2; u.bo = (unsigned)(WS_W + W_IN) + (unsigned)u.pn * 256u * D * 2u; u.ldb = D * 2; u.nt = D / 64; return true; }
    __device__ __forceinline__ unsigned char* wsbase() const { return ws; }
    __device__ __forceinline__ void epi(const f32x4 (&acc)[2][2][4][2], const GU& u, int wr, int wc, int fr, int fq) const {
        const int row0 = u.pm * 256 + wr * 64 + fr; bf16* P = (bf16*)(ws + WS_P); float* SM = (float*)(ws + WS_SM);
        if (u.pn < 12) {
#pragma unroll
            for (int ai = 0; ai < 2; ++ai)
#pragma unroll
                for (int m = 0; m < 4; ++m) { bf16* rowp = P + (size_t)(row0 + ai * 128 + m * 16) * NP + u.pn * 256 + wc * 32 + 8 * fq;
#pragma unroll
                    for (int bj = 0; bj < 2; ++bj) { const f32x4 v0 = acc[ai][bj][m][0], v1 = acc[ai][bj][m][1];
                        v4u w; w.x = pg8::cvt_pk_bf16(v0[0], v0[1]); w.y = pg8::cvt_pk_bf16(v0[2], v0[3]); w.z = pg8::cvt_pk_bf16(v1[0], v1[1]); w.w = pg8::cvt_pk_bf16(v1[2], v1[3]);
                        *(GAS v4u*)(rowp + bj * 128) = w; } }
        } else if (wc < 2) {
            const int col = wc * 32 + 8 * fq;
#pragma unroll
            for (int ai = 0; ai < 2; ++ai)
#pragma unroll
                for (int m = 0; m < 4; ++m) { float* rowp = SM + (size_t)(row0 + ai * 128 + m * 16) * SMP + col;
                    *(GAS f32x4*)(rowp) = acc[ai][0][m][0]; *(GAS f32x4*)(rowp + 4) = acc[ai][0][m][1]; }
        }
    }
};
struct SchedMerge : SchedBase {
    static constexpr bool PERM = true, GATHER = false;
    int npan; unsigned char* ws; const float* bgate;
    __device__ __forceinline__ bool next(int i, GU& u) const {
        const int njl = (NPAN_L * 4 - c + G - 1) / G;
        int j;
        if (i < 8 * njl) { pg8::tile_of((long)(i >> 3) * G + c, NPAN_L, 4, u.pm, u.pn); const int sub = i & 7; j = sub >> 1; u.kind = sub & 1; u.aux = j; }
        else { if (npan == NPAN_L) return false; const int qi = i - 8 * njl, qj = c + (qi >> 1) * G; if (qj >= 32) return false;
            u.pm = NPAN_L + (qj >> 4); u.pn = (qj >> 2) & 3; j = qj & 3; u.kind = qi & 1; u.aux = j + (u.kind ? 4 : 0); }
        unsigned ao, bo; unsigned la, lb; int nt;
        if (u.kind == 0) { ao = (unsigned)WS_H + (unsigned)u.pm * 256u * D * 2u; la = D * 2; bo = (unsigned)(WS_W + W_GATE) + ((unsigned)j * 1024u + u.pn * 256u) * D * 2u; lb = D * 2; nt = 16; }
        else { const bool isP = (j != 1); const int tc = (j == 0) ? TC_MLO : (j == 2 ? TC_GQQ : TC_GLR); const int kk = (j == 1 || j == 2) ? 512 : 256;
            ao = isP ? (unsigned)WS_P + ((unsigned)u.pm * 256u * NP + tc) * 2u : (unsigned)(WS_XM + XO_FT) + (unsigned)u.pm * 256u * 512u * 2u; la = isP ? NP * 2 : 1024;
            const unsigned wo = (unsigned)((j == 0) ? W_BML : (j == 1 ? W_BFT : (j == 2 ? W_BAT : W_BGL)));
            bo = (unsigned)WS_W + wo + (unsigned)u.pn * 256u * kk * 2u; lb = kk * 2; nt = kk / 64; }
        u.ao = ao; u.bo = bo; u.lda = la; u.ldb = lb; u.nt = nt;
        return true; }
    __device__ __forceinline__ unsigned char* wsbase() const { return ws; }
    __device__ __forceinline__ void epi(const f32x4 (&acc)[2][2][4][2], const GU& u, int wr, int wc, int fr, int fq) const {
        const int tid = threadIdx.x; v4u* sp_ = (v4u*)(ws + WS_XM + XO_GST) + (size_t)blockIdx.x * 8192 + tid;
        if (u.kind == 0) {
            const float* bp = bgate + u.aux * 1024 + u.pn * 256 + wc * 32 + 8 * fq;
#pragma unroll
            for (int ai = 0; ai < 2; ++ai)
#pragma unroll
                for (int m = 0; m < 4; ++m)
#pragma unroll
                    for (int bj = 0; bj < 2; ++bj) { const f32x4 v0 = acc[ai][bj][m][0] + *(const GAS f32x4*)(bp + bj * 128), v1 = acc[ai][bj][m][1] + *(const GAS f32x4*)(bp + bj * 128 + 4);
                        v4u w; w.x = pg8::cvt_pk_bf16(sigm(v0[0]), sigm(v0[1])); w.y = pg8::cvt_pk_bf16(sigm(v0[2]), sigm(v0[3])); w.z = pg8::cvt_pk_bf16(sigm(v1[0]), sigm(v1[1])); w.w = pg8::cvt_pk_bf16(sigm(v1[2]), sigm(v1[3]));
                        *(GAS v4u*)sp_ = w; sp_ += 512; asm volatile("" : "+v"(sp_) :: "memory"); }
        } else {
            bf16* rowp = (u.aux < 4 ? (bf16*)(ws + WS_XM + XO_MIX) + (size_t)(u.pm * 256) * D : (bf16*)(ws + WS_UQ) + ((size_t)(u.aux - 4) * 512 + (u.pm - NPAN_L) * 256) * D) + (size_t)(wr * 64 + fr) * D + u.pn * 256 + wc * 32 + 8 * fq;
            const bool accum = (u.aux > 0 && u.aux < 4);
            bf16* nxp = rowp; v4u g_n = *(const GAS v4u*)sp_; v4u p_n = (v4u){0u, 0u, 0u, 0u}; if (accum) p_n = *(const GAS v4u*)nxp;
#pragma unroll
            for (int e = 0; e < 16; ++e) { const int ai = e >> 3, m = (e >> 1) & 3, bj = e & 1;
                const v4u g = g_n, p = p_n; bf16* curp = nxp;
                if (e < 15) { sp_ += 512; asm volatile("" : "+v"(sp_)); nxp += (bj == 0) ? 128 : ((m == 3 ? 80 : 16) * D - 128); asm volatile("" : "+v"(nxp));
                    g_n = *(const GAS v4u*)sp_; if (accum) p_n = *(const GAS v4u*)nxp; }
                const f32x4 a0 = acc[ai][bj][m][0], a1 = acc[ai][bj][m][1];
                const float o0 = bflo(g.x) * a0[0] + bflo(p.x), o1 = bfhi(g.x) * a0[1] + bfhi(p.x), o2 = bflo(g.y) * a0[2] + bflo(p.y), o3 = bfhi(g.y) * a0[3] + bfhi(p.y);
                const float o4 = bflo(g.z) * a1[0] + bflo(p.z), o5 = bfhi(g.z) * a1[1] + bfhi(p.z), o6 = bflo(g.w) * a1[2] + bflo(p.w), o7 = bfhi(g.w) * a1[3] + bfhi(p.w);
                v4u w; w.x = pg8::cvt_pk_bf16(o0, o1); w.y = pg8::cvt_pk_bf16(o2, o3); w.z = pg8::cvt_pk_bf16(o4, o5); w.w = pg8::cvt_pk_bf16(o6, o7);
                *(GAS v4u*)curp = w; }
        }
    }
};
struct SchedOut : SchedBase {
    static constexpr bool PERM = false, GATHER = false;
    int npan, l; unsigned char* ws; const float* xlat; const float* xctx;
    __device__ __forceinline__ bool next(int i, GU& u) const {
        const int nul = (NPAN_L * 4 - c + G - 1) / G;
        if (i < nul) { pg8::tile_of((long)i * G + c, NPAN_L, 4, u.pm, u.pn); u.ao = (unsigned)(WS_XM + XO_MIX) + (unsigned)u.pm * 256u * D * 2u; }
        else { if (npan == NPAN_L) return false; const int q = c + (i - nul) * G; if (q >= 8) return false; u.pm = NPAN_L + (q >> 2); u.pn = q & 3; u.ao = (unsigned)WS_PA + (unsigned)q * 524288u; }
        u.lda = D * 2; u.bo = (unsigned)(WS_W + W_OUT) + (unsigned)u.pn * 256u * D * 2u; u.ldb = D * 2; u.nt = 16; return true; }
    __device__ __forceinline__ unsigned char* wsbase() const { return ws; }
    __device__ __forceinline__ void epi(const f32x4 (&acc)[2][2][4][2], const GU& u, int wr, int wc, int fr, int fq) const {
        const int r0 = u.pm * 256, col0 = u.pn * 256 + wc * 32 + 4 * fq, rl = wr * 64 + fr; const float* ada = (const float*)(ws + WS_ADA); float* XM = (float*)(ws + WS_P);
        const float* xs = r0 < RL ? xlat + (size_t)r0 * D : xctx + (size_t)(r0 - RL) * D; const float* gv = ada + ((size_t)(l * 3 + set_of_panel(u.pm)) * 6 + 2) * D + col0;
        f32x4 gg[2][2];
#pragma unroll
        for (int bj = 0; bj < 2; ++bj)
#pragma unroll
            for (int n = 0; n < 2; ++n) gg[bj][n] = *(const GAS f32x4*)(gv + bj * 128 + n * 16);
        const float* xp = xs + (size_t)rl * D + col0; float* op = XM + (size_t)(r0 + rl) * D + col0;
        f32x4 xq[4][4];
#pragma unroll
        for (int g = 0; g < 4; ++g) { xq[g][0] = *(const GAS f32x4*)(xp); xq[g][1] = *(const GAS f32x4*)(xp + 16); xq[g][2] = *(const GAS f32x4*)(xp + 128); xq[g][3] = *(const GAS f32x4*)(xp + 144);
            xp += (g == 3 ? 80 : 16) * D; asm volatile("" : "+v"(xp)); }
#pragma unroll
        for (int g = 0; g < 8; ++g) { const int ai = g >> 2, m = g & 3;
            const f32x4 x00 = xq[g & 3][0], x01 = xq[g & 3][1], x10 = xq[g & 3][2], x11 = xq[g & 3][3]; float* oc = op;
            if (g < 4) { xq[g & 3][0] = *(const GAS f32x4*)(xp); xq[g & 3][1] = *(const GAS f32x4*)(xp + 16); xq[g & 3][2] = *(const GAS f32x4*)(xp + 128); xq[g & 3][3] = *(const GAS f32x4*)(xp + 144);
                xp += 16 * D; asm volatile("" : "+v"(xp)); }
            if (g < 7) { op += (m == 3 ? 80 : 16) * D; asm volatile("" : "+v"(op)); }
            *(GAS f32x4*)(oc) = x00 * ALPHA + gg[0][0] * acc[ai][0][m][0]; *(GAS f32x4*)(oc + 16) = x01 * ALPHA + gg[0][1] * acc[ai][0][m][1];
            *(GAS f32x4*)(oc + 128) = x10 * ALPHA + gg[1][0] * acc[ai][1][m][0]; *(GAS f32x4*)(oc + 144) = x11 * ALPHA + gg[1][1] * acc[ai][1][m][1]; }
    }
};
__device__ __forceinline__ void swiglu_store(const f32x4 (&acc)[2][2][4][2], bf16* ACT, size_t pitch, int row0, int hid0, int wc, int fq) {
#pragma unroll
    for (int ai = 0; ai < 2; ++ai)
#pragma unroll
        for (int m = 0; m < 4; ++m) { bf16* rowp = ACT + (size_t)(row0 + ai * 128 + m * 16) * pitch + hid0 + wc * 16 + 4 * fq;
#pragma unroll
            for (int bj = 0; bj < 2; ++bj) { const f32x4 g = acc[ai][bj][m][0], uu = acc[ai][bj][m][1];
                v2u w; w.x = pg8::cvt_pk_bf16(g[0] * sigm(g[0]) * uu[0], g[1] * sigm(g[1]) * uu[1]); w.y = pg8::cvt_pk_bf16(g[2] * sigm(g[2]) * uu[2], g[3] * sigm(g[3]) * uu[3]);
                *(GAS v2u*)(rowp + bj * 64) = w; } }
}
struct SchedUp : SchedBase {
    static constexpr bool PERM = true, GATHER = false;
    unsigned char* ws;
    __device__ __forceinline__ bool next(int i, GU& u) const {
        if (!pg8::tile_of((long)i * G + c, NPAN, 22, u.pm, u.pn)) return false;
        u.ao = (unsigned)WS_H + (unsigned)u.pm * 256u * D * 2u; u.lda = D * 2; u.bo = (unsigned)(WS_W + W_FFD_GU) + (unsigned)u.pn * 256u * D * 2u; u.ldb = D * 2; u.nt = 16; return true; }
    __device__ __forceinline__ unsigned char* wsbase() const { return ws; }
    __device__ __forceinline__ void epi(const f32x4 (&acc)[2][2][4][2], const GU& u, int wr, int wc, int fr, int fq) const {
        swiglu_store(acc, (bf16*)(ws + WS_P), FFD, u.pm * 256 + wr * 64 + fr, u.pn * 128, wc, fq); }
};
struct SchedDown : SchedBase {
    static constexpr bool PERM = false, GATHER = false;
    int l; unsigned char* ws;
    __device__ __forceinline__ bool next(int i, GU& u) const {
        const int nul = (NPAN_L * 4 - c + G - 1) / G; u.aux = 0; u.nt = FFD / 64; unsigned ko = 0;
        if (i < nul) pg8::tile_of((long)i * G + c, NPAN_L, 4, u.pm, u.pn);
        else { const int q = c + (i - nul) * G; if (q >= 16) return false; u.pm = NPAN_L + (q >> 3); u.pn = (q >> 1) & 3; u.aux = 1 + (q & 1); u.nt = FFD / 128; ko = (unsigned)(q & 1) * (FFD / 128) * 128u; }
        u.ao = (unsigned)WS_P + (unsigned)u.pm * 256u * FFD * 2u + ko; u.lda = FFD * 2; u.bo = (unsigned)(WS_W + W_FFD_D) + (unsigned)u.pn * 256u * FFD * 2u + ko; u.ldb = FFD * 2; return true; }
    __device__ __forceinline__ unsigned char* wsbase() const { return ws; }
    __device__ __forceinline__ void epi(const f32x4 (&acc)[2][2][4][2], const GU& u, int wr, int wc, int fr, int fq) const {
        const int col0 = u.pn * 256 + wc * 32 + 4 * fq, row0 = u.pm * 256 + wr * 64 + fr; const float* ada = (const float*)(ws + WS_ADA); float* XM = (float*)(ws + WS_XM);
        if (u.aux) { float* dp = (float*)(ws + WS_DP) + ((size_t)(u.aux - 1) * 512 + (row0 - RL)) * D + col0;
#pragma unroll
            for (int ai = 0; ai < 2; ++ai)
#pragma unroll
                for (int m = 0; m < 4; ++m)
#pragma unroll
                    for (int bj = 0; bj < 2; ++bj)
#pragma unroll
                        for (int n = 0; n < 2; ++n) *(GAS f32x4*)(dp + (size_t)(ai * 128 + m * 16) * D + bj * 128 + n * 16) = acc[ai][bj][m][n];
            return; }
        const float* gv = ada + ((size_t)(l * 3 + set_of_panel(u.pm)) * 6 + 5) * D + col0;
        f32x4 gg[2][2];
#pragma unroll
        for (int bj = 0; bj < 2; ++bj)
#pragma unroll
            for (int n = 0; n < 2; ++n) gg[bj][n] = *(const GAS f32x4*)(gv + bj * 128 + n * 16);
        const float* xp = XM + (size_t)row0 * D + col0; float* op = XM + (size_t)row0 * D + col0;
        f32x4 xq[4][4];
#pragma unroll
        for (int g = 0; g < 4; ++g) { xq[g][0] = *(const GAS f32x4*)(xp); xq[g][1] = *(const GAS f32x4*)(xp + 16); xq[g][2] = *(const GAS f32x4*)(xp + 128); xq[g][3] = *(const GAS f32x4*)(xp + 144);
            xp += (g == 3 ? 80 : 16) * D; asm volatile("" : "+v"(xp)); }
#pragma unroll
        for (int g = 0; g < 8; ++g) { const int ai = g >> 2, m = g & 3;
            const f32x4 x00 = xq[g & 3][0], x01 = xq[g & 3][1], x10 = xq[g & 3][2], x11 = xq[g & 3][3]; float* oc = op;
            if (g < 4) { xq[g & 3][0] = *(const GAS f32x4*)(xp); xq[g & 3][1] = *(const GAS f32x4*)(xp + 16); xq[g & 3][2] = *(const GAS f32x4*)(xp + 128); xq[g & 3][3] = *(const GAS f32x4*)(xp + 144);
                xp += 16 * D; asm volatile("" : "+v"(xp)); }
            if (g < 7) { op += (m == 3 ? 80 : 16) * D; asm volatile("" : "+v"(op)); }
            *(GAS f32x4*)(oc) = x00 * ALPHA + gg[0][0] * acc[ai][0][m][0]; *(GAS f32x4*)(oc + 16) = x01 * ALPHA + gg[0][1] * acc[ai][0][m][1];
            *(GAS f32x4*)(oc + 128) = x10 * ALPHA + gg[1][0] * acc[ai][1][m][0]; *(GAS f32x4*)(oc + 144) = x11 * ALPHA + gg[1][1] * acc[ai][1][m][1]; }
    }
};
struct MoeTabs { unsigned char* ws; LAS unsigned char* lds;
    __device__ __forceinline__ int tile_e_lds(int t) const { return ((const LAS int*)(lds + TILE_E_OFF))[t]; }
    __device__ __forceinline__ const int* tok() const { return (const int*)(ws + WS_MOE + MO_TOK); }
    __device__ __forceinline__ const int* dst() const { return (const int*)(ws + WS_MOE + MO_DST); }
    __device__ __forceinline__ const int* tile_e() const { return (const int*)(ws + WS_MOE + MO_SEL + (size_t)RL * 16); }
    __device__ __forceinline__ const int* ntiles() const { return tile_e() + 512; } };
struct SchedMoeUp : SchedBase {
    static constexpr bool PERM = true, GATHER = true;
    MoeTabs mt; int nt_;
    __device__ __forceinline__ bool next(int i, GU& u) const {
        if (!pg8::tile_of((long)i * G + c, nt_, 11, u.pm, u.pn)) return false;
        const int e = mt.tile_e_lds(u.pm); u.aux = e;
        u.ao = (unsigned)WS_H; u.lda = D * 2; u.bo = (unsigned)(WS_W + W_MOE_GU) + ((unsigned)e * 2816u + u.pn * 256u) * D * 2u; u.ldb = D * 2; u.nt = 16; return true; }
    __device__ __forceinline__ unsigned char* wsbase() const { return mt.ws; }
    __device__ __forceinline__ unsigned arow(const GU& u, int r) const { return (unsigned)((const GAS int*)mt.tok())[u.pm * 256 + r] * (unsigned)(D * 2); }
    __device__ __forceinline__ void epi(const f32x4 (&acc)[2][2][4][2], const GU& u, int wr, int wc, int fr, int fq) const {
        swiglu_store(acc, (bf16*)(mt.ws + WS_P), FFE, u.pm * 256 + wr * 64 + fr, u.pn * 128, wc, fq); }
};
struct SchedMoeDown : SchedBase {
    static constexpr bool PERM = true, GATHER = false;
    MoeTabs mt; bf16* Dst; int nt_;
    __device__ __forceinline__ bool next(int i, GU& u) const {
        if (!pg8::tile_of((long)i * G + c, nt_, 4, u.pm, u.pn)) return false;
        const int e = mt.tile_e_lds(u.pm);
        u.ao = (unsigned)WS_P + (unsigned)u.pm * 256u * FFE * 2u; u.lda = FFE * 2; u.bo = (unsigned)(WS_W + W_MOE_D) + ((unsigned)e * 1024u + u.pn * 256u) * FFE * 2u; u.ldb = FFE * 2; u.nt = FFE / 64; return true; }
    __device__ __forceinline__ unsigned char* wsbase() const { return mt.ws; }
    __device__ __forceinline__ void epi(const f32x4 (&acc)[2][2][4][2], const GU& u, int wr, int wc, int fr, int fq) const {
        const int srow0 = u.pm * 256 + wr * 64 + fr;
#pragma unroll
        for (int ai = 0; ai < 2; ++ai)
#pragma unroll
            for (int m = 0; m < 4; ++m) { asm volatile("" ::: "memory"); const int d = ((const GAS int*)mt.dst())[srow0 + ai * 128 + m * 16];
                if (d >= 0) { bf16* rowp = Dst + (size_t)d * D + u.pn * 256 + wc * 32 + 8 * fq;
#pragma unroll
                    for (int bj = 0; bj < 2; ++bj) { const f32x4 v0 = acc[ai][bj][m][0], v1 = acc[ai][bj][m][1];
                        v4u w; w.x = pg8::cvt_pk_bf16(v0[0], v0[1]); w.y = pg8::cvt_pk_bf16(v0[2], v0[3]); w.z = pg8::cvt_pk_bf16(v1[0], v1[1]); w.w = pg8::cvt_pk_bf16(v1[2], v1[3]);
                        *(GAS v4u*)(rowp + bj * 128) = w; } } }
    }
};
struct CvSeg { int first, K, nblk, ldw, kind; unsigned dst; const float* a; const float* b; };
constexpr int CVSEG_OFF = 12288, CVTOT_OFF = CVSEG_OFF + 2040;
#define RFL(x) __builtin_amdgcn_readfirstlane(x)
__device__ __forceinline__ const float* rfl_ptr(const float* p) { const unsigned long long v = (unsigned long long)p; const unsigned lo = RFL((unsigned)v), hi = RFL((unsigned)(v >> 32)); return (const float*)(((unsigned long long)hi << 32) | lo); }
__device__ __forceinline__ const float* cv_src(int kind, const float* a, const float* b, int n) {
    if (kind == 0) return a + n;
    if (kind == 1) { int o;
        if (n < 1024) o = n; else if (n < 1280) o = 1040 + (n - 1024); else if (n < 1792) o = 1296 + (n - 1280); else if (n < 2048) o = 1808 + (n - 1792);
        else if (n < 3072) o = 2064 + (n - 2048); else { const int j = n - 3072; if (j < 16) o = 1024 + j; else if (j < 48) o = 3088 + (j - 16); else return nullptr; }
        return a + o; }
    const int hid = (n >> 8) * 128 + ((n & 255) >> 3) * 4 + (n & 3); const long dlt = (n & 4) ? (long)(b - a) : 0l; return a + dlt + hid; }

__device__ __forceinline__ void convert_layer_weights(const Frame& F, int l) {
    unsigned char* wb = F.ws + WS_W;
    LAS CvSeg* seg = (LAS CvSeg*)(F.lds + CVSEG_OFF);
    const float* wbr = F.in[I_WBR] + (size_t)l * 1280 * D;
    __syncthreads();
    if (F.tid == 0) { int ns = 0, tot = 0;
#define CV_ADD(K_, N_, LDW_, KIND_, DST_, A_, B_) do { LAS CvSeg* g_ = seg + ns; g_->first = tot; g_->K = (K_); g_->nblk = (N_) / 32; g_->ldw = (LDW_); g_->kind = (KIND_); g_->dst = (unsigned)(DST_); g_->a = (A_); g_->b = (B_); tot += ((K_) / 64) * ((N_) / 32); ++ns; } while (0)
        CV_ADD(D, 3328, NIN, 1, W_IN, F.in[I_WIN] + (size_t)l * D * NIN, (const float*)nullptr);
        CV_ADD(D, 4096, 4096, 0, W_GATE, F.in[I_WGATE] + (size_t)l * D * 4096, (const float*)nullptr);
        CV_ADD(D, D, D, 0, W_OUT, F.in[I_WOUT] + (size_t)l * D * D, (const float*)nullptr);
        CV_ADD(256, D, D, 0, W_BML, wbr, (const float*)nullptr);
        CV_ADD(512, D, D, 0, W_BAT, wbr + (size_t)512 * D, (const float*)nullptr);
        CV_ADD(256, D, D, 0, W_BGL, wbr + (size_t)1024 * D, (const float*)nullptr);
        if (l == 0) { CV_ADD(D, 2 * FFD, FFD, 2, W_FFD_GU, F.in[I_FFDWG], F.in[I_FFDWU]); CV_ADD(FFD, D, D, 0, W_FFD_D, F.in[I_FFDWD], (const float*)nullptr); }
        else { const float* wg = F.in[I_MOEWG]; const float* wu = F.in[I_MOEWU]; const float* wd = F.in[I_MOEWD];
            for (int e = 0; e < NEXP; ++e) { CV_ADD(D, 2 * FFE, FFE, 2, W_MOE_GU + (size_t)e * 2816 * D * 2, wg + (size_t)e * D * FFE, wu + (size_t)e * D * FFE);
                CV_ADD(FFE, D, D, 0, W_MOE_D + (size_t)e * 1024 * FFE * 2, wd + (size_t)e * FFE * D, (const float*)nullptr); } }
#undef CV_ADD
        seg[ns].first = tot; *(LAS int*)(F.lds + CVTOT_OFF) = tot; }
    __syncthreads();
    {   const int total = RFL(*(const LAS int*)(F.lds + CVTOT_OFF));
        LAS float* scr = (LAS float*)(F.lds + F.wave * 16384);
        const int gw = F.vcu * NWAVES + F.wave, NGW = F.G * NWAVES, lane = F.lane;
        int s = 0, nK = 0, nkb = 0, nnb = 0; unsigned ndst = 0u;
        float tn[32];
#define CV_FETCH(it_) do { while ((it_) >= RFL(seg[s + 1].first)) ++s; const int loc_ = (it_) - RFL(seg[s].first), nblk_ = RFL(seg[s].nblk); nkb = loc_ / nblk_; nnb = loc_ - nkb * nblk_; nK = RFL(seg[s].K); ndst = RFL(seg[s].dst); \
        const int ldw_ = RFL(seg[s].ldw), kind_ = RFL(seg[s].kind); const float* a_ = rfl_ptr(seg[s].a); const float* b_ = rfl_ptr(seg[s].b); \
        const float* src_ = cv_src(kind_, a_, b_, 32 * nnb + (lane & 31)); \
        _Pragma("unroll") for (int i = 0; i < 32; ++i) { const int kk = 2 * i + (lane >> 5); tn[i] = src_ ? ((const GAS float*)src_)[(size_t)(64 * nkb + kk) * ldw_] : 0.f; } } while (0)
        if (gw < total) CV_FETCH(gw);
        for (int it = gw; it < total; it += NGW) {
            const int K = nK, k0 = 64 * nkb, n0 = 32 * nnb; bf16* WT = (bf16*)(wb + ndst);
            float tv[32];
#pragma unroll
            for (int i = 0; i < 32; ++i) tv[i] = tn[i];
            if (it + NGW < total) CV_FETCH(it + NGW);
#pragma unroll
            for (int i = 0; i < 32; ++i) { const int kk = 2 * i + (lane >> 5); scr[kk * 33 + (lane & 31)] = tv[i]; }
            LDS_WAIT(); asm volatile("" ::: "memory");
            const int c = lane & 7;
#pragma unroll
            for (int j = 0; j < 4; ++j) { const int n = (lane >> 3) + 8 * j; const LAS float* sq = scr + (8 * c) * 33 + n;
                v4u o; o.x = pk2(sq[0 * 33], sq[1 * 33]); o.y = pk2(sq[2 * 33], sq[3 * 33]); o.z = pk2(sq[4 * 33], sq[5 * 33]); o.w = pk2(sq[6 * 33], sq[7 * 33]);
                *(GAS v4u*)(WT + (size_t)(n0 + n) * K + k0 + 8 * c) = o; }
            LDS_WAIT(); asm volatile("" ::: "memory");
        }
#undef CV_FETCH
    }
    { bf16* WT = (bf16*)(wb + W_BFT); const float* src = wbr + (size_t)256 * D;
      LAS f32x2* tcs = (LAS f32x2*)(F.lds + 131072 - 512);
      __syncthreads(); if (F.tid < 64) { const float ph = (float)F.tid * (1.f / 32.f); tcs[F.tid] = (f32x2){cospif(ph), sinpif(ph)}; } __syncthreads();
      if (F.tid < 256) for (int idx = F.vcu * 256 + F.tid; idx < 4 * 16 * 1024; idx += F.G * 256) { const int n = idx & 1023, c0 = ((idx >> 10) & 15) * 4, g = idx >> 14;
          float ac[4] = {0.f, 0.f, 0.f, 0.f}, as[4] = {0.f, 0.f, 0.f, 0.f};
#pragma unroll 1
          for (int q = 0; q < 4; ++q) { float v[16];
#pragma unroll
              for (int kk = 0; kk < 16; ++kk) v[kk] = ((const GAS float*)src)[(size_t)(64 * g + 16 * q + kk) * D + n];
#pragma unroll
              for (int kk = 0; kk < 16; ++kk) {
#pragma unroll
                  for (int j = 0; j < 4; ++j) { const f32x2 t = tcs[((16 * q + kk) * (c0 + j)) & 63]; ac[j] += t.x * v[kk]; as[j] += t.y * v[kk]; } } }
          bf16* o = WT + (size_t)n * 512 + g * 64 + c0;
          *(GAS v2u*)o = (v2u){pk2(ac[0] * 0.125f, ac[1] * 0.125f), pk2(ac[2] * 0.125f, ac[3] * 0.125f)};
          *(GAS v2u*)(o + 256) = (v2u){pk2(as[0] * 0.125f, as[1] * 0.125f), pk2(as[2] * 0.125f, as[3] * 0.125f)}; }
      __syncthreads(); }
}
__device__ __forceinline__ void build_tables(const Frame& F) {
    const int gt = F.vcu * 512 + F.tid, NT_ = F.G * 512;
    float* rc = (float*)(F.ws + WS_ROPE_C); float* rs = (float*)(F.ws + WS_ROPE_S);
    for (int i = gt; i < 256 * 16; i += NT_) { const int pos = i >> 4, p = i & 15;
        double inv = (p & 3) == 0 ? 1.0 : ((p & 3) == 1 ? 0.5623413251903491 : ((p & 3) == 2 ? 0.31622776601683794 : 0.17782794100389228));
        for (int q = 0; q < (p >> 2); ++q) inv *= 0.1;
        const float angf = (float)pos * (float)inv;
        double xr = (double)angf * 0.3183098861837907; xr -= 2.0 * rint(xr * 0.5);
        rc[i] = cospif((float)xr); rs[i] = sinpif((float)xr); }
    bf16* dc = (bf16*)(F.ws + WS_DFT_C); bf16* ds = (bf16*)(F.ws + WS_DFT_S);
    for (int i = gt; i < 128 * 128; i += NT_) { const int j = i >> 7, k = i & 127; const float ph = (float)((j * k) & 127) * (1.f / 64.f); dc[i] = (bf16)f2bf(cospif(ph)); ds[i] = (bf16)f2bf(sinpif(ph)); }
}
__device__ __forceinline__ void ada_phase(const Frame& F) {
    LAS float* sc = (LAS float*)(F.lds);
    LAS float* red = (LAS float*)(F.lds + 16384);
    for (int i = F.tid; i < 3 * D; i += 512) { const int s = i >> 10, k = i & 1023; const float v = s < 2 ? F.in[I_C][s * D + k] : F.in[I_CCTX][k]; sc[i] = v * sigm(v); }
    __syncthreads();
    for (int task = F.vcu; task < 2 * 96; task += F.G) { const int l = task / 96, cb = task % 96, col = cb * 64 + F.lane;
        const float* w = F.in[I_WADA] + (size_t)l * D * 6144 + col; float a0 = 0.f, a1 = 0.f, a2 = 0.f;
        const int kb = F.wave * 128;
#pragma unroll 32
        for (int k = 0; k < 128; ++k) { const float wv = ((const GAS float*)w)[(size_t)(kb + k) * 6144]; a0 += sc[kb + k] * wv; a1 += sc[D + kb + k] * wv; a2 += sc[2 * D + kb + k] * wv; }
        red[(F.wave * 3 + 0) * 64 + F.lane] = a0; red[(F.wave * 3 + 1) * 64 + F.lane] = a1; red[(F.wave * 3 + 2) * 64 + F.lane] = a2;
        __syncthreads();
        if (F.tid < 192) { const int s = F.tid >> 6, ln = F.tid & 63; float t = 0.f;
#pragma unroll
            for (int w8 = 0; w8 < 8; ++w8) t += red[(w8 * 3 + s) * 64 + ln];
            F.ADA()[(size_t)(l * 3 + s) * 6144 + cb * 64 + ln] = t + F.in[I_BADA][(size_t)l * 6144 + cb * 64 + ln]; }
        __syncthreads();
    }
}
struct Row16 { f32x4 v[4]; };
__device__ __forceinline__ Row16 ld_row(const float* p, int lane) { Row16 r; const GAS f32x4* q = (const GAS f32x4*)p + lane;
#pragma unroll
    for (int j = 0; j < 4; ++j) r.v[j] = q[64 * j];
    return r; }
__device__ __forceinline__ void st_row(float* p, int lane, const Row16& r) { GAS f32x4* q = (GAS f32x4*)p + lane;
#pragma unroll
    for (int j = 0; j < 4; ++j) q[64 * j] = r.v[j]; }
__device__ __forceinline__ void ln_norm(Row16& r) {
    float s = 0.f;
#pragma unroll
    for (int j = 0; j < 4; ++j) s += (r.v[j].x + r.v[j].y) + (r.v[j].z + r.v[j].w);
    const float mean = wave_sum(s) * (1.f / D); float s2 = 0.f;
#pragma unroll
    for (int j = 0; j < 4; ++j) { r.v[j] = r.v[j] - mean; s2 += (r.v[j].x * r.v[j].x + r.v[j].y * r.v[j].y) + (r.v[j].z * r.v[j].z + r.v[j].w * r.v[j].w); }
    const float rstd = 1.f / sqrtf(wave_sum(s2) * (1.f / D) + LN_EPS);
#pragma unroll
    for (int j = 0; j < 4; ++j) r.v[j] = r.v[j] * rstd;
}
__device__ __forceinline__ void affine(Row16& r, const float* g, const float* b, int lane, bool one_plus) {
    const Row16 gg = ld_row(g, lane), bb = ld_row(b, lane);
#pragma unroll
    for (int j = 0; j < 4; ++j) r.v[j] = r.v[j] * (one_plus ? gg.v[j] + 1.0f : gg.v[j]) + bb.v[j];
}
__device__ __forceinline__ void affine_r(Row16& r, const Row16& gg, const Row16& bb, bool one_plus) {
#pragma unroll
    for (int j = 0; j < 4; ++j) r.v[j] = r.v[j] * (one_plus ? gg.v[j] + 1.0f : gg.v[j]) + bb.v[j];
}
__device__ __forceinline__ void st_row_bf16(bf16* p, int lane, const Row16& r) { GAS v2u* q = (GAS v2u*)p + lane;
#pragma unroll
    for (int j = 0; j < 4; ++j) { v2u w; w.x = pk2(r.v[j].x, r.v[j].y); w.y = pk2(r.v[j].z, r.v[j].w); q[64 * j] = w; } }
__device__ __forceinline__ void phase_ln_mod(const Frame& F, int l) {
    const int gw = F.vcu * NWAVES + F.wave, NGW = F.G * NWAVES;
    Row16 nx; if (gw < R) nx = ld_row(xin_row(F, l, gw), F.lane);
    int cs = -1; Row16 asc, ash;
    for (int r = gw; r < R; r += NGW) { Row16 x = nx; if (r + NGW < R) nx = ld_row(xin_row(F, l, r + NGW), F.lane);
        ln_norm(x); const int s = set_of_row(r); if (s != cs) { cs = s; asc = ld_row(ada_vec(F, l, s, 1), F.lane); ash = ld_row(ada_vec(F, l, s, 0), F.lane); }
        affine_r(x, asc, ash, true); st_row_bf16(F.H() + (size_t)r * D, F.lane, x); }
}
__device__ __forceinline__ void phase_qk(const Frame& F, int l, bool dry = false) {
    const int gw = F.vcu * NWAVES + F.wave, NGW = F.G * NWAVES, lane = F.lane, hd = lane >> 2, qd = lane & 3;
    const float* rc = (const float*)(F.ws + WS_ROPE_C); const float* rs = (const float*)(F.ws + WS_ROPE_S);
    const float* gq = F.in[I_GQQG] + l * 64; const float* gk = F.in[I_GQKG] + l * 64;
    const int coff = (hd < 8 ? TC_GQQ + hd * 64 : TC_GQK + (hd - 8) * 64) + qd * 16;
    float gl_[16];
    { const float* g = (hd < 8 ? gq : gk) + qd * 16;
#pragma unroll
        for (int i = 0; i < 16; ++i) gl_[i] = ((const GAS float*)g)[i]; }
    v4u na = {0u, 0u, 0u, 0u}, nb = {0u, 0u, 0u, 0u};
    if (gw < R && hd < 10) { const bf16* p0 = F.P() + (size_t)gw * NP + coff; na = *(const GAS v4u*)p0; nb = *(const GAS v4u*)(p0 + 8); }
    for (int r = gw; r < R; r += NGW) {
        float x[16]; bf16* p = F.P() + (size_t)r * NP + coff;
        const v4u a = na, b = nb;
        if (r + NGW < R && hd < 10) { const bf16* p1 = F.P() + (size_t)(r + NGW) * NP + coff; na = *(const GAS v4u*)p1; nb = *(const GAS v4u*)(p1 + 8); }
        float ss = 0.f;
        if (hd < 10) {
            x[0] = bflo(a.x); x[1] = bfhi(a.x); x[2] = bflo(a.y); x[3] = bfhi(a.y); x[4] = bflo(a.z); x[5] = bfhi(a.z); x[6] = bflo(a.w); x[7] = bfhi(a.w);
            x[8] = bflo(b.x); x[9] = bfhi(b.x); x[10] = bflo(b.y); x[11] = bfhi(b.y); x[12] = bflo(b.z); x[13] = bfhi(b.z); x[14] = bflo(b.w); x[15] = bfhi(b.w);
#pragma unroll
            for (int i = 0; i < 16; ++i) ss += x[i] * x[i]; }
        else {
#pragma unroll
            for (int i = 0; i < 16; ++i) x[i] = 0.f; }
        ss += dpp_get<0xB1>(ss); ss += dpp_get<0x4E>(ss);
        const float rstd = __builtin_amdgcn_rsqf(ss * (1.f / 64.f) + LN_EPS);
#pragma unroll
        for (int i = 0; i < 16; ++i) x[i] = x[i] * rstd * gl_[i];
        float y[16];
#pragma unroll
        for (int i = 0; i < 16; ++i) y[i] = dpp_get<0xB1>(x[i]);
        if (r < RL) { const int t = r & (T - 1), pos = (qd >> 1) ? (t & 63) : (t >> 6); const GAS f32x4* c4 = (const GAS f32x4*)(rc + pos * 16); const GAS f32x4* s4 = (const GAS f32x4*)(rs + pos * 16);
            const f32x4 cv[4] = {c4[0], c4[1], c4[2], c4[3]}, sv[4] = {s4[0], s4[1], s4[2], s4[3]};
#pragma unroll
            for (int i = 0; i < 16; ++i) { const float c = cv[i >> 2][i & 3], s = sv[i >> 2][i & 3]; x[i] = (qd & 1) ? (y[i] * s + x[i] * c) : (x[i] * c - y[i] * s); } }
        if (hd < 8) {
#pragma unroll
            for (int i = 0; i < 16; ++i) x[i] *= C2Q; }
        if (hd < 10 && !dry) { v4u a, b; a.x = pk2(x[0], x[1]); a.y = pk2(x[2], x[3]); a.z = pk2(x[4], x[5]); a.w = pk2(x[6], x[7]); b.x = pk2(x[8], x[9]); b.y = pk2(x[10], x[11]); b.z = pk2(x[12], x[13]); b.w = pk2(x[14], x[15]);
            *(GAS v4u*)p = a; *(GAS v4u*)(p + 8) = b; }
    }
}
__device__ __forceinline__ void build_ctx_panels(const Frame& F) {
    const int q = (int)blockIdx.x; if (q >= 8) return;
    const bf16* uq = (const bf16*)(F.ws + WS_UQ) + (size_t)(q >> 2) * 256 * D; bf16* pa = (bf16*)(F.ws + WS_PA) + (size_t)q * 256 * D;
    for (int idx = F.tid; idx < 256 * D / 8; idx += 512) { float a[8], t[8]; unpack8(*(const v4u*)(uq + (size_t)idx * 8), a);
#pragma unroll
        for (int j = 1; j < 4; ++j) { unpack8(*(const v4u*)(uq + (size_t)j * 512 * D + (size_t)idx * 8), t);
#pragma unroll
            for (int e = 0; e < 8; ++e) a[e] += t[e]; }
        *(v4u*)(pa + (size_t)idx * 8) = pack8(a); }
    asm volatile("s_waitcnt vmcnt(0)" ::: "memory"); __syncthreads();
}
__device__ __forceinline__ void phase_post_mix(const Frame& F, int l, int nrows, const float* T1) {
    const int gw = F.vcu * NWAVES + F.wave, NGW = F.G * NWAVES, lane = F.lane;
    volatile LAS int* hist = (volatile LAS int*)(F.lds + 1024);
    float brv[8];
#pragma unroll
    for (int e = 0; e < 8; ++e) brv[e] = (l == 1) ? ((const GAS float*)F.in[I_MOEBR])[e] : 0.f;
    if (l == 1) { if (F.tid < 8) hist[F.tid] = 0; __syncthreads(); }
    const Row16 g1 = ld_row(F.in[I_LN1G] + l * D, lane), b1 = ld_row(F.in[I_LN1B] + l * D, lane);
    int cs = -1; Row16 asc, ash;
    LAS float* wrl = (LAS float*)(F.lds + 4096);
    if (l == 1) { for (int i = F.tid; i < D * 8 / 4; i += 512) *(LAS f32x4*)(wrl + i * 4) = *(const GAS f32x4*)(F.in[I_MOEWR] + i * 4); __syncthreads(); }
    Row16 nx; if (gw < nrows) nx = ld_row(T1 + (size_t)gw * D, lane);
    for (int r = gw; r < nrows; r += NGW) {
        Row16 x = nx; if (r + NGW < nrows) nx = ld_row(T1 + (size_t)(r + NGW) * D, lane);
        ln_norm(x); affine_r(x, g1, b1, false);
        st_row(F.XM() + (size_t)r * D, lane, x);
        ln_norm(x); const int s = set_of_row(r); if (s != cs) { cs = s; asc = ld_row(ada_vec(F, l, s, 4), lane); ash = ld_row(ada_vec(F, l, s, 3), lane); }
        affine_r(x, asc, ash, true);
        st_row_bf16(F.H() + (size_t)r * D, lane, x);
        if (l == 1) {
            float lg[8];
#pragma unroll
            for (int e = 0; e < 8; ++e) lg[e] = 0.f;
#pragma unroll
            for (int j = 0; j < 4; ++j)
#pragma unroll
                for (int q = 0; q < 4; ++q) { const float xv = x.v[j][q]; const LAS f32x4* wp = (const LAS f32x4*)(wrl + (256 * j + 4 * lane + q) * 8); const f32x4 w0 = wp[0], w1 = wp[1];
                    lg[0] += xv * w0.x; lg[1] += xv * w0.y; lg[2] += xv * w0.z; lg[3] += xv * w0.w; lg[4] += xv * w1.x; lg[5] += xv * w1.y; lg[6] += xv * w1.z; lg[7] += xv * w1.w; }
#pragma unroll
            for (int e = 0; e < 8; ++e) lg[e] = wave_sum(lg[e]);
            int i0 = 0; float b0 = lg[0] + brv[0];
#pragma unroll
            for (int e = 1; e < 8; ++e) { const float v = lg[e] + brv[e]; if (v > b0) { b0 = v; i0 = e; } }
            int i1 = (i0 == 0) ? 1 : 0; float b1 = (i0 == 0) ? lg[1] + brv[1] : lg[0] + brv[0];
#pragma unroll
            for (int e = 1; e < 8; ++e) { const float v = lg[e] + brv[e]; if (e != i0 && v > b1) { b1 = v; i1 = e; } }
            float l0 = 0.f, l1 = 0.f;
#pragma unroll
            for (int e = 0; e < 8; ++e) { l0 = (e == i0) ? lg[e] : l0; l1 = (e == i1) ? lg[e] : l1; }
            const float mx = fmaxf(l0, l1), e0 = __expf(l0 - mx), e1 = __expf(l1 - mx), inv = 1.f / (e0 + e1);
            if (lane == 0) { GAS v4u* sel = (GAS v4u*)(F.ws + WS_MOE + MO_SEL) + (size_t)r; *sel = (v4u){(unsigned)i0, (unsigned)i1, __float_as_uint(e0 * inv), __float_as_uint(e1 * inv)};
                __hip_atomic_fetch_add((LAS int*)&hist[i0], 1, __ATOMIC_RELAXED, __HIP_MEMORY_SCOPE_WORKGROUP); __hip_atomic_fetch_add((LAS int*)&hist[i1], 1, __ATOMIC_RELAXED, __HIP_MEMORY_SCOPE_WORKGROUP); }
        }
    }
    if (l == 1) { __syncthreads(); if (F.tid < 8) __hip_atomic_fetch_add((unsigned*)(F.ctl() + CW_MOECNT + 64 * F.tid), (unsigned)hist[F.tid], RLX_AGENT); }
}
__device__ __forceinline__ void phase_moe_assign(const Frame& F) {
    volatile LAS int* L = (volatile LAS int*)(F.lds + 1024);
    int* tok = (int*)(F.ws + WS_MOE + MO_TOK); int* dst = (int*)(F.ws + WS_MOE + MO_DST); int* tile_e = (int*)(F.ws + WS_MOE + MO_SEL + (size_t)RL * 16); int* ntl = tile_e + 512;
    if (F.tid < 8) L[F.tid] = 0;
    if (F.tid == 0) { int base = 0;
        for (int e = 0; e < 8; ++e) { const int c = (int)__hip_atomic_load((unsigned*)(F.ctl() + CW_MOECNT + 64 * e), RLX_AGENT); const int tl = (c + 255) >> 8; L[16 + e] = base * 256; L[24 + e] = c;
            if (blockIdx.x == 0) for (int q = 0; q < tl; ++q) tile_e[base + q] = e;
            base += tl; }
        if (blockIdx.x == 0) ntl[0] = base; }
    __syncthreads();
    const int wg = F.vcu; int e = 0, rank = 0, token = 0, k = 0; const bool act = F.tid < 256 && wg * 128 < RL;
    for (int w0 = wg; w0 * 128 < RL; w0 += F.G) {
        if (F.tid < 256) { token = w0 * 128 + (F.tid >> 1); k = F.tid & 1; e = ((const GAS int*)(F.ws + WS_MOE + MO_SEL))[(size_t)token * 4 + k]; rank = __hip_atomic_fetch_add((LAS int*)&L[e], 1, __ATOMIC_RELAXED, __HIP_MEMORY_SCOPE_WORKGROUP); }
        __syncthreads();
        if (F.tid < 8) { L[8 + F.tid] = (int)__hip_atomic_fetch_add((unsigned*)(F.ctl() + CW_MOECUR + 64 * F.tid), (unsigned)L[F.tid], RLX_AGENT); }
        __syncthreads();
        if (F.tid < 256) { const int slot = L[16 + e] + L[8 + e] + rank; tok[slot] = token; dst[slot] = token * 2 + k; }
        __syncthreads();
        if (F.tid < 8) L[F.tid] = 0;
        __syncthreads();
    }
    (void)act;
    if (wg < 8) { const int c = L[24 + wg], tl = (c + 255) >> 8, b = L[16 + wg]; for (int s = c + F.tid; s < tl * 256; s += 512) { tok[b + s] = 0; dst[b + s] = -1; } }
}
__device__ __forceinline__ void phase_final(const Frame& F, int l) {
    const int gw = F.vcu * NWAVES + F.wave, NGW = F.G * NWAVES, lane = F.lane;
    if (l == 0) {
        const Row16 g2 = ld_row(F.in[I_LN2G], lane), b2 = ld_row(F.in[I_LN2B], lane); int cs = -1; Row16 asc, ash;
        Row16 nx; if (gw < R) nx = ld_row(F.XM() + (size_t)gw * D, lane);
        for (int r = gw; r < R; r += NGW) {
            Row16 x = nx; if (r + NGW < R) nx = ld_row(F.XM() + (size_t)(r + NGW) * D, lane);
            if (r >= RL) { const float* dp = (const float*)(F.ws + WS_DP) + (size_t)(r - RL) * D; const Row16 p0 = ld_row(dp, lane), p1 = ld_row(dp + (size_t)512 * D, lane), g5 = ld_row(ada_vec(F, 0, 2, 5), lane);
#pragma unroll
                for (int j = 0; j < 4; ++j) x.v[j] = x.v[j] * ALPHA + g5.v[j] * (p0.v[j] + p1.v[j]); }
            ln_norm(x); affine_r(x, g2, b2, false);
            st_row(r < RL ? F.out + (size_t)r * D : F.XC() + (size_t)(r - RL) * D, lane, x);
            ln_norm(x); const int s = set_of_row(r); if (s != cs) { cs = s; asc = ld_row(ada_vec(F, 1, s, 1), lane); ash = ld_row(ada_vec(F, 1, s, 0), lane); }
            affine_r(x, asc, ash, true);
            st_row_bf16(F.H() + (size_t)r * D, lane, x); }
    } else {
        const Row16 g2 = ld_row(F.in[I_LN2G] + D, lane), b2 = ld_row(F.in[I_LN2B] + D, lane); int cs = -1; Row16 g5;
        Row16 nx; v2u na[4], nb[4]; float nw0 = 0.f, nw1 = 0.f;
#define FIN_LOAD(rr) do { const GAS float* sel_ = (const GAS float*)(F.ws + WS_MOE + MO_SEL) + (size_t)(rr) * 4; nw0 = sel_[2]; nw1 = sel_[3]; \
            const bf16* d0_ = (const bf16*)F.out + (size_t)(rr) * 2 * D; const GAS v2u* q0_ = (const GAS v2u*)d0_ + lane; const GAS v2u* q1_ = (const GAS v2u*)(d0_ + D) + lane; \
            nx = ld_row(F.XM() + (size_t)(rr) * D, lane); _Pragma("unroll") for (int j = 0; j < 4; ++j) { na[j] = q0_[64 * j]; nb[j] = q1_[64 * j]; } } while (0)
        if (gw < RL) FIN_LOAD(gw);
        for (int r = gw; r < RL; r += NGW) {
            Row16 x = nx; v2u a4[4], b4[4]; const float w0 = nw0, w1 = nw1;
#pragma unroll
            for (int j = 0; j < 4; ++j) { a4[j] = na[j]; b4[j] = nb[j]; }
            if (r + NGW < RL) FIN_LOAD(r + NGW);
            { const int s = set_of_row(r); if (s != cs) { cs = s; g5 = ld_row(ada_vec(F, 1, s, 5), lane); } }
#pragma unroll
            for (int j = 0; j < 4; ++j) { const v2u a = a4[j], b = b4[j];
                f32x4 f; f.x = w0 * bflo(a.x) + w1 * bflo(b.x); f.y = w0 * bfhi(a.x) + w1 * bfhi(b.x); f.z = w0 * bflo(a.y) + w1 * bflo(b.y); f.w = w0 * bfhi(a.y) + w1 * bfhi(b.y);
                x.v[j] = x.v[j] * ALPHA + g5.v[j] * f; }
            ln_norm(x); affine_r(x, g2, b2, false);
            st_row(F.out + (size_t)r * D, lane, x); }
#undef FIN_LOAD
    }
}
__device__ __forceinline__ void lds_barrier() { asm volatile("s_waitcnt lgkmcnt(0)\n\ts_barrier" ::: "memory"); }
constexpr int PT = 72;
typedef LAS bf16* ltile;
__device__ __forceinline__ bf16x8 ldfrag(const LAS bf16* t, int row, int k0, int pitch) { return *(const LAS bf16x8*)(t + row * pitch + k0); }
template <int KD, int PX, int PY>
__device__ __forceinline__ f32x4 mmt(f32x4 acc, const LAS bf16* X, int x0, const LAS bf16* Y, int y0, int fr, int fq) {
#pragma unroll
    for (int kk = 0; kk < KD; kk += 32) acc = __builtin_amdgcn_mfma_f32_16x16x32_bf16(ldfrag(X, x0 + fr, kk + 8 * fq, PX), ldfrag(Y, y0 + fr, kk + 8 * fq, PY), acc, 0, 0, 0);
    return acc;
}
typedef short s16x4_t __attribute__((ext_vector_type(4)));
__device__ __forceinline__ bf16x8 ldfrag_tr(const LAS bf16* X, int k0, int n0, int pitch, int lane) {
    const int fq = lane >> 4, q = (lane & 15) >> 2, p = lane & 3;
    const LAS bf16* a = X + (k0 + 8 * fq + q) * pitch + n0 + 4 * p;
    const s16x4_t lo = __builtin_bit_cast(s16x4_t, __builtin_amdgcn_ds_read_tr16_b64_v4i16((LAS s16x4_t*)a));
    const s16x4_t hi = __builtin_bit_cast(s16x4_t, __builtin_amdgcn_ds_read_tr16_b64_v4i16((LAS s16x4_t*)(a + 4 * pitch)));
    return (bf16x8){lo[0], lo[1], lo[2], lo[3], hi[0], hi[1], hi[2], hi[3]};
}
template <int KD, int PX, int PY>
__device__ __forceinline__ f32x4 mmt_tx(f32x4 acc, const LAS bf16* XR, int x0, const LAS bf16* Y, int y0, int fr, int fq, int lane) {
#pragma unroll
    for (int kk = 0; kk < KD; kk += 32) acc = __builtin_amdgcn_mfma_f32_16x16x32_bf16(ldfrag_tr(XR, kk, x0, PX, lane), ldfrag(Y, y0 + fr, kk + 8 * fq, PY), acc, 0, 0, 0);
    return acc;
}
template <int KD, int PX, int PY>
__device__ __forceinline__ f32x4 mmt_txy(f32x4 acc, const LAS bf16* XR, int x0, const LAS bf16* YR, int y0, int lane) {
#pragma unroll
    for (int kk = 0; kk < KD; kk += 32) acc = __builtin_amdgcn_mfma_f32_16x16x32_bf16(ldfrag_tr(XR, kk, x0, PX, lane), ldfrag_tr(YR, kk, y0, PY, lane), acc, 0, 0, 0);
    return acc;
}
template <int CTRL, int RMASK> __device__ __forceinline__ float dpp_or(float v, float ident) { return __builtin_bit_cast(float, __builtin_amdgcn_update_dpp(__builtin_bit_cast(int, ident), __builtin_bit_cast(int, v), CTRL, RMASK, 0xF, false)); }
__device__ __forceinline__ float wave_incl_scan_add(float v, int lane) {
    v += dpp_or<0x111, 0xF>(v, 0.f); v += dpp_or<0x112, 0xF>(v, 0.f); v += dpp_or<0x114, 0xF>(v, 0.f); v += dpp_or<0x118, 0xF>(v, 0.f);
    v += dpp_or<0x142, 0xA>(v, 0.f); v += dpp_or<0x143, 0xC>(v, 0.f);
    return v; }
__device__ __forceinline__ float wave_incl_scan_max(float v, int lane) {
    const float NI = -INFINITY;
    v = fmaxf(v, dpp_or<0x111, 0xF>(v, NI)); v = fmaxf(v, dpp_or<0x112, 0xF>(v, NI)); v = fmaxf(v, dpp_or<0x114, 0xF>(v, NI)); v = fmaxf(v, dpp_or<0x118, 0xF>(v, NI));
    v = fmaxf(v, dpp_or<0x142, 0xA>(v, NI)); v = fmaxf(v, dpp_or<0x143, 0xC>(v, NI));
    return v; }
__device__ __forceinline__ float wave_max(float v) {
    v = fmaxf(v, dpp_get<0xB1>(v)); v = fmaxf(v, dpp_get<0x4E>(v)); v = fmaxf(v, dpp_get<0x141>(v)); v = fmaxf(v, dpp_get<0x140>(v));
    { const auto rr = __builtin_amdgcn_permlane16_swap(__float_as_uint(v), __float_as_uint(v), false, false); v = fmaxf(__uint_as_float(rr[0]), __uint_as_float(rr[1])); }
    { const auto rr = __builtin_amdgcn_permlane32_swap(__float_as_uint(v), __float_as_uint(v), false, false); v = fmaxf(__uint_as_float(rr[0]), __uint_as_float(rr[1])); }
    return v; }

constexpr int DIRB = 65536;
constexpr int L_QS = 0, L_KS = 9216, L_VT = 18432, L_WS = 27648, L_CS = 36864, L_VEC = 48384, L_AF = 49408, L_PRE = 53504, L_G = 27648, L_HB = 0;
struct ScanPtrs { bf16* Cst; float* Nst; float* Amx; float* Bl; float* Mst; bf16* Gst; float* Gld; };
__device__ __forceinline__ int chunk_row0(int b, int tc) { return tc < 4 ? RL + b * CTX + tc * 64 : b * T + (tc - 4) * 64; }
__device__ __forceinline__ int chunk_pos(int tc, int d) { return d == 0 ? tc : (tc < 4 ? 3 - tc : 263 - tc); }

struct ScanRegs { v4u q0, q1, k0, k1, v0, v1, st0, st1; f32x4 nv0, nv1, af; v2u og0, og1, og2, og3; float gi, gf, mc; };
#define SR_SEL2(R, f, rep) ((rep) == 0 ? (R).f##0 : (R).f##1)
struct UnitId { int fam, b, head, tc; };
__device__ __forceinline__ bool unit_decode(int u, UnitId& id) { if (u >= 2 * 2080) return false; id.fam = ((u >> 8) + u) & 1;   const int rem = u >> 1; id.b = rem / 1040; id.head = (rem / 260) & 3; id.tc = rem % 260; return true; }
__device__ __forceinline__ bool unit_decode_q(int q, int l, bool out, UnitId& id) {
    if (out && l == 1) { if (q >= 2 * 2048) return false; id.fam = q & 1; const int rem = q >> 1; id.b = rem >> 10; id.head = (rem >> 8) & 3; id.tc = 4 + (rem & 255); return true; }
    if (q >= 2 * 2080) return false; id.fam = q & 1; const int rem = q >> 1; id.b = rem / 1040; id.head = (rem / 260) & 3; id.tc = rem % 260; return true; }
template <bool OUT>
__device__ __forceinline__ void scan_fetch(const Frame& F, int l, const UnitId& id, const ScanPtrs& sp, ScanRegs& R_) {
    const int tid = F.tid, d = tid >> 8, ht = tid & 255, lane = F.lane, hw = F.wave & 3;
    const int row0 = chunk_row0(id.b, id.tc), pos = chunk_pos(id.tc, d), chain = (id.b * 4 + id.head) * 2 + d; const size_t slot = (size_t)chain * NCH + pos;
    const bool ml = id.fam == 0;
#define SF_ONE(rep, QF, KF, VF, SF) { const int q = ht + 256 * rep, i = q >> 3, c8 = q & 7, tok = d ? 63 - i : i; \
        const bf16* rp = F.P() + (size_t)(row0 + tok) * NP + id.head * 64 + c8 * 8; \
        if (OUT) R_.QF = *(const GAS v4u*)(rp + (ml ? TC_MLQ : TC_GLQ)); \
        R_.KF = *(const GAS v4u*)(rp + (ml ? TC_MLK : TC_GLK)); R_.VF = *(const GAS v4u*)(rp + (ml ? TC_MLV : TC_GLV)); \
        if (OUT) { const bf16* Cg = (ml ? sp.Cst : sp.Gst) + slot * 4096; R_.SF = *(const GAS v4u*)(Cg + (q >> 3) * 64 + c8 * 8); } }
    SF_ONE(0, q0, k0, v0, st0) SF_ONE(1, q1, k1, v1, st1)
#undef SF_ONE
    { const int tok = d ? 63 - lane : lane; const float* sm = F.SM() + (size_t)(row0 + tok) * SMP + d * 8 + id.head; R_.gi = ((const GAS float*)sm)[0]; R_.gf = ((const GAS float*)sm)[4]; }
    R_.mc = 0.f; R_.nv0 = (f32x4){0.f, 0.f, 0.f, 0.f}; R_.nv1 = R_.nv0;
    if (OUT) { R_.mc = ((const GAS float*)sp.Mst)[slot]; const float* np_ = sp.Nst + slot * 64 + (ht & 7) * 8; R_.nv0 = *(const f32x4*)np_; R_.nv1 = *(const GAS f32x4*)(np_ + 4); }
    { const int i = ht >> 2, q4 = ht & 3, tok = d ? 63 - i : i; R_.af = *(const GAS f32x4*)(F.SM() + (size_t)(row0 + tok) * SMP + 16 + d * 16 + q4 * 4); }
    R_.og0 = (v2u){0u, 0u}; R_.og1 = R_.og0; R_.og2 = R_.og0; R_.og3 = R_.og0;
    if (!OUT) { R_.q0 = (v4u){0u, 0u, 0u, 0u}; R_.q1 = R_.q0; R_.st0 = R_.q0; R_.st1 = R_.q0; }
    if (OUT) { const int fr = lane & 15, fq = lane >> 4, t = 16 * hw + fr; const bf16* op = F.P() + (size_t)(row0 + t) * NP + (ml ? TC_MLO : TC_GLR) + id.head * 64;
        R_.og0 = *(const GAS v2u*)(op + 4 * fq); R_.og1 = *(const GAS v2u*)(op + 16 + 4 * fq); R_.og2 = *(const GAS v2u*)(op + 32 + 4 * fq); R_.og3 = *(const GAS v2u*)(op + 48 + 4 * fq); }
}
__device__ __forceinline__ void gla_build_g(const Frame& F, int l, int head, int d, const f32x4 af, LAS unsigned char* base, int ht) {
    LAS float* AF = (LAS float*)(base + L_AF); LAS float* G = (LAS float*)(base + L_G); LAS float* PRE = (LAS float*)(base + L_PRE);
    { const int i = ht >> 2, q4 = ht & 3; *(LAS f32x4*)(AF + i * 16 + q4 * 4) = af; }
    lds_barrier();
    const int k = ht & 63, tq = ht >> 6;
    const float* w2 = F.in[I_GLW2] + ((size_t)(l * 2 + d) * 16) * 256 + head * 64 + k; const float bb = ((const GAS float*)F.in[I_GLB2])[(size_t)(l * 2 + d) * 256 + head * 64 + k];
    float w[16];
#pragma unroll
    for (int r = 0; r < 16; ++r) w[r] = ((const GAS float*)w2)[(size_t)r * 256];
    float run = 0.f;
#pragma unroll 4
    for (int ii = 0; ii < 16; ++ii) { const int i = 16 * tq + ii; float a = bb;
        const f32x4 f0 = *(const LAS f32x4*)(AF + i * 16), f1 = *(const LAS f32x4*)(AF + i * 16 + 4), f2 = *(const LAS f32x4*)(AF + i * 16 + 8), f3 = *(const LAS f32x4*)(AF + i * 16 + 12);
        a += f0.x * w[0] + f0.y * w[1] + f0.z * w[2] + f0.w * w[3]; a += f1.x * w[4] + f1.y * w[5] + f1.z * w[6] + f1.w * w[7];
        a += f2.x * w[8] + f2.y * w[9] + f2.z * w[10] + f2.w * w[11]; a += f3.x * w[12] + f3.y * w[13] + f3.z * w[14] + f3.w * w[15];
        run += logsig(a) * (1.f / 16.f); G[i * 65 + k] = run; }
    PRE[tq * 64 + k] = run;
    lds_barrier();
    float off = 0.f;
#pragma unroll
    for (int q = 0; q < 3; ++q) off += (q < tq) ? PRE[q * 64 + k] : 0.f;
    if (tq > 0) { for (int ii = 0; ii < 16; ++ii) G[(16 * tq + ii) * 65 + k] += off; }
    lds_barrier();
}
__device__ __forceinline__ void ml_gates(const Frame& F, int l, int head, int d, float gi, float gf, int lane, float& a, float& bcum) {
    const float* gb = F.in[I_MLGB] + (size_t)l * 16 + d * 8 + head;
    const float li = gi + ((const GAS float*)gb)[0], lf = logsig(gf + ((const GAS float*)gb)[4]);
    bcum = wave_incl_scan_add(lf, lane); a = li - bcum;
}
template <bool IS_ML>
__device__ __forceinline__ void scan_local_unit(const Frame& F, int l, int b, int head, int tc, const ScanPtrs& sp, const ScanRegs& R_) {
    const int tid = F.tid, d = tid >> 8, ht = tid & 255, hw = F.wave & 3, lane = F.lane, fr = lane & 15, fq = lane >> 4;
    LAS unsigned char* base = F.lds + d * DIRB;
    LAS bf16* Kt = (LAS bf16*)(base + L_KS); LAS bf16* Vt = (LAS bf16*)(base + L_VT); LAS float* vec = (LAS float*)(base + L_VEC);
    const int pos = chunk_pos(tc, d), chain = (b * 4 + head) * 2 + d; const size_t slot = (size_t)chain * NCH + pos;
    if constexpr (IS_ML) {
        if (hw == 0) { float a, bc; ml_gates(F, l, head, d, R_.gi, R_.gf, lane, a, bc); const float amax = wave_max(a); vec[lane] = __expf(a - amax);
            if (lane == 63) { ((GAS float*)sp.Amx)[slot] = amax; ((GAS float*)sp.Bl)[slot] = bc; } }
        lds_barrier();
    } else { gla_build_g(F, l, head, d, R_.af, base, ht); }
    const LAS float* G = (const LAS float*)(base + L_G);
#pragma unroll
    for (int rep = 0; rep < 2; ++rep) { const int q = ht + 256 * rep, i = q >> 3, c8 = q & 7;
        float kx[8], vx[8]; unpack8(SR_SEL2(R_, k, rep), kx); unpack8(SR_SEL2(R_, v, rep), vx);
        const float wsi = IS_ML ? vec[i] : 1.f;
#pragma unroll
        for (int e = 0; e < 8; ++e) { kx[e] = IS_ML ? kx[e] * 0.125f : kx[e] * __expf(-G[i * 65 + c8 * 8 + e]); vx[e] *= wsi; }
        *(LAS v4u*)(Kt + i * PT + c8 * 8) = pack8(kx); *(LAS v4u*)(Vt + i * PT + c8 * 8) = pack8(vx); }
    if (!IS_ML && ht < 64) ((GAS float*)sp.Gld)[slot * 64 + ht] = __expf(G[63 * 65 + ht]);
    lds_barrier();
    bf16* Cg = (IS_ML ? sp.Cst : sp.Gst) + slot * 4096;
#pragma unroll
    for (int kt = 0; kt < 4; ++kt) { f32x4 acc = {0.f, 0.f, 0.f, 0.f}; acc = mmt_txy<64, PT, PT>(acc, Kt, 16 * kt, Vt, 16 * hw, lane);
        v2u w; w.x = pk2(acc[0], acc[1]); w.y = pk2(acc[2], acc[3]); *(GAS v2u*)(Cg + (size_t)(16 * hw + fr) * 64 + 16 * kt + 4 * fq) = w; }
    if (IS_ML && ht < 64) { float s_ = 0.f; for (int i = 0; i < 64; ++i) s_ += bf2f(Kt[i * PT + ht]) * vec[i]; ((GAS float*)sp.Nst)[slot * 64 + ht] = s_; }
    lds_barrier();
}
template <bool IS_ML>
__device__ __forceinline__ void scan_chain(const Frame& F, int chain, int quarter, const ScanPtrs& sp, bool dry = false) {
    const int tid = F.tid, k0 = (tid & 7) * 8;
    LAS float* LA = (LAS float*)(F.lds);
    if constexpr (IS_ML) { for (int p = tid; p < NCH; p += 512) { LA[p] = ((const GAS float*)sp.Amx)[(size_t)chain * NCH + p]; LA[512 + p] = ((const GAS float*)sp.Bl)[(size_t)chain * NCH + p]; } }
    else { for (int q = tid; q < NCH * 16; q += 512) *(LAS f32x4*)(LA + q * 4) = *(const GAS f32x4*)(sp.Gld + (size_t)chain * NCH * 64 + q * 4); }
    __syncthreads();
    if (tid < 128) {
    float S[8]; float nst = 0.f, m = 0.f;
#pragma unroll
    for (int e = 0; e < 8; ++e) S[e] = 0.f;
    bf16* Cb = (IS_ML ? sp.Cst : sp.Gst) + (size_t)chain * NCH * 4096 + (size_t)quarter * 1024 + (size_t)tid * 8;
    const bool own_n = IS_ML && quarter == 0 && tid < 64;
    constexpr int GS = 20;
    v4u cn[GS]; float nn[GS];
#pragma unroll
    for (int j = 0; j < GS; ++j) nn[j] = 0.f;
#define SC_LOAD(g) do { _Pragma("unroll") for (int j = 0; j < GS; ++j) { cn[j] = *(const GAS v4u*)(Cb + (size_t)((g) * GS + j) * 4096); \
        if (own_n) nn[j] = ((const GAS float*)sp.Nst)[((size_t)chain * NCH + (g) * GS + j) * 64 + tid]; } } while (0)
    SC_LOAD(0);
    for (int g = 0; g < NCH / GS; ++g) {
        v4u cc[GS]; float nc[GS];
#pragma unroll
        for (int j = 0; j < GS; ++j) { cc[j] = cn[j]; nc[j] = nn[j]; }
        if (g + 1 < NCH / GS) SC_LOAD(g + 1);
#pragma unroll
        for (int j = 0; j < GS; ++j) { const int pp = g * GS + j; const size_t p = (size_t)chain * NCH + pp;
            if (!dry) *(GAS v4u*)(Cb + (size_t)pp * 4096) = pack8(S);
            float x[8]; unpack8(cc[j], x);
            if constexpr (IS_ML) {
                if (own_n && !dry) ((GAS float*)sp.Nst)[p * 64 + tid] = nst;
                if (quarter == 0 && tid == 0 && !dry) ((GAS float*)sp.Mst)[p] = m;
                const float am = LA[pp], bl = LA[512 + pp];
                const float mx = fmaxf(m, am), fa = __expf(m - mx), fb = __expf(am - mx);
#pragma unroll
                for (int e = 0; e < 8; ++e) S[e] = fa * S[e] + fb * x[e];
                nst = fa * nst + fb * nc[j]; m = bl + mx;
            } else {
                const f32x4 e0 = *(const LAS f32x4*)(LA + pp * 64 + k0), e1 = *(const LAS f32x4*)(LA + pp * 64 + k0 + 4);
                const float dd[8] = {e0.x, e0.y, e0.z, e0.w, e1.x, e1.y, e1.z, e1.w};
#pragma unroll
                for (int e = 0; e < 8; ++e) S[e] = dd[e] * (S[e] + x[e]);
            }
        }
    }
#undef SC_LOAD
    if (dry && S[0] == 1.2345e-33f) sp.Mst[0] = nst + m;
    }
    __syncthreads();
}
template <bool IS_ML>
__device__ __forceinline__ void scan_out_unit(const Frame& F, int l, int b, int head, int tc, const ScanPtrs& sp, const ScanRegs& R_, bool dry = false) {
    const int tid = F.tid, d = tid >> 8, ht = tid & 255, hw = F.wave & 3, lane = F.lane, fr = lane & 15, fq = lane >> 4;
    LAS unsigned char* base = F.lds + d * DIRB;
    LAS bf16* Qs = (LAS bf16*)(base + L_QS); LAS bf16* Ks = (LAS bf16*)(base + L_KS); LAS bf16* Vt = (LAS bf16*)(base + L_VT); LAS bf16* Ws = (LAS bf16*)(base + L_WS); LAS bf16* Cs = (LAS bf16*)(base + L_CS);
    LAS float* vec = (LAS float*)(base + L_VEC);
    const int row0 = chunk_row0(b, tc), pos = chunk_pos(tc, d), chain = (b * 4 + head) * 2 + d; const size_t slot = (size_t)chain * NCH + pos;
    float m_c = 0.f;
    if constexpr (IS_ML) {
        m_c = R_.mc;
        if (hw == 0) { float a, bc; ml_gates(F, l, head, d, R_.gi, R_.gf, lane, a, bc); const float cm = wave_incl_scan_max(a, lane); vec[lane] = a; vec[64 + lane] = fmaxf(m_c, cm); vec[128 + lane] = bc; }
    } else { gla_build_g(F, l, head, d, R_.af, base, ht); }
    const LAS float* G = (const LAS float*)(base + L_G);
#pragma unroll
    for (int rep = 0; rep < 2; ++rep) { const int q = ht + 256 * rep, i = q >> 3, c8 = q & 7;
        float qx[8], kx[8], vx[8]; unpack8(SR_SEL2(R_, q, rep), qx); unpack8(SR_SEL2(R_, k, rep), kx); unpack8(SR_SEL2(R_, v, rep), vx);
#pragma unroll
        for (int e = 0; e < 8; ++e) {
            if constexpr (IS_ML) { kx[e] *= 0.125f; } else { const float g = G[i * 65 + c8 * 8 + e]; qx[e] *= 0.125f * __expf(g); kx[e] *= __expf(-g); }
        }
        *(LAS v4u*)(Qs + i * PT + c8 * 8) = pack8(qx); *(LAS v4u*)(Ks + i * PT + c8 * 8) = pack8(kx); *(LAS v4u*)(Vt + i * PT + c8 * 8) = pack8(vx); }
    if constexpr (!IS_ML) lds_barrier();
    {
#pragma unroll
        for (int rep = 0; rep < 2; ++rep) { const int q = ht + 256 * rep, v = q >> 3, c8 = q & 7; *(LAS v4u*)(Cs + v * PT + c8 * 8) = SR_SEL2(R_, st, rep); }
        if constexpr (IS_ML) { if (ht < 128) { const int rr = 64 + (ht >> 3), c8 = ht & 7; const bool isn = (rr == 64);
            const float x[8] = {isn ? R_.nv0.x : 0.f, isn ? R_.nv0.y : 0.f, isn ? R_.nv0.z : 0.f, isn ? R_.nv0.w : 0.f, isn ? R_.nv1.x : 0.f, isn ? R_.nv1.y : 0.f, isn ? R_.nv1.z : 0.f, isn ? R_.nv1.w : 0.f};
            *(LAS v4u*)(Cs + rr * PT + c8 * 8) = pack8(x); } }
    }
    lds_barrier();
    const int t = 16 * hw + fr; float rs = 0.f;
    const float Mt = IS_ML ? vec[64 + t] : 0.f;
#pragma unroll
    for (int st = 0; st < 4; ++st) {
        v2u w; w.x = 0u; w.y = 0u;
        if (st <= hw) { f32x4 acc = {0.f, 0.f, 0.f, 0.f}; acc = mmt<64, PT, PT>(acc, Ks, 16 * st, Qs, 16 * hw, fr, fq);
            float o[4];
#pragma unroll
            for (int r = 0; r < 4; ++r) { const int s = 16 * st + 4 * fq + r; float wg = (s <= t) ? 1.f : 0.f; if constexpr (IS_ML) wg = (s <= t) ? __expf(vec[s] - Mt) : 0.f; o[r] = wg * acc[r]; rs += o[r]; }
            w.x = pk2(o[0], o[1]); w.y = pk2(o[2], o[3]); }
        *(LAS v2u*)(Ws + t * PT + 16 * st + 4 * fq) = w; }
    rs = xor16_32_sum(rs);
    float h[4][4]; float wi = 1.f, dn = 1.f;
    if constexpr (IS_ML) { f32x4 an = {0.f, 0.f, 0.f, 0.f}; an = mmt<64, PT, PT>(an, Cs, 64, Qs, 16 * hw, fr, fq); const float nq = xor16_32_sum(an[0]);
        wi = __expf(m_c - Mt); const float den = rs + wi * nq; dn = 1.f / fmaxf(fabsf(den), __expf(-(vec[128 + t] + Mt))); }
#pragma unroll
    for (int vt = 0; vt < 4; ++vt) { f32x4 ai = {0.f, 0.f, 0.f, 0.f}, ac = {0.f, 0.f, 0.f, 0.f};
        ai = mmt_tx<64, PT, PT>(ai, Vt, 16 * vt, Ws, 16 * hw, fr, fq, lane); ac = mmt<64, PT, PT>(ac, Cs, 16 * vt, Qs, 16 * hw, fr, fq);
#pragma unroll
        for (int r = 0; r < 4; ++r) h[vt][r] = (ai[r] + wi * ac[r]) * dn; }
    lds_barrier();
    LAS float* HB = (LAS float*)(F.lds + DIRB + L_HB);
    if (d == 1) {
#pragma unroll
        for (int vt = 0; vt < 4; ++vt)
#pragma unroll
            for (int r = 0; r < 4; ++r) HB[(63 - t) * 65 + 16 * vt + 4 * fq + r] = h[vt][r]; }
    lds_barrier();
    if (d == 0) {
        float s1 = 0.f;
#pragma unroll
        for (int vt = 0; vt < 4; ++vt)
#pragma unroll
            for (int r = 0; r < 4; ++r) { h[vt][r] += HB[t * 65 + 16 * vt + 4 * fq + r]; s1 += IS_ML ? h[vt][r] : h[vt][r] * h[vt][r]; }
        s1 = xor16_32_sum(s1);
        float mean = 0.f, rstd;
        if constexpr (IS_ML) { mean = s1 * (1.f / 64.f); float s2 = 0.f;
#pragma unroll
            for (int vt = 0; vt < 4; ++vt)
#pragma unroll
                for (int r = 0; r < 4; ++r) { const float dd = h[vt][r] - mean; s2 += dd * dd; }
            s2 = xor16_32_sum(s2); rstd = 1.f / sqrtf(s2 * (1.f / 64.f) + LN_EPS);
        } else rstd = 1.f / sqrtf(s1 * (1.f / 64.f) + LN_EPS);
        const float* ng = F.in[IS_ML ? I_MLNG : I_GLNG] + (size_t)l * 256 + head * 64;
        bf16* op = F.P() + (size_t)(row0 + t) * NP + (IS_ML ? TC_MLO : TC_GLR) + head * 64;
#pragma unroll
        for (int vt = 0; vt < 4; ++vt) { const int c = 16 * vt + 4 * fq; const v2u gp = (vt == 0) ? R_.og0 : (vt == 1 ? R_.og1 : (vt == 2 ? R_.og2 : R_.og3)); const f32x4 gn = *(const GAS f32x4*)(ng + c);
            const float gt[4] = {bflo(gp.x), bfhi(gp.x), bflo(gp.y), bfhi(gp.y)}; float y[4];
#pragma unroll
            for (int r = 0; r < 4; ++r) { const float gate = IS_ML ? sigm(gt[r]) : gt[r] * sigm(gt[r]); y[r] = (h[vt][r] - mean) * rstd * gn[r] * gate; }
            v2u w; w.x = pk2(y[0], y[1]); w.y = pk2(y[2], y[3]); if (!dry) *(GAS v2u*)(op + c) = w; }
    }
    lds_barrier();
}
constexpr int DP = 136;
constexpr int LF_C = 0, LF_S = 34816, LF_XR = 69632, LF_XI = 69632 + 18432;
__device__ __forceinline__ void dft_load_mats(const Frame& F) {
    LAS bf16* CM = (LAS bf16*)(F.lds + LF_C); LAS bf16* SMt = (LAS bf16*)(F.lds + LF_S);
    const bf16* gc = (const bf16*)(F.ws + WS_DFT_C); const bf16* gs = (const bf16*)(F.ws + WS_DFT_S);
    for (int q = F.tid; q < 128 * 16; q += 512) { const int j = q >> 4, c8 = q & 15; *(LAS v4u*)(CM + j * DP + c8 * 8) = *(const GAS v4u*)(gc + j * 128 + c8 * 8); *(LAS v4u*)(SMt + j * DP + c8 * 8) = *(const GAS v4u*)(gs + j * 128 + c8 * 8); }
    __syncthreads();
}
template <int STEP>
__device__ __forceinline__ void dft_unit(const Frame& F, int b, int idx, int slab, bf16* IM1, bf16* FT, bool dry = false) {
    LAS bf16* CM = (LAS bf16*)(F.lds + LF_C); LAS bf16* SMt = (LAS bf16*)(F.lds + LF_S); LAS bf16* XR = (LAS bf16*)(F.lds + LF_XR); LAS bf16* XI = (LAS bf16*)(F.lds + LF_XI);
    const int tid = F.tid, lane = F.lane, fr = lane & 15, fq = lane >> 4, w = F.wave;
#pragma unroll
    for (int rep = 0; rep < 2; ++rep) { const int q = tid + 512 * rep, i = q >> 3, c8 = q & 7;
        const int row = (STEP == 1) ? b * T + 128 * i + idx : b * T + 128 * idx + i;
        *(LAS v4u*)(XR + i * PT + c8 * 8) = *(const GAS v4u*)(F.P() + (size_t)row * NP + TC_FT + slab * 64 + c8 * 8);
        if (STEP == 2) *(LAS v4u*)(XI + i * PT + c8 * 8) = *(const GAS v4u*)(IM1 + (size_t)row * 256 + slab * 64 + c8 * 8); }
    lds_barrier();
    const int j = 16 * w + fr;
#pragma unroll
    for (int ct = 0; ct < 4; ++ct) {
        f32x4 dr = {0.f, 0.f, 0.f, 0.f}, p1 = {0.f, 0.f, 0.f, 0.f}, p2 = {0.f, 0.f, 0.f, 0.f};
        dr = mmt_tx<128, PT, DP>(dr, XR, 16 * ct, CM, 16 * w, fr, fq, lane); p2 = mmt_tx<128, PT, DP>(p2, XR, 16 * ct, SMt, 16 * w, fr, fq, lane);
        if (STEP == 2) { dr = mmt_tx<128, PT, DP>(dr, XI, 16 * ct, SMt, 16 * w, fr, fq, lane); p1 = mmt_tx<128, PT, DP>(p1, XI, 16 * ct, CM, 16 * w, fr, fq, lane); }
        float orr[4], oi[4];
        if (STEP == 1) { const float ph = (float)((j * idx) & 16383) * (1.f / 8192.f); const float cs = cospif(ph), sn = sinpif(ph);
#pragma unroll
            for (int r = 0; r < 4; ++r) { const float di = -p2[r]; orr[r] = dr[r] * cs + di * sn; oi[r] = di * cs - dr[r] * sn; }
            const int orow = b * T + 128 * j + idx;
            v2u wr_, wi_; wr_.x = pk2(orr[0], orr[1]); wr_.y = pk2(orr[2], orr[3]); wi_.x = pk2(oi[0], oi[1]); wi_.y = pk2(oi[2], oi[3]);
            if (!dry) { *(GAS v2u*)(F.P() + (size_t)orow * NP + TC_FT + slab * 64 + 16 * ct + 4 * fq) = wr_; *(GAS v2u*)(IM1 + (size_t)orow * 256 + slab * 64 + 16 * ct + 4 * fq) = wi_; }
        } else {
#pragma unroll
            for (int r = 0; r < 4; ++r) { orr[r] = dr[r] * (1.f / 128.f); oi[r] = (p1[r] - p2[r]) * (1.f / 128.f); }
            const int orow = b * T + idx + 128 * j;
            v2u wr_, wi_; wr_.x = pk2(orr[0], orr[1]); wr_.y = pk2(orr[2], orr[3]); wi_.x = pk2(oi[0], oi[1]); wi_.y = pk2(oi[2], oi[3]);
            if (!dry) { *(GAS v2u*)(FT + (size_t)orow * 512 + slab * 64 + 16 * ct + 4 * fq) = wr_; *(GAS v2u*)(FT + (size_t)orow * 512 + 256 + slab * 64 + 16 * ct + 4 * fq) = wi_; }
        } }
    lds_barrier();
}
__device__ __forceinline__ void ctx_dft(const Frame& F, bf16* FT, int widx, int nw) {
    LAS float* ct = (LAS float*)(F.lds + LF_XR); LAS float* st = ct + 256;
    if (F.tid < 256) { const float ph = (float)F.tid * (1.f / 128.f); ct[F.tid] = cospif(ph); st[F.tid] = sinpif(ph); }
    __syncthreads();
    for (int o = widx * 512 + F.tid; o < NB * 256 * 256; o += nw * 512) { const int col = o & 255, k = (o >> 8) & 255, b = o >> 16;
        const bf16* up = F.P() + (size_t)(RL + b * CTX) * NP + TC_FT + col; float re = 0.f, im = 0.f;
        for (int t = 0; t < 256; ++t) { const float u = bf2f(((const GAS bf16*)up)[(size_t)t * NP]); const int a = (k * t) & 255; re += u * ct[a]; im -= u * st[a]; }
        bf16* op = FT + (size_t)(RL + b * CTX + k) * 512 + col; op[0] = (bf16)f2bf(re * 0.0625f); op[256] = (bf16)f2bf(im * 0.0625f); }
    __syncthreads();
}
namespace attn_body {
using bf16=__hip_bfloat16;
using bf16x8=__attribute__((ext_vector_type(8)))short;
using s16x4=__attribute__((ext_vector_type(4)))short;
using f32x16=__attribute__((ext_vector_type(16)))float;
using u32x4=__attribute__((ext_vector_type(4)))unsigned;
using f32x4a=__attribute__((ext_vector_type(4)))float;
constexpr int D=64,DM=3072;
constexpr int NW=8,QBLK=32,QB=QBLK*NW,KVBLK=64;
constexpr int ATTN_PITCH=DM, ATTN_UNIT_ROWS=QB;
__device__ __forceinline__ int crow(int r,int hi){return (r&3)+8*(r>>2)+4*hi;}
#define SBAR() __builtin_amdgcn_sched_barrier(0)
__device__ __forceinline__ void cmask(f32x16&p0,f32x16&p1,int jb,int qrel,int hi){
  const float NEG=-INFINITY; int kb=64*jb+4*hi;
  #pragma unroll
  for(int r=0;r<16;++r){int kv=kb+(r&3)+8*(r>>2); if(kv>qrel)p0[r]=NEG; if(kv+32>qrel)p1[r]=NEG;}
}

constexpr int NSLOT=3, SLOTB=8192;
constexpr int LDS_K=0, LDS_V=NSLOT*SLOTB, LDS_WS=2*NSLOT*SLOTB, LDS_OST=LDS_WS+NW*64*4, LDS_BYTES=LDS_OST+NW*4096;
constexpr float C2=0.125f*1.4426950408889634f;
__device__ __forceinline__ void glds16(const void*gsrc,unsigned lds_dst){unsigned keep;
  asm volatile("s_mov_b32 %0, m0\n\ts_mov_b32 m0, %2\n\ts_nop 0\n\tglobal_load_lds_dwordx4 %1, off\n\ts_mov_b32 m0, %0":"=&s"(keep):"v"(gsrc),"s"(lds_dst):"memory");}
__device__ __forceinline__ float max3f(float a,float b,float c){float r;asm("v_max3_f32 %0, %1, %2, %3":"=v"(r):"v"(a),"v"(b),"v"(c));return r;}
__device__ __forceinline__ float max2f(float a,float b){float r;asm("v_max_f32_e32 %0, %1, %2":"=v"(r):"v"(a),"v"(b));return r;}
__device__ __forceinline__ float fadd_s(float a,float b){float r;asm("v_add_f32_e32 %0, %1, %2":"=v"(r):"v"(a),"v"(b));return r;}
__device__ __forceinline__ float fsub_s(float a,float b){float r;asm("v_sub_f32_e32 %0, %1, %2":"=v"(r):"v"(a),"v"(b));return r;}
typedef float f32x2_t __attribute__((ext_vector_type(2))); typedef __bf16 bf16x2_t __attribute__((ext_vector_type(2)));
__device__ __forceinline__ unsigned cvtpk_s(float lo,float hi){f32x2_t v={lo,hi};bf16x2_t b=__builtin_convertvector(v,bf16x2_t);return __builtin_bit_cast(unsigned,b);}
#define WAIT_BAR(N) asm volatile("s_waitcnt vmcnt(" #N ") lgkmcnt(0)\n\ts_barrier":::"memory")

__device__ __forceinline__ void qkt(f32x16&p0,f32x16&p1,const char*Kslot,const bf16x8*qr,const f32x16&negm,int r32,int hi){
  const char*kb=Kslot+hi*1024+r32*16;
  #pragma unroll
  for(int d0=0;d0<4;++d0){
    const bf16x8 b0=*reinterpret_cast<const bf16x8*>(kb+d0*2048);
    const bf16x8 b1=*reinterpret_cast<const bf16x8*>(kb+d0*2048+512);
    if(d0==0){p0=__builtin_amdgcn_mfma_f32_32x32x16_bf16(b0,qr[0],negm,0,0,0);p1=__builtin_amdgcn_mfma_f32_32x32x16_bf16(b1,qr[0],negm,0,0,0);}
    else{p0=__builtin_amdgcn_mfma_f32_32x32x16_bf16(b0,qr[d0],p0,0,0,0);p1=__builtin_amdgcn_mfma_f32_32x32x16_bf16(b1,qr[d0],p1,0,0,0);}}
}
typedef __attribute__((address_space(3))) const char* lds_cptr;
typedef short v4i16_t __attribute__((ext_vector_type(4)));
__device__ __forceinline__ void kload8(bf16x8*kf,lds_cptr kp){
  kf[0]=*(const __attribute__((address_space(3))) bf16x8*)(kp);      kf[1]=*(const __attribute__((address_space(3))) bf16x8*)(kp+512);
  kf[2]=*(const __attribute__((address_space(3))) bf16x8*)(kp+2048); kf[3]=*(const __attribute__((address_space(3))) bf16x8*)(kp+2560);
  kf[4]=*(const __attribute__((address_space(3))) bf16x8*)(kp+4096); kf[5]=*(const __attribute__((address_space(3))) bf16x8*)(kp+4608);
  kf[6]=*(const __attribute__((address_space(3))) bf16x8*)(kp+6144); kf[7]=*(const __attribute__((address_space(3))) bf16x8*)(kp+6656);
}
__device__ __forceinline__ void kload2(bf16x8*kf,lds_cptr kp,int j){ kf[2*j]=*(const __attribute__((address_space(3))) bf16x8*)(kp+j*2048); kf[2*j+1]=*(const __attribute__((address_space(3))) bf16x8*)(kp+j*2048+512); }
__device__ __forceinline__ s16x4 vtr(lds_cptr p){ return __builtin_bit_cast(s16x4,__builtin_amdgcn_ds_read_tr16_b64_v4i16((__attribute__((address_space(3))) v4i16_t*)p)); }
__device__ __forceinline__ float rowmax(const f32x16&p0,const f32x16&p1){
  float a=max3f(p0[0],p0[1],p1[0]),b=max3f(p0[2],p0[3],p1[1]);a=max3f(a,p1[2],p1[3]);
  #pragma unroll
  for(int r=4;r<16;r+=4){a=max3f(a,p0[r],p0[r+1]);b=max3f(b,p0[r+2],p0[r+3]);a=max3f(a,p1[r],p1[r+1]);b=max3f(b,p1[r+2],p1[r+3]);}
  const float m=max2f(a,b);
  auto rr=__builtin_amdgcn_permlane32_swap(__float_as_uint(m),__float_as_uint(m),false,false);
  return max2f(__uint_as_float(rr[0]),__uint_as_float(rr[1]));
}
__device__ __forceinline__ void pv(f32x16*o,int vb,bf16x8 pa0,bf16x8 pa1,bf16x8 pa2,bf16x8 pa3){
  #pragma unroll
  for(int d0=0;d0<2;++d0){s16x4 lo[4],hi[4];
    #pragma unroll
    for(int ks=0;ks<4;++ks){
      asm volatile("ds_read_b64_tr_b16 %0,%1 offset:%c2":"=&v"(lo[ks]):"v"(vb),"i"(d0*4096+ks*1024):"memory");
      asm volatile("ds_read_b64_tr_b16 %0,%1 offset:%c2":"=&v"(hi[ks]):"v"(vb),"i"(d0*4096+ks*1024+512):"memory");}
    asm volatile("s_waitcnt lgkmcnt(0)":::"memory");SBAR();
    #define PK(k) (bf16x8){lo[k][0],lo[k][1],lo[k][2],lo[k][3],hi[k][0],hi[k][1],hi[k][2],hi[k][3]}
    o[d0]=__builtin_amdgcn_mfma_f32_32x32x16_bf16(pa0,PK(0),o[d0],0,0,0);
    o[d0]=__builtin_amdgcn_mfma_f32_32x32x16_bf16(pa1,PK(1),o[d0],0,0,0);
    o[d0]=__builtin_amdgcn_mfma_f32_32x32x16_bf16(pa2,PK(2),o[d0],0,0,0);
    o[d0]=__builtin_amdgcn_mfma_f32_32x32x16_bf16(pa3,PK(3),o[d0],0,0,0);
    #undef PK
  }
}

#ifndef ATTN_STORE16
#define ATTN_STORE16(p,v) (*(u32x4*)(p)=(v))
#endif
template<int THRL> __device__ __forceinline__ void attn_unit(const bf16*Qw0,const bf16*__restrict__ KL,const bf16*__restrict__ VL,const bf16*__restrict__ KC,const bf16*__restrict__ VC,int nlt,const int NT,bf16*Ow0,char*shm,const float MB){
  const int tid=threadIdx.x,lane=tid&63,r32=lane&31,hi=lane>>5; const int wid=__builtin_amdgcn_readfirstlane(tid>>6);
  const bf16*Qw=Qw0+(long)(wid*QBLK)*DM;
  const unsigned lds0=(unsigned)(uintptr_t)shm;
  float*wsf=(float*)(shm+LDS_WS)+wid*64;
  const long kvo_k=(long)lane*DM+wid*8; const bf16*ksrcL=KL+kvo_k; const bf16*ksrcC=KC+kvo_k-(long)nlt*KVBLK*DM;
  const long kvo_v=(long)(16*(wid&3)+(lane>>2))*DM+(wid>>2)*32+(lane&3)*8; const bf16*vsrcL=VL+kvo_v; const bf16*vsrcC=VC+kvo_v-(long)nlt*KVBLK*DM;
  const unsigned kdst=lds0+LDS_K+wid*1024, vdst=lds0+LDS_V+wid*1024;
  #define DMA_K(t,slot) glds16(((t)<nlt?ksrcL:ksrcC)+(long)(t)*KVBLK*DM,(unsigned)__builtin_amdgcn_readfirstlane(kdst+(slot)))
  #define DMA_V(t,slot) glds16(((t)<nlt?vsrcL:vsrcC)+(long)(t)*KVBLK*DM,(unsigned)__builtin_amdgcn_readfirstlane(vdst+(slot)))
  const int vb0=(int)(lds0+LDS_V)+((lane>>4)&1)*32+(lane&3)*8+(4*hi+((lane&15)>>2))*64;
  const char*Kbase=shm+LDS_K; bf16x8 kf[8];
  const lds_cptr shm3=(lds_cptr)shm; const lds_cptr kp0=shm3+LDS_K+hi*1024+r32*16; const lds_cptr vp0=shm3+LDS_V+((lane>>4)&1)*32+(lane&3)*8+(4*hi+((lane&15)>>2))*64;
  DMA_K(0,0);DMA_V(0,0);DMA_K(1,SLOTB);
  bf16x8 qr[4];
  #pragma unroll
  for(int d0=0;d0<4;++d0)qr[d0]=*reinterpret_cast<const bf16x8*>(&Qw[(long)r32*DM+d0*16+hi*8]);
  const short one_=((lane&15)<2&&(lane&15)==((lane>>4)&1))?(short)0x3F80:(short)0; bf16x8 sel={one_,one_,one_,one_,one_,one_,one_,one_}; asm volatile("":"+v"(sel));
  f32x4a lacc={0.f,0.f,0.f,0.f};
  f32x16 o[2];o[0]=f32x16{};o[1]=f32x16{};f32x16 negm;
  #pragma unroll
  for(int r=0;r<16;++r)negm[r]=-MB;
  asm volatile("":"+v"(negm));
  #define CMASK(P0,P1,t) do{}while(0)
  #define START(P0,P1) do{ _Pragma("unroll") for(int r=0;r<16;++r)P0[r]=__builtin_amdgcn_exp2f(P0[r]); }while(0)
  #define RESC() do{}while(0)
  f32x16 pA0,pA1,pB0,pB1;
  int sl_prev=0,sl_cur=0,sl_next=SLOTB;
  #define ROT() do{sl_prev=sl_cur;sl_cur=sl_next;sl_next=(sl_next==(NSLOT-1)*SLOTB)?0:sl_next+SLOTB;}while(0)
  DMA_K(2,2*SLOTB);
  WAIT_BAR(3);
  qkt(pA0,pA1,Kbase,qr,negm,r32,hi);asm volatile("s_nop 15\n\ts_nop 7":"+v"(pA0),"+v"(pA1));CMASK(pA0,pA1,0);
  START(pA0,pA1);
  _Pragma("unroll") for(int r=0;r<8;++r)pA1[r]=__builtin_amdgcn_exp2f(pA1[r]);
  WAIT_BAR(0);
  DMA_K(3,0);DMA_V(1,SLOTB);
  ROT();
  kload8(kf,kp0+sl_cur);
  WAIT_BAR(2);
  s16x4 vlo[8],vhi[8]; u32x4 pw0,pw1,pw2,pw3;
  #define PKW(P,B) cvtpk_s(P[B],P[B+1])
  #define PAF(k) __builtin_bit_cast(bf16x8,pw##k)
  #define VFR(i) (bf16x8){vlo[i][0],vlo[i][1],vlo[i][2],vlo[i][3],vhi[i][0],vhi[i][1],vhi[i][2],vhi[i][3]}
  #define PIN(x) asm volatile("":"+v"(x))
  #define MX3(a,b,c) __builtin_fmaxf(__builtin_fmaxf((a),(b)),(c))
  #define GAPA(MF,W0,W1,PW,EXTRA) do{ MF; W0; W1; PIN(PW); EXTRA; SBAR(); }while(0)
  #define LSUM(k) do{ lacc=__builtin_amdgcn_mfma_f32_16x16x32_bf16(sel,PAF(k),lacc,0,0,0); PIN(lacc); }while(0)
  #define NOX() do{}while(0)
  #define EX(v) __builtin_amdgcn_exp2f(v)
  #define GAPB(MF,E0,E1,E2,PX,PY,EXTRA) do{ MF; E0=EX(E0); E1=EX(E1); E2=EX(E2); PIN(PX); PIN(PY); EXTRA; SBAR(); }while(0)
  #define EXA(P,B) do{ P[B]=EX(P[B]); P[B+1]=EX(P[B+1]); PIN(P); }while(0)
  #define VRD(i) do{ vlo[i]=vtr(vp_+(((i)>>2)*4096+((i)&3)*1024)); vhi[i]=vtr(vp_+(((i)>>2)*4096+((i)&3)*1024+512)); }while(0)
  #define KRD(G,j) do{ if(G){ kload2(kf,kp0+sl_next,j); SBAR(); } }while(0)
  #define STEP(C0,C1,P0,P1,t,GK,GV,GL) do{ SBAR(); \
    const lds_cptr vp_=vp0+sl_prev; \
    VRD(0); SBAR(); \
    GAPA(C0=__builtin_amdgcn_mfma_f32_32x32x16_bf16(kf[0],qr[0],negm,0,0,0), pw0[0]=PKW(P0,0), pw0[1]=PKW(P0,2), pw0, EXA(P1,8)); \
    VRD(4); SBAR(); GAPA(C1=__builtin_amdgcn_mfma_f32_32x32x16_bf16(kf[1],qr[0],negm,0,0,0), pw0[2]=PKW(P0,4), pw0[3]=PKW(P0,6), pw0, EXA(P1,10)); \
    VRD(1); SBAR(); GAPA(C0=__builtin_amdgcn_mfma_f32_32x32x16_bf16(kf[2],qr[1],C0,0,0,0),   pw1[0]=PKW(P0,8), pw1[1]=PKW(P0,10), pw1, do{EXA(P1,12);LSUM(0);}while(0)); \
    VRD(5); SBAR(); GAPA(C1=__builtin_amdgcn_mfma_f32_32x32x16_bf16(kf[3],qr[1],C1,0,0,0),   pw1[2]=PKW(P0,12),pw1[3]=PKW(P0,14), pw1, EXA(P1,14)); \
    VRD(2); SBAR(); GAPA(C0=__builtin_amdgcn_mfma_f32_32x32x16_bf16(kf[4],qr[2],C0,0,0,0),   pw2[0]=PKW(P1,0), pw2[1]=PKW(P1,2), pw2, LSUM(1)); \
    VRD(6); SBAR(); GAPA(C1=__builtin_amdgcn_mfma_f32_32x32x16_bf16(kf[5],qr[2],C1,0,0,0),   pw2[2]=PKW(P1,4), pw2[3]=PKW(P1,6), pw2, NOX()); \
    VRD(3); SBAR(); GAPA(C0=__builtin_amdgcn_mfma_f32_32x32x16_bf16(kf[6],qr[3],C0,0,0,0),   pw3[0]=PKW(P1,8), pw3[1]=PKW(P1,10), pw3, LSUM(2)); \
    VRD(7); SBAR(); GAPA(C1=__builtin_amdgcn_mfma_f32_32x32x16_bf16(kf[7],qr[3],C1,0,0,0),   pw3[2]=PKW(P1,12),pw3[3]=PKW(P1,14), pw3, NOX()); \
    if(GK){DMA_K((t)+3,sl_cur);} if(GV){DMA_V((t)+1,sl_next);} \
    CMASK(C0,C1,t); \
    SBAR(); \
    GAPB(o[0]=__builtin_amdgcn_mfma_f32_32x32x16_bf16(PAF(0),VFR(0),o[0],0,0,0), C0[0],C0[1],C0[2],C0,C0,NOX()); \
    GAPB(o[1]=__builtin_amdgcn_mfma_f32_32x32x16_bf16(PAF(0),VFR(4),o[1],0,0,0), C0[3],C0[4],C0[5],C0,C0,LSUM(3)); \
    KRD(GL,0); GAPB(o[0]=__builtin_amdgcn_mfma_f32_32x32x16_bf16(PAF(1),VFR(1),o[0],0,0,0), C0[6],C0[7],C0[8],C0,C0,NOX()); \
    KRD(GL,1); GAPB(o[1]=__builtin_amdgcn_mfma_f32_32x32x16_bf16(PAF(1),VFR(5),o[1],0,0,0), C0[9],C0[10],C0[11],C0,C0,NOX()); \
    KRD(GL,2); GAPB(o[0]=__builtin_amdgcn_mfma_f32_32x32x16_bf16(PAF(2),VFR(2),o[0],0,0,0), C0[12],C0[13],C0[14],C0,C0,NOX()); \
    KRD(GL,3); GAPB(o[1]=__builtin_amdgcn_mfma_f32_32x32x16_bf16(PAF(2),VFR(6),o[1],0,0,0), C0[15],C1[0],C1[1],C0,C1,NOX()); \
    GAPB(o[0]=__builtin_amdgcn_mfma_f32_32x32x16_bf16(PAF(3),VFR(3),o[0],0,0,0), C1[2],C1[3],C1[4],C1,C1,NOX()); \
    GAPB(o[1]=__builtin_amdgcn_mfma_f32_32x32x16_bf16(PAF(3),VFR(7),o[1],0,0,0), C1[5],C1[6],C1[7],C1,C1,NOX()); \
    }while(0)
  int t=1;
  #undef CMASK
  #define CMASK(P0,P1,t) do{}while(0)
  for(;t+5<NT;t+=2){
    STEP(pB0,pB1,pA0,pA1,t,true,true,true);     WAIT_BAR(2); RESC(); ROT();
    STEP(pA0,pA1,pB0,pB1,t+1,true,true,true);   WAIT_BAR(2); RESC(); ROT();
  }
  #undef CMASK
  #define CMASK(P0,P1,t) do{}while(0)
  #define ENDW(tt) do{ if((tt)+3<NT){WAIT_BAR(2);} else if((tt)+2<NT){WAIT_BAR(1);} else {WAIT_BAR(0);} }while(0)
  for(;t+1<NT;t+=2){
    STEP(pB0,pB1,pA0,pA1,t,(t+3<NT),(t+1<NT),(t+1<NT));       ENDW(t);   RESC(); ROT();
    STEP(pA0,pA1,pB0,pB1,t+1,(t+4<NT),(t+2<NT),(t+2<NT));     ENDW(t+1); RESC(); ROT();
  }
  STEP(pB0,pB1,pA0,pA1,NT-1,false,false,false); RESC();
  { _Pragma("unroll") for(int r=8;r<16;++r)pB1[r]=__builtin_amdgcn_exp2f(pB1[r]);
    pw0=(u32x4){PKW(pB0,0),PKW(pB0,2),PKW(pB0,4),PKW(pB0,6)};pw1=(u32x4){PKW(pB0,8),PKW(pB0,10),PKW(pB0,12),PKW(pB0,14)};pw2=(u32x4){PKW(pB1,0),PKW(pB1,2),PKW(pB1,4),PKW(pB1,6)};pw3=(u32x4){PKW(pB1,8),PKW(pB1,10),PKW(pB1,12),PKW(pB1,14)};
    LSUM(0); LSUM(1); LSUM(2); LSUM(3);
    SBAR(); pv(o,vb0+sl_cur,PAF(0),PAF(1),PAF(2),PAF(3)); }
  #undef PKW
  #undef PAF
  #undef VFR
  #undef PIN
  #undef MX3
  #undef GAPA
  #undef LSUM
  #undef NOX
  #undef GAPB
  #undef EXA
  #undef EX
  #undef VRD
  #undef KRD
  #undef STEP
  #undef ENDW
  if(lane<16){wsf[32+lane]=lacc[0];wsf[48+lane]=lacc[1];}asm volatile("s_waitcnt lgkmcnt(0)":::"memory");
  float rli[16];
  #pragma unroll
  for(int r=0;r<16;++r)rli[r]=__builtin_amdgcn_rcpf(wsf[32+crow(r,hi)]);
  bf16*Ow=Ow0+(long)(wid*QBLK)*DM;
  { bf16*stg=(bf16*)(shm+LDS_OST)+wid*2048;
    #pragma unroll
    for(int r=0;r<16;++r){const int orow=crow(r,hi);
      #pragma unroll
      for(int d0=0;d0<2;++d0)stg[orow*64+d0*32+r32]=__float2bfloat16(o[d0][r]*rli[r]);}
    asm volatile("s_waitcnt lgkmcnt(0)":::"memory");
    #pragma unroll
    for(int i=0;i<4;++i){const int row=i*8+(lane>>3),ch=lane&7; const u32x4 v=*(const u32x4*)(stg+row*64+ch*8); ATTN_STORE16(Ow+(long)row*DM+ch*8,v);} }
  asm volatile("s_waitcnt lgkmcnt(0)\n\ts_barrier":::"memory");
  #undef DMA_K
  #undef DMA_V
  #undef CMASK
  #undef START
  #undef RESC
  #undef ROT
}
constexpr int ATTN_LDS_BYTES=LDS_BYTES;
#undef SBAR
#undef WAIT_BAR
}

constexpr int PH_PER_LAYER = 11, PH_L0 = 2, N_PHASES = PH_L0 + 2 * PH_PER_LAYER;
__device__ __forceinline__ void phase_scale_rows(const Frame& F, int l, bool from_x) {
    const int gw = F.vcu * NWAVES + F.wave, NGW = F.G * NWAVES;
    for (int r = gw; r < R; r += NGW) { Row16 x = ld_row(from_x ? xin_row(F, l, r) : F.XM() + (size_t)r * D, F.lane);
#pragma unroll
        for (int j = 0; j < 4; ++j) x.v[j] = x.v[j] * ALPHA;
        st_row(F.XM() + (size_t)r * D, F.lane, x); }
}
__device__ __forceinline__ Frame make_frame(unsigned char* lds_, unsigned char* ws, float* out) {
    Frame F; F.lds = (LAS unsigned char*)lds_; F.MISC = (volatile LAS unsigned*)(F.lds + MISC_OFF);
    F.tid = opq_v((int)threadIdx.x); F.lane = F.tid & 63; F.wave = __builtin_amdgcn_readfirstlane(F.tid >> 6);
    F.G = opq_s((int)gridDim.x); { const int bx = opq_s((int)blockIdx.x); F.vcu = (F.G % 8 == 0) ? (bx % 8) * (F.G / 8) + bx / 8 : bx; }
    F.ws = opq(ws); F.out = opq(out); F.in.lds = F.lds; return F; }
#ifndef PHM
#define PHM 0xFF
#endif
#ifndef R_IN
#define R_IN 1
#endif
#ifndef R_LOC
#define R_LOC 1
#endif
#ifndef R_MRG
#define R_MRG 1
#endif
#ifndef R_OUT
#define R_OUT 1
#endif
#ifndef R_UP
#define R_UP 1
#endif
#ifndef R_ATT
#define R_ATT 0
#endif
#ifndef D_OUTU
#define D_OUTU 0
#endif
#ifndef D_CHAIN
#define D_CHAIN 0
#endif
#ifndef D_DFT
#define D_DFT 0
#endif
#ifndef D_QK
#define D_QK 0
#endif
#ifndef R_FIN0
#define R_FIN0 1
#endif
#ifndef R_PM0
#define R_PM0 1
#endif
#ifndef R_MDN
#define R_MDN 1
#endif
#ifndef X_BAR
#define X_BAR 0
#endif
#ifndef R_CONV
#define R_CONV 1
#endif
#ifndef R_PRO
#define R_PRO 1
#endif
#define MKF() Frame F = make_frame(lds, args.ws, args.out)
#define IN(k) (args.ph_lo <= (k) && (k) < args.ph_hi)
#define SEAM(k) do { if (IN(k) && IN((k) + 1)) { XcdBarrier bar_; bar_.bar = (unsigned*)((gu32*)(opq(args.ws) + WS_CTL) + CW_BAR) + args.li * XCD_BAR_WORDS; bar_.x = xb_xcc_id(); \
        bar_.st = (volatile LAS unsigned*)((LAS unsigned char*)lds + MISC_OFF) + 8; xcd_barrier(bar_); if (X_BAR) xcd_barrier(bar_); } PROF_TICK(k); } while (0)
#define xm (F.ws + WS_XM)
#define P_IM1 ((bf16*)(xm + XO_IM1))
#define P_FT ((bf16*)(xm + XO_FT))
#define MK_SP() ScanPtrs sp; sp.Cst = (bf16*)(xm + XO_MLC); sp.Gst = (bf16*)(xm + XO_GLS); sp.Nst = (float*)(F.ws + WS_SCAL + SC_MLN); sp.Amx = (float*)(F.ws + WS_SCAL + SC_MLA); sp.Bl = (float*)(F.ws + WS_SCAL + SC_MLB); sp.Mst = (float*)(F.ws + WS_SCAL + SC_MLM); sp.Gld = (float*)(F.ws + WS_SCAL + SC_GLD)

template <int l> __device__ __forceinline__ void layer_body(const Args& args, unsigned char* lds) {
        const int pb = PH_L0 + l * PH_PER_LAYER;
        if (IN(pb + 0)) {
#if DBG_LEVEL >= 3 && (PHM & 1)
            for (int rep = 0; rep < R_IN; ++rep) { SchedIn S; S.G = opq_s((int)gridDim.x); S.c = opq_s((int)blockIdx.x); S.ws = opq(args.ws);
            pg8::gemm_stream((LAS unsigned char*)lds, S); }
#endif
        }
        SEAM(pb + 0);
        if (IN(pb + 1)) {
#if DBG_LEVEL >= 3 && (PHM & 2)
            MKF(); MK_SP(); phase_qk(F, l); for (int rep = 0; rep < D_QK; ++rep) phase_qk(F, l, __builtin_amdgcn_readfirstlane(opq_v(1)) != 0);
            __syncthreads(); PROF_TICK(24);
            dft_load_mats(F);
            for (int u = F.vcu; u < 1024; u += F.G) dft_unit<1>(F, u >> 9, (u >> 2) & 127, u & 3, P_IM1, P_FT);
            for (int rep = 0; rep < D_DFT; ++rep) for (int u = F.vcu; u < 1024; u += F.G) dft_unit<1>(F, u >> 9, (u >> 2) & 127, u & 3, P_IM1, P_FT, __builtin_amdgcn_readfirstlane(opq_v(1)) != 0);
            __syncthreads(); PROF_TICK(25);
            {
                volatile LAS int* qs = (volatile LAS int*)(F.lds + MISC_OFF + 96); unsigned* qh = (unsigned*)(F.ctl() + CW_QUEUE + (l * 2 + 0) * 64);
                if (F.tid == 0) { qs[2] = (int)__hip_atomic_fetch_add(qh, 1u, RLX_AGENT); qs[3] = (int)__hip_atomic_fetch_add(qh, 1u, RLX_AGENT); }
                __syncthreads();
                UnitId id, idn; ScanRegs RA, RB; int u = qs[2], un = qs[3]; bool ok = unit_decode_q(u, l, false, id), okn = unit_decode_q(un, l, false, idn); int par = 0;
                if (ok) scan_fetch<false>(F, l, id, sp, RA);
                while (ok) {
                    if (okn) scan_fetch<false>(F, l, idn, sp, RB);
                    if (F.tid == 0) qs[par] = (int)__hip_atomic_fetch_add(qh, 1u, RLX_AGENT);
                    if (id.fam == 0) scan_local_unit<true>(F, l, id.b, id.head, id.tc, sp, RA); else scan_local_unit<false>(F, l, id.b, id.head, id.tc, sp, RA);
                    const int u2 = qs[par]; par ^= 1;
                    RA = RB; id = idn; ok = okn; okn = unit_decode_q(u2, l, false, idn); }
            }
            __syncthreads(); PROF_TICK(26);
#endif
        }
        SEAM(pb + 1);
        if (IN(pb + 2)) {
#if DBG_LEVEL >= 3 && (PHM & 4)
            MKF(); MK_SP(); const bool split = F.G >= 256; const int nsc = split ? 128 : F.G;
            if (F.vcu < nsc) for (int rep = 0; rep <= D_CHAIN; ++rep) for (int cq = F.vcu; cq < 128; cq += nsc) { const bool dry = __builtin_amdgcn_readfirstlane(opq_v(rep)) != 0; const int c = cq >> 2, qt = cq & 3;
                if (c < 16) scan_chain<true>(F, c, qt, sp, dry); else scan_chain<false>(F, c - 16, qt, sp, dry); }
            PROF_TICK(27);
            if (!split || F.vcu >= nsc) { const int widx = split ? F.vcu - nsc : F.vcu, nw = split ? F.G - nsc : F.G;
                dft_load_mats(F);
                for (int rep = 0; rep <= D_DFT; ++rep) for (int u = widx; u < 1024; u += nw) dft_unit<2>(F, u >> 9, (u >> 2) & 127, u & 3, P_IM1, P_FT, __builtin_amdgcn_readfirstlane(opq_v(rep)) != 0);
                PROF_TICK(28); if (l == 0) ctx_dft(F, P_FT, widx, nw); PROF_TICK(29); }
#endif
        }
        SEAM(pb + 2);
        if (IN(pb + 3)) {
#if DBG_LEVEL >= 3 && (PHM & 24)
#if (PHM & 8)
            {   MKF(); typedef attn_body::bf16 abf; abf* Pb = (abf*)F.P();
                const float MB = fminf(C2Q * 64.f * wave_max(fabsf(F.in[I_GQQG][l * 64 + F.lane])) * wave_max(fabsf(F.in[I_GQKG][l * 64 + F.lane])), 40.f);
                for (int i = 0;; ++i) { const int U = i * F.G + F.vcu; if (U >= 1024) break;
                    const int combo = (U >> 6) & 3, hg = (U >> 8) & 3, qb = U & 63, b = combo >> 1, kvh = combo & 1, h = kvh * 4 + hg;
                    abf* q = Pb + (size_t)(b * T + qb * 256) * NP + TC_GQQ + h * 64; const abf* kl = Pb + (size_t)(b * T) * NP + TC_GQK + kvh * 64; const abf* kc = Pb + (size_t)(RL + b * CTX) * NP + TC_GQK + kvh * 64;
                    attn_body::attn_unit<8>(q, kl, kl + (TC_GQV - TC_GQK), kc, kc + (TC_GQV - TC_GQK), 256, 260, q, (char*)lds, MB); }
                for (int rep = 0; rep < R_ATT; ++rep)
                for (int i = 0;; ++i) { const int U = i * F.G + F.vcu; if (U >= 1024) break;
                    const int combo = (U >> 6) & 3, hg = (U >> 8) & 3, qb = U & 63, b = combo >> 1, kvh = combo & 1, h = kvh * 4 + hg;
                    abf* q = Pb + (size_t)(b * T + qb * 256) * NP + TC_MLQ + (h & 3) * 64; const abf* kl = Pb + (size_t)(b * T) * NP + TC_GQK + kvh * 64; const abf* kc = Pb + (size_t)(RL + b * CTX) * NP + TC_GQK + kvh * 64;
                    attn_body::attn_unit<8>(q, kl, kl + (TC_GQV - TC_GQK), kc, kc + (TC_GQV - TC_GQK), 256, 260, Pb + (size_t)(b * T + qb * 256) * NP + TC_FT + (h & 3) * 64, (char*)lds, MB); }
                if (l == 0 && F.vcu < 16) { const int b = F.vcu >> 3, h = F.vcu & 7, kvh = h >> 2;
                    abf* q = Pb + (size_t)(RL + b * CTX) * NP + TC_GQQ + h * 64; const abf* kc = Pb + (size_t)(RL + b * CTX) * NP + TC_GQK + kvh * 64;
                    attn_body::attn_unit<8>(q, kc, kc + (TC_GQV - TC_GQK), kc, kc + (TC_GQV - TC_GQK), 4, 4, q, (char*)lds, MB); }
            }
#endif
            __syncthreads(); PROF_TICK(31);
#if (PHM & 16)
            {   MKF(); MK_SP();
                {
                    const bool dry = false;
                    volatile LAS int* qs = (volatile LAS int*)(F.lds + MISC_OFF + 96); unsigned* qh = (unsigned*)(F.ctl() + CW_QUEUE + (l * 2 + 1) * 64);
                    if (F.tid == 0) { qs[2] = (int)__hip_atomic_fetch_add(qh, 1u, RLX_AGENT); qs[3] = (int)__hip_atomic_fetch_add(qh, 1u, RLX_AGENT); }
                    __syncthreads();
                    UnitId id, idn; ScanRegs RA, RB; int u = qs[2], un = qs[3]; bool ok = unit_decode_q(u, l, true, id), okn = unit_decode_q(un, l, true, idn); int par = 0;
                    if (ok) scan_fetch<true>(F, l, id, sp, RA);
                    while (ok) {
                        if (okn) scan_fetch<true>(F, l, idn, sp, RB);
                        if (F.tid == 0) qs[par] = (int)__hip_atomic_fetch_add(qh, 1u, RLX_AGENT);
                        if (id.fam == 0) scan_out_unit<true>(F, l, id.b, id.head, id.tc, sp, RA, dry); else scan_out_unit<false>(F, l, id.b, id.head, id.tc, sp, RA, dry);
                        const int u2 = qs[par]; par ^= 1;
                        RA = RB; id = idn; ok = okn; okn = unit_decode_q(u2, l, true, idn); }
                }
            }
#endif
#endif
        }
        SEAM(pb + 3);
        if (IN(pb + 4)) {
#if DBG_LEVEL >= 3 && (PHM & 32)
            for (int rep = 0; rep < R_MRG; ++rep) { SchedMerge S; S.G = opq_s((int)gridDim.x); S.c = opq_s((int)blockIdx.x); S.npan = (l == 0) ? NPAN : NPAN_L; S.ws = opq(args.ws); S.bgate = args.in[I_BGATE] + (size_t)l * 4096;
            pg8::gemm_stream((LAS unsigned char*)lds, S); }
#endif
        }
        SEAM(pb + 4);
        if (IN(pb + 5)) {
#if DBG_LEVEL >= 3 && (PHM & 64)
            SchedOut S; S.G = opq_s((int)gridDim.x); S.c = opq_s((int)blockIdx.x); S.npan = (l == 0) ? NPAN : NPAN_L; S.l = l; S.ws = opq(args.ws); S.xlat = (l == 0) ? args.in[I_X] : args.out; S.xctx = (l == 0) ? args.in[I_CTX] : (const float*)(args.ws + WS_XC);
            if (l == 0) { MKF(); build_ctx_panels(F); }
            for (int rep = 0; rep < R_OUT; ++rep) pg8::gemm_stream((LAS unsigned char*)lds, S);
#else
            MKF(); phase_scale_rows(F, l, true);
#endif
        }
        SEAM(pb + 5);
        if (IN(pb + 6)) { MKF();
#if DBG_LEVEL >= 3 && (PHM & 64)
            phase_post_mix(F, l, l == 0 ? R : RL, (const float*)(F.ws + WS_P)); if (l == 0) for (int rep = 1; rep < R_PM0; ++rep) phase_post_mix(F, l, R, (const float*)(F.ws + WS_P));
#else
            phase_post_mix(F, l, l == 0 ? R : RL, F.XM());
#endif
        }
        if (l == 1) SEAM(pb + 6);
        if (IN(pb + 7)) { if (l == 1) { MKF(); phase_moe_assign(F); } }
        SEAM(pb + 7);
        if (IN(pb + 8)) {
#if DBG_LEVEL >= 2
            for (int rep = 0; rep < R_UP; ++rep) {
            if (l == 0) { SchedUp S; S.G = opq_s((int)gridDim.x); S.c = opq_s((int)blockIdx.x); S.ws = opq(args.ws); pg8::gemm_stream((LAS unsigned char*)lds, S); }
            else { SchedMoeUp S; S.G = opq_s((int)gridDim.x); S.c = opq_s((int)blockIdx.x); S.mt.ws = opq(args.ws); S.mt.lds = (LAS unsigned char*)lds; S.nt_ = *(const volatile int*)S.mt.ntiles();
                for (int t_ = threadIdx.x; t_ < MOE_MAXT; t_ += 512) ((LAS int*)((LAS unsigned char*)lds + TILE_E_OFF))[t_] = ((const GAS int*)S.mt.tile_e())[t_]; __syncthreads(); pg8::gemm_stream((LAS unsigned char*)lds, S); } }
#endif
        }
        SEAM(pb + 8);
        if (IN(pb + 9)) {
#if DBG_LEVEL >= 2
            if (l == 0) { SchedDown S; S.G = opq_s((int)gridDim.x); S.c = opq_s((int)blockIdx.x); S.l = 0; S.ws = opq(args.ws); pg8::gemm_stream((LAS unsigned char*)lds, S); }
            else { SchedMoeDown S; S.G = opq_s((int)gridDim.x); S.c = opq_s((int)blockIdx.x); S.mt.ws = opq(args.ws); S.mt.lds = (LAS unsigned char*)lds; S.Dst = (bf16*)args.out; S.nt_ = *(const volatile int*)S.mt.ntiles();
                for (int t_ = threadIdx.x; t_ < MOE_MAXT; t_ += 512) ((LAS int*)((LAS unsigned char*)lds + TILE_E_OFF))[t_] = ((const GAS int*)S.mt.tile_e())[t_]; __syncthreads(); for (int rep = 0; rep < R_MDN; ++rep) pg8::gemm_stream((LAS unsigned char*)lds, S); }
#else
            MKF();
            if (l == 0) phase_scale_rows(F, l, false);
            else { for (size_t i = (size_t)F.vcu * 512 + F.tid; i < (size_t)RL * D / 4; i += (size_t)F.G * 512) ((v4u*)F.out)[i] = (v4u){0u, 0u, 0u, 0u}; }
#endif
        }
        SEAM(pb + 9);
        if (IN(pb + 10)) { MKF(); phase_final(F, l); if (l == 0) for (int rep = 1; rep < R_FIN0; ++rep) phase_final(F, l); __syncthreads(); PROF_TICK(28); if (l == 0) { for (int rep = 0; rep < R_CONV; ++rep) convert_layer_weights(F, 1); } }
        if (l == 0) SEAM(pb + 10);
    }
__global__ void __launch_bounds__(NWAVES * 64, 2) mega_fwd(Args args) {
    extern __shared__ __attribute__((aligned(16))) unsigned char lds[];
    {   LAS unsigned char* L = (LAS unsigned char*)lds; const int tid = threadIdx.x;
        for (int u = tid; u < (LDS_BYTES - LDSCTL_OFF) / 4; u += NWAVES * 64) ((LAS unsigned*)(L + LDSCTL_OFF))[u] = 0u;
        __syncthreads();
        if (tid == 0) {
#pragma unroll
            for (int i = 0; i < 30; ++i) *(LAS unsigned long long*)(L + INTAB_OFF + 8 * i) = (unsigned long long)args.in[i]; }
        __syncthreads();
        if (PROF_MASK != 0u && blockIdx.x == PROF_WG && tid == 0) { volatile LAS unsigned long long* pw_ = (volatile LAS unsigned long long*)(L + MISC_OFF + 64); pw_[0] = __builtin_amdgcn_s_memrealtime(); pw_[1] = 0ull; }
        (void)xcd_barrier_post((unsigned*)((gu32*)(args.ws + WS_CTL) + CW_BAR) + args.li * XCD_BAR_WORDS, (volatile LAS unsigned*)(L + MISC_OFF) + 8);
    }
    if (IN(0)) { MKF(); for (int rep = 0; rep < R_PRO; ++rep) { build_tables(F); convert_layer_weights(F, 0); __syncthreads(); PROF_TICK(27); ada_phase(F); } }
    SEAM(0);
    if (IN(1)) { MKF(); for (int rep = 0; rep < R_PRO; ++rep) phase_ln_mod(F, 0); }
    SEAM(1);
    layer_body<0>(args, lds);
    layer_body<1>(args, lds);
    PROF_TICK(N_PHASES - 1);
    if (PROF_MASK != 0u && blockIdx.x == PROF_WG && threadIdx.x == 0) { volatile LAS unsigned long long* pw_ = (volatile LAS unsigned long long*)((LAS unsigned char*)lds + MISC_OFF + 64);
        const unsigned long long t0_ = pw_[0], w_ = 4ull * pw_[1]; while (__builtin_amdgcn_s_memrealtime() - t0_ < w_) __builtin_amdgcn_s_sleep(8); }
}
#undef IN
#undef SEAM


extern "C" void kernel_launch(void* const* d_in, const int* in_sizes, int n_in, void* d_out, int out_size, void* d_ws, size_t ws_size, hipStream_t stream) {
    static int grid = 0;
    if (grid == 0) {
        if (n_in != 30 || out_size != RL * D || ws_size < WS_END) { fprintf(stderr, "kernel_launch: unexpected problem (n_in %d out %d ws %zu)\n", n_in, out_size, ws_size); grid = -1; return; }
        int dev = 0, cus = 0;
        if (hipGetDevice(&dev) != hipSuccess || hipDeviceGetAttribute(&cus, hipDeviceAttributeMultiprocessorCount, dev) != hipSuccess) { grid = -1; return; }
        if (hipFuncSetAttribute((const void*)mega_fwd, hipFuncAttributeMaxDynamicSharedMemorySize, LDS_BYTES) != hipSuccess) { fprintf(stderr, "kernel_launch: hipFuncSetAttribute failed\n"); grid = -1; return; }
        int per_cu = 0; (void)hipOccupancyMaxActiveBlocksPerMultiprocessor(&per_cu, (const void*)mega_fwd, NWAVES * 64, LDS_BYTES); (void)hipGetLastError();
        grid = cus;
        if (per_cu < 1) fprintf(stderr, "kernel_launch: occupancy query says %d\n", per_cu);
    }
    if (grid < 0) return;
    if (hipMemsetAsync((char*)d_ws + WS_CTL, 0, CTL_ZERO_BYTES, stream) != hipSuccess) return;
    Args a{};
    for (int i = 0; i < 30; ++i) a.in[i] = (const float*)d_in[i];
    a.out = (float*)d_out; a.ws = (unsigned char*)d_ws;
#if MK_N_LAUNCHES == 1
    a.ph_lo = 0; a.ph_hi = N_PHASES; a.li = 0;
    hipLaunchKernelGGL(mega_fwd, dim3(grid), dim3(NWAVES * 64), LDS_BYTES, stream, a);
#else
    for (int k = 0; k < N_PHASES; ++k) { a.ph_lo = k; a.ph_hi = k + 1; a.li = 0; hipLaunchKernelGGL(mega_fwd, dim3(grid), dim3(NWAVES * 64), LDS_BYTES, stream, a); }
#endif
}
```

```cpp
#include <hip/hip_runtime.h>
#include <hip/hip_bf16.h>
#include <cstdio>
#include <cstdint>

#ifndef MK_N_LAUNCHES
#define MK_N_LAUNCHES 1
#endif
#ifndef DBG_LEVEL
#define DBG_LEVEL 99
#endif

#define GAS __attribute__((address_space(1)))
#define LAS __attribute__((address_space(3)))
typedef unsigned short bf16;
typedef unsigned v4u __attribute__((ext_vector_type(4)));
typedef unsigned v2u __attribute__((ext_vector_type(2)));
typedef float f32x4 __attribute__((ext_vector_type(4)));
typedef float f32x2 __attribute__((ext_vector_type(2)));
typedef short bf16x8 __attribute__((ext_vector_type(8)));
typedef float f32x16 __attribute__((ext_vector_type(16)));
typedef GAS unsigned gu32;
#define RLX_AGENT __ATOMIC_RELAXED, __HIP_MEMORY_SCOPE_AGENT
#define LDS_WAIT() asm volatile("s_waitcnt lgkmcnt(0)" ::: "memory")
#define VM_WAIT() asm volatile("s_waitcnt vmcnt(0)" ::: "memory")

constexpr int D = 1024, NB = 2, T = 16384, CTX = 256;
constexpr int RL = NB * T;
constexpr int R = RL + NB * CTX;
constexpr int NPAN = R / 256, NPAN_L = RL / 256;
constexpr int NIN = 3120;
constexpr int NP = 3072;
constexpr int TC_MLQ = 0, TC_MLK = 256, TC_MLV = 512, TC_MLO = 768, TC_FT = 1024, TC_GQQ = 1280, TC_GQK = 1792, TC_GQV = 1920,
              TC_GLQ = 2048, TC_GLK = 2304, TC_GLV = 2560, TC_GLR = 2816;
constexpr int SMP = 64;
constexpr int FFD = 2816, NEXP = 8, FFE = 1408;
constexpr float LN_EPS = 1e-6f;
constexpr float ALPHA = 1.4142135623730951f;
constexpr int NCH = 260;
constexpr int NCHAIN = 16;
constexpr float C2Q = 0.125f * 1.4426950408889634f;

constexpr size_t MiB = 1u << 20;
constexpr size_t WS_CTL = 0, CTL_ZERO_BYTES = 128 * 1024;
constexpr size_t WS_ADA = 1 * MiB;
constexpr size_t WS_TAB = WS_ADA + 256 * 1024;
constexpr size_t WS_ROPE_C = WS_TAB, WS_ROPE_S = WS_TAB + 16384, WS_DFT_C = WS_TAB + 32768, WS_DFT_S = WS_DFT_C + 32768;
constexpr size_t WS_MOE = 2 * MiB;
constexpr size_t WS_XC = 4 * MiB;
constexpr size_t WS_SM = 6 * MiB;
constexpr size_t WS_SCAL = 15 * MiB;
constexpr size_t WS_W = 20 * MiB;
constexpr size_t W_IN = 0, W_GATE = W_IN + (size_t)3328 * 1024 * 2, W_OUT = W_GATE + (size_t)4096 * 1024 * 2,
                 W_BML = W_OUT + (size_t)1024 * 1024 * 2, W_BFT = W_BML + (size_t)1024 * 256 * 2, W_BAT = W_BFT + (size_t)1024 * 512 * 2,
                 W_BGL = W_BAT + (size_t)1024 * 512 * 2, W_FFN = W_BGL + (size_t)1024 * 256 * 2;
constexpr size_t W_FFD_GU = W_FFN, W_FFD_D = W_FFN + (size_t)5632 * 1024 * 2;
constexpr size_t W_MOE_GU = W_FFN, W_MOE_D = W_FFN + (size_t)8 * 2816 * 1024 * 2;
constexpr size_t W_END = W_MOE_D + (size_t)8 * 1024 * 1408 * 2;
static_assert(W_END <= 86 * MiB, "weights region");
constexpr size_t WS_H = 106 * MiB;
constexpr size_t WS_P = 172 * MiB;
constexpr size_t WS_XM = 368 * MiB;
constexpr size_t WS_UQ = 498 * MiB;
constexpr size_t WS_PA = 502 * MiB;
constexpr size_t WS_OPART = 172 * MiB + 160 * MiB;
constexpr size_t WS_DP = 502 * MiB;
constexpr size_t WS_END = 510 * MiB;
static_assert(WS_H + (size_t)R * 1024 * 2 <= WS_P && WS_P + (size_t)R * NP * 2 <= WS_XM && WS_XM + (size_t)R * 1024 * 4 <= WS_END, "ws map");
constexpr size_t XO_MLC = 0;
constexpr size_t XO_GLS = 33 * MiB;
constexpr size_t XO_MIX = 0;
constexpr size_t XO_IM1 = 68 * MiB;
constexpr size_t XO_GST = 65 * MiB;
constexpr size_t XO_FT = 97 * MiB + 512 * 1024;
static_assert(XO_FT + (size_t)R * 512 * 2 <= (size_t)R * 1024 * 4 && XO_GST + 32 * MiB <= XO_FT && XO_IM1 + 16 * MiB <= XO_FT && XO_GLS + 33 * MiB <= XO_IM1, "XM overlays");
constexpr size_t SC_MLN = 0;
constexpr size_t SC_MLA = SC_MLN + (size_t)16 * 260 * 64 * 4;
constexpr size_t SC_MLB = SC_MLA + 16 * 260 * 4;
constexpr size_t SC_MLM = SC_MLB + 16 * 260 * 4;
constexpr size_t SC_GLD = SC_MLM + 16 * 260 * 4;
static_assert(SC_GLD + (size_t)16 * 260 * 64 * 4 <= 5 * MiB, "scal");
constexpr int MOE_MAXT = 264;
constexpr size_t MO_TOK = 0;
constexpr size_t MO_DST = MO_TOK + (size_t)MOE_MAXT * 256 * 4;
constexpr size_t MO_SEL = MO_DST + (size_t)MOE_MAXT * 256 * 4;
static_assert(MO_SEL + (size_t)RL * 16 <= 2 * MiB, "moe tables");
constexpr int CW_QUEUE = 2048  , CW_TMO = 0, CW_CODE = 1, CW_BAR = 4096, CW_MOECNT = 16384  , CW_MOECUR = 16384 + 8 * 64;
static_assert((CW_MOECUR + 8 * 64) * 4 <= (int)CTL_ZERO_BYTES && (CW_BAR + 3456) * 4 <= (int)CTL_ZERO_BYTES, "control words inside the per-call memset");
#define XB_TMO      128
#define XB_XCNT(j)  (256  + 64 * (j))
#define XB_XSUB(j)  (1280 + 64 * (j))
#define XB_XGEN(j)  (2304 + 64 * (j))
#define XB_TOP      3328
#define XB_TOPGEN   3392
#define XCD_BAR_WORDS 3456
#define XB_SPIN_CAP (1u << 18)

constexpr int RING_BYTES = 131072, LDSCTL_OFF = RING_BYTES, MISC_OFF = LDSCTL_OFF + 320, LDS_BYTES = 147456;
constexpr int NWAVES = 8;

#ifndef PROF_WG
#define PROF_WG 0
#endif
#ifndef PROF_MASK
#define PROF_MASK 0u
#endif
#define PROF_LDS lds
#define PROF_TICK(k) do { if (PROF_MASK != 0u && blockIdx.x == PROF_WG && threadIdx.x == 0) { volatile LAS unsigned long long* pw_ = (volatile LAS unsigned long long*)((LAS unsigned char*)PROF_LDS + MISC_OFF + 64); \
        const unsigned long long now_ = __builtin_amdgcn_s_memrealtime(); if ((PROF_MASK >> (k)) & 1u) pw_[1] += now_ - pw_[0]; pw_[0] = now_; if ((k) < 24) pw_[2] = (unsigned long long)((k) + 1); } } while (0)
#ifndef PROF_SEL
#define PROF_SEL -1
#endif
#define PROF_GEMM_ON() ((PROF_MASK & 0xE0000000u) != 0u && (PROF_SEL < 0 || (((volatile LAS unsigned long long*)((LAS unsigned char*)PROF_LDS + MISC_OFF + 64))[2] >= 2ull && (int)((((volatile LAS unsigned long long*)((LAS unsigned char*)PROF_LDS + MISC_OFF + 64))[2] - 2ull) % 11ull) == PROF_SEL)))
#define PROF_SPAN_BEGIN() do { if (PROF_MASK != 0u && blockIdx.x == PROF_WG && threadIdx.x == 0) { volatile LAS unsigned long long* pw_ = (volatile LAS unsigned long long*)((LAS unsigned char*)PROF_LDS + MISC_OFF + 64); pw_[0] = __builtin_amdgcn_s_memrealtime(); } } while (0)
template <class T_> __device__ __forceinline__ T_* opq(T_* p) { asm volatile("" : "+s"(p)); return p; }
__device__ __forceinline__ int opq_s(int v) { asm volatile("" : "+s"(v)); return v; }
__device__ __forceinline__ int opq_v(int v) { asm volatile("" : "+v"(v)); return v; }
__device__ __forceinline__ unsigned f2bf(float f) { unsigned u = __builtin_bit_cast(unsigned, f); return (u + 0x7fffu + ((u >> 16) & 1u)) >> 16; }
typedef __bf16 hwbf16x2 __attribute__((ext_vector_type(2)));
__device__ __forceinline__ unsigned pk2(float lo, float hi) { const f32x2 v = {lo, hi}; return __builtin_bit_cast(unsigned, __builtin_convertvector(v, hwbf16x2)); }
__device__ __forceinline__ float bflo(unsigned w) { return __uint_as_float(w << 16); }
__device__ __forceinline__ float bfhi(unsigned w) { return __uint_as_float(w & 0xffff0000u); }
__device__ __forceinline__ float bf2f(bf16 b) { return __uint_as_float((unsigned)b << 16); }
__device__ __forceinline__ void unpack8(const v4u a, float (&x)[8]) { x[0] = bflo(a.x); x[1] = bfhi(a.x); x[2] = bflo(a.y); x[3] = bfhi(a.y); x[4] = bflo(a.z); x[5] = bfhi(a.z); x[6] = bflo(a.w); x[7] = bfhi(a.w); }
__device__ __forceinline__ v4u pack8(const float (&x)[8]) { v4u w; w.x = pk2(x[0], x[1]); w.y = pk2(x[2], x[3]); w.z = pk2(x[4], x[5]); w.w = pk2(x[6], x[7]); return w; }
template <int CTRL> __device__ __forceinline__ float dpp_get(float v) { return __builtin_bit_cast(float, __builtin_amdgcn_update_dpp(0, __builtin_bit_cast(int, v), CTRL, 0xF, 0xF, true)); }
__device__ __forceinline__ float wave_sum(float v) {
    v += dpp_get<0xB1>(v);
    v += dpp_get<0x4E>(v);
    v += dpp_get<0x141>(v);
    v += dpp_get<0x140>(v);
    { const auto rr = __builtin_amdgcn_permlane16_swap(__float_as_uint(v), __float_as_uint(v), false, false); v = __uint_as_float(rr[0]) + __uint_as_float(rr[1]); }
    { const auto rr = __builtin_amdgcn_permlane32_swap(__float_as_uint(v), __float_as_uint(v), false, false); v = __uint_as_float(rr[0]) + __uint_as_float(rr[1]); }
    return v;
}
__device__ __forceinline__ float xor16_32_sum(float v) {
    { const auto rr = __builtin_amdgcn_permlane16_swap(__float_as_uint(v), __float_as_uint(v), false, false); v = __uint_as_float(rr[0]) + __uint_as_float(rr[1]); }
    { const auto rr = __builtin_amdgcn_permlane32_swap(__float_as_uint(v), __float_as_uint(v), false, false); v = __uint_as_float(rr[0]) + __uint_as_float(rr[1]); }
    return v; }
__device__ __forceinline__ float sigm(float x) { return __builtin_amdgcn_rcpf(1.f + __expf(-x)); }
__device__ __forceinline__ float logsig(float a) { return fminf(a, 0.f) - __logf(1.f + __expf(-fabsf(a))); }

__device__ __forceinline__ unsigned xb_ld(unsigned* p)              { return __hip_atomic_load(p, __ATOMIC_RELAXED, __HIP_MEMORY_SCOPE_AGENT); }
__device__ __forceinline__ unsigned xb_add(unsigned* p, unsigned v) { return __hip_atomic_fetch_add(p, v, __ATOMIC_RELAXED, __HIP_MEMORY_SCOPE_AGENT); }
__device__ __forceinline__ unsigned xb_xcc_id() { return (unsigned)__builtin_amdgcn_s_getreg((3 << 11) | 20) & 0xFu; }
#define XB_SPIN(cond, bar) do { unsigned _sp = 0; while (cond) { __builtin_amdgcn_s_sleep(1); \
    if ((++_sp & 255u) == 0u) { if (xb_ld(&(bar)[XB_TMO])) break; if (_sp > XB_SPIN_CAP) { atomicAdd(&(bar)[XB_TMO], 1u); break; } } } } while (0)
struct XcdBarrier { unsigned* bar; unsigned x; volatile LAS unsigned* st; };
__device__ __forceinline__ XcdBarrier xcd_barrier_post(unsigned* bar, volatile LAS unsigned* st) {
    XcdBarrier b; b.bar = bar; b.x = xb_xcc_id(); b.st = st;
    if (threadIdx.x == 0) (void)xb_add(&bar[XB_XCNT(b.x)], 1u);
    return b;
}
__device__ __forceinline__ void xcd_barrier_complete(unsigned* bar, unsigned x, unsigned& nloc, unsigned& nx) {
    const unsigned G = gridDim.x * gridDim.y * gridDim.z;
    unsigned sum, cnt, mine, sp = 0u;
    for (;;) {
        sum = 0u; cnt = 0u; mine = 0u;
#pragma unroll
        for (unsigned j = 0; j < 16; ++j) { const unsigned c = xb_ld(&bar[XB_XCNT(j)]); sum += c; cnt += (c > 0u) ? 1u : 0u; mine = (j == x) ? c : mine; }
        if (sum == G) break;
        __builtin_amdgcn_s_sleep(1);
        if ((++sp & 255u) == 0u) { if (xb_ld(&bar[XB_TMO])) break; if (sp > XB_SPIN_CAP) { atomicAdd(&bar[XB_TMO], 1u); break; } }
    }
    nloc = mine > 0u ? mine : 1u; nx = cnt > 0u ? cnt : 1u;
}
__device__ __forceinline__ void xcd_barrier(const XcdBarrier& b) {
    asm volatile("s_waitcnt vmcnt(0)" ::: "memory");
    __syncthreads();
    if (threadIdx.x == 0) {
        unsigned* bar = b.bar;
        __builtin_amdgcn_s_waitcnt(0);
        unsigned nloc = b.st[0], nx = b.st[1];
        if (nloc == 0u) { xcd_barrier_complete(bar, b.x, nloc, nx); b.st[0] = nloc; b.st[1] = nx; }
        const unsigned old = xb_add(&bar[XB_XSUB(b.x)], 1u);
        const unsigned gen = old / nloc;
        if (old + 1u == (gen + 1u) * nloc) {
            __builtin_amdgcn_fence(__ATOMIC_RELEASE, "agent");
            asm volatile("s_waitcnt vmcnt(0)" ::: "memory");
            const unsigned og = xb_add(&bar[XB_TOP], 1u);
            const unsigned tg = og / nx;
            if (og + 1u == (tg + 1u) * nx) xb_add(&bar[XB_TOPGEN], 1u);
            else XB_SPIN(xb_ld(&bar[XB_TOPGEN]) == tg, bar);
            __builtin_amdgcn_fence(__ATOMIC_ACQUIRE, "agent");
            xb_add(&bar[XB_XGEN(b.x)], 1u);
            asm volatile("s_waitcnt vmcnt(0)" ::: "memory");
        } else {
            XB_SPIN(xb_ld(&bar[XB_XGEN(b.x)]) == gen, bar);
            __builtin_amdgcn_fence(__ATOMIC_ACQUIRE, "agent");
            asm volatile("s_waitcnt vmcnt(0)" ::: "memory");
        }
    }
    __syncthreads();
}
namespace pg8 {
constexpr int BM = 256, BK = 64, HALF = 128, HTB = HALF * BK * 2, STAGE_BYTES = 8 * HTB, NXCD = 8, WGM = 4;
__host__ __device__ __forceinline__ int lds_byte(int r, int c) { const int st = (r >> 4) * 2 + (c >> 5), rr = r & 15, cc = c & 31, ob = rr * 64 + cc * 2; return st * 1024 + (ob ^ (((ob >> 9) & 1) << 5)); }
__host__ __device__ __forceinline__ void stage_rc(int b, int& R_, int& C_) { const int st = b / 1024, sb = b % 1024, swz = sb ^ (((sb >> 9) & 1) << 5); R_ = (st >> 1) * 16 + swz / 64; C_ = (st & 1) * 32 + (swz % 64) / 2; }
__host__ __device__ __forceinline__ int perm32(int rho) { const int n = rho >> 4, i = rho & 15; return 8 * (i >> 2) + 4 * n + (i & 3); }
struct GU { unsigned ao, bo; unsigned lda, ldb; int nt; int pm, pn, kind, aux; };
template <int WGM_ = WGM>
__device__ __forceinline__ bool tile_of(long L, int nM, int nN, int& pm, int& pn) {
    const int nwg = nM * nN; if (L >= nwg) return false;
    int wgid = (int)L; { const int q = nwg / NXCD, r = nwg % NXCD, xcd = wgid % NXCD, off = wgid / NXCD; wgid = (xcd < r ? xcd * (q + 1) : r * (q + 1) + (xcd - r) * q) + off; }
    const int nig = WGM_ * nN, gid = wgid / nig, fm = gid * WGM_, gsz = (nM - fm) < WGM_ ? (nM - fm) : WGM_;
    pm = fm + ((wgid % nig) % gsz); pn = (wgid % nig) / gsz; return true;
}
__device__ __forceinline__ unsigned cvt_pk_bf16(float lo, float hi) { return pk2(lo, hi); }

template <class S>
__device__ __forceinline__ void gemm_stream(LAS unsigned char* lds, const S& sch) {
    const int tid = opq_v((int)threadIdx.x), wid = __builtin_amdgcn_readfirstlane(tid >> 6), lane = tid & 63, wr = wid >> 2, wc = wid & 3, fr = lane & 15, fq = lane >> 4;
    const unsigned ldsw = (unsigned)wid * 1024u;
    const int aoff = lds_byte(wr * 64 + fr, fq * 8), boff = lds_byte(wc * 32 + fr, fq * 8);
#define PG8_SA(b, h) (((b) * 2 + (h)) * HTB)
#define PG8_SB(b, h) ((4 + (b) * 2 + (h)) * HTB)
#define PG8_STG(bufoff, soff, o0, o1) do { \
        __builtin_amdgcn_raw_ptr_buffer_load_lds(rs, (LAS unsigned*)(lds + (bufoff) + ldsw), 16, (o0), (soff), 0, 0); \
        __builtin_amdgcn_raw_ptr_buffer_load_lds(rs, (LAS unsigned*)(lds + (bufoff) + ldsw + 8192), 16, (o1), (soff), 0, 0); } while (0)
#define PG8_LDA(dst, b, h) do { _Pragma("unroll") for (int m = 0; m < 4; ++m) _Pragma("unroll") for (int k = 0; k < 2; ++k) dst[m][k] = *(const LAS bf16x8*)(lds + PG8_SA(b, h) + aoff + m * 2048 + k * 1024); } while (0)
#define PG8_LDB(dst, b, h) do { _Pragma("unroll") for (int n = 0; n < 2; ++n) _Pragma("unroll") for (int k = 0; k < 2; ++k) dst[n][k] = *(const LAS bf16x8*)(lds + PG8_SB(b, h) + boff + n * 2048 + k * 1024); } while (0)
#define PG8_MMA(ai, bj, At, Bt) do { __builtin_amdgcn_s_setprio(1); _Pragma("unroll") for (int m = 0; m < 4; ++m) _Pragma("unroll") for (int n = 0; n < 2; ++n) _Pragma("unroll") for (int k = 0; k < 2; ++k) \
        acc[ai][bj][m][n] = __builtin_amdgcn_mfma_f32_16x16x32_bf16(Bt[n][k], At[m][k], acc[ai][bj][m][n], 0, 0, 0); __builtin_amdgcn_s_setprio(0); } while (0)
#define PG8_WAIT_V(n) asm volatile("s_waitcnt vmcnt(" #n ")" ::: "memory")
#define PG8_WAIT_L(n) asm volatile("s_waitcnt lgkmcnt(" #n ")" ::: "memory")
#define PG8_BAR __builtin_amdgcn_s_barrier()
#define PG8_SCHED __builtin_amdgcn_sched_barrier(0)
#define PG8_SETUP(u, oA, oB, hB) do { _Pragma("unroll") for (int i = 0; i < 2; ++i) { \
        int R_, C_; stage_rc(tid * 16 + i * 8192, R_, C_); const unsigned RA_ = (unsigned)R_, RB_ = (unsigned)(S::PERM ? ((R_ & ~31) + perm32(R_ & 31)) : R_), CB_ = (unsigned)C_ * 2u; \
        if constexpr (S::GATHER) { oA[0][i] = sch.arow(u, (int)RA_) + CB_; oA[1][i] = sch.arow(u, (int)RA_ + 128) + CB_; } \
        else { oA[0][i] = RA_ * (u).lda + CB_; oA[1][i] = oA[0][i] + 128u * (u).lda; } \
        oB[i] = RB_ * (u).ldb + CB_; } hB = 128u * (u).ldb; } while (0)
    GU cur, nxt; int ui = 0;
    if (!sch.next(0, cur)) return;
    f32x4 acc[2][2][4][2];
#pragma unroll
    for (int a = 0; a < 2; ++a)
#pragma unroll
        for (int b = 0; b < 2; ++b)
#pragma unroll
            for (int m = 0; m < 4; ++m)
#pragma unroll
                for (int n = 0; n < 2; ++n) acc[a][b][m][n] = (f32x4){0.f, 0.f, 0.f, 0.f};
    bf16x8 At[4][2], B0[2][2], B1[2][2];
    const __amdgpu_buffer_rsrc_t rs = __builtin_amdgcn_make_buffer_rsrc((void*)sch.wsbase(), (short)0, (int)WS_END, 0x00020000);
    unsigned oA[2][2], oB[2]; unsigned hB;
    PG8_SETUP(cur, oA, oB, hB);
    unsigned cA = cur.ao, cB = cur.bo;
    PG8_STG(PG8_SB(0, 0), cB, oB[0], oB[1]); PG8_STG(PG8_SB(0, 1), cB + hB, oB[0], oB[1]); PG8_STG(PG8_SA(0, 0), cA, oA[0][0], oA[0][1]); PG8_STG(PG8_SA(0, 1), cA, oA[1][0], oA[1][1]);
    if (wr == 1) PG8_BAR;
    PG8_WAIT_V(2); PG8_BAR;
    PG8_STG(PG8_SB(1, 0), cB + 128, oB[0], oB[1]); PG8_STG(PG8_SA(1, 0), cA + 128, oA[0][0], oA[0][1]); PG8_STG(PG8_SB(1, 1), cB + hB + 128, oB[0], oB[1]);
    PG8_WAIT_V(6); PG8_BAR;
    if (PROF_GEMM_ON()) { PROF_TICK(31); }
    for (;;) {
        const bool has_next = sch.next(ui + 1, nxt);
        unsigned gA[2][2];
        if constexpr (S::GATHER) { if (has_next) {
#pragma unroll
            for (int i = 0; i < 2; ++i) { int R_, C_; stage_rc(tid * 16 + i * 8192, R_, C_); gA[0][i] = sch.arow(nxt, R_) + (unsigned)C_ * 2u; gA[1][i] = sch.arow(nxt, R_ + 128) + (unsigned)C_ * 2u; } } }
        const int nt = cur.nt;
        for (int t = 0; t < nt; t += 2) {
            const bool last = (t == nt - 2);
            const unsigned a1 = cA + (unsigned)(t + 1) * 128u;
            PG8_LDB(B0, 0, 0); PG8_LDB(B1, 0, 1); PG8_SCHED; PG8_LDA(At, 0, 0); PG8_STG(PG8_SA(1, 1), a1, oA[1][0], oA[1][1]);
            PG8_WAIT_V(8); PG8_WAIT_L(0); PG8_BAR; PG8_MMA(0, 0, At, B0); PG8_MMA(0, 1, At, B1); PG8_BAR; PG8_SCHED;
            unsigned a2 = cA + (unsigned)(t + 2) * 128u, b2 = cB + (unsigned)(t + 2) * 128u;
            if (last) { a2 = cA; b2 = cB;
                if (has_next) { a2 = nxt.ao; b2 = nxt.bo;
                    if constexpr (S::GATHER) { oA[0][0] = gA[0][0]; oA[0][1] = gA[0][1]; oA[1][0] = gA[1][0]; oA[1][1] = gA[1][1];
#pragma unroll
                        for (int i = 0; i < 2; ++i) { int R_, C_; stage_rc(tid * 16 + i * 8192, R_, C_); const unsigned RB_ = (unsigned)(S::PERM ? ((R_ & ~31) + perm32(R_ & 31)) : R_); oB[i] = RB_ * nxt.ldb + (unsigned)C_ * 2u; }
                        hB = 128u * nxt.ldb; }
                    else { PG8_SETUP(nxt, oA, oB, hB); } } }
            const unsigned a3 = a2 + 128u, b3 = b2 + 128u;
            PG8_LDA(At, 0, 1); PG8_STG(PG8_SB(0, 0), b2, oB[0], oB[1]); PG8_STG(PG8_SB(0, 1), b2 + hB, oB[0], oB[1]); PG8_STG(PG8_SA(0, 0), a2, oA[0][0], oA[0][1]);
            PG8_WAIT_V(8); PG8_WAIT_L(0); PG8_BAR; PG8_MMA(1, 0, At, B0); PG8_MMA(1, 1, At, B1); PG8_BAR; PG8_SCHED;
            PG8_LDB(B0, 1, 0); PG8_LDB(B1, 1, 1); PG8_SCHED; PG8_LDA(At, 1, 0); PG8_STG(PG8_SA(0, 1), a2, oA[1][0], oA[1][1]);
            PG8_WAIT_V(8); PG8_WAIT_L(0); PG8_BAR; PG8_MMA(0, 0, At, B0); PG8_MMA(0, 1, At, B1); PG8_BAR; PG8_SCHED;
            PG8_LDA(At, 1, 1); PG8_STG(PG8_SB(1, 0), b3, oB[0], oB[1]); PG8_STG(PG8_SB(1, 1), b3 + hB, oB[0], oB[1]); PG8_STG(PG8_SA(1, 0), a3, oA[0][0], oA[0][1]);
            PG8_WAIT_V(8); PG8_WAIT_L(0); PG8_BAR; PG8_MMA(1, 0, At, B0); PG8_MMA(1, 1, At, B1); PG8_BAR; PG8_SCHED;
        }
        if (wr == 0) PG8_BAR;
        { const bool pon_ = PROF_GEMM_ON(); if (pon_) { PROF_TICK(29); } sch.epi(acc, cur, wr, wc, fr, fq); if (pon_) { asm volatile("s_waitcnt vmcnt(0)" ::: "memory"); PROF_TICK(30); } }
        if (!has_next) break;
#pragma unroll
        for (int a = 0; a < 2; ++a)
#pragma unroll
            for (int b = 0; b < 2; ++b)
#pragma unroll
                for (int m = 0; m < 4; ++m)
#pragma unroll
                    for (int n = 0; n < 2; ++n) acc[a][b][m][n] = (f32x4){0.f, 0.f, 0.f, 0.f};
        cur = nxt; cA = cur.ao; cB = cur.bo; ++ui;
        if (wr == 1) PG8_BAR;
    }
    PG8_WAIT_V(0);
    PG8_BAR;
#undef PG8_SA
#undef PG8_SB
#undef PG8_STG
#undef PG8_LDA
#undef PG8_LDB
#undef PG8_MMA
#undef PG8_WAIT_V
#undef PG8_WAIT_L
#undef PG8_BAR
#undef PG8_SCHED
#undef PG8_SETUP
}
}
struct Args { const float* in[30]; float* out; unsigned char* ws; int ph_lo, ph_hi, li, pad; };
constexpr int INTAB_OFF = LDSCTL_OFF + 512;
constexpr int TILE_E_OFF = LDSCTL_OFF + 1024;
struct InTab { LAS unsigned char* lds;
    __device__ __forceinline__ const float* operator[](int i) const { return (const float*)(*(const LAS unsigned long long*)(lds + INTAB_OFF + 8 * i)); } };
struct Frame {
    LAS unsigned char* lds; volatile LAS unsigned* MISC;
    int tid, lane, wave, vcu, G;
    InTab in; float* out; unsigned char* ws;
    __device__ __forceinline__ gu32* ctl() const { return (gu32*)(ws + WS_CTL); }
    __device__ __forceinline__ bf16* H() const { return (bf16*)(ws + WS_H); }
    __device__ __forceinline__ bf16* P() const { return (bf16*)(ws + WS_P); }
    __device__ __forceinline__ float* XM() const { return (float*)(ws + WS_XM); }
    __device__ __forceinline__ float* XC() const { return (float*)(ws + WS_XC); }
    __device__ __forceinline__ float* SM() const { return (float*)(ws + WS_SM); }
    __device__ __forceinline__ float* ADA() const { return (float*)(ws + WS_ADA); }
};
enum { I_X = 0, I_C, I_CTX, I_CCTX, I_WADA, I_BADA, I_WIN, I_MLGB, I_MLNG, I_GQQG, I_GQKG, I_GLW2, I_GLB2, I_GLNG, I_WBR, I_WGATE, I_BGATE, I_WOUT,
       I_LN1G, I_LN1B, I_LN2G, I_LN2B, I_FFDWG, I_FFDWU, I_FFDWD, I_MOEWR, I_MOEBR, I_MOEWG, I_MOEWU, I_MOEWD };
__device__ __forceinline__ int set_of_panel(int pm) { return pm < 64 ? 0 : (pm < 128 ? 1 : 2); }
__device__ __forceinline__ int set_of_row(int r) { return r < T ? 0 : (r < RL ? 1 : 2); }
__device__ __forceinline__ const float* ada_vec(const Frame& F, int l, int set, int k) { return F.ADA() + ((size_t)(l * 3 + set) * 6 + k) * D; }
__device__ __forceinline__ const float* xin_row(const Frame& F, int l, int r) {
    if (l == 0) return r < RL ? F.in[I_X] + (size_t)r * D : F.in[I_CTX] + (size_t)(r - RL) * D;
    return r < RL ? F.out + (size_t)r * D : F.XC() + (size_t)(r - RL) * D;
}

typedef pg8::GU GU;
struct SchedBase { int G, c; };
struct SchedIn : SchedBase {
    static constexpr bool PERM = true, GATHER = false;
    unsigned char* ws;
    __device__ __forceinline__ bool next(int i, GU& u) const {
        if (!pg8::tile_of<8>((long)i * G + c, NPAN, 13, u.pm, u.pn)) return false;
        u.ao = (unsigned)WS_H + (unsigned)u.pm * 256u * D * 2u; u.lda = D * 2; u.bo = (unsigned)(WS_W + W_IN) + (unsigned)u.pn * 256u * D * 2u; u.ldb = D * 2; u.nt = D / 64; return true; }
    __device__ __forceinline__ unsigned char* wsbase() const { return ws; }
    __device__ __forceinline__ void epi(const f32x4 (&acc)[2][2][4][2], const GU& u, int wr, int wc, int fr, int fq) const {
        const int row0 = u.pm * 256 + wr * 64 + fr; bf16* P = (bf16*)(ws + WS_P); float* SM = (float*)(ws + WS_SM);
        if (u.pn < 12) {
#pragma unroll
            for (int ai = 0; ai < 2; ++ai)
#pragma unroll
                for (int m = 0; m < 4; ++m) { bf16* rowp = P + (size_t)(row0 + ai * 128 + m * 16) * NP + u.pn * 256 + wc * 32 + 8 * fq;
#pragma unroll
                    for (int bj = 0; bj < 2; ++bj) { const f32x4 v0 = acc[ai][bj][m][0], v1 = acc[ai][bj][m][1];
                        v4u w; w.x = pg8::cvt_pk_bf16(v0[0], v0[1]); w.y = pg8::cvt_pk_bf16(v0[2], v0[3]); w.z = pg8::cvt_pk_bf16(v1[0], v1[1]); w.w = pg8::cvt_pk_bf16(v1[2], v1[3]);
                        *(GAS v4u*)(rowp + bj * 128) = w; } }
        } else if (wc < 2) {
            const int col = wc * 32 + 8 * fq;
#pragma unroll
            for (int ai = 0; ai < 2; ++ai)
#pragma unroll
                for (int m = 0; m < 4; ++m) { float* rowp = SM + (size_t)(row0 + ai * 128 + m * 16) * SMP + col;
                    *(GAS f32x4*)(rowp) = acc[ai][0][m][0]; *(GAS f32x4*)(rowp + 4) = acc[ai][0][m][1]; }
        }
    }
};
struct SchedMerge : SchedBase {
    static constexpr bool PERM = true, GATHER = false;
    int npan; unsigned char* ws; const float* bgate;
    __device__ __forceinline__ bool next(int i, GU& u) const {
        const int njl = (NPAN_L * 4 - c + G - 1) / G;
        int j;
        if (i < 8 * njl) { pg8::tile_of((long)(i >> 3) * G + c, NPAN_L, 4, u.pm, u.pn); const int sub = i & 7; j = sub >> 1; u.kind = sub & 1; u.aux = j; }
        else { if (npan == NPAN_L) return false; const int qi = i - 8 * njl, qj = c + (qi >> 1) * G; if (qj >= 32) return false;
            u.pm = NPAN_L + (qj >> 4); u.pn = (qj >> 2) & 3; j = qj & 3; u.kind = qi & 1; u.aux = j + (u.kind ? 4 : 0); }
        unsigned ao, bo; unsigned la, lb; int nt;
        if (u.kind == 0) { ao = (unsigned)WS_H + (unsigned)u.pm * 256u * D * 2u; la = D * 2; bo = (unsigned)(WS_W + W_GATE) + ((unsigned)j * 1024u + u.pn * 256u) * D * 2u; lb = D * 2; nt = 16; }
        else { const bool isP = (j != 1); const int tc = (j == 0) ? TC_MLO : (j == 2 ? TC_GQQ : TC_GLR); const int kk = (j == 1 || j == 2) ? 512 : 256;
            ao = isP ? (unsigned)WS_P + ((unsigned)u.pm * 256u * NP + tc) * 2u : (unsigned)(WS_XM + XO_FT) + (unsigned)u.pm * 256u * 512u * 2u; la = isP ? NP * 2 : 1024;
            const unsigned wo = (unsigned)((j == 0) ? W_BML : (j == 1 ? W_BFT : (j == 2 ? W_BAT : W_BGL)));
            bo = (unsigned)WS_W + wo + (unsigned)u.pn * 256u * kk * 2u; lb = kk * 2; nt = kk / 64; }
        u.ao = ao; u.bo = bo; u.lda = la; u.ldb = lb; u.nt = nt;
        return true; }
    __device__ __forceinline__ unsigned char* wsbase() const { return ws; }
    __device__ __forceinline__ void epi(const f32x4 (&acc)[2][2][4][2], const GU& u, int wr, int wc, int fr, int fq) const {
        const int tid = threadIdx.x; v4u* sp_ = (v4u*)(ws + WS_XM + XO_GST) + (size_t)blockIdx.x * 8192 + tid;
        if (u.kind == 0) {
            const float* bp = bgate + u.aux * 1024 + u.pn * 256 + wc * 32 + 8 * fq;
            constexpr float NL2E = -1.4426950408889634f;
            f32x4 bs[2][2];
#pragma unroll
            for (int bj = 0; bj < 2; ++bj) { bs[bj][0] = *(const GAS f32x4*)(bp + bj * 128) * NL2E; bs[bj][1] = *(const GAS f32x4*)(bp + bj * 128 + 4) * NL2E; }
#define SG_(a_, b_) __builtin_amdgcn_rcpf(1.f + __builtin_amdgcn_exp2f(__builtin_fmaf((a_), NL2E, (b_))))
#pragma unroll
            for (int ai = 0; ai < 2; ++ai)
#pragma unroll
                for (int m = 0; m < 4; ++m)
#pragma unroll
                    for (int bj = 0; bj < 2; ++bj) { const f32x4 a0 = acc[ai][bj][m][0], a1 = acc[ai][bj][m][1], b0 = bs[bj][0], b1 = bs[bj][1];
                        v4u w; w.x = pg8::cvt_pk_bf16(SG_(a0[0], b0[0]), SG_(a0[1], b0[1])); w.y = pg8::cvt_pk_bf16(SG_(a0[2], b0[2]), SG_(a0[3], b0[3])); w.z = pg8::cvt_pk_bf16(SG_(a1[0], b1[0]), SG_(a1[1], b1[1])); w.w = pg8::cvt_pk_bf16(SG_(a1[2], b1[2]), SG_(a1[3], b1[3]));
                        *(GAS v4u*)sp_ = w; sp_ += 512; asm volatile("" : "+v"(sp_) :: "memory"); }
#undef SG_
        } else {
            bf16* rowp = (u.aux < 4 ? (bf16*)(ws + WS_XM + XO_MIX) + (size_t)(u.pm * 256) * D : (bf16*)(ws + WS_UQ) + ((size_t)(u.aux - 4) * 512 + (u.pm - NPAN_L) * 256) * D) + (size_t)(wr * 64 + fr) * D + u.pn * 256 + wc * 32 + 8 * fq;
            const bool accum = (u.aux > 0 && u.aux < 4);
            bf16* nxp = rowp; v4u g_n = *(const GAS v4u*)sp_; v4u p_n = (v4u){0u, 0u, 0u, 0u}; if (accum) p_n = *(const GAS v4u*)nxp;
#pragma unroll
            for (int e = 0; e < 16; ++e) { const int ai = e >> 3, m = (e >> 1) & 3, bj = e & 1;
                const v4u g = g_n, p = p_n; bf16* curp = nxp;
                if (e < 15) { sp_ += 512; asm volatile("" : "+v"(sp_)); nxp += (bj == 0) ? 128 : ((m == 3 ? 80 : 16) * D - 128); asm volatile("" : "+v"(nxp));
                    g_n = *(const GAS v4u*)sp_; if (accum) p_n = *(const GAS v4u*)nxp; }
                const f32x4 a0 = acc[ai][bj][m][0], a1 = acc[ai][bj][m][1];
                const float o0 = bflo(g.x) * a0[0] + bflo(p.x), o1 = bfhi(g.x) * a0[1] + bfhi(p.x), o2 = bflo(g.y) * a0[2] + bflo(p.y), o3 = bfhi(g.y) * a0[3] + bfhi(p.y);
                const float o4 = bflo(g.z) * a1[0] + bflo(p.z), o5 = bfhi(g.z) * a1[1] + bfhi(p.z), o6 = bflo(g.w) * a1[2] + bflo(p.w), o7 = bfhi(g.w) * a1[3] + bfhi(p.w);
                v4u w; w.x = pg8::cvt_pk_bf16(o0, o1); w.y = pg8::cvt_pk_bf16(o2, o3); w.z = pg8::cvt_pk_bf16(o4, o5); w.w = pg8::cvt_pk_bf16(o6, o7);
                *(GAS v4u*)curp = w; }
        }
    }
};
struct SchedOut : SchedBase {
    static constexpr bool PERM = false, GATHER = false;
    int npan, l; unsigned char* ws; const float* xlat; const float* xctx;
    __device__ __forceinline__ bool next(int i, GU& u) const {
        const int nul = (NPAN_L * 4 - c + G - 1) / G;
        if (i < nul) { pg8::tile_of((long)i * G + c, NPAN_L, 4, u.pm, u.pn); u.ao = (unsigned)(WS_XM + XO_MIX) + (unsigned)u.pm * 256u * D * 2u; u.aux = 0;
            u.lda = D * 2; u.bo = (unsigned)(WS_W + W_OUT) + (unsigned)u.pn * 256u * D * 2u; u.ldb = D * 2; u.nt = 16; return true; }
        if (npan == NPAN_L) return false; const int q = c + (i - nul) * G; if (q >= 32) return false; const int tile = q >> 2, kq = q & 3;
        u.pm = NPAN_L + (tile >> 2); u.pn = tile & 3; u.aux = 1 + kq; u.ao = (unsigned)WS_PA + (unsigned)q * 131072u; u.lda = 256 * 2;
        u.bo = (unsigned)(WS_W + W_OUT) + (unsigned)u.pn * 256u * D * 2u + (unsigned)kq * 512u; u.ldb = D * 2; u.nt = 4; return true; }
    __device__ __forceinline__ unsigned char* wsbase() const { return ws; }
    __device__ __forceinline__ void epi(const f32x4 (&acc)[2][2][4][2], const GU& u, int wr, int wc, int fr, int fq) const {
        const int r0 = u.pm * 256, col0 = u.pn * 256 + wc * 32 + 4 * fq, rl = wr * 64 + fr; const float* ada = (const float*)(ws + WS_ADA); float* XM = (float*)(ws + WS_P);
        if (u.aux != 0) {
            float* pp = (float*)(ws + WS_OPART) + ((size_t)(u.aux - 1) * 512 + (size_t)(u.pm - NPAN_L) * 256 + rl) * D + col0;
#pragma unroll
            for (int g = 0; g < 8; ++g) { const int ai = g >> 2, m = g & 3; float* oc = pp; if (g < 7) { pp += (m == 3 ? 80 : 16) * D; asm volatile("" : "+v"(pp)); }
                *(GAS f32x4*)(oc) = acc[ai][0][m][0]; *(GAS f32x4*)(oc + 16) = acc[ai][0][m][1]; *(GAS f32x4*)(oc + 128) = acc[ai][1][m][0]; *(GAS f32x4*)(oc + 144) = acc[ai][1][m][1]; }
            return; }
        const float* xs = r0 < RL ? xlat + (size_t)r0 * D : xctx + (size_t)(r0 - RL) * D; const float* gv = ada + ((size_t)(l * 3 + set_of_panel(u.pm)) * 6 + 2) * D + col0;
        f32x4 gg[2][2];
#pragma unroll
        for (int bj = 0; bj < 2; ++bj)
#pragma unroll
            for (int n = 0; n < 2; ++n) gg[bj][n] = *(const GAS f32x4*)(gv + bj * 128 + n * 16);
        const float* xp = xs + (size_t)rl * D + col0; float* op = XM + (size_t)(r0 + rl) * D + col0;
        f32x4 xq[4][4];
#pragma unroll
        for (int g = 0; g < 4; ++g) { xq[g][0] = *(const GAS f32x4*)(xp); xq[g][1] = *(const GAS f32x4*)(xp + 16); xq[g][2] = *(const GAS f32x4*)(xp + 128); xq[g][3] = *(const GAS f32x4*)(xp + 144);
            xp += (g == 3 ? 80 : 16) * D; asm volatile("" : "+v"(xp)); }
#pragma unroll
        for (int g = 0; g < 8; ++g) { const int ai = g >> 2, m = g & 3;
            const f32x4 x00 = xq[g & 3][0], x01 = xq[g & 3][1], x10 = xq[g & 3][2], x11 = xq[g & 3][3]; float* oc = op;
            if (g < 4) { xq[g & 3][0] = *(const GAS f32x4*)(xp); xq[g & 3][1] = *(const GAS f32x4*)(xp + 16); xq[g & 3][2] = *(const GAS f32x4*)(xp + 128); xq[g & 3][3] = *(const GAS f32x4*)(xp + 144);
                xp += 16 * D; asm volatile("" : "+v"(xp)); }
            if (g < 7) { op += (m == 3 ? 80 : 16) * D; asm volatile("" : "+v"(op)); }
            *(GAS f32x4*)(oc) = x00 * ALPHA + gg[0][0] * acc[ai][0][m][0]; *(GAS f32x4*)(oc + 16) = x01 * ALPHA + gg[0][1] * acc[ai][0][m][1];
            *(GAS f32x4*)(oc + 128) = x10 * ALPHA + gg[1][0] * acc[ai][1][m][0]; *(GAS f32x4*)(oc + 144) = x11 * ALPHA + gg[1][1] * acc[ai][1][m][1]; }
    }
};
__device__ __forceinline__ void swiglu_store(const f32x4 (&acc)[2][2][4][2], bf16* ACT, size_t pitch, int row0, int hid0, int wc, int fq) {
#pragma unroll
    for (int ai = 0; ai < 2; ++ai)
#pragma unroll
        for (int m = 0; m < 4; ++m) { bf16* rowp = ACT + (size_t)(row0 + ai * 128 + m * 16) * pitch + hid0 + wc * 16 + 4 * fq;
#pragma unroll
            for (int bj = 0; bj < 2; ++bj) { const f32x4 g = acc[ai][bj][m][0], uu = acc[ai][bj][m][1];
                v2u w; w.x = pg8::cvt_pk_bf16(g[0] * sigm(g[0]) * uu[0], g[1] * sigm(g[1]) * uu[1]); w.y = pg8::cvt_pk_bf16(g[2] * sigm(g[2]) * uu[2], g[3] * sigm(g[3]) * uu[3]);
                *(GAS v2u*)(rowp + bj * 64) = w; } }
}
struct SchedUp : SchedBase {
    static constexpr bool PERM = true, GATHER = false;
    unsigned char* ws;
    __device__ __forceinline__ bool next(int i, GU& u) const {
        if (!pg8::tile_of<8>((long)i * G + c, NPAN, 22, u.pm, u.pn)) return false;
        u.ao = (unsigned)WS_H + (unsigned)u.pm * 256u * D * 2u; u.lda = D * 2; u.bo = (unsigned)(WS_W + W_FFD_GU) + (unsigned)u.pn * 256u * D * 2u; u.ldb = D * 2; u.nt = 16; return true; }
    __device__ __forceinline__ unsigned char* wsbase() const { return ws; }
    __device__ __forceinline__ void epi(const f32x4 (&acc)[2][2][4][2], const GU& u, int wr, int wc, int fr, int fq) const {
        swiglu_store(acc, (bf16*)(ws + WS_P), FFD, u.pm * 256 + wr * 64 + fr, u.pn * 128, wc, fq); }
};
struct SchedDown : SchedBase {
    static constexpr bool PERM = false, GATHER = false;
    int l; unsigned char* ws;
    __device__ __forceinline__ bool next(int i, GU& u) const {
        const int nul = (NPAN_L * 4 - c + G - 1) / G; u.aux = 0; u.nt = FFD / 64; unsigned ko = 0;
        if (i < nul) pg8::tile_of((long)i * G + c, NPAN_L, 4, u.pm, u.pn);
        else { const int q = c + (i - nul) * G; if (q >= 32) return false; u.pm = NPAN_L + (q >> 4); u.pn = (q >> 2) & 3; const int kq = q & 3; u.aux = 1 + kq; u.nt = kq < 2 ? 12 : 10; ko = (unsigned)(kq * 12 - (kq == 3 ? 2 : 0)) * 128u; }
        u.ao = (unsigned)WS_P + (unsigned)u.pm * 256u * FFD * 2u + ko; u.lda = FFD * 2; u.bo = (unsigned)(WS_W + W_FFD_D) + (unsigned)u.pn * 256u * FFD * 2u + ko; u.ldb = FFD * 2; return true; }
    __device__ __forceinline__ unsigned char* wsbase() const { return ws; }
    __device__ __forceinline__ void epi(const f32x4 (&acc)[2][2][4][2], const GU& u, int wr, int wc, int fr, int fq) const {
        const int col0 = u.pn * 256 + wc * 32 + 4 * fq, row0 = u.pm * 256 + wr * 64 + fr; const float* ada = (const float*)(ws + WS_ADA); float* XM = (float*)(ws + WS_XM);
        if (u.aux) { float* dp = (float*)(ws + WS_DP) + ((size_t)(u.aux - 1) * 512 + (row0 - RL)) * D + col0;
#pragma unroll
            for (int ai = 0; ai < 2; ++ai)
#pragma unroll
                for (int m = 0; m < 4; ++m)
#pragma unroll
                    for (int bj = 0; bj < 2; ++bj)
#pragma unroll
                        for (int n = 0; n < 2; ++n) *(GAS f32x4*)(dp + (size_t)(ai * 128 + m * 16) * D + bj * 128 + n * 16) = acc[ai][bj][m][n];
            return; }
        const float* gv = ada + ((size_t)(l * 3 + set_of_panel(u.pm)) * 6 + 5) * D + col0;
        f32x4 gg[2][2];
#pragma unroll
        for (int bj = 0; bj < 2; ++bj)
#pragma unroll
            for (int n = 0; n < 2; ++n) gg[bj][n] = *(const GAS f32x4*)(gv + bj * 128 + n * 16);
        const float* xp = XM + (size_t)row0 * D + col0; float* op = XM + (size_t)row0 * D + col0;
        f32x4 xq[4][4];
#pragma unroll
        for (int g = 0; g < 4; ++g) { xq[g][0] = *(const GAS f32x4*)(xp); xq[g][1] = *(const GAS f32x4*)(xp + 16); xq[g][2] = *(const GAS f32x4*)(xp + 128); xq[g][3] = *(const GAS f32x4*)(xp + 144);
            xp += (g == 3 ? 80 : 16) * D; asm volatile("" : "+v"(xp)); }
#pragma unroll
        for (int g = 0; g < 8; ++g) { const int ai = g >> 2, m = g & 3;
            const f32x4 x00 = xq[g & 3][0], x01 = xq[g & 3][1], x10 = xq[g & 3][2], x11 = xq[g & 3][3]; float* oc = op;
            if (g < 4) { xq[g & 3][0] = *(const GAS f32x4*)(xp); xq[g & 3][1] = *(const GAS f32x4*)(xp + 16); xq[g & 3][2] = *(const GAS f32x4*)(xp + 128); xq[g & 3][3] = *(const GAS f32x4*)(xp + 144);
                xp += 16 * D; asm volatile("" : "+v"(xp)); }
            if (g < 7) { op += (m == 3 ? 80 : 16) * D; asm volatile("" : "+v"(op)); }
            *(GAS f32x4*)(oc) = x00 * ALPHA + gg[0][0] * acc[ai][0][m][0]; *(GAS f32x4*)(oc + 16) = x01 * ALPHA + gg[0][1] * acc[ai][0][m][1];
            *(GAS f32x4*)(oc + 128) = x10 * ALPHA + gg[1][0] * acc[ai][1][m][0]; *(GAS f32x4*)(oc + 144) = x11 * ALPHA + gg[1][1] * acc[ai][1][m][1]; }
    }
};
struct MoeTabs { unsigned char* ws; LAS unsigned char* lds;
    __device__ __forceinline__ int tile_e_lds(int t) const { return ((const LAS int*)(lds + TILE_E_OFF))[t]; }
    __device__ __forceinline__ const int* tok() const { return (const int*)(ws + WS_MOE + MO_TOK); }
    __device__ __forceinline__ const int* dst() const { return (const int*)(ws + WS_MOE + MO_DST); }
    __device__ __forceinline__ const int* tile_e() const { return (const int*)(ws + WS_MOE + MO_SEL + (size_t)RL * 16); }
    __device__ __forceinline__ const int* ntiles() const { return tile_e() + 512; } };
struct SchedMoeUp : SchedBase {
    static constexpr bool PERM = true, GATHER = true;
    MoeTabs mt; int nt_;
    __device__ __forceinline__ bool next(int i, GU& u) const {
        if (!pg8::tile_of<8>((long)i * G + c, nt_, 11, u.pm, u.pn)) return false;
        const int e = mt.tile_e_lds(u.pm); u.aux = e;
        u.ao = (unsigned)WS_H; u.lda = D * 2; u.bo = (unsigned)(WS_W + W_MOE_GU) + ((unsigned)e * 2816u + u.pn * 256u) * D * 2u; u.ldb = D * 2; u.nt = 16; return true; }
    __device__ __forceinline__ unsigned char* wsbase() const { return mt.ws; }
    __device__ __forceinline__ unsigned arow(const GU& u, int r) const { return (unsigned)((const GAS int*)mt.tok())[u.pm * 256 + r] * (unsigned)(D * 2); }
    __device__ __forceinline__ void epi(const f32x4 (&acc)[2][2][4][2], const GU& u, int wr, int wc, int fr, int fq) const {
        swiglu_store(acc, (bf16*)(mt.ws + WS_P), FFE, u.pm * 256 + wr * 64 + fr, u.pn * 128, wc, fq); }
};
struct SchedMoeDown : SchedBase {
    static constexpr bool PERM = true, GATHER = false;
    MoeTabs mt; bf16* Dst; int nt_;
    __device__ __forceinline__ bool next(int i, GU& u) const {
        if (!pg8::tile_of((long)i * G + c, nt_, 4, u.pm, u.pn)) return false;
        const int e = mt.tile_e_lds(u.pm);
        u.ao = (unsigned)WS_P + (unsigned)u.pm * 256u * FFE * 2u; u.lda = FFE * 2; u.bo = (unsigned)(WS_W + W_MOE_D) + ((unsigned)e * 1024u + u.pn * 256u) * FFE * 2u; u.ldb = FFE * 2; u.nt = FFE / 64; return true; }
    __device__ __forceinline__ unsigned char* wsbase() const { return mt.ws; }
    __device__ __forceinline__ void epi(const f32x4 (&acc)[2][2][4][2], const GU& u, int wr, int wc, int fr, int fq) const {
        const int srow0 = u.pm * 256 + wr * 64 + fr;
#pragma unroll
        for (int ai = 0; ai < 2; ++ai)
#pragma unroll
            for (int m = 0; m < 4; ++m) { asm volatile("" ::: "memory"); const int d = ((const GAS int*)mt.dst())[srow0 + ai * 128 + m * 16];
                if (d >= 0) { bf16* rowp = Dst + (size_t)d * D + u.pn * 256 + wc * 32 + 8 * fq;
#pragma unroll
                    for (int bj = 0; bj < 2; ++bj) { const f32x4 v0 = acc[ai][bj][m][0], v1 = acc[ai][bj][m][1];
                        v4u w; w.x = pg8::cvt_pk_bf16(v0[0], v0[1]); w.y = pg8::cvt_pk_bf16(v0[2], v0[3]); w.z = pg8::cvt_pk_bf16(v1[0], v1[1]); w.w = pg8::cvt_pk_bf16(v1[2], v1[3]);
                        *(GAS v4u*)(rowp + bj * 128) = w; } } }
    }
};
struct CvSeg { int first, K, nblk, ldw, kind; unsigned dst; const float* a; const float* b; };
constexpr int CVSEG_OFF = 12288, CVTOT_OFF = CVSEG_OFF + 2040;
#define RFL(x) __builtin_amdgcn_readfirstlane(x)
__device__ __forceinline__ const float* rfl_ptr(const float* p) { const unsigned long long v = (unsigned long long)p; const unsigned lo = RFL((unsigned)v), hi = RFL((unsigned)(v >> 32)); return (const float*)(((unsigned long long)hi << 32) | lo); }
__device__ __forceinline__ const float* cv_src(int kind, const float* a, const float* b, int n) {
    if (kind == 0) return a + n;
    if (kind == 1) { int o;
        if (n < 1024) o = n; else if (n < 1280) o = 1040 + (n - 1024); else if (n < 1792) o = 1296 + (n - 1280); else if (n < 2048) o = 1808 + (n - 1792);
        else if (n < 3072) o = 2064 + (n - 2048); else { const int j = n - 3072; if (j < 16) o = 1024 + j; else if (j < 48) o = 3088 + (j - 16); else return nullptr; }
        return a + o; }
    const int hid = (n >> 8) * 128 + ((n & 255) >> 3) * 4 + (n & 3); const long dlt = (n & 4) ? (long)(b - a) : 0l; return a + dlt + hid; }

__device__ __forceinline__ void convert_layer_weights(const Frame& F, int l) {
    unsigned char* wb = F.ws + WS_W;
    LAS CvSeg* seg = (LAS CvSeg*)(F.lds + CVSEG_OFF);
    const float* wbr = F.in[I_WBR] + (size_t)l * 1280 * D;
    __syncthreads();
    if (F.tid == 0) { int ns = 0, tot = 0;
#define CV_ADD(K_, N_, LDW_, KIND_, DST_, A_, B_) do { LAS CvSeg* g_ = seg + ns; g_->first = tot; g_->K = (K_); g_->nblk = (N_) / 64; g_->ldw = (LDW_); g_->kind = (KIND_); g_->dst = (unsigned)(DST_); g_->a = (A_); g_->b = (B_); tot += ((K_) / 64) * ((N_) / 64); ++ns; } while (0)
        CV_ADD(D, 3328, NIN, 1, W_IN, F.in[I_WIN] + (size_t)l * D * NIN, (const float*)nullptr);
        CV_ADD(D, 4096, 4096, 0, W_GATE, F.in[I_WGATE] + (size_t)l * D * 4096, (const float*)nullptr);
        CV_ADD(D, D, D, 0, W_OUT, F.in[I_WOUT] + (size_t)l * D * D, (const float*)nullptr);
        CV_ADD(256, D, D, 0, W_BML, wbr, (const float*)nullptr);
        CV_ADD(512, D, D, 0, W_BAT, wbr + (size_t)512 * D, (const float*)nullptr);
        CV_ADD(256, D, D, 0, W_BGL, wbr + (size_t)1024 * D, (const float*)nullptr);
        if (l == 0) { CV_ADD(D, 2 * FFD, FFD, 2, W_FFD_GU, F.in[I_FFDWG], F.in[I_FFDWU]); CV_ADD(FFD, D, D, 0, W_FFD_D, F.in[I_FFDWD], (const float*)nullptr); }
        else { const float* wg = F.in[I_MOEWG]; const float* wu = F.in[I_MOEWU]; const float* wd = F.in[I_MOEWD];
            for (int e = 0; e < NEXP; ++e) { CV_ADD(D, 2 * FFE, FFE, 2, W_MOE_GU + (size_t)e * 2816 * D * 2, wg + (size_t)e * D * FFE, wu + (size_t)e * D * FFE);
                CV_ADD(FFE, D, D, 0, W_MOE_D + (size_t)e * 1024 * FFE * 2, wd + (size_t)e * FFE * D, (const float*)nullptr); } }
#undef CV_ADD
        seg[ns].first = tot; *(LAS int*)(F.lds + CVTOT_OFF) = tot; }
    __syncthreads();
    {   const int total = RFL(*(const LAS int*)(F.lds + CVTOT_OFF));
        LAS unsigned* scr = (LAS unsigned*)(F.lds + F.wave * 16384);
        const int gw = F.vcu * NWAVES + F.wave, NGW = F.G * NWAVES, lane = F.lane;
        int s = 0, nK = 0, nkb = 0, nnb = 0; unsigned ndst = 0u;
        float tn[64];
#define CV_FETCH(it_) do { while ((it_) >= RFL(seg[s + 1].first)) ++s; const int loc_ = (it_) - RFL(seg[s].first), nblk_ = RFL(seg[s].nblk); nkb = loc_ / nblk_; nnb = loc_ - nkb * nblk_; nK = RFL(seg[s].K); ndst = RFL(seg[s].dst); \
        const int ldw_ = RFL(seg[s].ldw), kind_ = RFL(seg[s].kind); const float* a_ = rfl_ptr(seg[s].a); const float* b_ = rfl_ptr(seg[s].b); \
        const float* src_ = cv_src(kind_, a_, b_, 64 * nnb + lane); \
        _Pragma("unroll") for (int i = 0; i < 64; ++i) { tn[i] = src_ ? __builtin_nontemporal_load(&((const GAS float*)src_)[(size_t)(64 * nkb + i) * ldw_]) : 0.f; } } while (0)
        if (gw < total) CV_FETCH(gw);
        for (int it = gw; it < total; it += NGW) {
            const int K = nK, k0 = 64 * nkb, n0 = 64 * nnb; bf16* WT = (bf16*)(wb + ndst);
            unsigned tv[32];
#pragma unroll
            for (int i = 0; i < 32; ++i) tv[i] = pk2(tn[2 * i], tn[2 * i + 1]);
            if (it + NGW < total) CV_FETCH(it + NGW);
#pragma unroll
            for (int i = 0; i < 32; ++i) scr[lane * 33 + i] = tv[i];
            LDS_WAIT(); asm volatile("" ::: "memory");
            const int c = lane & 7;
#pragma unroll
            for (int j = 0; j < 8; ++j) { const int n = (lane >> 3) + 8 * j; const LAS unsigned* sq = scr + n * 33 + 4 * c;
                v4u o; o.x = sq[0]; o.y = sq[1]; o.z = sq[2]; o.w = sq[3];
                *(GAS v4u*)(WT + (size_t)(n0 + n) * K + k0 + 8 * c) = o; }
            LDS_WAIT(); asm volatile("" ::: "memory");
        }
#undef CV_FETCH
    }
    { bf16* WT = (bf16*)(wb + W_BFT); const float* src = wbr + (size_t)256 * D;
      LAS f32x2* tcs = (LAS f32x2*)(F.lds + 131072 - 512);
      __syncthreads(); if (F.tid < 64) { const float ph = (float)F.tid * (1.f / 32.f); tcs[F.tid] = (f32x2){cospif(ph), sinpif(ph)}; } __syncthreads();
      if (F.tid < 256) for (int idx = F.vcu * 256 + F.tid; idx < 4 * 16 * 1024; idx += F.G * 256) { const int n = idx & 1023, c0 = ((idx >> 10) & 15) * 4, g = idx >> 14;
          float ac[4] = {0.f, 0.f, 0.f, 0.f}, as[4] = {0.f, 0.f, 0.f, 0.f};
#pragma unroll 1
          for (int q = 0; q < 4; ++q) { float v[16];
#pragma unroll
              for (int kk = 0; kk < 16; ++kk) v[kk] = ((const GAS float*)src)[(size_t)(64 * g + 16 * q + kk) * D + n];
#pragma unroll
              for (int kk = 0; kk < 16; ++kk) {
#pragma unroll
                  for (int j = 0; j < 4; ++j) { const f32x2 t = tcs[((16 * q + kk) * (c0 + j)) & 63]; ac[j] += t.x * v[kk]; as[j] += t.y * v[kk]; } } }
          bf16* o = WT + (size_t)n * 512 + g * 64 + c0;
          *(GAS v2u*)o = (v2u){pk2(ac[0] * 0.125f, ac[1] * 0.125f), pk2(ac[2] * 0.125f, ac[3] * 0.125f)};
          *(GAS v2u*)(o + 256) = (v2u){pk2(as[0] * 0.125f, as[1] * 0.125f), pk2(as[2] * 0.125f, as[3] * 0.125f)}; }
      __syncthreads(); }
}
__device__ __forceinline__ void build_tables(const Frame& F) {
    const int gt = F.vcu * 512 + F.tid, NT_ = F.G * 512;
    float* rc = (float*)(F.ws + WS_ROPE_C); float* rs = (float*)(F.ws + WS_ROPE_S);
    for (int i = gt; i < 256 * 16; i += NT_) { const int pos = i >> 4, p = i & 15;
        double inv = (p & 3) == 0 ? 1.0 : ((p & 3) == 1 ? 0.5623413251903491 : ((p & 3) == 2 ? 0.31622776601683794 : 0.17782794100389228));
        for (int q = 0; q < (p >> 2); ++q) inv *= 0.1;
        const float angf = (float)pos * (float)inv;
        double xr = (double)angf * 0.3183098861837907; xr -= 2.0 * rint(xr * 0.5);
        rc[i] = cospif((float)xr); rs[i] = sinpif((float)xr); }
    bf16* dc = (bf16*)(F.ws + WS_DFT_C); bf16* ds = (bf16*)(F.ws + WS_DFT_S);
    for (int i = gt; i < 128 * 128; i += NT_) { const int j = i >> 7, k = i & 127; const float ph = (float)((j * k) & 127) * (1.f / 64.f); dc[i] = (bf16)f2bf(cospif(ph)); ds[i] = (bf16)f2bf(sinpif(ph)); }
}
__device__ __forceinline__ void ada_phase(const Frame& F) {
    LAS float* sc = (LAS float*)(F.lds);
    LAS float* red = (LAS float*)(F.lds + 16384);
    for (int i = F.tid; i < 3 * D; i += 512) { const int s = i >> 10, k = i & 1023; const float v = s < 2 ? F.in[I_C][s * D + k] : F.in[I_CCTX][k]; sc[i] = v * sigm(v); }
    __syncthreads();
    for (int task = F.vcu; task < 2 * 96; task += F.G) { const int l = task / 96, cb = task % 96, col = cb * 64 + F.lane;
        const float* w = F.in[I_WADA] + (size_t)l * D * 6144 + col; float a0 = 0.f, a1 = 0.f, a2 = 0.f;
        const int kb = F.wave * 128;
#pragma unroll 32
        for (int k = 0; k < 128; ++k) { const float wv = ((const GAS float*)w)[(size_t)(kb + k) * 6144]; a0 += sc[kb + k] * wv; a1 += sc[D + kb + k] * wv; a2 += sc[2 * D + kb + k] * wv; }
        red[(F.wave * 3 + 0) * 64 + F.lane] = a0; red[(F.wave * 3 + 1) * 64 + F.lane] = a1; red[(F.wave * 3 + 2) * 64 + F.lane] = a2;
        __syncthreads();
        if (F.tid < 192) { const int s = F.tid >> 6, ln = F.tid & 63; float t = 0.f;
#pragma unroll
            for (int w8 = 0; w8 < 8; ++w8) t += red[(w8 * 3 + s) * 64 + ln];
            F.ADA()[(size_t)(l * 3 + s) * 6144 + cb * 64 + ln] = t + F.in[I_BADA][(size_t)l * 6144 + cb * 64 + ln]; }
        __syncthreads();
    }
}
struct Row16 { f32x4 v[4]; };
__device__ __forceinline__ Row16 ld_row(const float* p, int lane) { Row16 r; const GAS f32x4* q = (const GAS f32x4*)p + lane;
#pragma unroll
    for (int j = 0; j < 4; ++j) r.v[j] = q[64 * j];
    return r; }
__device__ __forceinline__ Row16 ld_row_nt(const float* p, int lane) { Row16 r; const GAS f32x4* q = (const GAS f32x4*)p + lane;
#pragma unroll
    for (int j = 0; j < 4; ++j) r.v[j] = __builtin_nontemporal_load(&q[64 * j]);
    return r; }
__device__ __forceinline__ void st_row(float* p, int lane, const Row16& r) { GAS f32x4* q = (GAS f32x4*)p + lane;
#pragma unroll
    for (int j = 0; j < 4; ++j) __builtin_nontemporal_store(r.v[j], &q[64 * j]); }
__device__ __forceinline__ void ln_norm(Row16& r) {
    float s = 0.f;
#pragma unroll
    for (int j = 0; j < 4; ++j) s += (r.v[j].x + r.v[j].y) + (r.v[j].z + r.v[j].w);
    const float mean = wave_sum(s) * (1.f / D); float s2 = 0.f;
#pragma unroll
    for (int j = 0; j < 4; ++j) { r.v[j] = r.v[j] - mean; s2 += (r.v[j].x * r.v[j].x + r.v[j].y * r.v[j].y) + (r.v[j].z * r.v[j].z + r.v[j].w * r.v[j].w); }
    const float rstd = 1.f / sqrtf(wave_sum(s2) * (1.f / D) + LN_EPS);
#pragma unroll
    for (int j = 0; j < 4; ++j) r.v[j] = r.v[j] * rstd;
}
__device__ __forceinline__ void affine(Row16& r, const float* g, const float* b, int lane, bool one_plus) {
    const Row16 gg = ld_row(g, lane), bb = ld_row(b, lane);
#pragma unroll
    for (int j = 0; j < 4; ++j) r.v[j] = r.v[j] * (one_plus ? gg.v[j] + 1.0f : gg.v[j]) + bb.v[j];
}
__device__ __forceinline__ void affine_r(Row16& r, const Row16& gg, const Row16& bb, bool one_plus) {
#pragma unroll
    for (int j = 0; j < 4; ++j) r.v[j] = r.v[j] * (one_plus ? gg.v[j] + 1.0f : gg.v[j]) + bb.v[j];
}
__device__ __forceinline__ void st_row_bf16(bf16* p, int lane, const Row16& r) { GAS v2u* q = (GAS v2u*)p + lane;
#pragma unroll
    for (int j = 0; j < 4; ++j) { v2u w; w.x = pk2(r.v[j].x, r.v[j].y); w.y = pk2(r.v[j].z, r.v[j].w); q[64 * j] = w; } }
__device__ __forceinline__ void phase_ln_mod(const Frame& F, int l) {
    const int gw = F.vcu * NWAVES + F.wave, NGW = F.G * NWAVES;
    Row16 nx, nx2; if (gw < R) nx = ld_row_nt(xin_row(F, l, gw), F.lane); if (gw + NGW < R) nx2 = ld_row_nt(xin_row(F, l, gw + NGW), F.lane);
    int cs = -1; Row16 asc, ash;
    for (int r = gw; r < R; r += NGW) { Row16 x = nx; nx = nx2; if (r + 2 * NGW < R) nx2 = ld_row_nt(xin_row(F, l, r + 2 * NGW), F.lane);
        ln_norm(x); const int s = set_of_row(r); if (s != cs) { cs = s; asc = ld_row(ada_vec(F, l, s, 1), F.lane); ash = ld_row(ada_vec(F, l, s, 0), F.lane); }
        affine_r(x, asc, ash, true); st_row_bf16(F.H() + (size_t)r * D, F.lane, x); }
}
__device__ __forceinline__ void phase_qk(const Frame& F, int l, bool dry = false) {
    const int gw = F.vcu * NWAVES + F.wave, NGW = F.G * NWAVES, lane = F.lane, r8 = lane >> 3, kh = (lane >> 2) & 1, qd = lane & 3;
    const float* rc = (const float*)(F.ws + WS_ROPE_C); const float* rs = (const float*)(F.ws + WS_ROPE_S);
    const float* gk = F.in[I_GQKG] + l * 64;
    const int coff = TC_GQK + kh * 64 + qd * 16;
    float gl_[16];
#pragma unroll
    for (int i = 0; i < 16; ++i) gl_[i] = ((const GAS float*)gk)[qd * 16 + i];
    constexpr int NRB = R / 8;
    v4u na = {0u, 0u, 0u, 0u}, nb = {0u, 0u, 0u, 0u};
    if (gw < NRB) { const bf16* p0 = F.P() + (size_t)(gw * 8 + r8) * NP + coff; na = *(const GAS v4u*)p0; nb = *(const GAS v4u*)(p0 + 8); }
    for (int rb = gw; rb < NRB; rb += NGW) { const int r = rb * 8 + r8;
        float x[16]; bf16* p = F.P() + (size_t)r * NP + coff;
        const v4u a = na, b = nb;
        if (rb + NGW < NRB) { const bf16* p1 = F.P() + (size_t)((rb + NGW) * 8 + r8) * NP + coff; na = *(const GAS v4u*)p1; nb = *(const GAS v4u*)(p1 + 8); }
        float ss = 0.f;
        x[0] = bflo(a.x); x[1] = bfhi(a.x); x[2] = bflo(a.y); x[3] = bfhi(a.y); x[4] = bflo(a.z); x[5] = bfhi(a.z); x[6] = bflo(a.w); x[7] = bfhi(a.w);
        x[8] = bflo(b.x); x[9] = bfhi(b.x); x[10] = bflo(b.y); x[11] = bfhi(b.y); x[12] = bflo(b.z); x[13] = bfhi(b.z); x[14] = bflo(b.w); x[15] = bfhi(b.w);
#pragma unroll
        for (int i = 0; i < 16; ++i) ss += x[i] * x[i];
        ss += dpp_get<0xB1>(ss); ss += dpp_get<0x4E>(ss);
        const float rstd = __builtin_amdgcn_rsqf(ss * (1.f / 64.f) + LN_EPS);
#pragma unroll
        for (int i = 0; i < 16; ++i) x[i] = x[i] * rstd * gl_[i];
        float y[16];
#pragma unroll
        for (int i = 0; i < 16; ++i) y[i] = dpp_get<0xB1>(x[i]);
        if (r < RL) { const int t = r & (T - 1), pos = (qd >> 1) ? (t & 63) : (t >> 6); const GAS f32x4* c4 = (const GAS f32x4*)(rc + pos * 16); const GAS f32x4* s4 = (const GAS f32x4*)(rs + pos * 16);
            const f32x4 cv[4] = {c4[0], c4[1], c4[2], c4[3]}, sv[4] = {s4[0], s4[1], s4[2], s4[3]};
#pragma unroll
            for (int i = 0; i < 16; ++i) { const float c = cv[i >> 2][i & 3], s = sv[i >> 2][i & 3]; x[i] = (qd & 1) ? (y[i] * s + x[i] * c) : (x[i] * c - y[i] * s); } }
        if (!dry) { v4u a2, b2; a2.x = pk2(x[0], x[1]); a2.y = pk2(x[2], x[3]); a2.z = pk2(x[4], x[5]); a2.w = pk2(x[6], x[7]); b2.x = pk2(x[8], x[9]); b2.y = pk2(x[10], x[11]); b2.z = pk2(x[12], x[13]); b2.w = pk2(x[14], x[15]);
            *(GAS v4u*)p = a2; *(GAS v4u*)(p + 8) = b2; }
    }
}
__device__ __forceinline__ void build_ctx_panels(const Frame& F) {
    const int q = (int)blockIdx.x; if (q >= 32) return;
    const bf16* uq = (const bf16*)(F.ws + WS_UQ) + (size_t)(q >> 4) * 256 * D + (q & 3) * 256; bf16* pa = (bf16*)(F.ws + WS_PA) + (size_t)q * 65536;
    for (int idx = F.tid; idx < 256 * 256 / 8; idx += 512) { const int row = idx >> 5, c8 = idx & 31; const bf16* sp_ = uq + (size_t)row * D + c8 * 8; float a[8], t[8]; unpack8(*(const v4u*)sp_, a);
#pragma unroll
        for (int j = 1; j < 4; ++j) { unpack8(*(const v4u*)(sp_ + (size_t)j * 512 * D), t);
#pragma unroll
            for (int e = 0; e < 8; ++e) a[e] += t[e]; }
        *(v4u*)(pa + (size_t)row * 256 + c8 * 8) = pack8(a); }
    asm volatile("s_waitcnt vmcnt(0)" ::: "memory"); __syncthreads();
}
__device__ __forceinline__ Row16 ld_t1(const Frame& F, int l, const float* T1, int r, int lane) {
    if (l == 0 && r >= RL) { const int cr = r - RL; Row16 x = ld_row(F.in[I_CTX] + (size_t)cr * D, lane); const Row16 g = ld_row(ada_vec(F, 0, 2, 2), lane);
        const float* pp = (const float*)(F.ws + WS_OPART) + (size_t)cr * D; Row16 p = ld_row(pp, lane);
#pragma unroll
        for (int kq = 1; kq < 4; ++kq) { const Row16 t = ld_row(pp + (size_t)kq * 512 * D, lane);
#pragma unroll
            for (int j = 0; j < 4; ++j) p.v[j] = p.v[j] + t.v[j]; }
#pragma unroll
        for (int j = 0; j < 4; ++j) x.v[j] = x.v[j] * ALPHA + g.v[j] * p.v[j];
        return x; }
    return ld_row_nt(T1 + (size_t)r * D, lane);
}
__device__ __forceinline__ void phase_post_mix(const Frame& F, int l, int nrows, const float* T1) {
    const int gw = F.vcu * NWAVES + F.wave, NGW = F.G * NWAVES, lane = F.lane;
    volatile LAS int* hist = (volatile LAS int*)(F.lds + 1024);
    float brv[8];
#pragma unroll
    for (int e = 0; e < 8; ++e) brv[e] = (l == 1) ? ((const GAS float*)F.in[I_MOEBR])[e] : 0.f;
    if (l == 1) { if (F.tid < 8) hist[F.tid] = 0; __syncthreads(); }
    const Row16 g1 = ld_row(F.in[I_LN1G] + l * D, lane), b1 = ld_row(F.in[I_LN1B] + l * D, lane);
    int cs = -1; Row16 asc, ash;
    LAS float* wrl = (LAS float*)(F.lds + 4096);
    if (l == 1) { for (int i = F.tid; i < D * 8 / 4; i += 512) *(LAS f32x4*)(wrl + i * 4) = *(const GAS f32x4*)(F.in[I_MOEWR] + i * 4); __syncthreads(); }
    Row16 nx, nx2; if (gw < nrows) nx = ld_t1(F, l, T1, gw, lane); if (gw + NGW < nrows) nx2 = ld_t1(F, l, T1, gw + NGW, lane);
    for (int r = gw; r < nrows; r += NGW) {
        Row16 x = nx; nx = nx2; if (r + 2 * NGW < nrows) nx2 = ld_t1(F, l, T1, r + 2 * NGW, lane);
        ln_norm(x); affine_r(x, g1, b1, false);
        st_row(F.XM() + (size_t)r * D, lane, x);
        ln_norm(x); const int s = set_of_row(r); if (s != cs) { cs = s; asc = ld_row(ada_vec(F, l, s, 4), lane); ash = ld_row(ada_vec(F, l, s, 3), lane); }
        affine_r(x, asc, ash, true);
        st_row_bf16(F.H() + (size_t)r * D, lane, x);
        if (l == 1) {
            float lg[8];
#pragma unroll
            for (int e = 0; e < 8; ++e) lg[e] = 0.f;
#pragma unroll
            for (int j = 0; j < 4; ++j)
#pragma unroll
                for (int q = 0; q < 4; ++q) { const float xv = x.v[j][q]; const LAS f32x4* wp = (const LAS f32x4*)(wrl + (256 * j + 4 * lane + q) * 8); const f32x4 w0 = wp[0], w1 = wp[1];
                    lg[0] += xv * w0.x; lg[1] += xv * w0.y; lg[2] += xv * w0.z; lg[3] += xv * w0.w; lg[4] += xv * w1.x; lg[5] += xv * w1.y; lg[6] += xv * w1.z; lg[7] += xv * w1.w; }
#pragma unroll
            for (int e = 0; e < 8; ++e) lg[e] = wave_sum(lg[e]);
            int i0 = 0; float b0 = lg[0] + brv[0];
#pragma unroll
            for (int e = 1; e < 8; ++e) { const float v = lg[e] + brv[e]; if (v > b0) { b0 = v; i0 = e; } }
            int i1 = (i0 == 0) ? 1 : 0; float b1 = (i0 == 0) ? lg[1] + brv[1] : lg[0] + brv[0];
#pragma unroll
            for (int e = 1; e < 8; ++e) { const float v = lg[e] + brv[e]; if (e != i0 && v > b1) { b1 = v; i1 = e; } }
            float l0 = 0.f, l1 = 0.f;
#pragma unroll
            for (int e = 0; e < 8; ++e) { l0 = (e == i0) ? lg[e] : l0; l1 = (e == i1) ? lg[e] : l1; }
            const float mx = fmaxf(l0, l1), e0 = __expf(l0 - mx), e1 = __expf(l1 - mx), inv = 1.f / (e0 + e1);
            if (lane == 0) { GAS v4u* sel = (GAS v4u*)(F.ws + WS_MOE + MO_SEL) + (size_t)r; *sel = (v4u){(unsigned)i0, (unsigned)i1, __float_as_uint(e0 * inv), __float_as_uint(e1 * inv)};
                __hip_atomic_fetch_add((LAS int*)&hist[i0], 1, __ATOMIC_RELAXED, __HIP_MEMORY_SCOPE_WORKGROUP); __hip_atomic_fetch_add((LAS int*)&hist[i1], 1, __ATOMIC_RELAXED, __HIP_MEMORY_SCOPE_WORKGROUP); }
        }
    }
    if (l == 1) { __syncthreads(); if (F.tid < 8) __hip_atomic_fetch_add((unsigned*)(F.ctl() + CW_MOECNT + 64 * F.tid), (unsigned)hist[F.tid], RLX_AGENT); }
}
__device__ __forceinline__ void phase_moe_assign(const Frame& F) {
    volatile LAS int* L = (volatile LAS int*)(F.lds + 1024);
    int* tok = (int*)(F.ws + WS_MOE + MO_TOK); int* dst = (int*)(F.ws + WS_MOE + MO_DST); int* tile_e = (int*)(F.ws + WS_MOE + MO_SEL + (size_t)RL * 16); int* ntl = tile_e + 512;
    if (F.tid < 8) L[F.tid] = 0;
    if (F.tid == 0) { int base = 0;
        for (int e = 0; e < 8; ++e) { const int c = (int)__hip_atomic_load((unsigned*)(F.ctl() + CW_MOECNT + 64 * e), RLX_AGENT); const int tl = (c + 255) >> 8; L[16 + e] = base * 256; L[24 + e] = c;
            if (blockIdx.x == 0) for (int q = 0; q < tl; ++q) tile_e[base + q] = e;
            base += tl; }
        if (blockIdx.x == 0) ntl[0] = base; }
    __syncthreads();
    const int wg = F.vcu; int e = 0, rank = 0, token = 0, k = 0; const bool act = F.tid < 256 && wg * 128 < RL;
    for (int w0 = wg; w0 * 128 < RL; w0 += F.G) {
        if (F.tid < 256) { token = w0 * 128 + (F.tid >> 1); k = F.tid & 1; e = ((const GAS int*)(F.ws + WS_MOE + MO_SEL))[(size_t)token * 4 + k]; rank = __hip_atomic_fetch_add((LAS int*)&L[e], 1, __ATOMIC_RELAXED, __HIP_MEMORY_SCOPE_WORKGROUP); }
        __syncthreads();
        if (F.tid < 8) { L[8 + F.tid] = (int)__hip_atomic_fetch_add((unsigned*)(F.ctl() + CW_MOECUR + 64 * F.tid), (unsigned)L[F.tid], RLX_AGENT); }
        __syncthreads();
        if (F.tid < 256) { const int slot = L[16 + e] + L[8 + e] + rank; tok[slot] = token; dst[slot] = token * 2 + k; }
        __syncthreads();
        if (F.tid < 8) L[F.tid] = 0;
        __syncthreads();
    }
    (void)act;
    if (wg < 8) { const int c = L[24 + wg], tl = (c + 255) >> 8, b = L[16 + wg]; for (int s = c + F.tid; s < tl * 256; s += 512) { tok[b + s] = 0; dst[b + s] = -1; } }
}
__device__ __forceinline__ void phase_final(const Frame& F, int l) {
    const int gw = F.vcu * NWAVES + F.wave, NGW = F.G * NWAVES, lane = F.lane;
    if (l == 0) {
        const Row16 g2 = ld_row(F.in[I_LN2G], lane), b2 = ld_row(F.in[I_LN2B], lane); int cs = -1; Row16 asc, ash;
        Row16 nx, nx2; if (gw < R) nx = ld_row_nt(F.XM() + (size_t)gw * D, lane); if (gw + NGW < R) nx2 = ld_row_nt(F.XM() + (size_t)(gw + NGW) * D, lane);
        for (int r = gw; r < R; r += NGW) {
            Row16 x = nx; nx = nx2; if (r + 2 * NGW < R) nx2 = ld_row_nt(F.XM() + (size_t)(r + 2 * NGW) * D, lane);
            if (r >= RL) { const float* dp = (const float*)(F.ws + WS_DP) + (size_t)(r - RL) * D; const Row16 p0 = ld_row(dp, lane), p1 = ld_row(dp + (size_t)512 * D, lane), p2 = ld_row(dp + (size_t)1024 * D, lane), p3 = ld_row(dp + (size_t)1536 * D, lane), g5 = ld_row(ada_vec(F, 0, 2, 5), lane);
#pragma unroll
                for (int j = 0; j < 4; ++j) x.v[j] = x.v[j] * ALPHA + g5.v[j] * ((p0.v[j] + p1.v[j]) + (p2.v[j] + p3.v[j])); }
            ln_norm(x); affine_r(x, g2, b2, false);
            st_row(r < RL ? F.out + (size_t)r * D : F.XC() + (size_t)(r - RL) * D, lane, x);
            ln_norm(x); const int s = set_of_row(r); if (s != cs) { cs = s; asc = ld_row(ada_vec(F, 1, s, 1), lane); ash = ld_row(ada_vec(F, 1, s, 0), lane); }
            affine_r(x, asc, ash, true);
            st_row_bf16(F.H() + (size_t)r * D, lane, x); }
    } else {
        const Row16 g2 = ld_row(F.in[I_LN2G] + D, lane), b2 = ld_row(F.in[I_LN2B] + D, lane); int cs = -1; Row16 g5;
        Row16 nx, mx; v2u na[4], nb[4], ma[4], mb[4]; float nw0 = 0.f, nw1 = 0.f, mw0 = 0.f, mw1 = 0.f;
#define FIN_LOAD(rr, nx, na, nb, nw0, nw1) do { const GAS float* sel_ = (const GAS float*)(F.ws + WS_MOE + MO_SEL) + (size_t)(rr) * 4; nw0 = sel_[2]; nw1 = sel_[3]; \
            const bf16* d0_ = (const bf16*)F.out + (size_t)(rr) * 2 * D; const GAS v2u* q0_ = (const GAS v2u*)d0_ + lane; const GAS v2u* q1_ = (const GAS v2u*)(d0_ + D) + lane; \
            nx = ld_row_nt(F.XM() + (size_t)(rr) * D, lane); _Pragma("unroll") for (int j = 0; j < 4; ++j) { na[j] = __builtin_nontemporal_load(&q0_[64 * j]); nb[j] = __builtin_nontemporal_load(&q1_[64 * j]); } } while (0)
        if (gw < RL) FIN_LOAD(gw, nx, na, nb, nw0, nw1);
        if (gw + NGW < RL) FIN_LOAD(gw + NGW, mx, ma, mb, mw0, mw1);
        for (int r = gw; r < RL; r += NGW) {
            Row16 x = nx; v2u a4[4], b4[4]; const float w0 = nw0, w1 = nw1;
#pragma unroll
            for (int j = 0; j < 4; ++j) { a4[j] = na[j]; b4[j] = nb[j]; na[j] = ma[j]; nb[j] = mb[j]; }
            nx = mx; nw0 = mw0; nw1 = mw1;
            if (r + 2 * NGW < RL) FIN_LOAD(r + 2 * NGW, mx, ma, mb, mw0, mw1);
            { const int s = set_of_row(r); if (s != cs) { cs = s; g5 = ld_row(ada_vec(F, 1, s, 5), lane); } }
#pragma unroll
            for (int j = 0; j < 4; ++j) { const v2u a = a4[j], b = b4[j];
                f32x4 f; f.x = w0 * bflo(a.x) + w1 * bflo(b.x); f.y = w0 * bfhi(a.x) + w1 * bfhi(b.x); f.z = w0 * bflo(a.y) + w1 * bflo(b.y); f.w = w0 * bfhi(a.y) + w1 * bfhi(b.y);
                x.v[j] = x.v[j] * ALPHA + g5.v[j] * f; }
            ln_norm(x); affine_r(x, g2, b2, false);
            st_row(F.out + (size_t)r * D, lane, x); }
#undef FIN_LOAD
    }
}
__device__ __forceinline__ void lds_barrier() { asm volatile("s_waitcnt lgkmcnt(0)\n\ts_barrier" ::: "memory"); }
constexpr int PT = 72;
typedef LAS bf16* ltile;
__device__ __forceinline__ bf16x8 ldfrag(const LAS bf16* t, int row, int k0, int pitch) { return *(const LAS bf16x8*)(t + row * pitch + k0); }
template <int KD, int PX, int PY>
__device__ __forceinline__ f32x4 mmt(f32x4 acc, const LAS bf16* X, int x0, const LAS bf16* Y, int y0, int fr, int fq) {
#pragma unroll
    for (int kk = 0; kk < KD; kk += 32) acc = __builtin_amdgcn_mfma_f32_16x16x32_bf16(ldfrag(X, x0 + fr, kk + 8 * fq, PX), ldfrag(Y, y0 + fr, kk + 8 * fq, PY), acc, 0, 0, 0);
    return acc;
}
typedef short s16x4_t __attribute__((ext_vector_type(4)));
__device__ __forceinline__ bf16x8 ldfrag_tr(const LAS bf16* X, int k0, int n0, int pitch, int lane) {
    const int fq = lane >> 4, q = (lane & 15) >> 2, p = lane & 3;
    const LAS bf16* a = X + (k0 + 8 * fq + q) * pitch + n0 + 4 * p;
    const s16x4_t lo = __builtin_bit_cast(s16x4_t, __builtin_amdgcn_ds_read_tr16_b64_v4i16((LAS s16x4_t*)a));
    const s16x4_t hi = __builtin_bit_cast(s16x4_t, __builtin_amdgcn_ds_read_tr16_b64_v4i16((LAS s16x4_t*)(a + 4 * pitch)));
    return (bf16x8){lo[0], lo[1], lo[2], lo[3], hi[0], hi[1], hi[2], hi[3]};
}
template <int KD, int PX, int PY>
__device__ __forceinline__ f32x4 mmt_tx(f32x4 acc, const LAS bf16* XR, int x0, const LAS bf16* Y, int y0, int fr, int fq, int lane) {
#pragma unroll
    for (int kk = 0; kk < KD; kk += 32) acc = __builtin_amdgcn_mfma_f32_16x16x32_bf16(ldfrag_tr(XR, kk, x0, PX, lane), ldfrag(Y, y0 + fr, kk + 8 * fq, PY), acc, 0, 0, 0);
    return acc;
}
template <int KD, int PX, int PY>
__device__ __forceinline__ f32x4 mmt_txy(f32x4 acc, const LAS bf16* XR, int x0, const LAS bf16* YR, int y0, int lane) {
#pragma unroll
    for (int kk = 0; kk < KD; kk += 32) acc = __builtin_amdgcn_mfma_f32_16x16x32_bf16(ldfrag_tr(XR, kk, x0, PX, lane), ldfrag_tr(YR, kk, y0, PY, lane), acc, 0, 0, 0);
    return acc;
}
template <int CTRL, int RMASK> __device__ __forceinline__ float dpp_or(float v, float ident) { return __builtin_bit_cast(float, __builtin_amdgcn_update_dpp(__builtin_bit_cast(int, ident), __builtin_bit_cast(int, v), CTRL, RMASK, 0xF, false)); }
__device__ __forceinline__ float wave_incl_scan_add(float v, int lane) {
    v += dpp_or<0x111, 0xF>(v, 0.f); v += dpp_or<0x112, 0xF>(v, 0.f); v += dpp_or<0x114, 0xF>(v, 0.f); v += dpp_or<0x118, 0xF>(v, 0.f);
    v += dpp_or<0x142, 0xA>(v, 0.f); v += dpp_or<0x143, 0xC>(v, 0.f);
    return v; }
__device__ __forceinline__ float wave_incl_scan_max(float v, int lane) {
    const float NI = -INFINITY;
    v = fmaxf(v, dpp_or<0x111, 0xF>(v, NI)); v = fmaxf(v, dpp_or<0x112, 0xF>(v, NI)); v = fmaxf(v, dpp_or<0x114, 0xF>(v, NI)); v = fmaxf(v, dpp_or<0x118, 0xF>(v, NI));
    v = fmaxf(v, dpp_or<0x142, 0xA>(v, NI)); v = fmaxf(v, dpp_or<0x143, 0xC>(v, NI));
    return v; }
__device__ __forceinline__ float wave_max(float v) {
    v = fmaxf(v, dpp_get<0xB1>(v)); v = fmaxf(v, dpp_get<0x4E>(v)); v = fmaxf(v, dpp_get<0x141>(v)); v = fmaxf(v, dpp_get<0x140>(v));
    { const auto rr = __builtin_amdgcn_permlane16_swap(__float_as_uint(v), __float_as_uint(v), false, false); v = fmaxf(__uint_as_float(rr[0]), __uint_as_float(rr[1])); }
    { const auto rr = __builtin_amdgcn_permlane32_swap(__float_as_uint(v), __float_as_uint(v), false, false); v = fmaxf(__uint_as_float(rr[0]), __uint_as_float(rr[1])); }
    return v; }

constexpr int DIRB = 65536;
constexpr int L_QS = 0, L_KS = 9216, L_VT = 18432, L_WS = 27648, L_CS = 36864, L_VEC = 48384, L_AF = 49408, L_PRE = 53504, L_G = 27648, L_HB = 0;
struct ScanPtrs { bf16* Cst; float* Nst; float* Amx; float* Bl; float* Mst; bf16* Gst; float* Gld; };
__device__ __forceinline__ int chunk_row0(int b, int tc) { return tc < 4 ? RL + b * CTX + tc * 64 : b * T + (tc - 4) * 64; }
__device__ __forceinline__ int chunk_pos(int tc, int d) { return d == 0 ? tc : (tc < 4 ? 3 - tc : 263 - tc); }

struct ScanRegs { v4u q0, q1, k0, k1, v0, v1, st0, st1; f32x4 nv0, nv1, af; v2u og0, og1, og2, og3; float gi, gf, mc, bi, bf; };
#define SR_SEL2(R, f, rep) ((rep) == 0 ? (R).f##0 : (R).f##1)
struct UnitId { int fam, b, head, tc; };
__device__ __forceinline__ bool unit_decode(int u, UnitId& id) { if (u >= 2 * 2080) return false; id.fam = ((u >> 8) + u) & 1;   const int rem = u >> 1; id.b = rem / 1040; id.head = (rem / 260) & 3; id.tc = rem % 260; return true; }
__device__ __forceinline__ bool unit_decode_q(int q, int l, bool out, UnitId& id) {
    if (out && l == 1) { if (q >= 2 * 2048) return false; id.fam = q & 1; const int rem = q >> 1; id.b = rem >> 10; id.head = (rem >> 8) & 3; id.tc = 4 + (rem & 255); return true; }
    if (q >= 2 * 2080) return false; id.fam = q & 1; const int rem = q >> 1; id.b = rem / 1040; id.head = (rem / 260) & 3; id.tc = rem % 260; return true; }
template <bool OUT>
__device__ __forceinline__ void scan_fetch(const Frame& F, int l, const UnitId& id, const ScanPtrs& sp, ScanRegs& R_) {
    const int tid = F.tid, d = tid >> 8, ht = tid & 255, lane = F.lane, hw = F.wave & 3;
    const int row0 = chunk_row0(id.b, id.tc), pos = chunk_pos(id.tc, d), chain = (id.b * 4 + id.head) * 2 + d; const size_t slot = (size_t)chain * NCH + pos;
    const bool ml = id.fam == 0;
#define SF_ONE(rep, QF, KF, VF, SF) { const int q = ht + 256 * rep, i = q >> 3, c8 = q & 7, tok = d ? 63 - i : i; \
        const bf16* rp = F.P() + (size_t)(row0 + tok) * NP + id.head * 64 + c8 * 8; \
        if (OUT) R_.QF = *(const GAS v4u*)(rp + (ml ? TC_MLQ : TC_GLQ)); \
        R_.KF = *(const GAS v4u*)(rp + (ml ? TC_MLK : TC_GLK)); R_.VF = *(const GAS v4u*)(rp + (ml ? TC_MLV : TC_GLV)); \
        if (OUT) { const bf16* Cg = (ml ? sp.Cst : sp.Gst) + slot * 4096; R_.SF = __builtin_nontemporal_load((const GAS v4u*)(Cg + (q >> 3) * 64 + c8 * 8)); } }
    SF_ONE(0, q0, k0, v0, st0) SF_ONE(1, q1, k1, v1, st1)
#undef SF_ONE
    { const int tok = d ? 63 - lane : lane; const float* sm = F.SM() + (size_t)(row0 + tok) * SMP + d * 8 + id.head; R_.gi = ((const GAS float*)sm)[0]; R_.gf = ((const GAS float*)sm)[4]; }
    { const float* gb = F.in[I_MLGB] + (size_t)l * 16 + d * 8 + id.head; R_.bi = ((const GAS float*)gb)[0]; R_.bf = ((const GAS float*)gb)[4]; }
    R_.mc = 0.f; R_.nv0 = (f32x4){0.f, 0.f, 0.f, 0.f}; R_.nv1 = R_.nv0;
    if (OUT) { R_.mc = ((const GAS float*)sp.Mst)[slot]; const float* np_ = sp.Nst + slot * 64 + (ht & 7) * 8; R_.nv0 = *(const f32x4*)np_; R_.nv1 = *(const GAS f32x4*)(np_ + 4); }
    { const int i = ht >> 2, q4 = ht & 3, tok = d ? 63 - i : i; R_.af = *(const GAS f32x4*)(F.SM() + (size_t)(row0 + tok) * SMP + 16 + d * 16 + q4 * 4); }
    R_.og0 = (v2u){0u, 0u}; R_.og1 = R_.og0; R_.og2 = R_.og0; R_.og3 = R_.og0;
    if (!OUT) { R_.q0 = (v4u){0u, 0u, 0u, 0u}; R_.q1 = R_.q0; R_.st0 = R_.q0; R_.st1 = R_.q0; }
    if (OUT) { const int fr = lane & 15, fq = lane >> 4, t = 16 * hw + fr; const bf16* op = F.P() + (size_t)(row0 + t) * NP + (ml ? TC_MLO : TC_GLR) + id.head * 64;
        R_.og0 = *(const GAS v2u*)(op + 4 * fq); R_.og1 = *(const GAS v2u*)(op + 16 + 4 * fq); R_.og2 = *(const GAS v2u*)(op + 32 + 4 * fq); R_.og3 = *(const GAS v2u*)(op + 48 + 4 * fq); }
}
__device__ __forceinline__ void gla_build_g(const Frame& F, int l, int head, int d, const f32x4 af, LAS unsigned char* base, int ht) {
    LAS float* AF = (LAS float*)(base + L_AF); LAS float* G = (LAS float*)(base + L_G); LAS float* PRE = (LAS float*)(base + L_PRE);
    const int k = ht & 63, tq = ht >> 6;
    const float* w2 = F.in[I_GLW2] + ((size_t)(l * 2 + d) * 16) * 256 + head * 64 + k; const float bb = ((const GAS float*)F.in[I_GLB2])[(size_t)(l * 2 + d) * 256 + head * 64 + k];
    float w[16];
#pragma unroll
    for (int r = 0; r < 16; ++r) w[r] = ((const GAS float*)w2)[(size_t)r * 256];
    { const int i = ht >> 2, q4 = ht & 3; *(LAS f32x4*)(AF + i * 16 + q4 * 4) = af; }
    lds_barrier();
    float run = 0.f;
#pragma unroll 4
    for (int ii = 0; ii < 16; ++ii) { const int i = 16 * tq + ii; float a = bb;
        const f32x4 f0 = *(const LAS f32x4*)(AF + i * 16), f1 = *(const LAS f32x4*)(AF + i * 16 + 4), f2 = *(const LAS f32x4*)(AF + i * 16 + 8), f3 = *(const LAS f32x4*)(AF + i * 16 + 12);
        a += f0.x * w[0] + f0.y * w[1] + f0.z * w[2] + f0.w * w[3]; a += f1.x * w[4] + f1.y * w[5] + f1.z * w[6] + f1.w * w[7];
        a += f2.x * w[8] + f2.y * w[9] + f2.z * w[10] + f2.w * w[11]; a += f3.x * w[12] + f3.y * w[13] + f3.z * w[14] + f3.w * w[15];
        run += logsig(a) * (1.f / 16.f); G[i * 65 + k] = run; }
    PRE[tq * 64 + k] = run;
    lds_barrier();
    float off = 0.f;
#pragma unroll
    for (int q = 0; q < 3; ++q) off += (q < tq) ? PRE[q * 64 + k] : 0.f;
    if (tq > 0) { for (int ii = 0; ii < 16; ++ii) G[(16 * tq + ii) * 65 + k] += off; }
    lds_barrier();
}
__device__ __forceinline__ void ml_gates(float gi, float gf, float bi, float bf, int lane, float& a, float& bcum) {
    const float li = gi + bi, lf = logsig(gf + bf);
    bcum = wave_incl_scan_add(lf, lane); a = li - bcum;
}
template <bool IS_ML>
__device__ __forceinline__ void scan_local_unit(const Frame& F, int l, int b, int head, int tc, const ScanPtrs& sp, const ScanRegs& R_) {
    const int tid = F.tid, d = tid >> 8, ht = tid & 255, hw = F.wave & 3, lane = F.lane, fr = lane & 15, fq = lane >> 4;
    LAS unsigned char* base = F.lds + d * DIRB;
    LAS bf16* Kt = (LAS bf16*)(base + L_KS); LAS bf16* Vt = (LAS bf16*)(base + L_VT); LAS float* vec = (LAS float*)(base + L_VEC);
    const int pos = chunk_pos(tc, d), chain = (b * 4 + head) * 2 + d; const size_t slot = (size_t)chain * NCH + pos;
    if constexpr (IS_ML) {
        if (hw == 0) { float a, bc; ml_gates(R_.gi, R_.gf, R_.bi, R_.bf, lane, a, bc); const float amax = wave_max(a); vec[lane] = __expf(a - amax);
            if (lane == 63) { ((GAS float*)sp.Amx)[slot] = amax; ((GAS float*)sp.Bl)[slot] = bc; } }
        lds_barrier();
    } else { gla_build_g(F, l, head, d, R_.af, base, ht); }
    const LAS float* G = (const LAS float*)(base + L_G);
#pragma unroll
    for (int rep = 0; rep < 2; ++rep) { const int q = ht + 256 * rep, i = q >> 3, c8 = q & 7;
        float kx[8], vx[8]; unpack8(SR_SEL2(R_, k, rep), kx); unpack8(SR_SEL2(R_, v, rep), vx);
        const float wsi = IS_ML ? vec[i] : 1.f;
#pragma unroll
        for (int e = 0; e < 8; ++e) { kx[e] = IS_ML ? kx[e] * 0.125f : kx[e] * __expf(-G[i * 65 + c8 * 8 + e]); vx[e] *= wsi; }
        *(LAS v4u*)(Kt + i * PT + c8 * 8) = pack8(kx); *(LAS v4u*)(Vt + i * PT + c8 * 8) = pack8(vx); }
    if (!IS_ML && ht < 64) ((GAS float*)sp.Gld)[slot * 64 + ht] = __expf(G[63 * 65 + ht]);
    lds_barrier();
    bf16* Cg = (IS_ML ? sp.Cst : sp.Gst) + slot * 4096;
#pragma unroll
    for (int kt = 0; kt < 4; ++kt) { f32x4 acc = {0.f, 0.f, 0.f, 0.f}; acc = mmt_txy<64, PT, PT>(acc, Kt, 16 * kt, Vt, 16 * hw, lane);
        v2u w; w.x = pk2(acc[0], acc[1]); w.y = pk2(acc[2], acc[3]); *(GAS v2u*)(Cg + (size_t)(16 * hw + fr) * 64 + 16 * kt + 4 * fq) = w; }
    if (IS_ML && ht < 64) { float s_ = 0.f; for (int i = 0; i < 64; ++i) s_ += bf2f(Kt[i * PT + ht]) * vec[i]; ((GAS float*)sp.Nst)[slot * 64 + ht] = s_; }
    lds_barrier();
}
template <bool IS_ML>
__device__ __forceinline__ void scan_chain(const Frame& F, int chain, int quarter, const ScanPtrs& sp, bool dry = false) {
    const int tid = F.tid, k0 = (tid & 7) * 8;
    LAS float* LA = (LAS float*)(F.lds);
    if constexpr (IS_ML) { for (int p = tid; p < NCH; p += 512) { LA[p] = ((const GAS float*)sp.Amx)[(size_t)chain * NCH + p]; LA[512 + p] = ((const GAS float*)sp.Bl)[(size_t)chain * NCH + p]; } }
    else { for (int q = tid; q < NCH * 16; q += 512) *(LAS f32x4*)(LA + q * 4) = *(const GAS f32x4*)(sp.Gld + (size_t)chain * NCH * 64 + q * 4); }
    __syncthreads();
    if (tid < 128) {
    float S[8]; float nst = 0.f, m = 0.f;
#pragma unroll
    for (int e = 0; e < 8; ++e) S[e] = 0.f;
    bf16* Cb = (IS_ML ? sp.Cst : sp.Gst) + (size_t)chain * NCH * 4096 + (size_t)quarter * 1024 + (size_t)tid * 8;
    const bool own_n = IS_ML && quarter == 0 && tid < 64;
    constexpr int GS = 20;
    v4u cn[GS]; float nn[GS];
#pragma unroll
    for (int j = 0; j < GS; ++j) nn[j] = 0.f;
#define SC_LOAD(g) do { _Pragma("unroll") for (int j = 0; j < GS; ++j) { cn[j] = *(const GAS v4u*)(Cb + (size_t)((g) * GS + j) * 4096); \
        if (own_n) nn[j] = ((const GAS float*)sp.Nst)[((size_t)chain * NCH + (g) * GS + j) * 64 + tid]; } } while (0)
    SC_LOAD(0);
    for (int g = 0; g < NCH / GS; ++g) {
        v4u cc[GS]; float nc[GS];
#pragma unroll
        for (int j = 0; j < GS; ++j) { cc[j] = cn[j]; nc[j] = nn[j]; }
        if (g + 1 < NCH / GS) SC_LOAD(g + 1);
#pragma unroll
        for (int j = 0; j < GS; ++j) { const int pp = g * GS + j; const size_t p = (size_t)chain * NCH + pp;
            if (!dry) *(GAS v4u*)(Cb + (size_t)pp * 4096) = pack8(S);
            float x[8]; unpack8(cc[j], x);
            if constexpr (IS_ML) {
                if (own_n && !dry) ((GAS float*)sp.Nst)[p * 64 + tid] = nst;
                if (quarter == 0 && tid == 0 && !dry) ((GAS float*)sp.Mst)[p] = m;
                const float am = LA[pp], bl = LA[512 + pp];
                const float mx = fmaxf(m, am), fa = __expf(m - mx), fb = __expf(am - mx);
#pragma unroll
                for (int e = 0; e < 8; ++e) S[e] = fa * S[e] + fb * x[e];
                nst = fa * nst + fb * nc[j]; m = bl + mx;
            } else {
                const f32x4 e0 = *(const LAS f32x4*)(LA + pp * 64 + k0), e1 = *(const LAS f32x4*)(LA + pp * 64 + k0 + 4);
                const float dd[8] = {e0.x, e0.y, e0.z, e0.w, e1.x, e1.y, e1.z, e1.w};
#pragma unroll
                for (int e = 0; e < 8; ++e) S[e] = dd[e] * (S[e] + x[e]);
            }
        }
    }
#undef SC_LOAD
    if (dry && S[0] == 1.2345e-33f) sp.Mst[0] = nst + m;
    }
    __syncthreads();
}
template <bool IS_ML>
__device__ __forceinline__ void scan_out_unit(const Frame& F, int l, int b, int head, int tc, const ScanPtrs& sp, const ScanRegs& R_, bool dry = false) {
    const int tid = F.tid, d = tid >> 8, ht = tid & 255, hw = F.wave & 3, lane = F.lane, fr = lane & 15, fq = lane >> 4;
    LAS unsigned char* base = F.lds + d * DIRB;
    LAS bf16* Qs = (LAS bf16*)(base + L_QS); LAS bf16* Ks = (LAS bf16*)(base + L_KS); LAS bf16* Vt = (LAS bf16*)(base + L_VT); LAS bf16* Ws = (LAS bf16*)(base + L_WS); LAS bf16* Cs = (LAS bf16*)(base + L_CS);
    LAS float* vec = (LAS float*)(base + L_VEC);
    const int row0 = chunk_row0(b, tc), pos = chunk_pos(tc, d), chain = (b * 4 + head) * 2 + d; const size_t slot = (size_t)chain * NCH + pos;
    float m_c = 0.f;
    if constexpr (IS_ML) {
        m_c = R_.mc;
        if (hw == 0) { float a, bc; ml_gates(R_.gi, R_.gf, R_.bi, R_.bf, lane, a, bc); const float cm = wave_incl_scan_max(a, lane); vec[lane] = a; vec[64 + lane] = fmaxf(m_c, cm); vec[128 + lane] = bc; }
    } else { gla_build_g(F, l, head, d, R_.af, base, ht); }
    const LAS float* G = (const LAS float*)(base + L_G);
#pragma unroll
    for (int rep = 0; rep < 2; ++rep) { const int q = ht + 256 * rep, i = q >> 3, c8 = q & 7;
        float qx[8], kx[8], vx[8]; unpack8(SR_SEL2(R_, q, rep), qx); unpack8(SR_SEL2(R_, k, rep), kx); unpack8(SR_SEL2(R_, v, rep), vx);
#pragma unroll
        for (int e = 0; e < 8; ++e) {
            if constexpr (IS_ML) { kx[e] *= 0.125f; } else { const float g = G[i * 65 + c8 * 8 + e]; qx[e] *= 0.125f * __expf(g); kx[e] *= __expf(-g); }
        }
        *(LAS v4u*)(Qs + i * PT + c8 * 8) = pack8(qx); *(LAS v4u*)(Ks + i * PT + c8 * 8) = pack8(kx); *(LAS v4u*)(Vt + i * PT + c8 * 8) = pack8(vx); }
    if constexpr (!IS_ML) lds_barrier();
    {
#pragma unroll
        for (int rep = 0; rep < 2; ++rep) { const int q = ht + 256 * rep, v = q >> 3, c8 = q & 7; *(LAS v4u*)(Cs + v * PT + c8 * 8) = SR_SEL2(R_, st, rep); }
        if constexpr (IS_ML) { if (ht < 128) { const int rr = 64 + (ht >> 3), c8 = ht & 7; const bool isn = (rr == 64);
            const float x[8] = {isn ? R_.nv0.x : 0.f, isn ? R_.nv0.y : 0.f, isn ? R_.nv0.z : 0.f, isn ? R_.nv0.w : 0.f, isn ? R_.nv1.x : 0.f, isn ? R_.nv1.y : 0.f, isn ? R_.nv1.z : 0.f, isn ? R_.nv1.w : 0.f};
            *(LAS v4u*)(Cs + rr * PT + c8 * 8) = pack8(x); } }
    }
    lds_barrier();
    const int t = 16 * hw + fr; float rs = 0.f;
    const float Mt = IS_ML ? vec[64 + t] : 0.f;
#pragma unroll
    for (int st = 0; st < 4; ++st) {
        v2u w; w.x = 0u; w.y = 0u;
        if (st <= hw) { f32x4 acc = {0.f, 0.f, 0.f, 0.f}; acc = mmt<64, PT, PT>(acc, Ks, 16 * st, Qs, 16 * hw, fr, fq);
            float o[4];
#pragma unroll
            for (int r = 0; r < 4; ++r) { const int s = 16 * st + 4 * fq + r; float wg = (s <= t) ? 1.f : 0.f; if constexpr (IS_ML) wg = (s <= t) ? __expf(vec[s] - Mt) : 0.f; o[r] = wg * acc[r]; rs += o[r]; }
            w.x = pk2(o[0], o[1]); w.y = pk2(o[2], o[3]); }
        *(LAS v2u*)(Ws + t * PT + 16 * st + 4 * fq) = w; }
    rs = xor16_32_sum(rs);
    float h[4][4]; float wi = 1.f, dn = 1.f;
    if constexpr (IS_ML) { f32x4 an = {0.f, 0.f, 0.f, 0.f}; an = mmt<64, PT, PT>(an, Cs, 64, Qs, 16 * hw, fr, fq); const float nq = xor16_32_sum(an[0]);
        wi = __expf(m_c - Mt); const float den = rs + wi * nq; dn = 1.f / fmaxf(fabsf(den), __expf(-(vec[128 + t] + Mt))); }
#pragma unroll
    for (int vt = 0; vt < 4; ++vt) { f32x4 ai = {0.f, 0.f, 0.f, 0.f}, ac = {0.f, 0.f, 0.f, 0.f};
        ai = mmt_tx<64, PT, PT>(ai, Vt, 16 * vt, Ws, 16 * hw, fr, fq, lane); ac = mmt<64, PT, PT>(ac, Cs, 16 * vt, Qs, 16 * hw, fr, fq);
#pragma unroll
        for (int r = 0; r < 4; ++r) h[vt][r] = (ai[r] + wi * ac[r]) * dn; }
    f32x4 gn4[4];
    { const float* ng_ = F.in[IS_ML ? I_MLNG : I_GLNG] + (size_t)l * 256 + head * 64;
#pragma unroll
      for (int vt = 0; vt < 4; ++vt) gn4[vt] = *(const GAS f32x4*)(ng_ + 16 * vt + 4 * fq); }
    lds_barrier();
    LAS float* HB = (LAS float*)(F.lds + DIRB + L_HB);
    if (d == 1) {
#pragma unroll
        for (int vt = 0; vt < 4; ++vt)
#pragma unroll
            for (int r = 0; r < 4; ++r) HB[(63 - t) * 65 + 16 * vt + 4 * fq + r] = h[vt][r]; }
    lds_barrier();
    if (d == 0) {
        float s1 = 0.f;
#pragma unroll
        for (int vt = 0; vt < 4; ++vt)
#pragma unroll
            for (int r = 0; r < 4; ++r) { h[vt][r] += HB[t * 65 + 16 * vt + 4 * fq + r]; s1 += IS_ML ? h[vt][r] : h[vt][r] * h[vt][r]; }
        s1 = xor16_32_sum(s1);
        float mean = 0.f, rstd;
        if constexpr (IS_ML) { mean = s1 * (1.f / 64.f); float s2 = 0.f;
#pragma unroll
            for (int vt = 0; vt < 4; ++vt)
#pragma unroll
                for (int r = 0; r < 4; ++r) { const float dd = h[vt][r] - mean; s2 += dd * dd; }
            s2 = xor16_32_sum(s2); rstd = 1.f / sqrtf(s2 * (1.f / 64.f) + LN_EPS);
        } else rstd = 1.f / sqrtf(s1 * (1.f / 64.f) + LN_EPS);
        bf16* op = F.P() + (size_t)(row0 + t) * NP + (IS_ML ? TC_MLO : TC_GLR) + head * 64;
#pragma unroll
        for (int vt = 0; vt < 4; ++vt) { const int c = 16 * vt + 4 * fq; const v2u gp = (vt == 0) ? R_.og0 : (vt == 1 ? R_.og1 : (vt == 2 ? R_.og2 : R_.og3)); const f32x4 gn = gn4[vt];
            const float gt[4] = {bflo(gp.x), bfhi(gp.x), bflo(gp.y), bfhi(gp.y)}; float y[4];
#pragma unroll
            for (int r = 0; r < 4; ++r) { const float gate = IS_ML ? sigm(gt[r]) : gt[r] * sigm(gt[r]); y[r] = (h[vt][r] - mean) * rstd * gn[r] * gate; }
            v2u w; w.x = pk2(y[0], y[1]); w.y = pk2(y[2], y[3]); if (!dry) *(GAS v2u*)(op + c) = w; }
    }
    lds_barrier();
}
constexpr int DP = 136;
constexpr int LF_C = 0, LF_S = 34816, LF_XR = 69632, LF_XI = 69632 + 18432;
__device__ __forceinline__ void dft_load_mats(const Frame& F) {
    LAS bf16* CM = (LAS bf16*)(F.lds + LF_C); LAS bf16* SMt = (LAS bf16*)(F.lds + LF_S);
    const bf16* gc = (const bf16*)(F.ws + WS_DFT_C); const bf16* gs = (const bf16*)(F.ws + WS_DFT_S);
    for (int q = F.tid; q < 128 * 16; q += 512) { const int j = q >> 4, c8 = q & 15; *(LAS v4u*)(CM + j * DP + c8 * 8) = *(const GAS v4u*)(gc + j * 128 + c8 * 8); *(LAS v4u*)(SMt + j * DP + c8 * 8) = *(const GAS v4u*)(gs + j * 128 + c8 * 8); }
    __syncthreads();
}
template <int STEP>
__device__ __forceinline__ void dft_unit(const Frame& F, int b, int idx, int slab, bf16* IM1, bf16* FT, bool dry = false) {
    LAS bf16* CM = (LAS bf16*)(F.lds + LF_C); LAS bf16* SMt = (LAS bf16*)(F.lds + LF_S); LAS bf16* XR = (LAS bf16*)(F.lds + LF_XR); LAS bf16* XI = (LAS bf16*)(F.lds + LF_XI);
    const int tid = F.tid, lane = F.lane, fr = lane & 15, fq = lane >> 4, w = F.wave;
#pragma unroll
    for (int rep = 0; rep < 2; ++rep) { const int q = tid + 512 * rep, i = q >> 3, c8 = q & 7;
        const int row = (STEP == 1) ? b * T + 128 * i + idx : b * T + 128 * idx + i;
        *(LAS v4u*)(XR + i * PT + c8 * 8) = *(const GAS v4u*)(F.P() + (size_t)row * NP + TC_FT + slab * 64 + c8 * 8);
        if (STEP == 2) *(LAS v4u*)(XI + i * PT + c8 * 8) = *(const GAS v4u*)(IM1 + (size_t)row * 256 + slab * 64 + c8 * 8); }
    lds_barrier();
    const int j = 16 * w + fr;
#pragma unroll
    for (int ct = 0; ct < 4; ++ct) {
        f32x4 dr = {0.f, 0.f, 0.f, 0.f}, p1 = {0.f, 0.f, 0.f, 0.f}, p2 = {0.f, 0.f, 0.f, 0.f};
        dr = mmt_tx<128, PT, DP>(dr, XR, 16 * ct, CM, 16 * w, fr, fq, lane); p2 = mmt_tx<128, PT, DP>(p2, XR, 16 * ct, SMt, 16 * w, fr, fq, lane);
        if (STEP == 2) { dr = mmt_tx<128, PT, DP>(dr, XI, 16 * ct, SMt, 16 * w, fr, fq, lane); p1 = mmt_tx<128, PT, DP>(p1, XI, 16 * ct, CM, 16 * w, fr, fq, lane); }
        float orr[4], oi[4];
        if (STEP == 1) { const float ph = (float)((j * idx) & 16383) * (1.f / 8192.f); const float cs = cospif(ph), sn = sinpif(ph);
#pragma unroll
            for (int r = 0; r < 4; ++r) { const float di = -p2[r]; orr[r] = dr[r] * cs + di * sn; oi[r] = di * cs - dr[r] * sn; }
            const int orow = b * T + 128 * j + idx;
            v2u wr_, wi_; wr_.x = pk2(orr[0], orr[1]); wr_.y = pk2(orr[2], orr[3]); wi_.x = pk2(oi[0], oi[1]); wi_.y = pk2(oi[2], oi[3]);
            if (!dry) { *(GAS v2u*)(F.P() + (size_t)orow * NP + TC_FT + slab * 64 + 16 * ct + 4 * fq) = wr_; *(GAS v2u*)(IM1 + (size_t)orow * 256 + slab * 64 + 16 * ct + 4 * fq) = wi_; }
        } else {
#pragma unroll
            for (int r = 0; r < 4; ++r) { orr[r] = dr[r] * (1.f / 128.f); oi[r] = (p1[r] - p2[r]) * (1.f / 128.f); }
            const int orow = b * T + idx + 128 * j;
            v2u wr_, wi_; wr_.x = pk2(orr[0], orr[1]); wr_.y = pk2(orr[2], orr[3]); wi_.x = pk2(oi[0], oi[1]); wi_.y = pk2(oi[2], oi[3]);
            if (!dry) { *(GAS v2u*)(FT + (size_t)orow * 512 + slab * 64 + 16 * ct + 4 * fq) = wr_; *(GAS v2u*)(FT + (size_t)orow * 512 + 256 + slab * 64 + 16 * ct + 4 * fq) = wi_; }
        } }
    lds_barrier();
}
__device__ __forceinline__ void ctx_dft(const Frame& F, bf16* FT, int widx, int nw) {
    LAS float* ct = (LAS float*)(F.lds + LF_XR); LAS float* st = ct + 256;
    if (F.tid < 256) { const float ph = (float)F.tid * (1.f / 128.f); ct[F.tid] = cospif(ph); st[F.tid] = sinpif(ph); }
    __syncthreads();
    for (int o = widx * 512 + F.tid; o < NB * 256 * 256; o += nw * 512) { const int col = o & 255, k = (o >> 8) & 255, b = o >> 16;
        const bf16* up = F.P() + (size_t)(RL + b * CTX) * NP + TC_FT + col; float re = 0.f, im = 0.f;
        for (int t = 0; t < 256; ++t) { const float u = bf2f(((const GAS bf16*)up)[(size_t)t * NP]); const int a = (k * t) & 255; re += u * ct[a]; im -= u * st[a]; }
        bf16* op = FT + (size_t)(RL + b * CTX + k) * 512 + col; op[0] = (bf16)f2bf(re * 0.0625f); op[256] = (bf16)f2bf(im * 0.0625f); }
    __syncthreads();
}
namespace attn_body {
using bf16=__hip_bfloat16;
using bf16x8=__attribute__((ext_vector_type(8)))short;
using s16x4=__attribute__((ext_vector_type(4)))short;
using f32x16=__attribute__((ext_vector_type(16)))float;
using u32x4=__attribute__((ext_vector_type(4)))unsigned;
using f32x4a=__attribute__((ext_vector_type(4)))float;
constexpr int D=64,DM=3072;
constexpr int NW=8,QBLK=32,QB=QBLK*NW,KVBLK=64;
constexpr int ATTN_PITCH=DM, ATTN_UNIT_ROWS=QB;
__device__ __forceinline__ int crow(int r,int hi){return (r&3)+8*(r>>2)+4*hi;}
#define SBAR() __builtin_amdgcn_sched_barrier(0)
__device__ __forceinline__ void cmask(f32x16&p0,f32x16&p1,int jb,int qrel,int hi){
  const float NEG=-INFINITY; int kb=64*jb+4*hi;
  #pragma unroll
  for(int r=0;r<16;++r){int kv=kb+(r&3)+8*(r>>2); if(kv>qrel)p0[r]=NEG; if(kv+32>qrel)p1[r]=NEG;}
}

constexpr int NSLOT=3, SLOTB=8192;
constexpr int LDS_K=0, LDS_V=NSLOT*SLOTB, LDS_WS=2*NSLOT*SLOTB, LDS_OST=LDS_WS+NW*64*4, LDS_BYTES=LDS_OST+NW*4096;
constexpr float C2=0.125f*1.4426950408889634f;
__device__ __forceinline__ void glds16(const void*gsrc,unsigned lds_dst){unsigned keep;
  asm volatile("s_mov_b32 %0, m0\n\ts_mov_b32 m0, %2\n\ts_nop 0\n\tglobal_load_lds_dwordx4 %1, off\n\ts_mov_b32 m0, %0":"=&s"(keep):"v"(gsrc),"s"(lds_dst):"memory");}
__device__ __forceinline__ void glds16s(unsigned voff,const void*sbase,unsigned lds_dst){unsigned keep;
  asm volatile("s_mov_b32 %0, m0\n\ts_mov_b32 m0, %3\n\ts_nop 0\n\tglobal_load_lds_dwordx4 %1, %2\n\ts_mov_b32 m0, %0":"=&s"(keep):"v"(voff),"s"(sbase),"s"(lds_dst):"memory");}
__device__ __forceinline__ float max3f(float a,float b,float c){float r;asm("v_max3_f32 %0, %1, %2, %3":"=v"(r):"v"(a),"v"(b),"v"(c));return r;}
__device__ __forceinline__ float max2f(float a,float b){float r;asm("v_max_f32_e32 %0, %1, %2":"=v"(r):"v"(a),"v"(b));return r;}
__device__ __forceinline__ float fadd_s(float a,float b){float r;asm("v_add_f32_e32 %0, %1, %2":"=v"(r):"v"(a),"v"(b));return r;}
__device__ __forceinline__ float fsub_s(float a,float b){float r;asm("v_sub_f32_e32 %0, %1, %2":"=v"(r):"v"(a),"v"(b));return r;}
typedef float f32x2_t __attribute__((ext_vector_type(2))); typedef __bf16 bf16x2_t __attribute__((ext_vector_type(2)));
__device__ __forceinline__ unsigned cvtpk_s(float lo,float hi){f32x2_t v={lo,hi};bf16x2_t b=__builtin_convertvector(v,bf16x2_t);return __builtin_bit_cast(unsigned,b);}
#define WAIT_BAR(N) asm volatile("s_waitcnt vmcnt(" #N ") lgkmcnt(0)\n\ts_barrier":::"memory")

__device__ __forceinline__ void qkt(f32x16&p0,f32x16&p1,const char*Kslot,const bf16x8*qr,const f32x16&negm,int r32,int hi){
  const char*kb=Kslot+hi*1024+r32*16;
  #pragma unroll
  for(int d0=0;d0<4;++d0){
    const bf16x8 b0=*reinterpret_cast<const bf16x8*>(kb+d0*2048);
    const bf16x8 b1=*reinterpret_cast<const bf16x8*>(kb+d0*2048+512);
    if(d0==0){p0=__builtin_amdgcn_mfma_f32_32x32x16_bf16(b0,qr[0],negm,0,0,0);p1=__builtin_amdgcn_mfma_f32_32x32x16_bf16(b1,qr[0],negm,0,0,0);}
    else{p0=__builtin_amdgcn_mfma_f32_32x32x16_bf16(b0,qr[d0],p0,0,0,0);p1=__builtin_amdgcn_mfma_f32_32x32x16_bf16(b1,qr[d0],p1,0,0,0);}}
}
typedef __attribute__((address_space(3))) const char* lds_cptr;
typedef short v4i16_t __attribute__((ext_vector_type(4)));
__device__ __forceinline__ void kload8(bf16x8*kf,lds_cptr kp){
  kf[0]=*(const __attribute__((address_space(3))) bf16x8*)(kp);      kf[1]=*(const __attribute__((address_space(3))) bf16x8*)(kp+512);
  kf[2]=*(const __attribute__((address_space(3))) bf16x8*)(kp+2048); kf[3]=*(const __attribute__((address_space(3))) bf16x8*)(kp+2560);
  kf[4]=*(const __attribute__((address_space(3))) bf16x8*)(kp+4096); kf[5]=*(const __attribute__((address_space(3))) bf16x8*)(kp+4608);
  kf[6]=*(const __attribute__((address_space(3))) bf16x8*)(kp+6144); kf[7]=*(const __attribute__((address_space(3))) bf16x8*)(kp+6656);
}
__device__ __forceinline__ void kload2(bf16x8*kf,lds_cptr kp,int j){ kf[2*j]=*(const __attribute__((address_space(3))) bf16x8*)(kp+j*2048); kf[2*j+1]=*(const __attribute__((address_space(3))) bf16x8*)(kp+j*2048+512); }
__device__ __forceinline__ s16x4 vtr(lds_cptr p){ return __builtin_bit_cast(s16x4,__builtin_amdgcn_ds_read_tr16_b64_v4i16((__attribute__((address_space(3))) v4i16_t*)p)); }
__device__ __forceinline__ float rowmax(const f32x16&p0,const f32x16&p1){
  float a=max3f(p0[0],p0[1],p1[0]),b=max3f(p0[2],p0[3],p1[1]);a=max3f(a,p1[2],p1[3]);
  #pragma unroll
  for(int r=4;r<16;r+=4){a=max3f(a,p0[r],p0[r+1]);b=max3f(b,p0[r+2],p0[r+3]);a=max3f(a,p1[r],p1[r+1]);b=max3f(b,p1[r+2],p1[r+3]);}
  const float m=max2f(a,b);
  auto rr=__builtin_amdgcn_permlane32_swap(__float_as_uint(m),__float_as_uint(m),false,false);
  return max2f(__uint_as_float(rr[0]),__uint_as_float(rr[1]));
}
__device__ __forceinline__ void pv(f32x16*o,int vb,bf16x8 pa0,bf16x8 pa1,bf16x8 pa2,bf16x8 pa3){
  #pragma unroll
  for(int d0=0;d0<2;++d0){s16x4 lo[4],hi[4];
    #pragma unroll
    for(int ks=0;ks<4;++ks){
      asm volatile("ds_read_b64_tr_b16 %0,%1 offset:%c2":"=&v"(lo[ks]):"v"(vb),"i"(d0*4096+ks*1024):"memory");
      asm volatile("ds_read_b64_tr_b16 %0,%1 offset:%c2":"=&v"(hi[ks]):"v"(vb),"i"(d0*4096+ks*1024+512):"memory");}
    asm volatile("s_waitcnt lgkmcnt(0)":::"memory");SBAR();
    #define PK(k) (bf16x8){lo[k][0],lo[k][1],lo[k][2],lo[k][3],hi[k][0],hi[k][1],hi[k][2],hi[k][3]}
    o[d0]=__builtin_amdgcn_mfma_f32_32x32x16_bf16(pa0,PK(0),o[d0],0,0,0);
    o[d0]=__builtin_amdgcn_mfma_f32_32x32x16_bf16(pa1,PK(1),o[d0],0,0,0);
    o[d0]=__builtin_amdgcn_mfma_f32_32x32x16_bf16(pa2,PK(2),o[d0],0,0,0);
    o[d0]=__builtin_amdgcn_mfma_f32_32x32x16_bf16(pa3,PK(3),o[d0],0,0,0);
    #undef PK
  }
}

#ifndef ATTN_STORE16
#define ATTN_STORE16(p,v) (*(u32x4*)(p)=(v))
#endif
template<int THRL> __device__ __forceinline__ void attn_unit(const bf16*Qw0,const bf16*__restrict__ KL,const bf16*__restrict__ VL,const bf16*__restrict__ KC,const bf16*__restrict__ VC,int nlt,const int NT,bf16*Ow0,char*shm,const float MB,const float*gq,const float*rc,const float*rs,const int tq0){
  const int tid=threadIdx.x,lane=tid&63,r32=lane&31,hi=lane>>5; const int wid=__builtin_amdgcn_readfirstlane(tid>>6);
  const bf16*Qw=Qw0+(long)(wid*QBLK)*DM;
  const unsigned lds0=(unsigned)(uintptr_t)shm;
  float*wsf=(float*)(shm+LDS_WS)+wid*64;
  const unsigned kvo_k=(unsigned)(lane*DM+wid*8)*2u; const bf16*ksrcL=KL; const bf16*ksrcC=KC-(long)nlt*KVBLK*DM;
  const unsigned kvo_v=(unsigned)((16*(wid&3)+(lane>>2))*DM+(wid>>2)*32+(lane&3)*8)*2u; const bf16*vsrcL=VL; const bf16*vsrcC=VC-(long)nlt*KVBLK*DM;
  const unsigned kdst=lds0+LDS_K+wid*1024, vdst=lds0+LDS_V+wid*1024;
  #define DMA_K(t,slot) glds16s(kvo_k,((t)<nlt?ksrcL:ksrcC)+(long)(t)*KVBLK*DM,(unsigned)__builtin_amdgcn_readfirstlane(kdst+(slot)))
  #define DMA_V(t,slot) glds16s(kvo_v,((t)<nlt?vsrcL:vsrcC)+(long)(t)*KVBLK*DM,(unsigned)__builtin_amdgcn_readfirstlane(vdst+(slot)))
  const int vb0=(int)(lds0+LDS_V)+((lane>>4)&1)*32+(lane&3)*8+(4*hi+((lane&15)>>2))*64;
  const char*Kbase=shm+LDS_K; bf16x8 kf[8];
  const lds_cptr shm3=(lds_cptr)shm; const lds_cptr kp0=shm3+LDS_K+hi*1024+r32*16; const lds_cptr vp0=shm3+LDS_V+((lane>>4)&1)*32+(lane&3)*8+(4*hi+((lane&15)>>2))*64;
  DMA_K(0,0);DMA_V(0,0);DMA_K(1,SLOTB);
  bf16x8 qr[4];
  #pragma unroll
  for(int d0=0;d0<4;++d0)qr[d0]=*reinterpret_cast<const bf16x8*>(&Qw[(long)r32*DM+d0*16+hi*8]);
  { float x[4][8]; float ss=0.f;
    #pragma unroll
    for(int d0=0;d0<4;++d0){
      #pragma unroll
      for(int j=0;j<8;++j){x[d0][j]=__uint_as_float(((unsigned)(unsigned short)qr[d0][j])<<16);ss+=x[d0][j]*x[d0][j];}}
    {auto rr=__builtin_amdgcn_permlane32_swap(__float_as_uint(ss),__float_as_uint(ss),false,false);ss=__uint_as_float(rr[0])+__uint_as_float(rr[1]);}
    const float rstd=__builtin_amdgcn_rsqf(ss*(1.f/64.f)+::LN_EPS);
    #pragma unroll
    for(int d0=0;d0<4;++d0){const GAS f32x4a*g4=(const GAS f32x4a*)(gq+16*d0+8*hi);const f32x4a ga=g4[0],gb=g4[1];
      #pragma unroll
      for(int j=0;j<8;++j)x[d0][j]=x[d0][j]*rstd*(j<4?ga[j]:gb[j-4]);}
    if(tq0>=0){const int t=tq0+wid*QBLK+r32;
      #pragma unroll
      for(int ax=0;ax<2;++ax){const int pos=ax?(t&63):(t>>6);const GAS f32x4a*c4=(const GAS f32x4a*)(rc+pos*16+8*hi);const GAS f32x4a*s4=(const GAS f32x4a*)(rs+pos*16+8*hi);
        const f32x4a ca=c4[0],cb=c4[1],sa=s4[0],sb=s4[1];
        #pragma unroll
        for(int j=0;j<8;++j){const float c=j<4?ca[j]:cb[j-4],sn=j<4?sa[j]:sb[j-4];const float xe=x[2*ax][j],xo=x[2*ax+1][j];x[2*ax][j]=xe*c-xo*sn;x[2*ax+1][j]=xe*sn+xo*c;}}}
    #pragma unroll
    for(int d0=0;d0<4;++d0){u32x4 w;
      #pragma unroll
      for(int j=0;j<4;++j)w[j]=cvtpk_s(x[d0][2*j]*::C2Q,x[d0][2*j+1]*::C2Q);
      qr[d0]=__builtin_bit_cast(bf16x8,w);} }
  const short one_=((lane&15)<2&&(lane&15)==((lane>>4)&1))?(short)0x3F80:(short)0; bf16x8 sel={one_,one_,one_,one_,one_,one_,one_,one_}; asm volatile("":"+v"(sel));
  f32x4a lacc={0.f,0.f,0.f,0.f};
  f32x16 o[2];o[0]=f32x16{};o[1]=f32x16{};f32x16 negm;
  #pragma unroll
  for(int r=0;r<16;++r)negm[r]=-MB;
  asm volatile("":"+v"(negm));
  #define CMASK(P0,P1,t) do{}while(0)
  #define START(P0,P1) do{ _Pragma("unroll") for(int r=0;r<16;++r)P0[r]=__builtin_amdgcn_exp2f(P0[r]); }while(0)
  #define RESC() do{}while(0)
  f32x16 pA0,pA1,pB0,pB1;
  int sl_prev=0,sl_cur=0,sl_next=SLOTB;
  #define ROT() do{sl_prev=sl_cur;sl_cur=sl_next;sl_next=(sl_next==(NSLOT-1)*SLOTB)?0:sl_next+SLOTB;}while(0)
  DMA_K(2,2*SLOTB);
  WAIT_BAR(3);
  qkt(pA0,pA1,Kbase,qr,negm,r32,hi);asm volatile("s_nop 15\n\ts_nop 7":"+v"(pA0),"+v"(pA1));CMASK(pA0,pA1,0);
  START(pA0,pA1);
  _Pragma("unroll") for(int r=0;r<8;++r)pA1[r]=__builtin_amdgcn_exp2f(pA1[r]);
  WAIT_BAR(0);
  DMA_K(3,0);DMA_V(1,SLOTB);
  ROT();
  kload8(kf,kp0+sl_cur);
  WAIT_BAR(2);
  s16x4 vlo[8],vhi[8]; u32x4 pw0,pw1,pw2,pw3;
  #define PKW(P,B) cvtpk_s(P[B],P[B+1])
  #define PAF(k) __builtin_bit_cast(bf16x8,pw##k)
  #define VFR(i) (bf16x8){vlo[i][0],vlo[i][1],vlo[i][2],vlo[i][3],vhi[i][0],vhi[i][1],vhi[i][2],vhi[i][3]}
  #define PIN(x) asm volatile("":"+v"(x))
  #define MX3(a,b,c) __builtin_fmaxf(__builtin_fmaxf((a),(b)),(c))
  #define GAPA(MF,W0,W1,PW,EXTRA) do{ MF; W0; W1; PIN(PW); EXTRA; SBAR(); }while(0)
  #define LSUM(k) do{ lacc=__builtin_amdgcn_mfma_f32_16x16x32_bf16(sel,PAF(k),lacc,0,0,0); PIN(lacc); }while(0)
  #define NOX() do{}while(0)
  #define EX(v) __builtin_amdgcn_exp2f(v)
  #define GAPB(MF,E0,E1,E2,PX,PY,EXTRA) do{ MF; E0=EX(E0); E1=EX(E1); E2=EX(E2); PIN(PX); PIN(PY); EXTRA; SBAR(); }while(0)
  #define EXA(P,B) do{ P[B]=EX(P[B]); P[B+1]=EX(P[B+1]); PIN(P); }while(0)
  #define VRD(i) do{ vlo[i]=vtr(vp_+(((i)>>2)*4096+((i)&3)*1024)); vhi[i]=vtr(vp_+(((i)>>2)*4096+((i)&3)*1024+512)); }while(0)
  #define KRD(G,j) do{ if(G){ kload2(kf,kp0+sl_next,j); SBAR(); } }while(0)
  #define STEP(C0,C1,P0,P1,t,GK,GV,GL) do{ SBAR(); \
    const lds_cptr vp_=vp0+sl_prev; \
    VRD(0); SBAR(); \
    GAPA(C0=__builtin_amdgcn_mfma_f32_32x32x16_bf16(kf[0],qr[0],negm,0,0,0), pw0[0]=PKW(P0,0), pw0[1]=PKW(P0,2), pw0, EXA(P1,8)); \
    VRD(4); SBAR(); GAPA(C1=__builtin_amdgcn_mfma_f32_32x32x16_bf16(kf[1],qr[0],negm,0,0,0), pw0[2]=PKW(P0,4), pw0[3]=PKW(P0,6), pw0, EXA(P1,10)); \
    VRD(1); SBAR(); GAPA(C0=__builtin_amdgcn_mfma_f32_32x32x16_bf16(kf[2],qr[1],C0,0,0,0),   pw1[0]=PKW(P0,8), pw1[1]=PKW(P0,10), pw1, do{EXA(P1,12);LSUM(0);}while(0)); \
    VRD(5); SBAR(); GAPA(C1=__builtin_amdgcn_mfma_f32_32x32x16_bf16(kf[3],qr[1],C1,0,0,0),   pw1[2]=PKW(P0,12),pw1[3]=PKW(P0,14), pw1, EXA(P1,14)); \
    VRD(2); SBAR(); GAPA(C0=__builtin_amdgcn_mfma_f32_32x32x16_bf16(kf[4],qr[2],C0,0,0,0),   pw2[0]=PKW(P1,0), pw2[1]=PKW(P1,2), pw2, LSUM(1)); \
    VRD(6); SBAR(); GAPA(C1=__builtin_amdgcn_mfma_f32_32x32x16_bf16(kf[5],qr[2],C1,0,0,0),   pw2[2]=PKW(P1,4), pw2[3]=PKW(P1,6), pw2, NOX()); \
    VRD(3); SBAR(); GAPA(C0=__builtin_amdgcn_mfma_f32_32x32x16_bf16(kf[6],qr[3],C0,0,0,0),   pw3[0]=PKW(P1,8), pw3[1]=PKW(P1,10), pw3, LSUM(2)); \
    VRD(7); SBAR(); GAPA(C1=__builtin_amdgcn_mfma_f32_32x32x16_bf16(kf[7],qr[3],C1,0,0,0),   pw3[2]=PKW(P1,12),pw3[3]=PKW(P1,14), pw3, NOX()); \
    if(GK){DMA_K((t)+3,sl_cur);} if(GV){DMA_V((t)+1,sl_next);} \
    CMASK(C0,C1,t); \
    SBAR(); \
    GAPB(o[0]=__builtin_amdgcn_mfma_f32_32x32x16_bf16(PAF(0),VFR(0),o[0],0,0,0), C0[0],C0[1],C0[2],C0,C0,NOX()); \
    GAPB(o[1]=__builtin_amdgcn_mfma_f32_32x32x16_bf16(PAF(0),VFR(4),o[1],0,0,0), C0[3],C0[4],C0[5],C0,C0,LSUM(3)); \
    KRD(GL,0); GAPB(o[0]=__builtin_amdgcn_mfma_f32_32x32x16_bf16(PAF(1),VFR(1),o[0],0,0,0), C0[6],C0[7],C0[8],C0,C0,NOX()); \
    KRD(GL,1); GAPB(o[1]=__builtin_amdgcn_mfma_f32_32x32x16_bf16(PAF(1),VFR(5),o[1],0,0,0), C0[9],C0[10],C0[11],C0,C0,NOX()); \
    KRD(GL,2); GAPB(o[0]=__builtin_amdgcn_mfma_f32_32x32x16_bf16(PAF(2),VFR(2),o[0],0,0,0), C0[12],C0[13],C0[14],C0,C0,NOX()); \
    KRD(GL,3); GAPB(o[1]=__builtin_amdgcn_mfma_f32_32x32x16_bf16(PAF(2),VFR(6),o[1],0,0,0), C0[15],C1[0],C1[1],C0,C1,NOX()); \
    GAPB(o[0]=__builtin_amdgcn_mfma_f32_32x32x16_bf16(PAF(3),VFR(3),o[0],0,0,0), C1[2],C1[3],C1[4],C1,C1,NOX()); \
    GAPB(o[1]=__builtin_amdgcn_mfma_f32_32x32x16_bf16(PAF(3),VFR(7),o[1],0,0,0), C1[5],C1[6],C1[7],C1,C1,NOX()); \
    }while(0)
  int t=1;
  #undef CMASK
  #define CMASK(P0,P1,t) do{}while(0)
  for(;t+5<NT;t+=2){
    STEP(pB0,pB1,pA0,pA1,t,true,true,true);     WAIT_BAR(2); RESC(); ROT();
    STEP(pA0,pA1,pB0,pB1,t+1,true,true,true);   WAIT_BAR(2); RESC(); ROT();
  }
  #undef CMASK
  #define CMASK(P0,P1,t) do{}while(0)
  #define ENDW(tt) do{ if((tt)+3<NT){WAIT_BAR(2);} else if((tt)+2<NT){WAIT_BAR(1);} else {WAIT_BAR(0);} }while(0)
  for(;t+1<NT;t+=2){
    STEP(pB0,pB1,pA0,pA1,t,(t+3<NT),(t+1<NT),(t+1<NT));       ENDW(t);   RESC(); ROT();
    STEP(pA0,pA1,pB0,pB1,t+1,(t+4<NT),(t+2<NT),(t+2<NT));     ENDW(t+1); RESC(); ROT();
  }
  STEP(pB0,pB1,pA0,pA1,NT-1,false,false,false); RESC();
  { _Pragma("unroll") for(int r=8;r<16;++r)pB1[r]=__builtin_amdgcn_exp2f(pB1[r]);
    pw0=(u32x4){PKW(pB0,0),PKW(pB0,2),PKW(pB0,4),PKW(pB0,6)};pw1=(u32x4){PKW(pB0,8),PKW(pB0,10),PKW(pB0,12),PKW(pB0,14)};pw2=(u32x4){PKW(pB1,0),PKW(pB1,2),PKW(pB1,4),PKW(pB1,6)};pw3=(u32x4){PKW(pB1,8),PKW(pB1,10),PKW(pB1,12),PKW(pB1,14)};
    LSUM(0); LSUM(1); LSUM(2); LSUM(3);
    SBAR(); pv(o,vb0+sl_cur,PAF(0),PAF(1),PAF(2),PAF(3)); }
  #undef PKW
  #undef PAF
  #undef VFR
  #undef PIN
  #undef MX3
  #undef GAPA
  #undef LSUM
  #undef NOX
  #undef GAPB
  #undef EXA
  #undef EX
  #undef VRD
  #undef KRD
  #undef STEP
  #undef ENDW
  if(lane<16){wsf[32+lane]=lacc[0];wsf[48+lane]=lacc[1];}asm volatile("s_waitcnt lgkmcnt(0)":::"memory");
  float rli[16];
  #pragma unroll
  for(int r=0;r<16;++r)rli[r]=__builtin_amdgcn_rcpf(wsf[32+crow(r,hi)]);
  bf16*Ow=Ow0+(long)(wid*QBLK)*DM;
  { bf16*stg=(bf16*)(shm+LDS_OST)+wid*2048;
    #pragma unroll
    for(int r=0;r<16;++r){const int orow=crow(r,hi);
      #pragma unroll
      for(int d0=0;d0<2;++d0)stg[orow*64+d0*32+r32]=__float2bfloat16(o[d0][r]*rli[r]);}
    asm volatile("s_waitcnt lgkmcnt(0)":::"memory");
    #pragma unroll
    for(int i=0;i<4;++i){const int row=i*8+(lane>>3),ch=lane&7; const u32x4 v=*(const u32x4*)(stg+row*64+ch*8); ATTN_STORE16(Ow+(long)row*DM+ch*8,v);} }
  asm volatile("s_waitcnt lgkmcnt(0)\n\ts_barrier":::"memory");
  #undef DMA_K
  #undef DMA_V
  #undef CMASK
  #undef START
  #undef RESC
  #undef ROT
}
constexpr int ATTN_LDS_BYTES=LDS_BYTES;
#undef SBAR
#undef WAIT_BAR
}

constexpr int PH_PER_LAYER = 11, PH_L0 = 2, N_PHASES = PH_L0 + 2 * PH_PER_LAYER;
__device__ __forceinline__ void phase_scale_rows(const Frame& F, int l, bool from_x) {
    const int gw = F.vcu * NWAVES + F.wave, NGW = F.G * NWAVES;
    for (int r = gw; r < R; r += NGW) { Row16 x = ld_row(from_x ? xin_row(F, l, r) : F.XM() + (size_t)r * D, F.lane);
#pragma unroll
        for (int j = 0; j < 4; ++j) x.v[j] = x.v[j] * ALPHA;
        st_row(F.XM() + (size_t)r * D, F.lane, x); }
}
__device__ __forceinline__ Frame make_frame(unsigned char* lds_, unsigned char* ws, float* out) {
    Frame F; F.lds = (LAS unsigned char*)lds_; F.MISC = (volatile LAS unsigned*)(F.lds + MISC_OFF);
    F.tid = opq_v((int)threadIdx.x); F.lane = F.tid & 63; F.wave = __builtin_amdgcn_readfirstlane(F.tid >> 6);
    F.G = opq_s((int)gridDim.x); { const int bx = opq_s((int)blockIdx.x); F.vcu = (F.G % 8 == 0) ? (bx % 8) * (F.G / 8) + bx / 8 : bx; }
    F.ws = opq(ws); F.out = opq(out); F.in.lds = F.lds; return F; }
#ifndef PHM
#define PHM 0xFF
#endif
#ifndef R_IN
#define R_IN 1
#endif
#ifndef R_LOC
#define R_LOC 1
#endif
#ifndef R_MRG
#define R_MRG 1
#endif
#ifndef R_OUT
#define R_OUT 1
#endif
#ifndef R_UP
#define R_UP 1
#endif
#ifndef R_ATT
#define R_ATT 0
#endif
#ifndef D_OUTU
#define D_OUTU 0
#endif
#ifndef D_CHAIN
#define D_CHAIN 0
#endif
#ifndef D_DFT
#define D_DFT 0
#endif
#ifndef D_QK
#define D_QK 0
#endif
#ifndef R_FIN0
#define R_FIN0 1
#endif
#ifndef R_PM0
#define R_PM0 1
#endif
#ifndef R_MDN
#define R_MDN 1
#endif
#ifndef X_BAR
#define X_BAR 0
#endif
#ifndef R_CONV
#define R_CONV 1
#endif
#ifndef R_PRO
#define R_PRO 1
#endif
#define MKF() Frame F = make_frame(lds, args.ws, args.out)
#define IN(k) (args.ph_lo <= (k) && (k) < args.ph_hi)
#define SEAM(k) do { if (IN(k) && IN((k) + 1)) { XcdBarrier bar_; bar_.bar = (unsigned*)((gu32*)(opq(args.ws) + WS_CTL) + CW_BAR) + args.li * XCD_BAR_WORDS; bar_.x = xb_xcc_id(); \
        bar_.st = (volatile LAS unsigned*)((LAS unsigned char*)lds + MISC_OFF) + 8; xcd_barrier(bar_); for (int xb_ = 0; xb_ < X_BAR; ++xb_) xcd_barrier(bar_); } PROF_TICK(k); } while (0)
#define xm (F.ws + WS_XM)
#define P_IM1 ((bf16*)(xm + XO_IM1))
#define P_FT ((bf16*)(xm + XO_FT))
#define MK_SP() ScanPtrs sp; sp.Cst = (bf16*)(xm + XO_MLC); sp.Gst = (bf16*)(xm + XO_GLS); sp.Nst = (float*)(F.ws + WS_SCAL + SC_MLN); sp.Amx = (float*)(F.ws + WS_SCAL + SC_MLA); sp.Bl = (float*)(F.ws + WS_SCAL + SC_MLB); sp.Mst = (float*)(F.ws + WS_SCAL + SC_MLM); sp.Gld = (float*)(F.ws + WS_SCAL + SC_GLD)

template <int l> __device__ __forceinline__ void layer_body(const Args& args, unsigned char* lds) {
        const int pb = PH_L0 + l * PH_PER_LAYER;
        if (IN(pb + 0)) {
#if DBG_LEVEL >= 3 && (PHM & 1)
            for (int rep = 0; rep < R_IN; ++rep) { SchedIn S; S.G = opq_s((int)gridDim.x); S.c = opq_s((int)blockIdx.x); S.ws = opq(args.ws);
            pg8::gemm_stream((LAS unsigned char*)lds, S); }
#endif
        }
        SEAM(pb + 0);
        if (IN(pb + 1)) {
#if DBG_LEVEL >= 3 && (PHM & 2)
            MKF(); MK_SP(); phase_qk(F, l); for (int rep = 0; rep < D_QK; ++rep) phase_qk(F, l, __builtin_amdgcn_readfirstlane(opq_v(1)) != 0);
            __syncthreads(); PROF_TICK(24);
            dft_load_mats(F);
            for (int u = F.vcu; u < 1024; u += F.G) dft_unit<1>(F, u >> 9, (u >> 2) & 127, u & 3, P_IM1, P_FT);
            for (int rep = 0; rep < D_DFT; ++rep) for (int u = F.vcu; u < 1024; u += F.G) dft_unit<1>(F, u >> 9, (u >> 2) & 127, u & 3, P_IM1, P_FT, __builtin_amdgcn_readfirstlane(opq_v(1)) != 0);
            __syncthreads(); PROF_TICK(25);
            {
                volatile LAS int* qs = (volatile LAS int*)(F.lds + MISC_OFF + 96); unsigned* qh = (unsigned*)(F.ctl() + CW_QUEUE + (l * 2 + 0) * 64);
                if (F.tid == 0) { qs[2] = (int)__hip_atomic_fetch_add(qh, 1u, RLX_AGENT); qs[3] = (int)__hip_atomic_fetch_add(qh, 1u, RLX_AGENT); }
                __syncthreads();
                UnitId id, idn; ScanRegs RA, RB; int u = qs[2], un = qs[3]; bool ok = unit_decode_q(u, l, false, id), okn = unit_decode_q(un, l, false, idn); int par = 0;
                if (ok) scan_fetch<false>(F, l, id, sp, RA);
                while (ok) {
                    if (okn) scan_fetch<false>(F, l, idn, sp, RB);
                    if (F.tid == 0) qs[par] = (int)__hip_atomic_fetch_add(qh, 1u, RLX_AGENT);
                    if (id.fam == 0) scan_local_unit<true>(F, l, id.b, id.head, id.tc, sp, RA); else scan_local_unit<false>(F, l, id.b, id.head, id.tc, sp, RA);
                    const int u2 = qs[par]; par ^= 1;
                    RA = RB; id = idn; ok = okn; okn = unit_decode_q(u2, l, false, idn); }
            }
            __syncthreads(); PROF_TICK(26);
#endif
        }
        SEAM(pb + 1);
        if (IN(pb + 2)) {
#if DBG_LEVEL >= 3 && (PHM & 4)
            MKF(); MK_SP(); const bool split = F.G >= 256; const int nsc = split ? 128 : F.G;
            if (F.vcu < nsc) for (int rep = 0; rep <= D_CHAIN; ++rep) for (int cq = F.vcu; cq < 128; cq += nsc) { const bool dry = __builtin_amdgcn_readfirstlane(opq_v(rep)) != 0; const int c = cq >> 2, qt = cq & 3;
                if (c < 16) scan_chain<true>(F, c, qt, sp, dry); else scan_chain<false>(F, c - 16, qt, sp, dry); }
            if (F.vcu < nsc) {
                asm volatile("s_waitcnt vmcnt(0)" ::: "memory"); __syncthreads();
                if (F.tid == 0) { unsigned nj = 0u; for (int cq = F.vcu; cq < 128; cq += nsc) ++nj; __builtin_amdgcn_fence(__ATOMIC_RELEASE, "agent"); asm volatile("s_waitcnt vmcnt(0)" ::: "memory");
                    (void)xb_add((unsigned*)(F.ctl() + CW_QUEUE + (4 + l) * 64), nj); } }
            PROF_TICK(27);
            if (!split || F.vcu >= nsc) { const int widx = split ? F.vcu - nsc : F.vcu, nw = split ? F.G - nsc : F.G;
                dft_load_mats(F);
                for (int rep = 0; rep <= D_DFT; ++rep) for (int u = widx; u < 1024; u += nw) dft_unit<2>(F, u >> 9, (u >> 2) & 127, u & 3, P_IM1, P_FT, __builtin_amdgcn_readfirstlane(opq_v(rep)) != 0);
                PROF_TICK(28); if (l == 0) ctx_dft(F, P_FT, widx, nw); PROF_TICK(29); }
            __syncthreads();
#endif
        }
        PROF_TICK(pb + 2);
        if (IN(pb + 3)) {
#if DBG_LEVEL >= 3 && (PHM & 24)
#if (PHM & 8)
            {   MKF(); typedef attn_body::bf16 abf; abf* Pb = (abf*)F.P();
                const float MB = fminf(C2Q * 64.f * wave_max(fabsf(F.in[I_GQQG][l * 64 + F.lane])) * wave_max(fabsf(F.in[I_GQKG][l * 64 + F.lane])), 40.f);
                for (int i = 0;; ++i) { const int U = i * F.G + F.vcu; if (U >= 1024) break;
                    const int combo = (U >> 6) & 3, hg = (U >> 8) & 3, qb = U & 63, b = combo >> 1, kvh = combo & 1, h = kvh * 4 + hg;
                    abf* q = Pb + (size_t)(b * T + qb * 256) * NP + TC_GQQ + h * 64; const abf* kl = Pb + (size_t)(b * T) * NP + TC_GQK + kvh * 64; const abf* kc = Pb + (size_t)(RL + b * CTX) * NP + TC_GQK + kvh * 64;
                    attn_body::attn_unit<8>(q, kl, kl + (TC_GQV - TC_GQK), kc, kc + (TC_GQV - TC_GQK), 256, 260, q, (char*)lds, MB, F.in[I_GQQG] + l * 64, (const float*)(F.ws + WS_ROPE_C), (const float*)(F.ws + WS_ROPE_S), qb * 256); }
                for (int rep = 0; rep < R_ATT; ++rep)
                for (int i = 0;; ++i) { const int U = i * F.G + F.vcu; if (U >= 1024) break;
                    const int combo = (U >> 6) & 3, hg = (U >> 8) & 3, qb = U & 63, b = combo >> 1, kvh = combo & 1, h = kvh * 4 + hg;
                    abf* q = Pb + (size_t)(b * T + qb * 256) * NP + TC_MLQ + (h & 3) * 64; const abf* kl = Pb + (size_t)(b * T) * NP + TC_GQK + kvh * 64; const abf* kc = Pb + (size_t)(RL + b * CTX) * NP + TC_GQK + kvh * 64;
                    attn_body::attn_unit<8>(q, kl, kl + (TC_GQV - TC_GQK), kc, kc + (TC_GQV - TC_GQK), 256, 260, Pb + (size_t)(b * T + qb * 256) * NP + TC_FT + (h & 3) * 64, (char*)lds, MB, F.in[I_GQQG] + l * 64, (const float*)(F.ws + WS_ROPE_C), (const float*)(F.ws + WS_ROPE_S), qb * 256); }
                if (l == 0 && F.vcu < 16) { const int b = F.vcu >> 3, h = F.vcu & 7, kvh = h >> 2;
                    abf* q = Pb + (size_t)(RL + b * CTX) * NP + TC_GQQ + h * 64; const abf* kc = Pb + (size_t)(RL + b * CTX) * NP + TC_GQK + kvh * 64;
                    attn_body::attn_unit<8>(q, kc, kc + (TC_GQV - TC_GQK), kc, kc + (TC_GQV - TC_GQK), 4, 4, q, (char*)lds, MB, F.in[I_GQQG] + l * 64, (const float*)(F.ws + WS_ROPE_C), (const float*)(F.ws + WS_ROPE_S), -1); }
            }
#endif
            __syncthreads(); PROF_TICK(31);
#if (PHM & 16)
            {   MKF(); MK_SP();
                {
                    const bool dry = false;
                    if (F.tid == 0) { unsigned* cc_ = (unsigned*)(F.ctl() + CW_QUEUE + (4 + l) * 64); unsigned* bar_ = (unsigned*)((gu32*)(F.ws + WS_CTL) + CW_BAR) + args.li * XCD_BAR_WORDS;
                        XB_SPIN(xb_ld(cc_) < 128u, bar_); __builtin_amdgcn_fence(__ATOMIC_ACQUIRE, "agent"); asm volatile("s_waitcnt vmcnt(0)" ::: "memory"); }
                    __syncthreads();
                    volatile LAS int* qs = (volatile LAS int*)(F.lds + MISC_OFF + 96); unsigned* qh = (unsigned*)(F.ctl() + CW_QUEUE + (l * 2 + 1) * 64);
                    if (F.tid == 0) { qs[2] = (int)__hip_atomic_fetch_add(qh, 1u, RLX_AGENT); qs[3] = (int)__hip_atomic_fetch_add(qh, 1u, RLX_AGENT); }
                    __syncthreads();
                    UnitId id, idn; ScanRegs RA, RB; int u = qs[2], un = qs[3]; bool ok = unit_decode_q(u, l, true, id), okn = unit_decode_q(un, l, true, idn); int par = 0;
                    if (ok) scan_fetch<true>(F, l, id, sp, RA);
                    while (ok) {
                        if (okn) scan_fetch<true>(F, l, idn, sp, RB);
                        if (F.tid == 0) qs[par] = (int)__hip_atomic_fetch_add(qh, 1u, RLX_AGENT);
                        if (id.fam == 0) scan_out_unit<true>(F, l, id.b, id.head, id.tc, sp, RA, dry); else scan_out_unit<false>(F, l, id.b, id.head, id.tc, sp, RA, dry);
                        const int u2 = qs[par]; par ^= 1;
                        RA = RB; id = idn; ok = okn; okn = unit_decode_q(u2, l, true, idn); }
                }
            }
#endif
#endif
        }
        SEAM(pb + 3);
        if (IN(pb + 4)) {
#if DBG_LEVEL >= 3 && (PHM & 32)
            for (int rep = 0; rep < R_MRG; ++rep) { SchedMerge S; S.G = opq_s((int)gridDim.x); S.c = opq_s((int)blockIdx.x); S.npan = (l == 0) ? NPAN : NPAN_L; S.ws = opq(args.ws); S.bgate = args.in[I_BGATE] + (size_t)l * 4096;
            pg8::gemm_stream((LAS unsigned char*)lds, S); }
#endif
        }
        SEAM(pb + 4);
        if (IN(pb + 5)) {
#if DBG_LEVEL >= 3 && (PHM & 64)
            SchedOut S; S.G = opq_s((int)gridDim.x); S.c = opq_s((int)blockIdx.x); S.npan = (l == 0) ? NPAN : NPAN_L; S.l = l; S.ws = opq(args.ws); S.xlat = (l == 0) ? args.in[I_X] : args.out; S.xctx = (l == 0) ? args.in[I_CTX] : (const float*)(args.ws + WS_XC);
            if (l == 0) { MKF(); build_ctx_panels(F); }
            for (int rep = 0; rep < R_OUT; ++rep) pg8::gemm_stream((LAS unsigned char*)lds, S);
#else
            MKF(); phase_scale_rows(F, l, true);
#endif
        }
        SEAM(pb + 5);
        if (IN(pb + 6)) { MKF();
#if DBG_LEVEL >= 3 && (PHM & 64)
            phase_post_mix(F, l, l == 0 ? R : RL, (const float*)(F.ws + WS_P)); if (l == 0) for (int rep = 1; rep < R_PM0; ++rep) phase_post_mix(F, l, R, (const float*)(F.ws + WS_P));
#else
            phase_post_mix(F, l, l == 0 ? R : RL, F.XM());
#endif
        }
        if (l == 1) SEAM(pb + 6);
        if (IN(pb + 7)) { if (l == 1) { MKF(); phase_moe_assign(F); } }
        SEAM(pb + 7);
        if (IN(pb + 8)) {
#if DBG_LEVEL >= 2
            for (int rep = 0; rep < R_UP; ++rep) {
            if (l == 0) { SchedUp S; S.G = opq_s((int)gridDim.x); S.c = opq_s((int)blockIdx.x); S.ws = opq(args.ws); pg8::gemm_stream((LAS unsigned char*)lds, S); }
            else { SchedMoeUp S; S.G = opq_s((int)gridDim.x); S.c = opq_s((int)blockIdx.x); S.mt.ws = opq(args.ws); S.mt.lds = (LAS unsigned char*)lds; S.nt_ = *(const volatile int*)S.mt.ntiles();
                for (int t_ = threadIdx.x; t_ < MOE_MAXT; t_ += 512) ((LAS int*)((LAS unsigned char*)lds + TILE_E_OFF))[t_] = ((const GAS int*)S.mt.tile_e())[t_]; __syncthreads(); pg8::gemm_stream((LAS unsigned char*)lds, S); } }
#endif
        }
        SEAM(pb + 8);
        if (IN(pb + 9)) {
#if DBG_LEVEL >= 2
            if (l == 0) { SchedDown S; S.G = opq_s((int)gridDim.x); S.c = opq_s((int)blockIdx.x); S.l = 0; S.ws = opq(args.ws); pg8::gemm_stream((LAS unsigned char*)lds, S); }
            else { SchedMoeDown S; S.G = opq_s((int)gridDim.x); S.c = opq_s((int)blockIdx.x); S.mt.ws = opq(args.ws); S.mt.lds = (LAS unsigned char*)lds; S.Dst = (bf16*)args.out; S.nt_ = *(const volatile int*)S.mt.ntiles();
                for (int t_ = threadIdx.x; t_ < MOE_MAXT; t_ += 512) ((LAS int*)((LAS unsigned char*)lds + TILE_E_OFF))[t_] = ((const GAS int*)S.mt.tile_e())[t_]; __syncthreads(); for (int rep = 0; rep < R_MDN; ++rep) pg8::gemm_stream((LAS unsigned char*)lds, S); }
#else
            MKF();
            if (l == 0) phase_scale_rows(F, l, false);
            else { for (size_t i = (size_t)F.vcu * 512 + F.tid; i < (size_t)RL * D / 4; i += (size_t)F.G * 512) ((v4u*)F.out)[i] = (v4u){0u, 0u, 0u, 0u}; }
#endif
        }
        SEAM(pb + 9);
        if (IN(pb + 10)) { MKF(); phase_final(F, l); if (l == 0) for (int rep = 1; rep < R_FIN0; ++rep) phase_final(F, l); __syncthreads(); PROF_TICK(28); if (l == 0) { for (int rep = 0; rep < R_CONV; ++rep) convert_layer_weights(F, 1); } }
        if (l == 0) SEAM(pb + 10);
    }
__global__ void __launch_bounds__(NWAVES * 64, 2) mega_fwd(Args args) {
    extern __shared__ __attribute__((aligned(16))) unsigned char lds[];
    {   LAS unsigned char* L = (LAS unsigned char*)lds; const int tid = threadIdx.x;
        for (int u = tid; u < (LDS_BYTES - LDSCTL_OFF) / 4; u += NWAVES * 64) ((LAS unsigned*)(L + LDSCTL_OFF))[u] = 0u;
        __syncthreads();
        if (tid == 0) {
#pragma unroll
            for (int i = 0; i < 30; ++i) *(LAS unsigned long long*)(L + INTAB_OFF + 8 * i) = (unsigned long long)args.in[i]; }
        __syncthreads();
        if (PROF_MASK != 0u && blockIdx.x == PROF_WG && tid == 0) { volatile LAS unsigned long long* pw_ = (volatile LAS unsigned long long*)(L + MISC_OFF + 64); pw_[0] = __builtin_amdgcn_s_memrealtime(); pw_[1] = 0ull; }
        (void)xcd_barrier_post((unsigned*)((gu32*)(args.ws + WS_CTL) + CW_BAR) + args.li * XCD_BAR_WORDS, (volatile LAS unsigned*)(L + MISC_OFF) + 8);
    }
    if (IN(0)) { MKF(); for (int rep = 0; rep < R_PRO; ++rep) { build_tables(F); convert_layer_weights(F, 0); __syncthreads(); PROF_TICK(27); ada_phase(F); } }
    SEAM(0);
    if (IN(1)) { MKF(); for (int rep = 0; rep < R_PRO; ++rep) phase_ln_mod(F, 0); }
    SEAM(1);
    layer_body<0>(args, lds);
    layer_body<1>(args, lds);
    PROF_TICK(N_PHASES - 1);
    if (PROF_MASK != 0u && blockIdx.x == PROF_WG && threadIdx.x == 0) { volatile LAS unsigned long long* pw_ = (volatile LAS unsigned long long*)((LAS unsigned char*)lds + MISC_OFF + 64);
        const unsigned long long t0_ = pw_[0], w_ = 4ull * pw_[1]; while (__builtin_amdgcn_s_memrealtime() - t0_ < w_) __builtin_amdgcn_s_sleep(8); }
}
#undef IN
#undef SEAM


extern "C" void kernel_launch(void* const* d_in, const int* in_sizes, int n_in, void* d_out, int out_size, void* d_ws, size_t ws_size, hipStream_t stream) {
    static int grid = 0;
    if (grid == 0) {
        if (n_in != 30 || out_size != RL * D || ws_size < WS_END) { fprintf(stderr, "kernel_launch: unexpected problem (n_in %d out %d ws %zu)\n", n_in, out_size, ws_size); grid = -1; return; }
        int dev = 0, cus = 0;
        if (hipGetDevice(&dev) != hipSuccess || hipDeviceGetAttribute(&cus, hipDeviceAttributeMultiprocessorCount, dev) != hipSuccess) { grid = -1; return; }
        if (hipFuncSetAttribute((const void*)mega_fwd, hipFuncAttributeMaxDynamicSharedMemorySize, LDS_BYTES) != hipSuccess) { fprintf(stderr, "kernel_launch: hipFuncSetAttribute failed\n"); grid = -1; return; }
        int per_cu = 0; (void)hipOccupancyMaxActiveBlocksPerMultiprocessor(&per_cu, (const void*)mega_fwd, NWAVES * 64, LDS_BYTES); (void)hipGetLastError();
        grid = cus;
        if (per_cu < 1) fprintf(stderr, "kernel_launch: occupancy query says %d\n", per_cu);
    }
    if (grid < 0) return;
    if (hipMemsetAsync((char*)d_ws + WS_CTL, 0, CTL_ZERO_BYTES, stream) != hipSuccess) return;
    Args a{};
    for (int i = 0; i < 30; ++i) a.in[i] = (const float*)d_in[i];
    a.out = (float*)d_out; a.ws = (unsigned char*)d_ws;
#if MK_N_LAUNCHES == 1
    a.ph_lo = 0; a.ph_hi = N_PHASES; a.li = 0;
    hipLaunchKernelGGL(mega_fwd, dim3(grid), dim3(NWAVES * 64), LDS_BYTES, stream, a);
#else
    for (int k = 0; k < N_PHASES; ++k) { a.ph_lo = k; a.ph_hi = k + 1; a.li = 0; hipLaunchKernelGGL(mega_fwd, dim3(grid), dim3(NWAVES * 64), LDS_BYTES, stream, a); }
#endif
}
```
